# Optimizing an MI355X kernel written in HIP

```python
import jax, jax.numpy as jnp
from jax import lax
import numpy as np

D_MODEL = 1024
BATCH = 4
SEQ = 8192
DEPTH = 2

HEAD_DIM = 64
NSA_HEADS = 8
NSA_KV_HEADS = 2
CMP_LEN = 32
CMP_STRIDE = 16
SEL_LEN = 64
SEL_TOPK = 16
NSA_WINDOW = 512
SWA_HEADS = 8
SWA_KV_HEADS = 2
SWA_WINDOW = 128
Q_BLOCK = 128
MLSTM_HEADS = 4
MLSTM_QK_DIM = 128
MLSTM_V_DIM = 256
MLSTM_CHUNK = 64
CONV_WIDTH = 4
FFN_HIDDEN = -(-8 * D_MODEL // (3 * 256)) * 256
RMS_EPS = 1e-6
NEG_INF = -1e30
FORCE_SCORE = 1e9

NSA_REP = NSA_HEADS // NSA_KV_HEADS
SWA_REP = SWA_HEADS // SWA_KV_HEADS
AB_SPLITS = (NSA_HEADS * HEAD_DIM,) + (NSA_KV_HEADS * HEAD_DIM,) * 6 + (NSA_HEADS * 3, SWA_HEADS * HEAD_DIM, SWA_KV_HEADS * HEAD_DIM, SWA_KV_HEADS * HEAD_DIM)
AB_IN = sum(AB_SPLITS)
AB_MIX = (NSA_HEADS + SWA_HEADS) * HEAD_DIM
C_SPLITS = (2 * MLSTM_HEADS * MLSTM_QK_DIM, MLSTM_HEADS * MLSTM_V_DIM, MLSTM_HEADS * MLSTM_V_DIM, MLSTM_HEADS, MLSTM_HEADS)
C_IN = sum(C_SPLITS)
C_MIX = MLSTM_HEADS * MLSTM_V_DIM

kernel_name = 'nsa_swasink_mlstm_hybrid'


def _split(z, sizes):
    idx = np.cumsum(np.array(sizes))[:-1].tolist()
    return jnp.split(z, idx, axis=-1)


def rmsnorm(x, g):
    xf = x.astype(jnp.float32)
    y = xf * lax.rsqrt(jnp.mean(xf * xf, axis=-1, keepdims=True) + RMS_EPS)
    return (y * g.astype(jnp.float32)).astype(x.dtype)


def swiglu(x, wg, wu, wd):
    return (jax.nn.silu(x @ wg) * (x @ wu)) @ wd


def masked_softmax(logits, mask):
    p = jax.nn.softmax(jnp.where(mask, logits, NEG_INF), axis=-1)
    return jnp.where(mask, p, 0.0)


def selection_map(seq):
    nc = (seq - CMP_LEN) // CMP_STRIDE + 1
    ns = seq // SEL_LEN
    cs = np.arange(nc, dtype=np.int32)[:, None] * CMP_STRIDE
    ss = np.arange(ns, dtype=np.int32)[None, :] * SEL_LEN
    return ((cs < ss + SEL_LEN) & (cs + CMP_LEN > ss)).astype(np.float32)


def compress_kv(kv, pos, w1, w2):
    b, t = kv.shape[:2]
    nc = (t - CMP_LEN) // CMP_STRIDE + 1
    idx = np.arange(nc, dtype=np.int32)[:, None] * CMP_STRIDE + np.arange(CMP_LEN, dtype=np.int32)[None, :]
    blk = kv[:, idx] + pos[None, None, :, None, :]
    blk = blk.transpose(0, 3, 1, 2, 4).reshape(b, kv.shape[2], nc, CMP_LEN * HEAD_DIM)
    return jax.nn.silu(blk @ w1) @ w2


def nsa_attention(q, kc, vc, ksel, vsel, kwin, vwin, gates):
    b, t = q.shape[:2]
    nc = kc.shape[2]
    nb = t // Q_BLOCK
    ns = t // SEL_LEN
    topk = min(SEL_TOPK, ns)
    scale = HEAD_DIM ** -0.5
    sel_map = jnp.asarray(selection_map(t))
    cmp_end = jnp.asarray(np.arange(nc, dtype=np.int32) * CMP_STRIDE + CMP_LEN - 1)
    ksb = ksel.reshape(b, ns, SEL_LEN, NSA_KV_HEADS, HEAD_DIM).transpose(0, 3, 1, 2, 4)
    vsb = vsel.reshape(b, ns, SEL_LEN, NSA_KV_HEADS, HEAD_DIM).transpose(0, 3, 1, 2, 4)
    pad = ((0, 0), (NSA_WINDOW, 0), (0, 0), (0, 0))
    kwp = jnp.pad(kwin, pad)
    vwp = jnp.pad(vwin, pad)
    span = NSA_WINDOW + Q_BLOCK
    gather = jax.vmap(jax.vmap(lambda kb, ix: kb[ix]))
    blocks = jnp.arange(ns, dtype=jnp.int32)

    def block(n):
        start = n * Q_BLOCK
        qb = lax.dynamic_slice_in_dim(q, start, Q_BLOCK, axis=1).transpose(0, 2, 3, 1, 4)
        gb = lax.dynamic_slice_in_dim(gates, start, Q_BLOCK, axis=1).transpose(0, 2, 3, 1, 4)
        tq = start + jnp.arange(Q_BLOCK, dtype=jnp.int32)
        s = jnp.einsum('bgrtd,bgcd->bgrtc', qb, kc).astype(jnp.float32) * scale
        p_c = masked_softmax(s, cmp_end[None, :] <= tq[:, None])
        o_c = jnp.einsum('bgrtc,bgcd->bgrtd', p_c.astype(vc.dtype), vc)
        imp = jnp.einsum('bgrtc,cs->bgts', p_c, sel_map)
        cur = tq // SEL_LEN
        valid = blocks[None, :] * SEL_LEN <= tq[:, None]
        forced = (blocks[None, :] == 0) | (blocks[None, :] == cur[:, None]) | (blocks[None, :] == cur[:, None] - 1)
        score = jnp.where(forced, FORCE_SCORE, jnp.where(valid, imp, NEG_INF))
        top_s, top_i = lax.top_k(score, topk)
        kg = gather(ksb, top_i)
        vg = gather(vsb, top_i)
        kpos = top_i[..., None] * SEL_LEN + jnp.arange(SEL_LEN, dtype=jnp.int32)
        m_s = (top_s > NEG_INF * 0.5)[..., None] & (kpos <= tq[:, None, None])
        m_s = m_s.reshape(b, NSA_KV_HEADS, 1, Q_BLOCK, topk * SEL_LEN)
        s = jnp.einsum('bgrtd,bgtkjd->bgrtkj', qb, kg).astype(jnp.float32) * scale
        p_s = masked_softmax(s.reshape(b, NSA_KV_HEADS, NSA_REP, Q_BLOCK, topk * SEL_LEN), m_s)
        o_s = jnp.einsum('bgrtm,bgtmd->bgrtd', p_s.astype(vg.dtype), vg.reshape(b, NSA_KV_HEADS, Q_BLOCK, topk * SEL_LEN, HEAD_DIM))
        kw = lax.dynamic_slice_in_dim(kwp, start, span, axis=1)
        vw = lax.dynamic_slice_in_dim(vwp, start, span, axis=1)
        sp = start - NSA_WINDOW + jnp.arange(span, dtype=jnp.int32)
        m_w = (sp[None, :] >= 0) & (sp[None, :] <= tq[:, None]) & (tq[:, None] - sp[None, :] < NSA_WINDOW)
        s = jnp.einsum('bgrtd,bsgd->bgrts', qb, kw).astype(jnp.float32) * scale
        p_w = masked_softmax(s, m_w)
        o_w = jnp.einsum('bgrts,bsgd->bgrtd', p_w.astype(vw.dtype), vw)
        o = gb[..., 0:1] * o_c + gb[..., 1:2] * o_s + gb[..., 2:3] * o_w
        return o.transpose(0, 3, 1, 2, 4).reshape(b, Q_BLOCK, NSA_HEADS * HEAD_DIM)

    out = lax.map(block, jnp.arange(nb, dtype=jnp.int32))
    return out.transpose(1, 0, 2, 3).reshape(b, t, NSA_HEADS * HEAD_DIM)


def swa_sink_attention(q, k, v, sinks):
    b, t = q.shape[:2]
    nb = t // Q_BLOCK
    span = SWA_WINDOW + Q_BLOCK
    scale = HEAD_DIM ** -0.5
    pad = ((0, 0), (SWA_WINDOW, 0), (0, 0), (0, 0))
    kp = jnp.pad(k, pad)
    vp = jnp.pad(v, pad)
    sink = sinks.astype(jnp.float32).reshape(1, SWA_KV_HEADS, SWA_REP, 1, 1)

    def block(n):
        start = n * Q_BLOCK
        qb = lax.dynamic_slice_in_dim(q, start, Q_BLOCK, axis=1).transpose(0, 2, 3, 1, 4)
        kb = lax.dynamic_slice_in_dim(kp, start, span, axis=1)
        vb = lax.dynamic_slice_in_dim(vp, start, span, axis=1)
        tq = start + jnp.arange(Q_BLOCK, dtype=jnp.int32)
        sp = start - SWA_WINDOW + jnp.arange(span, dtype=jnp.int32)
        mask = (sp[None, :] >= 0) & (sp[None, :] <= tq[:, None]) & (tq[:, None] - sp[None, :] < SWA_WINDOW)
        logits = jnp.where(mask, jnp.einsum('bgrtd,bsgd->bgrts', qb, kb).astype(jnp.float32) * scale, NEG_INF)
        mx = jnp.maximum(logits.max(axis=-1, keepdims=True), sink)
        e = jnp.exp(logits - mx)
        p = e / (e.sum(axis=-1, keepdims=True) + jnp.exp(sink - mx))
        o = jnp.einsum('bgrts,bsgd->bgrtd', p.astype(vb.dtype), vb)
        return o.transpose(0, 3, 1, 2, 4).reshape(b, Q_BLOCK, SWA_HEADS * HEAD_DIM)

    out = lax.map(block, jnp.arange(nb, dtype=jnp.int32))
    return out.transpose(1, 0, 2, 3).reshape(b, t, SWA_HEADS * HEAD_DIM)


def nsa_swa_mixer(h, w_in, gate_bias, pos_k, pos_v, ck_w1, ck_w2, cv_w1, cv_w2, sinks, w_out):
    b, t, _ = h.shape
    qa, kc, vc, ks, vs, kw, vw, g, qb, kb, vb = _split(h @ w_in, AB_SPLITS)
    kv = lambda a: a.reshape(b, t, NSA_KV_HEADS, HEAD_DIM)
    qa = qa.reshape(b, t, NSA_KV_HEADS, NSA_REP, HEAD_DIM)
    kc = compress_kv(kv(kc), pos_k, ck_w1, ck_w2)
    vc = compress_kv(kv(vc), pos_v, cv_w1, cv_w2)
    gates = jax.nn.sigmoid(g + gate_bias).reshape(b, t, NSA_KV_HEADS, NSA_REP, 3)
    o_a = nsa_attention(qa, kc, vc, kv(ks), kv(vs), kv(kw), kv(vw), gates)
    qb = qb.reshape(b, t, SWA_KV_HEADS, SWA_REP, HEAD_DIM)
    kb = kb.reshape(b, t, SWA_KV_HEADS, HEAD_DIM)
    vb = vb.reshape(b, t, SWA_KV_HEADS, HEAD_DIM)
    o_b = swa_sink_attention(qb, kb, vb, sinks)
    return jnp.concatenate([o_a, o_b], axis=-1) @ w_out


def causal_depthwise_conv(x, w, bias):
    ch = x.shape[-1]
    y = lax.conv_general_dilated(x, w[:, None, :].astype(x.dtype), window_strides=(1,), padding=((CONV_WIDTH - 1, 0),), dimension_numbers=('NWC', 'WIO', 'NWC'), feature_group_count=ch)
    return y + bias


def mlstm_chunkwise(q, k, v, logi, logf):
    b, nh, t, dk = q.shape
    dv = v.shape[-1]
    L = MLSTM_CHUNK
    nc = t // L

    def chunks(a):
        return jnp.moveaxis(a.reshape(a.shape[:2] + (nc, L) + a.shape[3:]), 2, 0)

    causal = jnp.tril(jnp.ones((L, L), dtype=bool))

    def step(carry, inp):
        C, n, m = carry
        qc, kc, vc, ic, fc = inp
        bcum = jnp.cumsum(fc, axis=-1)
        a = bcum + m[..., None]
        D = jnp.where(causal, bcum[..., :, None] - bcum[..., None, :] + ic[..., None, :], -jnp.inf)
        mt = jnp.maximum(a, D.max(axis=-1))
        w_inter = jnp.exp(a - mt)
        S = jnp.einsum('bhtd,bhsd->bhts', qc, kc) * jnp.exp(D - mt[..., None])
        num = w_inter[..., None] * jnp.einsum('bhtd,bhdv->bhtv', qc, C) + jnp.einsum('bhts,bhsv->bhtv', S, vc)
        den = w_inter * jnp.einsum('bhtd,bhd->bht', qc, n) + S.sum(axis=-1)
        hc = num / jnp.maximum(jnp.abs(den), jnp.exp(-mt))[..., None]
        bl = bcum[..., -1]
        wl = bl[..., None] - bcum + ic
        m_new = jnp.maximum(bl + m, wl.max(axis=-1))
        decay = jnp.exp(bl + m - m_new)
        w = jnp.exp(wl - m_new[..., None])
        C_new = decay[..., None, None] * C + jnp.einsum('bhs,bhsd,bhsv->bhdv', w, kc, vc)
        n_new = decay[..., None] * n + jnp.einsum('bhs,bhsd->bhd', w, kc)
        return (C_new, n_new, m_new), hc

    init = (jnp.zeros((b, nh, dk, dv), jnp.float32), jnp.zeros((b, nh, dk), jnp.float32), jnp.zeros((b, nh), jnp.float32))
    _, hs = lax.scan(step, init, (chunks(q), chunks(k), chunks(v), chunks(logi), chunks(logf)))
    return jnp.moveaxis(hs, 0, 2).reshape(b, nh, t, dv)


def mlstm_mixer(h, w_in, conv_w, conv_b, igate_bias, fgate_bias, w_out):
    b, t, _ = h.shape
    qk, v, og, ig, fg = _split(h @ w_in, C_SPLITS)
    qk = jax.nn.silu(causal_depthwise_conv(qk, conv_w, conv_b))
    q, k = jnp.split(qk, 2, axis=-1)

    def heads(a, d):
        return a.reshape(b, t, MLSTM_HEADS, d).transpose(0, 2, 1, 3).astype(jnp.float32)

    q = heads(q, MLSTM_QK_DIM)
    k = heads(k, MLSTM_QK_DIM) * (MLSTM_QK_DIM ** -0.5)
    v = heads(v, MLSTM_V_DIM)
    logi = (ig + igate_bias).astype(jnp.float32).transpose(0, 2, 1)
    logf = jax.nn.log_sigmoid((fg + fgate_bias).astype(jnp.float32)).transpose(0, 2, 1)
    hh = mlstm_chunkwise(q, k, v, logi, logf)
    hh = hh.transpose(0, 2, 1, 3).reshape(b, t, C_MIX).astype(h.dtype) * jax.nn.sigmoid(og)
    return hh @ w_out


def setup_inputs(seed: int = 0) -> dict:
    key = jax.random.key(seed)
    ks = jax.random.split(key, 24)
    ne = (DEPTH + 1) // 2
    no = DEPTH // 2

    def nrm(k, shape, scale):
        return jax.random.normal(k, shape, jnp.float32) * scale

    qk_ch = 2 * MLSTM_HEADS * MLSTM_QK_DIM
    return {
        'x': nrm(ks[0], (BATCH, SEQ, D_MODEL), 1.0),
        'norm_mix': 1.0 + nrm(ks[1], (DEPTH, D_MODEL), 0.02),
        'norm_ffn': 1.0 + nrm(ks[2], (DEPTH, D_MODEL), 0.02),
        'ffn_w_gate': nrm(ks[3], (DEPTH, D_MODEL, FFN_HIDDEN), D_MODEL ** -0.5),
        'ffn_w_up': nrm(ks[4], (DEPTH, D_MODEL, FFN_HIDDEN), D_MODEL ** -0.5),
        'ffn_w_down': nrm(ks[5], (DEPTH, FFN_HIDDEN, D_MODEL), FFN_HIDDEN ** -0.5),
        'ab_w_in': nrm(ks[6], (ne, D_MODEL, AB_IN), D_MODEL ** -0.5),
        'ab_gate_bias': nrm(ks[7], (ne, NSA_HEADS * 3), 0.1),
        'nsa_pos_k': nrm(ks[8], (ne, CMP_LEN, HEAD_DIM), 0.1),
        'nsa_pos_v': nrm(ks[9], (ne, CMP_LEN, HEAD_DIM), 0.1),
        'nsa_cmp_k_w1': nrm(ks[10], (ne, CMP_LEN * HEAD_DIM, HEAD_DIM), (CMP_LEN * HEAD_DIM) ** -0.5),
        'nsa_cmp_k_w2': nrm(ks[11], (ne, HEAD_DIM, HEAD_DIM), HEAD_DIM ** -0.5),
        'nsa_cmp_v_w1': nrm(ks[12], (ne, CMP_LEN * HEAD_DIM, HEAD_DIM), (CMP_LEN * HEAD_DIM) ** -0.5),
        'nsa_cmp_v_w2': nrm(ks[13], (ne, HEAD_DIM, HEAD_DIM), HEAD_DIM ** -0.5),
        'swa_sinks': nrm(ks[14], (ne, SWA_HEADS), 0.5),
        'ab_w_out': nrm(ks[15], (ne, AB_MIX, D_MODEL), AB_MIX ** -0.5),
        'c_w_in': nrm(ks[16], (no, D_MODEL, C_IN), D_MODEL ** -0.5),
        'c_conv_w': nrm(ks[17], (no, CONV_WIDTH, qk_ch), CONV_WIDTH ** -0.5),
        'c_conv_b': nrm(ks[18], (no, qk_ch), 0.02),
        'c_igate_bias': nrm(ks[19], (no, MLSTM_HEADS), 0.1),
        'c_fgate_bias': jnp.linspace(3.0, 6.0, MLSTM_HEADS, dtype=jnp.float32)[None, :] + nrm(ks[20], (no, MLSTM_HEADS), 0.1),
        'c_w_out': nrm(ks[21], (no, C_MIX, D_MODEL), C_MIX ** -0.5),
        'final_norm': 1.0 + nrm(ks[22], (D_MODEL,), 0.02),
    }


def reference(x, norm_mix, norm_ffn, ffn_w_gate, ffn_w_up, ffn_w_down, ab_w_in, ab_gate_bias, nsa_pos_k, nsa_pos_v, nsa_cmp_k_w1, nsa_cmp_k_w2, nsa_cmp_v_w1, nsa_cmp_v_w2, swa_sinks, ab_w_out, c_w_in, c_conv_w, c_conv_b, c_igate_bias, c_fgate_bias, c_w_out, final_norm):
    h = x
    for layer in range(DEPTH):
        j = layer // 2
        hn = rmsnorm(h, norm_mix[layer])
        if layer % 2 == 0:
            h = h + nsa_swa_mixer(hn, ab_w_in[j], ab_gate_bias[j], nsa_pos_k[j], nsa_pos_v[j], nsa_cmp_k_w1[j], nsa_cmp_k_w2[j], nsa_cmp_v_w1[j], nsa_cmp_v_w2[j], swa_sinks[j], ab_w_out[j])
        else:
            h = h + mlstm_mixer(hn, c_w_in[j], c_conv_w[j], c_conv_b[j], c_igate_bias[j], c_fgate_bias[j], c_w_out[j])
        h = h + swiglu(rmsnorm(h, norm_ffn[layer]), ffn_w_gate[layer], ffn_w_up[layer], ffn_w_down[layer])
    return rmsnorm(h, final_norm)
```

```cpp
#include <hip/hip_runtime.h>
#include <cstdio>
#include <cstdint>
#include <cmath>
namespace pg8 {
#define PG8_LAS __attribute__((address_space(3)))
typedef unsigned short bf16_t;
typedef short bf16x8 __attribute__((ext_vector_type(8)));
typedef float f32x4 __attribute__((ext_vector_type(4)));
typedef unsigned u32x4 __attribute__((ext_vector_type(4)));
constexpr int BM = 256, BK = 64, HALF = 128, HTB = HALF * BK * 2  , STAGE_BYTES = 8 * HTB, NXCD = 8, WGM = 8;

__host__ __device__ __forceinline__ int lds_byte(int r, int c) { const int st = (r >> 4) * 2 + (c >> 5), rr = r & 15, cc = c & 31, ob = rr * 64 + cc * 2; return st * 1024 + (ob ^ (((ob >> 9) & 1) << 5)); }
__host__ __device__ __forceinline__ void stage_rc(int b, int& R, int& C) { const int st = b / 1024, sb = b % 1024, swz = sb ^ (((sb >> 9) & 1) << 5); R = (st >> 1) * 16 + swz / 64; C = (st & 1) * 32 + (swz % 64) / 2; }
__host__ __device__ __forceinline__ int perm32(int rho) { const int n = rho >> 4, i = rho & 15; return 8 * (i >> 2) + 4 * n + (i & 3); }

struct Unit { int pm, pn; };
struct Gemm { const bf16_t* A; const bf16_t* Bt; int M, N, K; };

struct StaticOrder {
    int nM, nN, nwg, G, c;
    __host__ __device__ void init(int M, int N, int G_, int c_) { nM = M / BM; nN = N / BM; nwg = nM * nN; G = G_; c = c_; }
    __host__ __device__ bool next(int i, Unit& u) const {
        const long L = (long)i * G + c; if (L >= nwg) return false;
        int wgid = (int)L; { const int q = nwg / NXCD, r = nwg % NXCD, xcd = wgid % NXCD, off = wgid / NXCD; wgid = (xcd < r ? xcd * (q + 1) : r * (q + 1) + (xcd - r) * q) + off; }
        const int nig = WGM * nN, gid = wgid / nig, fm = gid * WGM, gsz = (nM - fm) < WGM ? (nM - fm) : WGM;
        u.pm = fm + ((wgid % nig) % gsz); u.pn = (wgid % nig) / gsz; return true;
    }
    __device__ __forceinline__ void a_ready(const Unit&) const {}
    __device__ __forceinline__ void done(const Unit&) const {}
};

__device__ __forceinline__ unsigned cvt_pk_bf16(float lo, float hi) { unsigned r; asm volatile("v_cvt_pk_bf16_f32 %0, %1, %2" : "=v"(r) : "v"(lo), "v"(hi)); return r; }
typedef float f32x2 __attribute__((ext_vector_type(2)));
constexpr int MROWS = 32768;
constexpr float RMS_EPS_F = 1e-6f;
struct RowScale { const float* rs; const float* psum; };
__device__ __forceinline__ float row_scale(const RowScale& R, int row) {
    if (R.psum) { float s = 0.f;
#pragma unroll
        for (int j = 0; j < 16; ++j) s += R.psum[(size_t)j * MROWS + row];
        return 1.0f / sqrtf(s * (1.0f / 1024.0f) + RMS_EPS_F); }
    return R.rs[row];
}
struct EpiScaleBf16 {
    static constexpr bool PERM = true, AFTER_DRAIN = false;
    bf16_t* O; int ldc; RowScale R; int split_cols; size_t split_stride;
    __device__ __forceinline__ void operator()(const f32x4 (&acc)[2][2][4][2], const Unit& u, int wr, int wc, int fr, int fq) const {
        const int row0 = u.pm * BM + wr * 64 + fr; int colt = u.pn * BM; bf16_t* base = O;
        if (split_cols) { const int t = colt / split_cols; base += (size_t)t * split_stride; colt -= t * split_cols; }
        const int col0 = colt + wc * 32 + 8 * fq;
#pragma unroll
        for (int ai = 0; ai < 2; ++ai)
#pragma unroll
            for (int m = 0; m < 4; ++m) { const int row = row0 + ai * HALF + m * 16; const float sc = row_scale(R, row); bf16_t* rowp = base + (size_t)row * ldc + col0;
#pragma unroll
                for (int bj = 0; bj < 2; ++bj) { f32x4 v0 = acc[ai][bj][m][0] * sc, v1 = acc[ai][bj][m][1] * sc;
                    u32x4 w; w.x = cvt_pk_bf16(v0[0], v0[1]); w.y = cvt_pk_bf16(v0[2], v0[3]); w.z = cvt_pk_bf16(v1[0], v1[1]); w.w = cvt_pk_bf16(v1[2], v1[3]);
                    *(u32x4*)(rowp + bj * HALF) = w; } }
    }
};
struct EpiSwiglu {
    static constexpr bool PERM = true, AFTER_DRAIN = false;
    bf16_t* O; int ldc; RowScale R;
    __device__ __forceinline__ void operator()(const f32x4 (&acc)[2][2][4][2], const Unit& u, int wr, int wc, int fr, int fq) const {
        const int row0 = u.pm * BM + wr * 64 + fr; const int col0 = u.pn * HALF + wc * 32 + 8 * fq;
#pragma unroll
        for (int ai = 0; ai < 2; ++ai)
#pragma unroll
            for (int m = 0; m < 4; ++m) { const int row = row0 + ai * HALF + m * 16; const float sc = row_scale(R, row); bf16_t* rowp = O + (size_t)row * ldc + col0;
                float o[8];
#pragma unroll
                for (int n = 0; n < 2; ++n)
#pragma unroll
                    for (int e = 0; e < 4; ++e) { const float g = acc[ai][0][m][n][e] * sc, up = acc[ai][1][m][n][e] * sc; o[n * 4 + e] = g * up / (1.0f + __expf(-g)); }
                u32x4 w; w.x = cvt_pk_bf16(o[0], o[1]); w.y = cvt_pk_bf16(o[2], o[3]); w.z = cvt_pk_bf16(o[4], o[5]); w.w = cvt_pk_bf16(o[6], o[7]);
                *(u32x4*)rowp = w; }
    }
};
struct EpiResid {
    static constexpr bool PERM = false, AFTER_DRAIN = false;
    const float* base; float* out; bf16_t* h16; float* psum; int ldc;
    __device__ __forceinline__ void operator()(const f32x4 (&acc)[2][2][4][2], const Unit& u, int wr, int wc, int fr, int fq) const {
        typedef unsigned u32x2v __attribute__((ext_vector_type(2)));
        const int row0 = u.pm * BM + wr * 64 + fr, col0 = u.pn * BM + wc * 32 + 4 * fq;
#pragma unroll
        for (int ai = 0; ai < 2; ++ai)
#pragma unroll
            for (int m = 0; m < 4; ++m) { const int row = row0 + ai * HALF + m * 16; const size_t off = (size_t)row * ldc + col0; float ss = 0.f;
#pragma unroll
                for (int bj = 0; bj < 2; ++bj)
#pragma unroll
                    for (int n = 0; n < 2; ++n) { const f32x4 bs = *(const f32x4*)(base + off + bj * HALF + n * 16); const f32x4 o = bs + acc[ai][bj][m][n];
                        *(f32x4*)(out + off + bj * HALF + n * 16) = o; ss += (o[0] * o[0] + o[1] * o[1]) + (o[2] * o[2] + o[3] * o[3]);
                        u32x2v w; w.x = cvt_pk_bf16(o[0], o[1]); w.y = cvt_pk_bf16(o[2], o[3]); *(u32x2v*)(h16 + off + bj * HALF + n * 16) = w; }
                ss += __shfl_xor(ss, 16); ss += __shfl_xor(ss, 32);
                if (fq == 0) psum[(size_t)(u.pn * 4 + wc) * MROWS + row] = ss; }
    }
};
template <class Epi, class Sched, bool ALIGN_EPI = false, bool SP2 = false>
__device__ __forceinline__ void gemm_phase(PG8_LAS unsigned char* lds, const Gemm g, const Sched& S, const Epi& E) {
    const int tid = threadIdx.x, wid = __builtin_amdgcn_readfirstlane(tid >> 6), lane = tid & 63, wr = wid >> 2, wc = wid & 3, fr = lane & 15, fq = lane >> 4;
    const int K = g.K, nt = K / BK;
    unsigned voffA[2], voffB[2];
#pragma unroll
    for (int i = 0; i < 2; ++i) { int R, C; stage_rc(tid * 16 + i * 8192, R, C); const int Rb = Epi::PERM ? ((R & ~31) + perm32(R & 31)) : R;
        voffA[i] = (unsigned)(R * K + C) * 2u; voffB[i] = (unsigned)(Rb * K + C) * 2u; }
    const size_t kstep = (size_t)(BK * 2);
    const size_t hstep = (size_t)HALF * K * 2;
    const size_t tstep = 2 * hstep;
    const unsigned ldsw = (unsigned)wid * 1024u;
    const int aoff = lds_byte(wr * 64 + fr, fq * 8), boff = lds_byte(wc * 32 + fr, fq * 8);
#define PG8_SA(b, h) (((b) * 2 + (h)) * HTB)
#define PG8_SB(b, h) ((4 + (b) * 2 + (h)) * HTB)
#define PG8_STAGE(bufoff, gbase, voff) do { _Pragma("unroll") for (int _i = 0; _i < 2; ++_i) \
        __builtin_amdgcn_global_load_lds((const unsigned*)((const char*)(gbase) + (voff)[_i]), (PG8_LAS unsigned*)(lds + (bufoff) + ldsw + _i * 8192), 16, 0, 0); } while (0)
#define PG8_LDA(dst, b, h) do { _Pragma("unroll") for (int m = 0; m < 4; ++m) _Pragma("unroll") for (int k = 0; k < 2; ++k) dst[m][k] = *(const PG8_LAS bf16x8*)(lds + PG8_SA(b, h) + aoff + m * 2048 + k * 1024); } while (0)
#define PG8_LDB(dst, b, h) do { _Pragma("unroll") for (int n = 0; n < 2; ++n) _Pragma("unroll") for (int k = 0; k < 2; ++k) dst[n][k] = *(const PG8_LAS bf16x8*)(lds + PG8_SB(b, h) + boff + n * 2048 + k * 1024); } while (0)
#define PG8_MMA(ai, bj, At, Bt) do { __builtin_amdgcn_s_setprio(1); _Pragma("unroll") for (int m = 0; m < 4; ++m) _Pragma("unroll") for (int n = 0; n < 2; ++n) _Pragma("unroll") for (int k = 0; k < 2; ++k) \
        acc[ai][bj][m][n] = __builtin_amdgcn_mfma_f32_16x16x32_bf16(Bt[n][k], At[m][k], acc[ai][bj][m][n], 0, 0, 0); __builtin_amdgcn_s_setprio(0); } while (0)
#define PG8_WAIT_V(n) asm volatile("s_waitcnt vmcnt(" #n ")" ::: "memory")
#define PG8_WAIT_L(n) asm volatile("s_waitcnt lgkmcnt(" #n ")" ::: "memory")
#define PG8_BAR __builtin_amdgcn_s_barrier()
#define PG8_SCHED __builtin_amdgcn_sched_barrier(0)
    Unit cur, nxt; int ui = 0;
    if (!S.next(0, cur)) return;
    f32x4 acc[2][2][4][2];
#pragma unroll
    for (int a = 0; a < 2; ++a)
#pragma unroll
        for (int b = 0; b < 2; ++b)
#pragma unroll
            for (int m = 0; m < 4; ++m)
#pragma unroll
                for (int n = 0; n < 2; ++n) acc[a][b][m][n] = (f32x4){0.f, 0.f, 0.f, 0.f};
    bf16x8 At[4][2], B0[2][2], B1[2][2];
    const char* cA = (const char*)g.A + (size_t)cur.pm * tstep; const char* cB = (const char*)g.Bt + (size_t)cur.pn * tstep;
    S.a_ready(cur);
    if constexpr (SP2) {
        PG8_STAGE(PG8_SB(0, 0), cB, voffB); PG8_STAGE(PG8_SB(0, 1), cB + hstep, voffB); PG8_STAGE(PG8_SA(0, 0), cA, voffA); PG8_STAGE(PG8_SA(0, 1), cA + hstep, voffA);
        if (wr == 1) PG8_BAR;
        PG8_WAIT_V(2); PG8_BAR;
        PG8_STAGE(PG8_SB(1, 0), cB + kstep, voffB); PG8_STAGE(PG8_SA(1, 0), cA + kstep, voffA); PG8_STAGE(PG8_SB(1, 1), cB + hstep + kstep, voffB);
        PG8_WAIT_V(6); PG8_BAR;
    } else {
        PG8_STAGE(PG8_SB(0, 0), cB, voffB); PG8_STAGE(PG8_SA(0, 0), cA, voffA); PG8_STAGE(PG8_SB(0, 1), cB + hstep, voffB); PG8_STAGE(PG8_SA(0, 1), cA + hstep, voffA);
        if (wr == 1) PG8_BAR;
        PG8_WAIT_V(4); PG8_BAR;
        PG8_STAGE(PG8_SB(1, 0), cB + kstep, voffB); PG8_STAGE(PG8_SA(1, 0), cA + kstep, voffA); PG8_STAGE(PG8_SB(1, 1), cB + hstep + kstep, voffB);
        PG8_WAIT_V(6); PG8_BAR;
    }
    for (;;) {
        const bool has_next = S.next(ui + 1, nxt);
        const char* nA = has_next ? (const char*)g.A + (size_t)nxt.pm * tstep : cA; const char* nB = has_next ? (const char*)g.Bt + (size_t)nxt.pn * tstep : cB;
        for (int t = 0; t < nt; t += 2) {
            const bool last = (t == nt - 2);
            const char* a1 = cA + (size_t)(t + 1) * kstep;
            const char* a2 = last ? nA : cA + (size_t)(t + 2) * kstep; const char* b2 = last ? nB : cB + (size_t)(t + 2) * kstep;
            const char* a3 = a2 + kstep; const char* b3 = b2 + kstep;
            if (last && has_next) S.a_ready(nxt);
            if constexpr (SP2) {
            PG8_LDB(B0, 0, 0); PG8_LDB(B1, 0, 1); PG8_SCHED; PG8_LDA(At, 0, 0); PG8_STAGE(PG8_SA(1, 1), a1 + hstep, voffA);
            PG8_WAIT_V(8); PG8_WAIT_L(0); PG8_BAR; PG8_MMA(0, 0, At, B0); PG8_MMA(0, 1, At, B1); PG8_BAR; PG8_SCHED;
            PG8_LDA(At, 0, 1); PG8_STAGE(PG8_SB(0, 0), b2, voffB); PG8_STAGE(PG8_SB(0, 1), b2 + hstep, voffB); PG8_STAGE(PG8_SA(0, 0), a2, voffA);
            PG8_WAIT_V(8); PG8_WAIT_L(0); PG8_BAR; PG8_MMA(1, 0, At, B0); PG8_MMA(1, 1, At, B1); PG8_BAR; PG8_SCHED;
            PG8_LDB(B0, 1, 0); PG8_LDB(B1, 1, 1); PG8_SCHED; PG8_LDA(At, 1, 0); PG8_STAGE(PG8_SA(0, 1), a2 + hstep, voffA);
            PG8_WAIT_V(8); PG8_WAIT_L(0); PG8_BAR; PG8_MMA(0, 0, At, B0); PG8_MMA(0, 1, At, B1); PG8_BAR; PG8_SCHED;
            PG8_LDA(At, 1, 1); PG8_STAGE(PG8_SB(1, 0), b3, voffB); PG8_STAGE(PG8_SB(1, 1), b3 + hstep, voffB); PG8_STAGE(PG8_SA(1, 0), a3, voffA);
            PG8_WAIT_V(8); PG8_WAIT_L(0); PG8_BAR; PG8_MMA(1, 0, At, B0); PG8_MMA(1, 1, At, B1); PG8_BAR; PG8_SCHED;
            } else {
            PG8_LDB(B0, 0, 0); PG8_SCHED; PG8_LDA(At, 0, 0); PG8_STAGE(PG8_SA(1, 1), a1 + hstep, voffA);
            PG8_WAIT_L(8); PG8_BAR; PG8_WAIT_L(0); PG8_MMA(0, 0, At, B0); PG8_BAR; PG8_SCHED;
            PG8_LDB(B1, 0, 1); PG8_STAGE(PG8_SB(0, 0), b2, voffB);
            PG8_BAR; PG8_WAIT_L(0); PG8_MMA(0, 1, At, B1); PG8_BAR;
            PG8_LDA(At, 0, 1); PG8_STAGE(PG8_SA(0, 0), a2, voffA);
            PG8_BAR; PG8_WAIT_L(0); PG8_MMA(1, 0, At, B0); PG8_BAR; PG8_SCHED;
            PG8_STAGE(PG8_SB(0, 1), b2 + hstep, voffB);
            PG8_WAIT_V(6); PG8_BAR; PG8_MMA(1, 1, At, B1); PG8_BAR;
            PG8_LDB(B0, 1, 0); PG8_SCHED; PG8_LDA(At, 1, 0); PG8_STAGE(PG8_SA(0, 1), a2 + hstep, voffA);
            PG8_WAIT_L(8); PG8_BAR; PG8_WAIT_L(0); PG8_MMA(0, 0, At, B0); PG8_BAR; PG8_SCHED;
            PG8_LDB(B1, 1, 1); PG8_STAGE(PG8_SB(1, 0), b3, voffB);
            PG8_BAR; PG8_WAIT_L(0); PG8_MMA(0, 1, At, B1); PG8_BAR;
            PG8_LDA(At, 1, 1); PG8_STAGE(PG8_SA(1, 0), a3, voffA);
            PG8_BAR; PG8_WAIT_L(0); PG8_MMA(1, 0, At, B0); PG8_BAR; PG8_SCHED;
            PG8_STAGE(PG8_SB(1, 1), b3 + hstep, voffB);
            PG8_WAIT_V(6); PG8_BAR; PG8_MMA(1, 1, At, B1); PG8_BAR;
            }
        }
        if constexpr (ALIGN_EPI) { if (wr == 0) PG8_BAR; }
        if constexpr (!Epi::AFTER_DRAIN) { E(acc, cur, wr, wc, fr, fq); S.done(cur); }
        if (!has_next) break;
#pragma unroll
        for (int a = 0; a < 2; ++a)
#pragma unroll
            for (int b = 0; b < 2; ++b)
#pragma unroll
                for (int m = 0; m < 4; ++m)
#pragma unroll
                    for (int n = 0; n < 2; ++n) acc[a][b][m][n] = (f32x4){0.f, 0.f, 0.f, 0.f};
        cur = nxt; cA = nA; cB = nB; ++ui;
        if constexpr (ALIGN_EPI) { if (wr == 1) PG8_BAR; }
    }
    PG8_WAIT_V(0);
    if constexpr (!ALIGN_EPI) { if (wr == 0) PG8_BAR; }
    PG8_BAR;
    if constexpr (Epi::AFTER_DRAIN) { E.fused(acc, cur, wr, wc, fr, fq, lds, wid, lane); S.done(cur); }
#undef PG8_SA
#undef PG8_SB
#undef PG8_STAGE
#undef PG8_LDA
#undef PG8_LDB
#undef PG8_MMA
#undef PG8_WAIT_V
#undef PG8_WAIT_L
#undef PG8_BAR
#undef PG8_SCHED
}
}
#ifndef PG8_SP2
#define PG8_SP2 true
#endif
#ifndef PG8_ALIGN
#define PG8_ALIGN true
#endif
constexpr int NWAVES = 8;
#ifndef MK_PER_PHASE
#define MK_PER_PHASE 1
#endif
constexpr int NPHASE = 16;

constexpr int BATCH = 4, T = 8192, D = 1024, M = BATCH * T, FF = 2816;
constexpr int AB_LD = 2072, C_LD = 3080;
constexpr float C2 = 0.125f * 1.4426950408889634f;
constexpr float LOG2E = 1.4426950408889634f;
constexpr int QC_QN = 0, QC_KC = 512, QC_VC = 640, QC_KS = 768, QC_VS = 896, QC_KW = 1024, QC_VW = 1152, QC_QS = 1280, QC_KSW = 1792, QC_VSW = 1920;

constexpr size_t MiB = 1u << 20, KiB = 1024;
constexpr size_t WS_CTL = 0, CTL_ZERO_BYTES = 1 * MiB;
constexpr size_t WS_RS0 = 1 * MiB;
constexpr size_t WS_PSUM = WS_RS0 + 128 * KiB;
constexpr size_t WS_GATES = WS_PSUM + 2 * MiB;
constexpr size_t WS_SCA = WS_GATES + 4 * MiB;
constexpr size_t WS_SCM = WS_SCA + 512 * KiB;
constexpr size_t WS_SCE = WS_SCM + 512 * KiB;
constexpr size_t WS_KC = WS_SCE + 512 * KiB;
constexpr size_t WS_VC = WS_KC + 512 * KiB;
constexpr size_t WS_WABG = WS_VC + 512 * KiB;
constexpr size_t WS_WCG = WS_WABG + 64 * KiB;
constexpr size_t WS_CW1K = WS_WCG + 64 * KiB;
constexpr size_t WS_CW1V = WS_CW1K + 256 * KiB;
constexpr size_t WS_CW2K = WS_CW1V + 256 * KiB;
constexpr size_t WS_CW2V = WS_CW2K + 8 * KiB;
constexpr size_t WS_CBIAS = WS_CW2V + 8 * KiB;
constexpr size_t WS_NLOC = WS_CBIAS + 4 * KiB;
constexpr size_t WS_NST = WS_NLOC + 256 * KiB;
static_assert(WS_NST + 256 * KiB <= 13 * MiB, "small region");
constexpr size_t WS_WAB = 13 * MiB;
constexpr size_t WS_WABO = WS_WAB + 4 * MiB;
constexpr size_t WS_WUP0 = WS_WABO + 2 * MiB;
constexpr size_t WS_WUP1 = WS_WUP0 + 11 * MiB;
constexpr size_t WS_WDN0 = WS_WUP1 + 11 * MiB;
constexpr size_t WS_WDN1 = WS_WDN0 + 5632 * KiB;
constexpr size_t WS_WCIN = WS_WDN1 + 5632 * KiB;
constexpr size_t WS_WCO = WS_WCIN + 6 * MiB;
static_assert(WS_WCO + 2 * MiB <= 60 * MiB, "weights region");
constexpr size_t WS_H16 = 60 * MiB;
constexpr size_t WS_A = 124 * MiB;
constexpr size_t WS_QKV0 = WS_A, WS_ATT = WS_A + 128 * MiB;
constexpr size_t WS_QKP = WS_A, WS_V1 = WS_A + 64 * MiB, WS_OG = WS_A + 128 * MiB;
constexpr size_t WS_B = 316 * MiB;
constexpr size_t WS_HID = WS_B;
constexpr size_t WS_ACCF = WS_B;
constexpr size_t WS_QKC = WS_B, WS_LT = WS_B + 64 * MiB, WS_CST = WS_B + 128 * MiB;
constexpr size_t WS_END = 492 * MiB;
static_assert(WS_HID + (size_t)M * FF * 2 <= WS_END && WS_CST + 32 * MiB <= WS_END, "d_ws map");
constexpr int CW_TMO = 0, CW_CODE = 1;
constexpr int CW_BAR = 4096;

constexpr int RING_OFF = 0, RING_BYTES = 131072;
constexpr int LDSCTL_OFF = RING_BYTES, MISC_OFF = LDSCTL_OFF + 320;
constexpr int LDS_BYTES = 147456;
static_assert(MISC_OFF + 128 <= LDS_BYTES, "LDS map");

#define GAS __attribute__((address_space(1)))
#define LAS __attribute__((address_space(3)))
typedef unsigned short bf16;
typedef unsigned v4u __attribute__((ext_vector_type(4)));
typedef unsigned v2u __attribute__((ext_vector_type(2)));
typedef float f32x4 __attribute__((ext_vector_type(4)));
typedef float f32x16 __attribute__((ext_vector_type(16)));
typedef short bf16x8 __attribute__((ext_vector_type(8)));
typedef short s16x4 __attribute__((ext_vector_type(4)));
typedef GAS unsigned gu32;
typedef GAS unsigned long long gu64;
#define RLX_AGENT __ATOMIC_RELAXED, __HIP_MEMORY_SCOPE_AGENT
#define LDS_WAIT() asm volatile("s_waitcnt lgkmcnt(0)" ::: "memory")
#define VM_WAIT() asm volatile("s_waitcnt vmcnt(0)" ::: "memory")
__device__ __forceinline__ unsigned f2bf(float f) { unsigned u = __builtin_bit_cast(unsigned, f); return (u + 0x7fffu + ((u >> 16) & 1u)) >> 16; }
__device__ __forceinline__ unsigned pk2(float lo, float hi) { return f2bf(lo) | (f2bf(hi) << 16); }
__device__ __forceinline__ float bf2f(unsigned short b) { return __builtin_bit_cast(float, (unsigned)b << 16); }
__device__ __forceinline__ float bflo(unsigned w) { return __builtin_bit_cast(float, w << 16); }
__device__ __forceinline__ float bfhi(unsigned w) { return __builtin_bit_cast(float, w & 0xffff0000u); }
__device__ __forceinline__ int crow(int r, int hi) { return (r & 3) + 8 * (r >> 2) + 4 * hi; }
__device__ __forceinline__ f32x16 mfma32(bf16x8 a, bf16x8 b, f32x16 c) { return __builtin_amdgcn_mfma_f32_32x32x16_bf16(a, b, c, 0, 0, 0); }
typedef short v4i16_t __attribute__((ext_vector_type(4)));
__device__ __forceinline__ s16x4 ds_tr(LAS unsigned char* p) { return __builtin_bit_cast(s16x4, __builtin_amdgcn_ds_read_tr16_b64_v4i16((LAS v4i16_t*)p)); }
__device__ __forceinline__ bf16x8 frag_tr(LAS unsigned char* lb, int off0, int off1) {
    const s16x4 lo = ds_tr(lb + off0), hi = ds_tr(lb + off1);
    return (bf16x8){lo[0], lo[1], lo[2], lo[3], hi[0], hi[1], hi[2], hi[3]};
}
typedef float f32x2_t __attribute__((ext_vector_type(2))); typedef __bf16 bf16x2_t __attribute__((ext_vector_type(2)));
__device__ __forceinline__ unsigned cvtpk(float lo, float hi) { f32x2_t v = {lo, hi}; bf16x2_t b = __builtin_convertvector(v, bf16x2_t); return __builtin_bit_cast(unsigned, b); }
template <int s> __device__ __forceinline__ bf16x8 pack8(const f32x16& p) {
    v4u w; w.x = cvtpk(p[8 * s + 0], p[8 * s + 1]); w.y = cvtpk(p[8 * s + 2], p[8 * s + 3]); w.z = cvtpk(p[8 * s + 4], p[8 * s + 5]); w.w = cvtpk(p[8 * s + 6], p[8 * s + 7]);
    return __builtin_bit_cast(bf16x8, w);
}
__device__ __forceinline__ float wave_sum(float v) {
#pragma unroll
    for (int o = 1; o < 64; o <<= 1) v += __shfl_xor(v, o);
    return v;
}
#define XB_TMO      128
#define XB_XCNT(j)  (256  + 64 * (j))
#define XB_XSUB(j)  (1280 + 64 * (j))
#define XB_XGEN(j)  (2304 + 64 * (j))
#define XB_TOP      3328
#define XB_TOPGEN   3392
#define XCD_BAR_WORDS 3456
#define XB_SPIN_CAP (1u << 18)

__device__ __forceinline__ unsigned xb_ld(unsigned* p)              { return __hip_atomic_load(p, __ATOMIC_RELAXED, __HIP_MEMORY_SCOPE_AGENT); }
__device__ __forceinline__ unsigned xb_add(unsigned* p, unsigned v) { return __hip_atomic_fetch_add(p, v, __ATOMIC_RELAXED, __HIP_MEMORY_SCOPE_AGENT); }
__device__ __forceinline__ unsigned xb_xcc_id() { return (unsigned)__builtin_amdgcn_s_getreg((3 << 11) | 20) & 0xFu; }
#define XB_SPIN(cond, bar) do { unsigned _sp = 0; while (cond) { __builtin_amdgcn_s_sleep(1); \
    if ((++_sp & 255u) == 0u) { if (xb_ld(&(bar)[XB_TMO])) break; if (_sp > XB_SPIN_CAP) { atomicAdd(&(bar)[XB_TMO], 1u); break; } } } } while (0)

struct XcdBarrier {
    unsigned* bar; unsigned x;
    volatile LAS unsigned* st;
};

__device__ __forceinline__ XcdBarrier xcd_barrier_post(unsigned* bar, volatile LAS unsigned* st) {
    XcdBarrier b; b.bar = bar; b.x = xb_xcc_id(); b.st = st;
    if (threadIdx.x == 0) (void)xb_add(&bar[XB_XCNT(b.x)], 1u);
    return b;
}
__device__ __forceinline__ void xcd_barrier_complete(unsigned* bar, unsigned x, unsigned& nloc, unsigned& nx) {
    const unsigned G = gridDim.x * gridDim.y * gridDim.z;
    unsigned sum, cnt, mine, sp = 0u;
    for (;;) {
        sum = 0u; cnt = 0u; mine = 0u;
#pragma unroll
        for (unsigned j = 0; j < 16; ++j) { const unsigned c = xb_ld(&bar[XB_XCNT(j)]); sum += c; cnt += (c > 0u) ? 1u : 0u; mine = (j == x) ? c : mine; }
        if (sum == G) break;
        __builtin_amdgcn_s_sleep(1);
        if ((++sp & 255u) == 0u) { if (xb_ld(&bar[XB_TMO])) break; if (sp > XB_SPIN_CAP) { atomicAdd(&bar[XB_TMO], 1u); break; } }
    }
    nloc = mine > 0u ? mine : 1u; nx = cnt > 0u ? cnt : 1u;
}

__device__ __forceinline__ void xcd_barrier(const XcdBarrier& b) {
    asm volatile("s_waitcnt vmcnt(0)" ::: "memory");
    __syncthreads();
    if (threadIdx.x == 0) {
        unsigned* bar = b.bar;
        __builtin_amdgcn_s_waitcnt(0);
        unsigned nloc = b.st[0], nx = b.st[1];
        if (nloc == 0u) { xcd_barrier_complete(bar, b.x, nloc, nx); b.st[0] = nloc; b.st[1] = nx; }
        const unsigned old = xb_add(&bar[XB_XSUB(b.x)], 1u);
        const unsigned gen = old / nloc;
        if (old + 1u == (gen + 1u) * nloc) {
            __builtin_amdgcn_fence(__ATOMIC_RELEASE, "agent");
            asm volatile("s_waitcnt vmcnt(0)" ::: "memory");
            const unsigned og = xb_add(&bar[XB_TOP], 1u);
            const unsigned tg = og / nx;
            if (og + 1u == (tg + 1u) * nx) xb_add(&bar[XB_TOPGEN], 1u);
            else XB_SPIN(xb_ld(&bar[XB_TOPGEN]) == tg, bar);
            __builtin_amdgcn_fence(__ATOMIC_ACQUIRE, "agent");
            xb_add(&bar[XB_XGEN(b.x)], 1u);
            asm volatile("s_waitcnt vmcnt(0)" ::: "memory");
        } else {
            XB_SPIN(xb_ld(&bar[XB_XGEN(b.x)]) == gen, bar);
            __builtin_amdgcn_fence(__ATOMIC_ACQUIRE, "agent");
            asm volatile("s_waitcnt vmcnt(0)" ::: "memory");
        }
    }
    __syncthreads();
}
struct Frame {
    LAS unsigned char* lds;
    volatile LAS unsigned* MISC;
    gu32* ctl;
    int tid, lane, wave;
    int vcu, G;
    unsigned char* ws;
    const float* in[23];
    float* out;
};
#define WSP(T_, off) ((T_*)(F.ws + (off)))

__device__ __forceinline__ void p0_titem(const float* W, int ldw, int c0, const float* kscale, float mul, bf16* WT, int Kd, int drow0, LAS float* scr, int kb, int lane) {
    const int k0 = 64 * kb;
#pragma unroll 8
    for (int i = 0; i < 32; ++i) { const int kk = 2 * i + (lane >> 5); float v = W[(size_t)(k0 + kk) * ldw + c0 + (lane & 31)]; if (kscale) v *= kscale[k0 + kk]; scr[kk * 33 + (lane & 31)] = v * mul; }
    LDS_WAIT(); asm volatile("" ::: "memory");
    const int c = lane & 7;
#pragma unroll
    for (int j = 0; j < 4; ++j) { const int n = (lane >> 3) + 8 * j; const LAS float* s = scr + (8 * c) * 33 + n;
        v4u o; o.x = pk2(s[0 * 33], s[1 * 33]); o.y = pk2(s[2 * 33], s[3 * 33]); o.z = pk2(s[4 * 33], s[5 * 33]); o.w = pk2(s[6 * 33], s[7 * 33]);
        *(GAS v4u*)(WT + (size_t)(drow0 + n) * Kd + k0 + 8 * c) = o; }
    LDS_WAIT(); asm volatile("" ::: "memory");
}
__device__ __forceinline__ void p0_prologue(Frame& F) {
    LAS float* scr = (LAS float*)(F.lds + RING_OFF + F.wave * 16384);
    const int gw = F.vcu * NWAVES + F.wave, NGW = F.G * NWAVES, lane = F.lane;
    const float* norm_mix = F.in[1]; const float* norm_ffn = F.in[2];
    constexpr int I_AB1 = 16 * 40, I_AB2 = 16 * 24, I_ABO = 16 * 32, I_FF = 16 * 88, I_DN = 44 * 32, I_CIN = 16 * 96, I_CO = 16 * 32, I_W1 = 32 * 2, I_W2 = 2;
    constexpr int NITEMS = I_AB1 + I_AB2 + I_ABO + 4 * I_FF + 2 * I_DN + I_CIN + I_CO + 2 * I_W1 + 2 * I_W2;
    for (int it = gw; it < NITEMS; it += NGW) {
        int r = it;
        if (r < I_AB1) { const int kb = r / 40, nb = r % 40; p0_titem(F.in[6], AB_LD, 32 * nb, norm_mix, nb < 16 ? C2 : 1.f, WSP(bf16, WS_WAB), 1024, 32 * nb, scr, kb, lane); continue; } r -= I_AB1;
        if (r < I_AB2) { const int kb = r / 24, nb = r % 24; p0_titem(F.in[6], AB_LD, 1304 + 32 * nb, norm_mix, nb < 16 ? C2 : 1.f, WSP(bf16, WS_WAB), 1024, 1280 + 32 * nb, scr, kb, lane); continue; } r -= I_AB2;
        if (r < I_ABO) { const int kb = r / 32, nb = r % 32; p0_titem(F.in[15], 1024, 32 * nb, nullptr, 1.f, WSP(bf16, WS_WABO), 1024, 32 * nb, scr, kb, lane); continue; } r -= I_ABO;
        if (r < 4 * I_FF) { const int q = r / I_FF, rr = r % I_FF, l = q >> 1, up = q & 1, kb = rr / 88, nb = rr % 88, n0 = 32 * nb;
            const float* W = (up ? F.in[4] : F.in[3]) + (size_t)l * 1024 * FF;
            p0_titem(W, FF, n0, norm_ffn + l * 1024, 1.f, WSP(bf16, l ? WS_WUP1 : WS_WUP0), 1024, 256 * (n0 / 128) + (n0 % 128) + 128 * up, scr, kb, lane); continue; } r -= 4 * I_FF;
        if (r < 2 * I_DN) { const int l = r / I_DN, rr = r % I_DN, kb = rr / 32, nb = rr % 32;
            p0_titem(F.in[5] + (size_t)l * FF * 1024, 1024, 32 * nb, nullptr, 1.f, WSP(bf16, l ? WS_WDN1 : WS_WDN0), FF, 32 * nb, scr, kb, lane); continue; } r -= 2 * I_DN;
        if (r < I_CIN) { const int kb = r / 96, nb = r % 96; p0_titem(F.in[16], C_LD, 32 * nb, norm_mix + 1024, 1.f, WSP(bf16, WS_WCIN), 1024, 32 * nb, scr, kb, lane); continue; } r -= I_CIN;
        if (r < I_CO) { const int kb = r / 32, nb = r % 32; p0_titem(F.in[21], 1024, 32 * nb, nullptr, 1.f, WSP(bf16, WS_WCO), 1024, 32 * nb, scr, kb, lane); continue; } r -= I_CO;
        if (r < 2 * I_W1) { const int kv = r / I_W1, rr = r % I_W1, kb = rr / 2, nb = rr % 2; p0_titem(F.in[kv ? 12 : 10], 64, 32 * nb, nullptr, 1.f, WSP(bf16, kv ? WS_CW1V : WS_CW1K), 2048, 32 * nb, scr, kb, lane); continue; } r -= 2 * I_W1;
        { const int kv = r / I_W2, nb = r % I_W2; p0_titem(F.in[kv ? 13 : 11], 64, 32 * nb, nullptr, 1.f, WSP(bf16, kv ? WS_CW2V : WS_CW2K), 64, 32 * nb, scr, 0, lane); }
    }
    { const int gt = (F.vcu * NWAVES + F.wave) * 64 + lane, NGT = F.G * NWAVES * 64;
      for (int i = gt; i < 2 * 32 * 1024; i += NGT) { const int which = i >> 15, n = (i >> 10) & 31, k = i & 1023; float v = 0.f;
          if (which == 0) { if (n < 24) v = F.in[6][(size_t)k * AB_LD + 1280 + n] * norm_mix[k]; WSP(bf16, WS_WABG)[n * 1024 + k] = (bf16)f2bf(v); }
          else { if (n < 8) v = F.in[16][(size_t)k * C_LD + 3072 + n] * norm_mix[1024 + k]; WSP(bf16, WS_WCG)[n * 1024 + k] = (bf16)f2bf(v); } } }
    for (int m = gw; m < M; m += NGW) {
        const GAS f32x4* xr = (const GAS f32x4*)(F.in[0] + (size_t)m * D) + lane; f32x4 v[4]; float s = 0.f;
#pragma unroll
        for (int j = 0; j < 4; ++j) { v[j] = xr[64 * j]; s += (v[j].x * v[j].x + v[j].y * v[j].y) + (v[j].z * v[j].z + v[j].w * v[j].w); }
        s = wave_sum(s);
        GAS unsigned long long* o8 = (GAS unsigned long long*)(WSP(bf16, WS_H16) + (size_t)m * D) + lane;
#pragma unroll
        for (int j = 0; j < 4; ++j) o8[64 * j] = (unsigned long long)pk2(v[j].x, v[j].y) | ((unsigned long long)pk2(v[j].z, v[j].w) << 32);
        if (lane == 0) WSP(float, WS_RS0)[m] = 1.0f / sqrtf(s * (1.0f / D) + 1e-6f);
    }
    if (F.vcu == 0) {
        __syncthreads();
        LAS float* red = (LAS float*)(F.lds + RING_OFF);
#pragma unroll
        for (int kv = 0; kv < 2; ++kv) { const float* pos = F.in[kv ? 9 : 8]; const float* w1 = F.in[kv ? 12 : 10]; float a = 0.f;
            for (int k = F.wave * 256; k < F.wave * 256 + 256; ++k) a += pos[k] * w1[(size_t)k * 64 + lane];
            red[(kv * 8 + F.wave) * 64 + lane] = a; }
        __syncthreads();
        if (F.tid < 128) { const int kv = F.tid >> 6, n = F.tid & 63; float a = 0.f;
#pragma unroll
            for (int w = 0; w < 8; ++w) a += red[(kv * 8 + w) * 64 + n];
            WSP(float, WS_CBIAS)[kv * 64 + n] = a; }
        __syncthreads();
    }
}
__device__ __forceinline__ f32x16 skinny_tile(const bf16* A, const bf16* Wt, int row0, int lane) {
    const int r32 = lane & 31, h = lane >> 5; f32x16 acc = {};
    const bf16* ap = A + (size_t)(row0 + r32) * 1024 + 8 * h; const bf16* wp = Wt + (size_t)r32 * 1024 + 8 * h;
#pragma unroll 8
    for (int s = 0; s < 64; ++s) acc = mfma32(*(const bf16x8*)(wp + 16 * s), *(const bf16x8*)(ap + 16 * s), acc);
    return acc;
}
__device__ __forceinline__ void gates0_phase(Frame& F) {
    const int gw = F.vcu * NWAVES + F.wave, NGW = F.G * NWAVES, lane = F.lane, r32 = lane & 31, h = lane >> 5;
    for (int t = gw; t < M / 32; t += NGW) {
        const f32x16 acc = skinny_tile(WSP(bf16, WS_H16), WSP(bf16, WS_WABG), 32 * t, lane);
        const int row = 32 * t + r32; const float rs = WSP(float, WS_RS0)[row]; float* g = WSP(float, WS_GATES) + (size_t)row * 32;
#pragma unroll
        for (int r = 0; r < 16; ++r) { const int c = crow(r, h); if (c < 24) g[c] = 1.0f / (1.0f + __expf(-(acc[r] * rs + F.in[7][c]))); }
    }
}
__device__ __forceinline__ void gates1_phase(Frame& F) {
    const int gw = F.vcu * NWAVES + F.wave, NGW = F.G * NWAVES, lane = F.lane, r32 = lane & 31, h = lane >> 5;
    const pg8::RowScale R{nullptr, WSP(float, WS_PSUM)};
    for (int t = gw; t < M / 32; t += NGW) {
        const f32x16 acc = skinny_tile(WSP(bf16, WS_H16), WSP(bf16, WS_WCG), 32 * t, lane);
        const int row = 32 * t + r32; const float rs = pg8::row_scale(R, row); float* g = WSP(float, WS_GATES) + (size_t)row * 32;
#pragma unroll
        for (int r = 0; r < 16; ++r) { const int c = crow(r, h);
            if (c < 4) g[c] = acc[r] * rs + F.in[19][c];
            else if (c < 8) { const float x = acc[r] * rs + F.in[20][c - 4]; g[c] = fminf(x, 0.f) - log1pf(__expf(-fabsf(x))); } }
    }
}

__device__ __forceinline__ void compress_phase(Frame& F) {
    const int lane = F.lane, r32 = lane & 31, h = lane >> 5, w = F.wave;
    LAS float* red = (LAS float*)(F.lds + RING_OFF);
    LAS unsigned char* Hs = F.lds + RING_OFF + 65536;
    for (int task = F.vcu; task < 256; task += F.G) {
        const int kv = task & 1, bg = (task >> 1) & 7, rt = task >> 4, b = bg >> 1, g = bg & 1, i0 = rt * 32;
        const bf16* raw = WSP(bf16, WS_QKV0) + (size_t)b * T * 2048 + (kv ? QC_VC : QC_KC) + g * 64;
        const bf16* w1t = WSP(bf16, kv ? WS_CW1V : WS_CW1K);
        const bf16* w2t = WSP(bf16, kv ? WS_CW2V : WS_CW2K);
        int ic = i0 + r32; if (ic > 510) ic = 510;
        f32x16 d0 = {}, d1 = {};
#pragma unroll
        for (int ll = 0; ll < 4; ++ll) { const int l = 4 * w + ll;
#pragma unroll
            for (int ss = 0; ss < 4; ++ss) { const int k = l * 64 + 16 * ss + 8 * h;
                const bf16x8 bfr = *(const bf16x8*)(raw + (size_t)(16 * ic + l) * 2048 + 16 * ss + 8 * h);
                d0 = mfma32(*(const bf16x8*)(w1t + (size_t)r32 * 2048 + k), bfr, d0);
                d1 = mfma32(*(const bf16x8*)(w1t + (size_t)(32 + r32) * 2048 + k), bfr, d1); } }
#pragma unroll
        for (int r = 0; r < 16; ++r) { red[(w * 64 + crow(r, h)) * 32 + r32] = d0[r]; red[(w * 64 + 32 + crow(r, h)) * 32 + r32] = d1[r]; }
        __syncthreads();
#pragma unroll
        for (int e = 0; e < 4; ++e) { const int idx = F.tid * 4 + e, hid = idx >> 5, i = idx & 31; float a = WSP(float, WS_CBIAS)[kv * 64 + hid];
#pragma unroll
            for (int ww = 0; ww < 8; ++ww) a += red[(ww * 64 + hid) * 32 + i];
            a = a / (1.0f + __expf(-a));
            *(LAS bf16*)(Hs + i * 144 + hid * 2) = (bf16)f2bf(a); }
        __syncthreads();
        if (w < 2) { f32x16 o = {};
#pragma unroll
            for (int s = 0; s < 4; ++s) o = mfma32(*(const bf16x8*)(w2t + (size_t)(32 * w + r32) * 64 + 16 * s + 8 * h), *(const LAS bf16x8*)(Hs + r32 * 144 + (16 * s + 8 * h) * 2), o);
            bf16* dst = WSP(bf16, kv ? WS_VC : WS_KC) + ((size_t)bg * 512 + i0 + r32) * 64 + 32 * w + 4 * h;
#pragma unroll
            for (int q = 0; q < 4; ++q) { v2u pk; pk.x = pk2(o[4 * q], o[4 * q + 1]); pk.y = pk2(o[4 * q + 2], o[4 * q + 3]); *(v2u*)(dst + 8 * q) = pk; } }
        __syncthreads();
    }
}
constexpr int AT_K = 0, AT_V = 9216, AT_IMP = 18432, AT_SEL = AT_IMP + 128 * 132 * 4, AT_END = AT_SEL + 2048;
static_assert(AT_END <= RING_BYTES, "attention LDS");
constexpr int KV_STRIDE = 144;
__device__ __forceinline__ void stage_kv(Frame& F, const bf16* Kg, const bf16* Vg, int pitch, int row0, int rmax) {
    const int row = F.tid >> 3, ch = F.tid & 7; int rr = row0 + row; rr = rr < 0 ? 0 : (rr > rmax ? rmax : rr);
    const v4u kx = *(const v4u*)(Kg + (size_t)rr * pitch + ch * 8);
    *(LAS v4u*)(F.lds + AT_K + row * KV_STRIDE + ch * 16) = kx;
    if (Vg) { const v4u vx = *(const v4u*)(Vg + (size_t)rr * pitch + ch * 8); *(LAS v4u*)(F.lds + AT_V + row * KV_STRIDE + ch * 16) = vx; }
}
__device__ __forceinline__ f32x16 qk_tile(LAS unsigned char* klb, int sub, const bf16x8 (&qf)[4]) {
    f32x16 s = {};
#pragma unroll
    for (int st = 0; st < 4; ++st) s = mfma32(*(const LAS bf16x8*)(klb + 32 * sub * KV_STRIDE + 32 * st), qf[st], s);
    return s;
}
__device__ __forceinline__ void pv_tile(LAS unsigned char* vlb, int sub, const f32x16& p, f32x16 (&o)[2]) {
    const bf16x8 p0 = pack8<0>(p), p1 = pack8<1>(p);
#pragma unroll
    for (int dt = 0; dt < 2; ++dt) {
        o[dt] = mfma32(frag_tr(vlb, (32 * sub) * KV_STRIDE + 64 * dt, (32 * sub + 8) * KV_STRIDE + 64 * dt), p0, o[dt]);
        o[dt] = mfma32(frag_tr(vlb, (32 * sub + 16) * KV_STRIDE + 64 * dt, (32 * sub + 24) * KV_STRIDE + 64 * dt), p1, o[dt]);
    }
}
__device__ __forceinline__ void osm_update(f32x16& s, float& m, float& l, f32x16 (&o)[2]) {
    float mx = s[0];
#pragma unroll
    for (int r = 1; r < 16; ++r) mx = fmaxf(mx, s[r]);
    mx = fmaxf(mx, __shfl_xor(mx, 32));
    const float mn = fmaxf(m, mx), al = __builtin_amdgcn_exp2f(m - mn);
    float sum = 0.f;
#pragma unroll
    for (int r = 0; r < 16; ++r) { s[r] = __builtin_amdgcn_exp2f(s[r] - mn); sum += s[r]; }
    l = l * al + sum; m = mn;
#pragma unroll
    for (int dt = 0; dt < 2; ++dt)
#pragma unroll
        for (int r = 0; r < 16; ++r) o[dt][r] *= al;
}
template <int MODE, int WIN>
__device__ __forceinline__ void attn_blocks(Frame& F, const bf16* Kg, const bf16* Vg, int jlo, int jhi, int tq, int tqmax_w, int tqmin_w, const unsigned (&selw)[4],
                                            const bf16x8 (&qf)[2][4], float (&m)[2], float (&l)[2], f32x16 (&o)[2][2]) {
    const int lane = F.lane, r32 = lane & 31, h = lane >> 5;
    const int trl = ((lane & 15) >> 2) * KV_STRIDE + (16 * ((lane >> 4) & 1) + 4 * (lane & 3)) * 2;
    LAS unsigned char* klb = F.lds + AT_K + r32 * KV_STRIDE + 16 * h; LAS unsigned char* vlb = F.lds + AT_V + trl + 4 * h * KV_STRIDE;
    for (int j = jlo; j <= jhi; ++j) {
        __syncthreads();
        stage_kv(F, Kg, Vg, 2048, 64 * j, T - 1);
        __syncthreads();
        bool mine = true;
        if (MODE == 0) { const int jp = j & 3; const unsigned sw = jp == 0 ? selw[0] : jp == 1 ? selw[1] : jp == 2 ? selw[2] : selw[3]; mine = ((sw >> (j >> 2)) & 1u) != 0u; }
#pragma unroll
        for (int sub = 0; sub < 2; ++sub) {
            const int kb = 64 * j + 32 * sub;
            bool any;
            if (MODE == 0) any = __any(mine && kb <= tq);
            else any = (kb <= tqmax_w) && (kb + 31 > tqmin_w - WIN);
            if (!any) continue;
#pragma unroll
            for (int hd = 0; hd < 2; ++hd) {
                f32x16 s = qk_tile(klb, sub, qf[hd]);
#pragma unroll
                for (int r = 0; r < 16; ++r) { const int key = kb + crow(r, h); bool ok = key <= tq;
                    if (MODE == 0) ok = ok && mine; else ok = ok && (tq - key < WIN);
                    s[r] = ok ? s[r] : -INFINITY; }
                osm_update(s, m[hd], l[hd], o[hd]);
                pv_tile(vlb, sub, s, o[hd]);
                __builtin_amdgcn_sched_barrier(0);
            }
        }
    }
}
__device__ __forceinline__ void accf_store(float* accf, size_t tok, int hc, const f32x16 (&o)[2], float sc, int h, bool add) {
    float* p = accf + tok * 512 + hc + 4 * h;
#pragma unroll
    for (int dt = 0; dt < 2; ++dt)
#pragma unroll
        for (int q = 0; q < 4; ++q) { f32x4 v = {o[dt][4 * q] * sc, o[dt][4 * q + 1] * sc, o[dt][4 * q + 2] * sc, o[dt][4 * q + 3] * sc};
            f32x4* d = (f32x4*)(p + 32 * dt + 8 * q); if (add) v = v + *d; *d = v; }
}
__device__ __forceinline__ void att_store(bf16* att, const float* accf, size_t tok, int hc_att, int hc_acc, const f32x16 (&o)[2], float sc, int h) {
    bf16* p = att + tok * 1024 + hc_att + 4 * h;
#pragma unroll
    for (int dt = 0; dt < 2; ++dt)
#pragma unroll
        for (int q = 0; q < 4; ++q) { f32x4 v = {o[dt][4 * q] * sc, o[dt][4 * q + 1] * sc, o[dt][4 * q + 2] * sc, o[dt][4 * q + 3] * sc};
            if (accf) v = v + *(const f32x4*)(accf + tok * 512 + hc_acc + 4 * h + 32 * dt + 8 * q);
            v2u pk; pk.x = pk2(v[0], v[1]); pk.y = pk2(v[2], v[3]); *(v2u*)(p + 32 * dt + 8 * q) = pk; }
}
__device__ __forceinline__ void nsa_unit(Frame& F, int b, int g, int n) {
    const int lane = F.lane, r32 = lane & 31, h = lane >> 5, wave = F.wave, tid = F.tid;
    const int start = n * 128, qt = wave >> 1, hp = (wave & 1) * 2;
    const int tq = start + qt * 32 + r32, tqmin_w = start + qt * 32, tqmax_w = tqmin_w + 31;
    const size_t tok = (size_t)b * T + tq;
    const bf16* qkv = WSP(bf16, WS_QKV0) + (size_t)b * T * 2048;
    const int trl = ((lane & 15) >> 2) * KV_STRIDE + (16 * ((lane >> 4) & 1) + 4 * (lane & 3)) * 2;
    LAS unsigned char* klb = F.lds + AT_K + r32 * KV_STRIDE + 16 * h; LAS unsigned char* vlb = F.lds + AT_V + trl + 4 * h * KV_STRIDE;
    LAS float* imp = (LAS float*)(F.lds + AT_IMP); LAS unsigned* sel = (LAS unsigned*)(F.lds + AT_SEL);
    bf16x8 qf[2][4];
#pragma unroll
    for (int hd = 0; hd < 2; ++hd)
#pragma unroll
        for (int s = 0; s < 4; ++s) qf[hd][s] = *(const bf16x8*)(qkv + (size_t)tq * 2048 + QC_QN + (g * 4 + hp + hd) * 64 + 16 * s + 8 * h);
    const float* gatep = WSP(float, WS_GATES) + tok * 32 + (g * 4 + hp) * 3;
    float* accf = WSP(float, WS_ACCF);
    __syncthreads();
    for (int i = tid; i < 128 * 132; i += 512) imp[i] = 0.f;
    const bf16* kcg = WSP(bf16, WS_KC) + (size_t)(b * 2 + g) * 512 * 64; const bf16* vcg = WSP(bf16, WS_VC) + (size_t)(b * 2 + g) * 512 * 64;
    const int nvalid = 8 * n + 7, nbc = (nvalid + 63) >> 6;
    float m[2] = {-1e30f, -1e30f}, l[2] = {0.f, 0.f};
    for (int jb = 0; jb < nbc; ++jb) {
        __syncthreads();
        stage_kv(F, kcg, nullptr, 64, 64 * jb, 511);
        __syncthreads();
#pragma unroll
        for (int sub = 0; sub < 2; ++sub)
#pragma unroll
            for (int hd = 0; hd < 2; ++hd) {
                f32x16 s = qk_tile(klb, sub, qf[hd]); float mx = -INFINITY;
#pragma unroll
                for (int r = 0; r < 16; ++r) { const int i = 64 * jb + 32 * sub + crow(r, h); s[r] = (16 * i + 31 <= tq) ? s[r] : -INFINITY; mx = fmaxf(mx, s[r]); }
                mx = fmaxf(mx, __shfl_xor(mx, 32));
                const float mn = fmaxf(m[hd], mx), al = __builtin_amdgcn_exp2f(m[hd] - mn); float sum = 0.f;
#pragma unroll
                for (int r = 0; r < 16; ++r) sum += __builtin_amdgcn_exp2f(s[r] - mn);
                l[hd] = l[hd] * al + sum; m[hd] = mn;
            }
    }
    float il[2];
#pragma unroll
    for (int hd = 0; hd < 2; ++hd) { const float lt = l[hd] + __shfl_xor(l[hd], 32); il[hd] = lt > 0.f ? 1.0f / lt : 0.f; }
    f32x16 o[2][2];
#pragma unroll
    for (int hd = 0; hd < 2; ++hd) { o[hd][0] = (f32x16){}; o[hd][1] = (f32x16){}; }
    float carry = 0.f;
    for (int jb = 0; jb < nbc; ++jb) {
        __syncthreads();
        stage_kv(F, kcg, vcg, 64, 64 * jb, 511);
        __syncthreads();
#pragma unroll
        for (int sub = 0; sub < 2; ++sub) {
            float ps4[4] = {0.f, 0.f, 0.f, 0.f}, sp[4] = {0.f, 0.f, 0.f, 0.f};
#pragma unroll
            for (int hd = 0; hd < 2; ++hd) {
                f32x16 s = qk_tile(klb, sub, qf[hd]);
#pragma unroll
                for (int r = 0; r < 16; ++r) { const int i = 64 * jb + 32 * sub + crow(r, h); s[r] = (16 * i + 31 <= tq) ? __builtin_amdgcn_exp2f(s[r] - m[hd]) * il[hd] : 0.f; }
#pragma unroll
                for (int q = 0; q < 4; ++q) { ps4[q] += (s[4 * q] + s[4 * q + 1]) + (s[4 * q + 2] + s[4 * q + 3]); sp[q] += s[4 * q + 3]; }
                pv_tile(vlb, sub, s, o[hd]);
            }
            float cell[4];
#pragma unroll
            for (int q = 0; q < 4; ++q) { const float rv = __shfl_xor(sp[q], 32);
                if (h == 1) cell[q] = ps4[q] + rv; else { cell[q] = ps4[q] + carry; carry = rv; } }
            const int j0 = (64 * jb + 32 * sub) / 4 + h;
#pragma unroll
            for (int q = 0; q < 4; ++q) atomicAdd((float*)&imp[(qt * 32 + r32) * 132 + j0 + 2 * q], cell[q]);
        }
    }
#pragma unroll
    for (int hd = 0; hd < 2; ++hd) accf_store(accf, tok, (g * 4 + hp + hd) * 64, o[hd], gatep[3 * hd + 0], h, false);
    __syncthreads();
    {
        const int q = tid >> 2, part = tid & 3, tq2 = start + q, cur = tq2 >> 6; unsigned bits = 0u;
        float val[32];
#pragma unroll
        for (int e = 0; e < 32; ++e) { const int j = 4 * e + part; const bool forced = (j == 0) || (j == cur) || (j == cur - 1);
            if (cur <= 15) { if (j <= cur) bits |= 1u << e; val[e] = -INFINITY; }
            else { if (forced) bits |= 1u << e; val[e] = (!forced && j >= 1 && j <= cur - 2) ? imp[q * 132 + j] : -INFINITY; } }
        if (cur > 15) {
            for (int itr = 0; itr < 13; ++itr) {
                float bv = val[0]; int be = 0;
#pragma unroll
                for (int e = 1; e < 32; ++e) if (val[e] > bv) { bv = val[e]; be = e; }
                int bj = 4 * be + part; float wv = bv; int wj = bj;
#pragma unroll
                for (int d = 1; d < 4; d <<= 1) { const float ov = __shfl_xor(wv, d); const int oj = __shfl_xor(wj, d); if (ov > wv || (ov == wv && oj < wj)) { wv = ov; wj = oj; } }
                const bool win = (wj == bj) && (wv > -INFINITY);
#pragma unroll
                for (int e = 0; e < 32; ++e) if (win && e == be) { val[e] = -INFINITY; bits |= 1u << e; }
            }
        }
        sel[q * 4 + part] = bits;
    }
    __syncthreads();
    unsigned selw[4];
#pragma unroll
    for (int p = 0; p < 4; ++p) selw[p] = sel[(qt * 32 + r32) * 4 + p];
#pragma unroll
    for (int hd = 0; hd < 2; ++hd) { o[hd][0] = (f32x16){}; o[hd][1] = (f32x16){}; m[hd] = -1e30f; l[hd] = 0.f; }
    attn_blocks<0, 0>(F, qkv + QC_KS + g * 64, qkv + QC_VS + g * 64, 0, 2 * n + 1, tq, tqmax_w, tqmin_w, selw, qf, m, l, o);
#pragma unroll
    for (int hd = 0; hd < 2; ++hd) { const float lt = l[hd] + __shfl_xor(l[hd], 32); accf_store(accf, tok, (g * 4 + hp + hd) * 64, o[hd], lt > 0.f ? gatep[3 * hd + 1] / lt : 0.f, h, true); }
#pragma unroll
    for (int hd = 0; hd < 2; ++hd) { o[hd][0] = (f32x16){}; o[hd][1] = (f32x16){}; m[hd] = -1e30f; l[hd] = 0.f; }
    attn_blocks<1, 512>(F, qkv + QC_KW + g * 64, qkv + QC_VW + g * 64, (2 * n - 8) < 0 ? 0 : (2 * n - 8), 2 * n + 1, tq, tqmax_w, tqmin_w, selw, qf, m, l, o);
#pragma unroll
    for (int hd = 0; hd < 2; ++hd) { const float lt = l[hd] + __shfl_xor(l[hd], 32);
        att_store(WSP(bf16, WS_ATT), accf, tok, (g * 4 + hp + hd) * 64, (g * 4 + hp + hd) * 64, o[hd], lt > 0.f ? gatep[3 * hd + 2] / lt : 0.f, h); }
}
__device__ __forceinline__ void swa_unit(Frame& F, int b, int g, int n) {
    const int lane = F.lane, r32 = lane & 31, h = lane >> 5, wave = F.wave;
    const int start = n * 128, qt = wave >> 1, hp = (wave & 1) * 2;
    const int tq = start + qt * 32 + r32, tqmin_w = start + qt * 32, tqmax_w = tqmin_w + 31;
    const size_t tok = (size_t)b * T + tq;
    const bf16* qkv = WSP(bf16, WS_QKV0) + (size_t)b * T * 2048;
    bf16x8 qf[2][4];
#pragma unroll
    for (int hd = 0; hd < 2; ++hd)
#pragma unroll
        for (int s = 0; s < 4; ++s) qf[hd][s] = *(const bf16x8*)(qkv + (size_t)tq * 2048 + QC_QS + (g * 4 + hp + hd) * 64 + 16 * s + 8 * h);
    f32x16 o[2][2]; float m[2], l[2]; const unsigned selw[4] = {0u, 0u, 0u, 0u};
#pragma unroll
    for (int hd = 0; hd < 2; ++hd) { o[hd][0] = (f32x16){}; o[hd][1] = (f32x16){}; m[hd] = F.in[14][g * 4 + hp + hd] * LOG2E; l[hd] = (h == 0) ? 1.0f : 0.f; }
    attn_blocks<1, 128>(F, qkv + QC_KSW + g * 64, qkv + QC_VSW + g * 64, (2 * n - 2) < 0 ? 0 : (2 * n - 2), 2 * n + 1, tq, tqmax_w, tqmin_w, selw, qf, m, l, o);
#pragma unroll
    for (int hd = 0; hd < 2; ++hd) { const float lt = l[hd] + __shfl_xor(l[hd], 32);
        att_store(WSP(bf16, WS_ATT), nullptr, tok, 512 + (g * 4 + hp + hd) * 64, 0, o[hd], 1.0f / lt, h); }
}
__device__ __forceinline__ void attention_phase(Frame& F) {
    for (int i = 0;; ++i) { const int u = i * F.G + F.vcu; if (u >= 512) break;
        const int pi = u & 255, bg = pi >> 5, s = pi & 31, n = (u < 256) ? s : 63 - s; nsa_unit(F, bg >> 1, bg & 1, n); }
    for (int i = 0;; ++i) { const int u = i * F.G + F.vcu; if (u >= 512) break; const int bg = u >> 6, n = u & 63; swa_unit(F, bg >> 1, bg & 1, n); }
    __syncthreads();
}
__device__ __forceinline__ void conv_scan_phase(Frame& F) {
    const int lane = F.lane, w = F.wave;
    if (F.vcu < 16 && F.G >= 32) {
        const int bh = F.vcu, b = bh >> 2, hh = bh & 3;
        const float* gt = WSP(float, WS_GATES) + (size_t)b * T * 32;
        LAS float* segG = (LAS float*)(F.lds + RING_OFF); LAS float* segP = segG + 8;
        float Gl[16], al[16], Pl[16]; float c = 0.f, cm = -INFINITY;
#pragma unroll
        for (int it = 0; it < 16; ++it) { const int t = 1024 * w + 64 * it + lane; const float li = gt[(size_t)t * 32 + hh]; float x = gt[(size_t)t * 32 + 4 + hh];
#pragma unroll
            for (int d = 1; d < 64; d <<= 1) { const float y = __shfl_up(x, d); if (lane >= d) x += y; }
            Gl[it] = c + x; c = __shfl(Gl[it], 63);
            al[it] = li - Gl[it]; float pm = al[it];
#pragma unroll
            for (int d = 1; d < 64; d <<= 1) { const float y = __shfl_up(pm, d); if (lane >= d) pm = fmaxf(pm, y); }
            pm = fmaxf(pm, cm); Pl[it] = pm; cm = __shfl(pm, 63); }
        if (lane == 0) { segG[w] = c; segP[w] = cm; }
        __syncthreads();
        double gc = 0.0; float mc = 0.f;
        for (int k = 0; k < w; ++k) { mc = fmaxf(mc, (float)((double)segP[k] - gc)); gc += (double)segG[k]; }
#pragma unroll
        for (int it = 0; it < 16; ++it) { const int t = 1024 * w + 64 * it + lane; const float gcf = (float)gc;
            const float a = al[it] - gcf, mv = fmaxf(mc, Pl[it] - gcf); const double mt = (gc + (double)Gl[it]) + (double)mv;
            WSP(float, WS_SCA)[bh * T + t] = a; WSP(float, WS_SCM)[bh * T + t] = mv; WSP(float, WS_SCE)[bh * T + t] = (float)exp(-mt); }
        __syncthreads();
        return;
    }
    const int first = (F.G >= 32) ? 16 : 0, nblk = F.G - first, bi = F.vcu - first;
    const int c8 = (F.tid & 127) * 8;
    const float* cw = F.in[17]; const float* cb = F.in[18];
    float wv[4][8], bv[8];
#pragma unroll
    for (int e = 0; e < 8; ++e) { bv[e] = cb[c8 + e];
#pragma unroll
        for (int k = 0; k < 4; ++k) wv[k][e] = cw[k * 1024 + c8 + e]; }
    const float ksc = (c8 >= 512) ? 0.08838834764831845f : 1.0f;
    const bf16* src = WSP(bf16, WS_QKP); bf16* dst = WSP(bf16, WS_QKC);
    for (int tok = bi * 4 + (F.tid >> 7); tok < M; tok += nblk * 4) {
        const int t = tok & (T - 1); float acc[8];
#pragma unroll
        for (int e = 0; e < 8; ++e) acc[e] = bv[e];
#pragma unroll
        for (int k = 0; k < 4; ++k) { if (t - 3 + k >= 0) { const v4u x = *(const v4u*)(src + (size_t)(tok - 3 + k) * 1024 + c8);
                acc[0] += bflo(x.x) * wv[k][0]; acc[1] += bfhi(x.x) * wv[k][1]; acc[2] += bflo(x.y) * wv[k][2]; acc[3] += bfhi(x.y) * wv[k][3];
                acc[4] += bflo(x.z) * wv[k][4]; acc[5] += bfhi(x.z) * wv[k][5]; acc[6] += bflo(x.w) * wv[k][6]; acc[7] += bfhi(x.w) * wv[k][7]; } }
#pragma unroll
        for (int e = 0; e < 8; ++e) acc[e] = acc[e] / (1.0f + __expf(-acc[e])) * ksc;
        v4u o; o.x = pk2(acc[0], acc[1]); o.y = pk2(acc[2], acc[3]); o.z = pk2(acc[4], acc[5]); o.w = pk2(acc[6], acc[7]);
        *(v4u*)(dst + (size_t)tok * 1024 + c8) = o;
    }
}
constexpr int ML_KS = 272, ML_VS = 528;
constexpr int ML_K = 0, ML_V = 64 * ML_KS;
__device__ __forceinline__ void mlstm_p1_phase(Frame& F) {
    const int lane = F.lane, r32 = lane & 31, h = lane >> 5, w = F.wave, tid = F.tid;
    LAS unsigned char* kt = F.lds + ML_K; LAS unsigned char* vt = F.lds + ML_V;
    for (int u = F.vcu; u < 512; u += F.G) {
        const int bh = u >> 5, sc = u & 31, b = bh >> 2, hh = bh & 3;
        const float mend = WSP(float, WS_SCM)[bh * T + 256 * sc + 255];
        const float* av = WSP(float, WS_SCA) + bh * T + 256 * sc;
        f32x16 acc[4]; float nacc = 0.f;
#pragma unroll
        for (int i = 0; i < 4; ++i) acc[i] = (f32x16){};
        for (int c4 = 0; c4 < 4; ++c4) {
            __syncthreads();
            { const int row = tid >> 3, ch = tid & 7; const size_t tok = (size_t)b * T + 256 * sc + 64 * c4 + row;
              const float wgt = __expf(av[64 * c4 + row] - mend);
              const bf16* kp = WSP(bf16, WS_QKC) + tok * 1024 + 512 + hh * 128 + ch * 16;
#pragma unroll
              for (int q = 0; q < 2; ++q) { const v4u x = *(const v4u*)(kp + 8 * q); v4u y;
                  y.x = pk2(bflo(x.x) * wgt, bfhi(x.x) * wgt); y.y = pk2(bflo(x.y) * wgt, bfhi(x.y) * wgt); y.z = pk2(bflo(x.z) * wgt, bfhi(x.z) * wgt); y.w = pk2(bflo(x.w) * wgt, bfhi(x.w) * wgt);
                  *(LAS v4u*)(kt + row * ML_KS + (ch * 16 + 8 * q) * 2) = y; }
              const bf16* vp = WSP(bf16, WS_V1) + tok * 1024 + hh * 256 + ch * 32;
#pragma unroll
              for (int q = 0; q < 4; ++q) *(LAS v4u*)(vt + row * ML_VS + (ch * 32 + 8 * q) * 2) = *(const v4u*)(vp + 8 * q); }
            __syncthreads();
            if (tid < 128) { float s = 0.f;
#pragma unroll 8
                for (int row = 0; row < 64; ++row) s += bf2f(*(LAS bf16*)(kt + row * ML_KS + tid * 2));
                nacc += s; }
            LAS unsigned char* klb = kt + ((lane & 15) >> 2) * ML_KS + (16 * ((lane >> 4) & 1) + 4 * (lane & 3)) * 2 + 8 * h * ML_KS;
            LAS unsigned char* vlb = vt + ((lane & 15) >> 2) * ML_VS + (16 * ((lane >> 4) & 1) + 4 * (lane & 3)) * 2 + 8 * h * ML_VS + 64 * w;
#pragma unroll
            for (int s = 0; s < 4; ++s) {
                const bf16x8 a = frag_tr(vlb, 16 * s * ML_VS, (16 * s + 4) * ML_VS);
#pragma unroll
                for (int dkt = 0; dkt < 4; ++dkt) acc[dkt] = mfma32(a, frag_tr(klb, 16 * s * ML_KS + 64 * dkt, (16 * s + 4) * ML_KS + 64 * dkt), acc[dkt]);
            }
        }
        float* lt = WSP(float, WS_LT) + (size_t)u * 32768;
#pragma unroll
        for (int dkt = 0; dkt < 4; ++dkt)
#pragma unroll
            for (int r = 0; r < 16; ++r) lt[(32 * w + crow(r, h)) * 128 + 32 * dkt + r32] = acc[dkt][r];
        if (tid < 128) WSP(float, WS_NLOC)[u * 128 + tid] = nacc;
    }
    __syncthreads();
}
__device__ __forceinline__ void mlstm_scan_phase(Frame& F) {
    const int gt = F.vcu * 512 + F.tid, NT = F.G * 512;
    for (int item = gt; item < 16 * 8192; item += NT) {
        const int bh = item >> 13, e4 = (item & 8191) * 4; f32x4 C = {0.f, 0.f, 0.f, 0.f}; float mprev = 0.f;
        const float* mx = WSP(float, WS_SCM) + bh * T;
        for (int sc = 0; sc < 32; ++sc) {
            const size_t off = ((size_t)(bh * 32 + sc)) * 32768 + e4;
            v2u pk; pk.x = pk2(C[0], C[1]); pk.y = pk2(C[2], C[3]); *(v2u*)(WSP(bf16, WS_CST) + off) = pk;
            const float mend = mx[256 * sc + 255], dec = __expf(mprev - mend); mprev = mend;
            const f32x4 L = *(const f32x4*)(WSP(float, WS_LT) + off);
            C = C * dec + L;
        }
    }
    for (int item = gt; item < 16 * 128; item += NT) {
        const int bh = item >> 7, dk = item & 127; float nn = 0.f, mprev = 0.f; const float* mx = WSP(float, WS_SCM) + bh * T;
        for (int sc = 0; sc < 32; ++sc) { const int u = bh * 32 + sc; WSP(float, WS_NST)[u * 128 + dk] = nn;
            const float mend = mx[256 * sc + 255], dec = __expf(mprev - mend); mprev = mend; nn = nn * dec + WSP(float, WS_NLOC)[u * 128 + dk]; }
    }
}
constexpr int M3_C = 0, M3_K = 128 * ML_KS, M3_V = M3_K + 32 * ML_KS, M3_A = M3_V + 32 * ML_KS, M3_N = M3_A + 1024, M3_Q = M3_N + 512, M3_END = M3_Q + 256 * ML_KS;
static_assert(M3_END <= RING_BYTES, "mlstm p3 LDS");
__device__ __forceinline__ void mlstm_p3_phase(Frame& F) {
    const int w = F.wave, tid = F.tid;
    LAS unsigned char* ct = F.lds + M3_C; LAS unsigned char* kt = F.lds + M3_K; LAS unsigned char* vt = F.lds + M3_V;
    LAS float* als = (LAS float*)(F.lds + M3_A); LAS float* nls = (LAS float*)(F.lds + M3_N);
    for (int u = F.vcu; u < 512; u += F.G) {
        int lane_ = F.lane; asm volatile("" : "+v"(lane_));
        const int r32 = lane_ & 31, h = lane_ >> 5;
        LAS unsigned char* vlb = vt + ((lane_ & 15) >> 2) * ML_KS + (16 * ((lane_ >> 4) & 1) + 4 * (lane_ & 3)) * 2 + 4 * h * ML_KS;
        LAS unsigned char* klb = kt + r32 * ML_KS + 16 * h; LAS unsigned char* clb = ct + r32 * ML_KS + 16 * h;
        LAS unsigned char* qlb = F.lds + M3_Q + (32 * w + r32) * ML_KS + 16 * h;
        const int bh = u >> 5, sc = u & 31, b = bh >> 2, hh = bh & 3;
        const size_t tok0 = (size_t)b * T + 256 * sc;
        const int tl = 32 * w + r32;
        const size_t tokq = tok0 + tl;
        const float Mt = WSP(float, WS_SCM)[bh * T + 256 * sc + tl];
        const float mprev = sc ? WSP(float, WS_SCM)[bh * T + 256 * sc - 1] : 0.f;
        const float winter = __expf(mprev - Mt);
        float dsum = 0.f, hdiv = 0.f;
#pragma unroll 1
        for (int pass = 0; pass < 2; ++pass) {
            __syncthreads();
            { const bf16* cs = WSP(bf16, WS_CST) + (size_t)u * 32768 + pass * 16384;
#pragma unroll
              for (int q = 0; q < 4; ++q) { const int idx = q * 512 + tid, row = idx >> 4, ch = idx & 15; *(LAS v4u*)(ct + row * ML_KS + ch * 16) = *(const v4u*)(cs + row * 128 + ch * 8); }
              if (pass == 0) {
#pragma unroll
                  for (int q = 0; q < 8; ++q) { const int idx = q * 512 + tid, row = idx >> 4, ch = idx & 15; *(LAS v4u*)(F.lds + M3_Q + row * ML_KS + ch * 16) = *(const v4u*)(WSP(bf16, WS_QKC) + (tok0 + row) * 1024 + hh * 128 + ch * 8); }
                  if (tid < 256) als[tid] = WSP(float, WS_SCA)[bh * T + 256 * sc + tid];
                               if (tid < 128) nls[tid] = WSP(float, WS_NST)[u * 128 + tid]; } }
            __syncthreads();
            f32x16 acc[4];
#pragma unroll
            for (int dvt = 0; dvt < 4; ++dvt) { f32x16 a = {};
#pragma unroll
                for (int s = 0; s < 8; ++s) a = mfma32(*(const LAS bf16x8*)(clb + 32 * dvt * ML_KS + 32 * s), *(const LAS bf16x8*)(qlb + 32 * s), a);
                acc[dvt] = a * winter; __builtin_amdgcn_sched_barrier(0); }
            for (int ktile = 0; ktile < 8; ++ktile) {
                __syncthreads();
                { const int row = tid >> 4, ch = tid & 15; const size_t tk = tok0 + 32 * ktile + row;
                  *(LAS v4u*)(kt + row * ML_KS + ch * 16) = *(const v4u*)(WSP(bf16, WS_QKC) + tk * 1024 + 512 + hh * 128 + ch * 8);
                  *(LAS v4u*)(vt + row * ML_KS + ch * 16) = *(const v4u*)(WSP(bf16, WS_V1) + tk * 1024 + hh * 256 + pass * 128 + ch * 8); }
                __syncthreads();
                if (ktile <= w) {
                    f32x16 s = {};
#pragma unroll
                    for (int st = 0; st < 8; ++st) s = mfma32(*(const LAS bf16x8*)(klb + 32 * st), *(const LAS bf16x8*)(qlb + 32 * st), s);
                    __builtin_amdgcn_sched_barrier(0);
                    float ds = 0.f;
#pragma unroll
                    for (int r = 0; r < 16; ++r) { const int key = 32 * ktile + crow(r, h); const float wg = __expf(als[key] - Mt); s[r] = (key <= tl) ? s[r] * wg : 0.f; ds += s[r]; }
                    if (pass == 0) dsum += ds;
                    const bf16x8 p0 = pack8<0>(s), p1 = pack8<1>(s);
#pragma unroll
                    for (int dvt = 0; dvt < 4; ++dvt) {
                        acc[dvt] = mfma32(frag_tr(vlb, 64 * dvt, 8 * ML_KS + 64 * dvt), p0, acc[dvt]);
                        acc[dvt] = mfma32(frag_tr(vlb, 16 * ML_KS + 64 * dvt, 24 * ML_KS + 64 * dvt), p1, acc[dvt]);
                        __builtin_amdgcn_sched_barrier(0);
                    }
                }
            }
            if (pass == 0) {
                float qn = 0.f;
#pragma unroll
                for (int s = 0; s < 8; ++s) { const v4u qq = *(const LAS v4u*)(qlb + 32 * s); const LAS float* np = nls + 16 * s + 8 * h;
                    qn += bflo(qq.x) * np[0] + bfhi(qq.x) * np[1] + bflo(qq.y) * np[2] + bfhi(qq.y) * np[3] + bflo(qq.z) * np[4] + bfhi(qq.z) * np[5] + bflo(qq.w) * np[6] + bfhi(qq.w) * np[7]; }
                dsum += __shfl_xor(dsum, 32); qn += __shfl_xor(qn, 32);
                const float den = winter * qn + dsum, emt = WSP(float, WS_SCE)[bh * T + 256 * sc + tl];
                hdiv = 1.0f / fmaxf(fabsf(den), emt);
            }
            const bf16* og = WSP(bf16, WS_OG) + tokq * 1024 + hh * 256 + pass * 128 + 4 * h; bf16* op = WSP(bf16, WS_QKP) + tokq * 1024 + hh * 256 + pass * 128 + 4 * h;
#pragma unroll
            for (int dvt = 0; dvt < 4; ++dvt)
#pragma unroll
                for (int q = 0; q < 4; ++q) { const v2u g2 = *(const v2u*)(og + 32 * dvt + 8 * q);
                    const float o0 = acc[dvt][4 * q] * hdiv / (1.0f + __expf(-bflo(g2.x))), o1 = acc[dvt][4 * q + 1] * hdiv / (1.0f + __expf(-bfhi(g2.x)));
                    const float o2 = acc[dvt][4 * q + 2] * hdiv / (1.0f + __expf(-bflo(g2.y))), o3 = acc[dvt][4 * q + 3] * hdiv / (1.0f + __expf(-bfhi(g2.y)));
                    v2u pk; pk.x = pk2(o0, o1); pk.y = pk2(o2, o3); *(v2u*)(op + 32 * dvt + 8 * q) = pk; __builtin_amdgcn_sched_barrier(0); }
        }
    }
    __syncthreads();
}
__device__ __forceinline__ void final_norm_phase(Frame& F) {
    const int gw = F.vcu * NWAVES + F.wave, NGW = F.G * NWAVES, lane = F.lane;
    const pg8::RowScale R{nullptr, WSP(float, WS_PSUM)};
    f32x4 gv[4];
#pragma unroll
    for (int j = 0; j < 4; ++j) gv[j] = ((const f32x4*)F.in[22])[lane + 64 * j];
    for (int m = gw; m < M; m += NGW) { const float rs = pg8::row_scale(R, m); f32x4* xr = (f32x4*)(F.out + (size_t)m * D) + lane;
#pragma unroll
        for (int j = 0; j < 4; ++j) xr[64 * j] = xr[64 * j] * rs * gv[j]; }
}
#ifndef SKIPMASK
#define SKIPMASK 0
#endif
#define RUNP(n, call) do { if (!((SKIPMASK >> (n)) & 1)) { call; } } while (0)
struct Args { const float* in[23]; float* out; unsigned char* ws; int ph_lo, ph_hi; };
__global__ void __launch_bounds__(NWAVES * 64, 2) mk_fwd(Args args) {
    extern __shared__ __attribute__((aligned(16))) unsigned char lds[];
    Frame F;
    F.lds = (LAS unsigned char*)lds;
    F.MISC = (volatile LAS unsigned*)(F.lds + MISC_OFF);
    F.tid = threadIdx.x; F.lane = F.tid & 63; F.wave = __builtin_amdgcn_readfirstlane(F.tid >> 6);
    F.G = gridDim.x; { const int bx = blockIdx.x; F.vcu = (F.G % 8 == 0) ? (bx % 8) * (F.G / 8) + bx / 8 : bx; }
    F.ws = args.ws; F.ctl = (gu32*)(args.ws + WS_CTL); F.out = args.out;
#pragma unroll
    for (int i = 0; i < 23; ++i) F.in[i] = args.in[i];
    for (int u = F.tid; u < (LDS_BYTES - LDSCTL_OFF) / 4; u += NWAVES * 64) ((LAS unsigned*)(F.lds + LDSCTL_OFF))[u] = 0u;
    __syncthreads();
    const int lo = args.ph_lo, hi = args.ph_hi;
    XcdBarrier bar; bar.bar = (unsigned*)(F.ctl + CW_BAR); bar.x = 0; bar.st = nullptr;
    if (hi - lo > 1) bar = xcd_barrier_post((unsigned*)(F.ctl + CW_BAR), F.MISC + 8);

#define IN(k) (lo <= (k) && (k) < hi)
#define SEAM(k) do { if (IN(k) && IN((k) + 1)) xcd_barrier(bar); } while (0)
#define GEMM_PH(EPI, gg, ee) do { pg8::StaticOrder S_; S_.init(M, (gg).N, F.G, (int)blockIdx.x); pg8::gemm_phase<EPI, pg8::StaticOrder, PG8_ALIGN, PG8_SP2>(F.lds + RING_OFF, gg, S_, ee); } while (0)
    if (IN(0)) { RUNP(0, p0_prologue(F)); } SEAM(0);
    if (IN(1)) { const pg8::Gemm g{WSP(bf16, WS_H16), WSP(bf16, WS_WAB), M, 2048, 1024};
        const pg8::EpiScaleBf16 e{WSP(bf16, WS_QKV0), 2048, {WSP(float, WS_RS0), nullptr}, 0, 0};
        RUNP(16, GEMM_PH(pg8::EpiScaleBf16, g, e)); RUNP(19, gates0_phase(F)); } SEAM(1);
    if (IN(2)) { RUNP(2, compress_phase(F)); } SEAM(2);
    if (IN(3)) { RUNP(3, attention_phase(F)); } SEAM(3);
    if (IN(4)) { const pg8::Gemm g{WSP(bf16, WS_ATT), WSP(bf16, WS_WABO), M, 1024, 1024};
        const pg8::EpiResid e{F.in[0], F.out, WSP(bf16, WS_H16), WSP(float, WS_PSUM), D};
        RUNP(17, GEMM_PH(pg8::EpiResid, g, e)); } SEAM(4);
    if (IN(5)) { const pg8::Gemm g{WSP(bf16, WS_H16), WSP(bf16, WS_WUP0), M, 5632, 1024};
        const pg8::EpiSwiglu e{WSP(bf16, WS_HID), FF, {nullptr, WSP(float, WS_PSUM)}};
        RUNP(18, GEMM_PH(pg8::EpiSwiglu, g, e)); } SEAM(5);
    if (IN(6)) { const pg8::Gemm g{WSP(bf16, WS_HID), WSP(bf16, WS_WDN0), M, 1024, FF};
        const pg8::EpiResid e{F.out, F.out, WSP(bf16, WS_H16), WSP(float, WS_PSUM), D};
        RUNP(17, GEMM_PH(pg8::EpiResid, g, e)); } SEAM(6);
    if (IN(7)) { const pg8::Gemm g{WSP(bf16, WS_H16), WSP(bf16, WS_WCIN), M, 3072, 1024};
        const pg8::EpiScaleBf16 e{WSP(bf16, WS_QKP), 1024, {nullptr, WSP(float, WS_PSUM)}, 1024, (size_t)(64 * MiB / 2)};
        RUNP(16, GEMM_PH(pg8::EpiScaleBf16, g, e)); RUNP(20, gates1_phase(F)); } SEAM(7);
    if (IN(8)) { RUNP(8, conv_scan_phase(F)); } SEAM(8);
    if (IN(9)) { RUNP(9, mlstm_p1_phase(F)); } SEAM(9);
    if (IN(10)) { RUNP(10, mlstm_scan_phase(F)); } SEAM(10);
    if (IN(11)) { RUNP(11, mlstm_p3_phase(F)); } SEAM(11);
    if (IN(12)) { const pg8::Gemm g{WSP(bf16, WS_QKP), WSP(bf16, WS_WCO), M, 1024, 1024};
        const pg8::EpiResid e{F.out, F.out, WSP(bf16, WS_H16), WSP(float, WS_PSUM), D};
        RUNP(17, GEMM_PH(pg8::EpiResid, g, e)); } SEAM(12);
    if (IN(13)) { const pg8::Gemm g{WSP(bf16, WS_H16), WSP(bf16, WS_WUP1), M, 5632, 1024};
        const pg8::EpiSwiglu e{WSP(bf16, WS_HID), FF, {nullptr, WSP(float, WS_PSUM)}};
        RUNP(18, GEMM_PH(pg8::EpiSwiglu, g, e)); } SEAM(13);
    if (IN(14)) { const pg8::Gemm g{WSP(bf16, WS_HID), WSP(bf16, WS_WDN1), M, 1024, FF};
        const pg8::EpiResid e{F.out, F.out, WSP(bf16, WS_H16), WSP(float, WS_PSUM), D};
        RUNP(17, GEMM_PH(pg8::EpiResid, g, e)); } SEAM(14);
    if (IN(15)) { RUNP(15, final_norm_phase(F)); }
}

extern "C" void kernel_launch(void* const* d_in, const int* in_sizes, int n_in, void* d_out, int out_size, void* d_ws, size_t ws_size, hipStream_t stream) {
    static int grid = 0;
    if (grid == 0) {
        if (n_in != 23 || in_sizes[0] != M * D || out_size != M * D || ws_size < WS_END) { fprintf(stderr, "kernel_launch: shape/workspace mismatch (n_in %d, in0 %d, out %d, ws %zu, need %zu); nothing launched\n", n_in, n_in > 0 ? in_sizes[0] : -1, out_size, ws_size, (size_t)WS_END); grid = -1; return; }
        int dev = 0, cus = 0, per_cu = 0;
        if (hipGetDevice(&dev) != hipSuccess || hipDeviceGetAttribute(&cus, hipDeviceAttributeMultiprocessorCount, dev) != hipSuccess) { grid = -1; return; }
        if (hipFuncSetAttribute((const void*)mk_fwd, hipFuncAttributeMaxDynamicSharedMemorySize, LDS_BYTES) != hipSuccess) { fprintf(stderr, "kernel_launch: hipFuncSetAttribute failed\n"); grid = -1; return; }
        if (hipOccupancyMaxActiveBlocksPerMultiprocessor(&per_cu, (const void*)mk_fwd, NWAVES * 64, LDS_BYTES) != hipSuccess || per_cu < 1) { fprintf(stderr, "kernel_launch: occupancy query says %d blocks per CU\n", per_cu); per_cu = 1; }
        (void)hipGetLastError();
        grid = cus;
    }
    if (grid < 0) return;
    if (hipMemsetAsync((char*)d_ws + WS_CTL, 0, CTL_ZERO_BYTES, stream) != hipSuccess) { fprintf(stderr, "kernel_launch: memset failed\n"); return; }
    Args a{};
    for (int i = 0; i < 23; ++i) a.in[i] = (const float*)d_in[i];
    a.out = (float*)d_out; a.ws = (unsigned char*)d_ws;
#if MK_PER_PHASE
    for (int p = 0; p < NPHASE; ++p) { a.ph_lo = p; a.ph_hi = p + 1; hipLaunchKernelGGL(mk_fwd, dim3(grid), dim3(NWAVES * 64), LDS_BYTES, stream, a); }
#else
    a.ph_lo = 0; a.ph_hi = NPHASE;
    hipLaunchKernelGGL(mk_fwd, dim3(grid), dim3(NWAVES * 64), LDS_BYTES, stream, a);
#endif
    const hipError_t le = hipPeekAtLastError();
    if (le != hipSuccess) fprintf(stderr, "kernel_launch: launch failed: %s\n", hipGetErrorName(le));
}
```

```cpp
#include <hip/hip_runtime.h>
#include <cstdio>
#include <cstdint>
#include <cmath>
namespace pg8 {
#define PG8_LAS __attribute__((address_space(3)))
typedef unsigned short bf16_t;
typedef short bf16x8 __attribute__((ext_vector_type(8)));
typedef float f32x4 __attribute__((ext_vector_type(4)));
typedef unsigned u32x4 __attribute__((ext_vector_type(4)));
constexpr int BM = 256, BK = 64, HALF = 128, HTB = HALF * BK * 2  , STAGE_BYTES = 8 * HTB, NXCD = 8, WGM = 8;

__host__ __device__ __forceinline__ int lds_byte(int r, int c) { const int st = (r >> 4) * 2 + (c >> 5), rr = r & 15, cc = c & 31, ob = rr * 64 + cc * 2; return st * 1024 + (ob ^ (((ob >> 9) & 1) << 5)); }
__host__ __device__ __forceinline__ void stage_rc(int b, int& R, int& C) { const int st = b / 1024, sb = b % 1024, swz = sb ^ (((sb >> 9) & 1) << 5); R = (st >> 1) * 16 + swz / 64; C = (st & 1) * 32 + (swz % 64) / 2; }
__host__ __device__ __forceinline__ int perm32(int rho) { const int n = rho >> 4, i = rho & 15; return 8 * (i >> 2) + 4 * n + (i & 3); }

struct Unit { int pm, pn; };
struct Gemm { const bf16_t* A; const bf16_t* Bt; int M, N, K; };

struct StaticOrder {
    int nM, nN, nwg, G, c;
    __host__ __device__ void init(int M, int N, int G_, int c_) { nM = M / BM; nN = N / BM; nwg = nM * nN; G = G_; c = c_; }
    __host__ __device__ bool next(int i, Unit& u) const {
        const long L = (long)i * G + c; if (L >= nwg) return false;
        int wgid = (int)L; { const int q = nwg / NXCD, r = nwg % NXCD, xcd = wgid % NXCD, off = wgid / NXCD; wgid = (xcd < r ? xcd * (q + 1) : r * (q + 1) + (xcd - r) * q) + off; }
        const int nig = WGM * nN, gid = wgid / nig, fm = gid * WGM, gsz = (nM - fm) < WGM ? (nM - fm) : WGM;
        u.pm = fm + ((wgid % nig) % gsz); u.pn = (wgid % nig) / gsz; return true;
    }
    __device__ __forceinline__ void a_ready(const Unit&) const {}
    __device__ __forceinline__ void done(const Unit&) const {}
};

__device__ __forceinline__ unsigned cvt_pk_bf16(float lo, float hi) { unsigned r; asm volatile("v_cvt_pk_bf16_f32 %0, %1, %2" : "=v"(r) : "v"(lo), "v"(hi)); return r; }
typedef float f32x2 __attribute__((ext_vector_type(2)));
constexpr int MROWS = 32768;
constexpr float RMS_EPS_F = 1e-6f;
struct RowScale { const float* rs; const float* psum; };
__device__ __forceinline__ float row_scale(const RowScale& R, int row) {
    if (R.psum) { float s = 0.f;
#pragma unroll
        for (int j = 0; j < 16; ++j) s += R.psum[(size_t)j * MROWS + row];
        return 1.0f / sqrtf(s * (1.0f / 1024.0f) + RMS_EPS_F); }
    return R.rs[row];
}
struct EpiScaleBf16 {
    static constexpr bool PERM = true, AFTER_DRAIN = false;
    bf16_t* O; int ldc; RowScale R; int split_cols; size_t split_stride;
    __device__ __forceinline__ void operator()(const f32x4 (&acc)[2][2][4][2], const Unit& u, int wr, int wc, int fr, int fq) const {
        const int row0 = u.pm * BM + wr * 64 + fr; int colt = u.pn * BM; bf16_t* base = O;
        if (split_cols) { const int t = colt / split_cols; base += (size_t)t * split_stride; colt -= t * split_cols; }
        const int col0 = colt + wc * 32 + 8 * fq;
#pragma unroll
        for (int ai = 0; ai < 2; ++ai)
#pragma unroll
            for (int m = 0; m < 4; ++m) { const int row = row0 + ai * HALF + m * 16; const float sc = row_scale(R, row); bf16_t* rowp = base + (size_t)row * ldc + col0;
#pragma unroll
                for (int bj = 0; bj < 2; ++bj) { f32x4 v0 = acc[ai][bj][m][0] * sc, v1 = acc[ai][bj][m][1] * sc;
                    u32x4 w; w.x = cvt_pk_bf16(v0[0], v0[1]); w.y = cvt_pk_bf16(v0[2], v0[3]); w.z = cvt_pk_bf16(v1[0], v1[1]); w.w = cvt_pk_bf16(v1[2], v1[3]);
                    *(u32x4*)(rowp + bj * HALF) = w; } }
    }
};
struct EpiSwiglu {
    static constexpr bool PERM = true, AFTER_DRAIN = false;
    bf16_t* O; int ldc; RowScale R;
    __device__ __forceinline__ void operator()(const f32x4 (&acc)[2][2][4][2], const Unit& u, int wr, int wc, int fr, int fq) const {
        const int row0 = u.pm * BM + wr * 64 + fr; const int col0 = u.pn * HALF + wc * 32 + 8 * fq;
#pragma unroll
        for (int ai = 0; ai < 2; ++ai)
#pragma unroll
            for (int m = 0; m < 4; ++m) { const int row = row0 + ai * HALF + m * 16; const float sc = row_scale(R, row); bf16_t* rowp = O + (size_t)row * ldc + col0;
                float o[8];
#pragma unroll
                for (int n = 0; n < 2; ++n)
#pragma unroll
                    for (int e = 0; e < 4; ++e) { const float g = acc[ai][0][m][n][e] * sc, up = acc[ai][1][m][n][e] * sc; o[n * 4 + e] = g * up / (1.0f + __expf(-g)); }
                u32x4 w; w.x = cvt_pk_bf16(o[0], o[1]); w.y = cvt_pk_bf16(o[2], o[3]); w.z = cvt_pk_bf16(o[4], o[5]); w.w = cvt_pk_bf16(o[6], o[7]);
                *(u32x4*)rowp = w; }
    }
};
struct EpiResid {
    static constexpr bool PERM = false, AFTER_DRAIN = false;
    const float* base; float* out; bf16_t* h16; float* psum; int ldc;
    __device__ __forceinline__ void operator()(const f32x4 (&acc)[2][2][4][2], const Unit& u, int wr, int wc, int fr, int fq) const {
        typedef unsigned u32x2v __attribute__((ext_vector_type(2)));
        const int row0 = u.pm * BM + wr * 64 + fr, col0 = u.pn * BM + wc * 32 + 4 * fq;
#pragma unroll
        for (int ai = 0; ai < 2; ++ai)
#pragma unroll
            for (int m = 0; m < 4; ++m) { const int row = row0 + ai * HALF + m * 16; const size_t off = (size_t)row * ldc + col0; float ss = 0.f;
#pragma unroll
                for (int bj = 0; bj < 2; ++bj)
#pragma unroll
                    for (int n = 0; n < 2; ++n) { const f32x4 bs = *(const f32x4*)(base + off + bj * HALF + n * 16); const f32x4 o = bs + acc[ai][bj][m][n];
                        *(f32x4*)(out + off + bj * HALF + n * 16) = o; ss += (o[0] * o[0] + o[1] * o[1]) + (o[2] * o[2] + o[3] * o[3]);
                        u32x2v w; w.x = cvt_pk_bf16(o[0], o[1]); w.y = cvt_pk_bf16(o[2], o[3]); *(u32x2v*)(h16 + off + bj * HALF + n * 16) = w; }
                ss += __shfl_xor(ss, 16); ss += __shfl_xor(ss, 32);
                if (fq == 0) psum[(size_t)(u.pn * 4 + wc) * MROWS + row] = ss; }
    }
};
template <class Epi, class Sched, bool ALIGN_EPI = false, bool SP2 = false>
__device__ __forceinline__ void gemm_phase(PG8_LAS unsigned char* lds, const Gemm g, const Sched& S, const Epi& E) {
    const int tid = threadIdx.x, wid = __builtin_amdgcn_readfirstlane(tid >> 6), lane = tid & 63, wr = wid >> 2, wc = wid & 3, fr = lane & 15, fq = lane >> 4;
    const int K = g.K, nt = K / BK;
    unsigned voffA[2], voffB[2];
#pragma unroll
    for (int i = 0; i < 2; ++i) { int R, C; stage_rc(tid * 16 + i * 8192, R, C); const int Rb = Epi::PERM ? ((R & ~31) + perm32(R & 31)) : R;
        voffA[i] = (unsigned)(R * K + C) * 2u; voffB[i] = (unsigned)(Rb * K + C) * 2u; }
    const size_t kstep = (size_t)(BK * 2);
    const size_t hstep = (size_t)HALF * K * 2;
    const size_t tstep = 2 * hstep;
    const unsigned ldsw = (unsigned)wid * 1024u;
    const int aoff = lds_byte(wr * 64 + fr, fq * 8), boff = lds_byte(wc * 32 + fr, fq * 8);
#define PG8_SA(b, h) (((b) * 2 + (h)) * HTB)
#define PG8_SB(b, h) ((4 + (b) * 2 + (h)) * HTB)
#define PG8_STAGE(bufoff, gbase, voff) do { _Pragma("unroll") for (int _i = 0; _i < 2; ++_i) \
        __builtin_amdgcn_global_load_lds((const unsigned*)((const char*)(gbase) + (voff)[_i]), (PG8_LAS unsigned*)(lds + (bufoff) + ldsw + _i * 8192), 16, 0, 0); } while (0)
#define PG8_LDA(dst, b, h) do { _Pragma("unroll") for (int m = 0; m < 4; ++m) _Pragma("unroll") for (int k = 0; k < 2; ++k) dst[m][k] = *(const PG8_LAS bf16x8*)(lds + PG8_SA(b, h) + aoff + m * 2048 + k * 1024); } while (0)
#define PG8_LDB(dst, b, h) do { _Pragma("unroll") for (int n = 0; n < 2; ++n) _Pragma("unroll") for (int k = 0; k < 2; ++k) dst[n][k] = *(const PG8_LAS bf16x8*)(lds + PG8_SB(b, h) + boff + n * 2048 + k * 1024); } while (0)
#define PG8_MMA(ai, bj, At, Bt) do { __builtin_amdgcn_s_setprio(1); _Pragma("unroll") for (int m = 0; m < 4; ++m) _Pragma("unroll") for (int n = 0; n < 2; ++n) _Pragma("unroll") for (int k = 0; k < 2; ++k) \
        acc[ai][bj][m][n] = __builtin_amdgcn_mfma_f32_16x16x32_bf16(Bt[n][k], At[m][k], acc[ai][bj][m][n], 0, 0, 0); __builtin_amdgcn_s_setprio(0); } while (0)
#define PG8_WAIT_V(n) asm volatile("s_waitcnt vmcnt(" #n ")" ::: "memory")
#define PG8_WAIT_L(n) asm volatile("s_waitcnt lgkmcnt(" #n ")" ::: "memory")
#define PG8_BAR __builtin_amdgcn_s_barrier()
#define PG8_SCHED __builtin_amdgcn_sched_barrier(0)
    Unit cur, nxt; int ui = 0;
    if (!S.next(0, cur)) return;
    f32x4 acc[2][2][4][2];
#pragma unroll
    for (int a = 0; a < 2; ++a)
#pragma unroll
        for (int b = 0; b < 2; ++b)
#pragma unroll
            for (int m = 0; m < 4; ++m)
#pragma unroll
                for (int n = 0; n < 2; ++n) acc[a][b][m][n] = (f32x4){0.f, 0.f, 0.f, 0.f};
    bf16x8 At[4][2], B0[2][2], B1[2][2];
    const char* cA = (const char*)g.A + (size_t)cur.pm * tstep; const char* cB = (const char*)g.Bt + (size_t)cur.pn * tstep;
    S.a_ready(cur);
    if constexpr (SP2) {
        PG8_STAGE(PG8_SB(0, 0), cB, voffB); PG8_STAGE(PG8_SB(0, 1), cB + hstep, voffB); PG8_STAGE(PG8_SA(0, 0), cA, voffA); PG8_STAGE(PG8_SA(0, 1), cA + hstep, voffA);
        if (wr == 1) PG8_BAR;
        PG8_WAIT_V(2); PG8_BAR;
        PG8_STAGE(PG8_SB(1, 0), cB + kstep, voffB); PG8_STAGE(PG8_SA(1, 0), cA + kstep, voffA); PG8_STAGE(PG8_SB(1, 1), cB + hstep + kstep, voffB);
        PG8_WAIT_V(6); PG8_BAR;
    } else {
        PG8_STAGE(PG8_SB(0, 0), cB, voffB); PG8_STAGE(PG8_SA(0, 0), cA, voffA); PG8_STAGE(PG8_SB(0, 1), cB + hstep, voffB); PG8_STAGE(PG8_SA(0, 1), cA + hstep, voffA);
        if (wr == 1) PG8_BAR;
        PG8_WAIT_V(4); PG8_BAR;
        PG8_STAGE(PG8_SB(1, 0), cB + kstep, voffB); PG8_STAGE(PG8_SA(1, 0), cA + kstep, voffA); PG8_STAGE(PG8_SB(1, 1), cB + hstep + kstep, voffB);
        PG8_WAIT_V(6); PG8_BAR;
    }
    for (;;) {
        const bool has_next = S.next(ui + 1, nxt);
        const char* nA = has_next ? (const char*)g.A + (size_t)nxt.pm * tstep : cA; const char* nB = has_next ? (const char*)g.Bt + (size_t)nxt.pn * tstep : cB;
        for (int t = 0; t < nt; t += 2) {
            const bool last = (t == nt - 2);
            const char* a1 = cA + (size_t)(t + 1) * kstep;
            const char* a2 = last ? nA : cA + (size_t)(t + 2) * kstep; const char* b2 = last ? nB : cB + (size_t)(t + 2) * kstep;
            const char* a3 = a2 + kstep; const char* b3 = b2 + kstep;
            if (last && has_next) S.a_ready(nxt);
            if constexpr (SP2) {
            PG8_LDB(B0, 0, 0); PG8_LDB(B1, 0, 1); PG8_SCHED; PG8_LDA(At, 0, 0); PG8_STAGE(PG8_SA(1, 1), a1 + hstep, voffA);
            PG8_WAIT_V(8); PG8_WAIT_L(0); PG8_BAR; PG8_MMA(0, 0, At, B0); PG8_MMA(0, 1, At, B1); PG8_BAR; PG8_SCHED;
            PG8_LDA(At, 0, 1); PG8_STAGE(PG8_SB(0, 0), b2, voffB); PG8_STAGE(PG8_SB(0, 1), b2 + hstep, voffB); PG8_STAGE(PG8_SA(0, 0), a2, voffA);
            PG8_WAIT_V(8); PG8_WAIT_L(0); PG8_BAR; PG8_MMA(1, 0, At, B0); PG8_MMA(1, 1, At, B1); PG8_BAR; PG8_SCHED;
            PG8_LDB(B0, 1, 0); PG8_LDB(B1, 1, 1); PG8_SCHED; PG8_LDA(At, 1, 0); PG8_STAGE(PG8_SA(0, 1), a2 + hstep, voffA);
            PG8_WAIT_V(8); PG8_WAIT_L(0); PG8_BAR; PG8_MMA(0, 0, At, B0); PG8_MMA(0, 1, At, B1); PG8_BAR; PG8_SCHED;
            PG8_LDA(At, 1, 1); PG8_STAGE(PG8_SB(1, 0), b3, voffB); PG8_STAGE(PG8_SB(1, 1), b3 + hstep, voffB); PG8_STAGE(PG8_SA(1, 0), a3, voffA);
            PG8_WAIT_V(8); PG8_WAIT_L(0); PG8_BAR; PG8_MMA(1, 0, At, B0); PG8_MMA(1, 1, At, B1); PG8_BAR; PG8_SCHED;
            } else {
            PG8_LDB(B0, 0, 0); PG8_SCHED; PG8_LDA(At, 0, 0); PG8_STAGE(PG8_SA(1, 1), a1 + hstep, voffA);
            PG8_WAIT_L(8); PG8_BAR; PG8_WAIT_L(0); PG8_MMA(0, 0, At, B0); PG8_BAR; PG8_SCHED;
            PG8_LDB(B1, 0, 1); PG8_STAGE(PG8_SB(0, 0), b2, voffB);
            PG8_BAR; PG8_WAIT_L(0); PG8_MMA(0, 1, At, B1); PG8_BAR;
            PG8_LDA(At, 0, 1); PG8_STAGE(PG8_SA(0, 0), a2, voffA);
            PG8_BAR; PG8_WAIT_L(0); PG8_MMA(1, 0, At, B0); PG8_BAR; PG8_SCHED;
            PG8_STAGE(PG8_SB(0, 1), b2 + hstep, voffB);
            PG8_WAIT_V(6); PG8_BAR; PG8_MMA(1, 1, At, B1); PG8_BAR;
            PG8_LDB(B0, 1, 0); PG8_SCHED; PG8_LDA(At, 1, 0); PG8_STAGE(PG8_SA(0, 1), a2 + hstep, voffA);
            PG8_WAIT_L(8); PG8_BAR; PG8_WAIT_L(0); PG8_MMA(0, 0, At, B0); PG8_BAR; PG8_SCHED;
            PG8_LDB(B1, 1, 1); PG8_STAGE(PG8_SB(1, 0), b3, voffB);
            PG8_BAR; PG8_WAIT_L(0); PG8_MMA(0, 1, At, B1); PG8_BAR;
            PG8_LDA(At, 1, 1); PG8_STAGE(PG8_SA(1, 0), a3, voffA);
            PG8_BAR; PG8_WAIT_L(0); PG8_MMA(1, 0, At, B0); PG8_BAR; PG8_SCHED;
            PG8_STAGE(PG8_SB(1, 1), b3 + hstep, voffB);
            PG8_WAIT_V(6); PG8_BAR; PG8_MMA(1, 1, At, B1); PG8_BAR;
            }
        }
        if constexpr (ALIGN_EPI) { if (wr == 0) PG8_BAR; }
        if constexpr (!Epi::AFTER_DRAIN) { E(acc, cur, wr, wc, fr, fq); S.done(cur); }
        if (!has_next) break;
#pragma unroll
        for (int a = 0; a < 2; ++a)
#pragma unroll
            for (int b = 0; b < 2; ++b)
#pragma unroll
                for (int m = 0; m < 4; ++m)
#pragma unroll
                    for (int n = 0; n < 2; ++n) acc[a][b][m][n] = (f32x4){0.f, 0.f, 0.f, 0.f};
        cur = nxt; cA = nA; cB = nB; ++ui;
        if constexpr (ALIGN_EPI) { if (wr == 1) PG8_BAR; }
    }
    PG8_WAIT_V(0);
    if constexpr (!ALIGN_EPI) { if (wr == 0) PG8_BAR; }
    PG8_BAR;
    if constexpr (Epi::AFTER_DRAIN) { E.fused(acc, cur, wr, wc, fr, fq, lds, wid, lane); S.done(cur); }
#undef PG8_SA
#undef PG8_SB
#undef PG8_STAGE
#undef PG8_LDA
#undef PG8_LDB
#undef PG8_MMA
#undef PG8_WAIT_V
#undef PG8_WAIT_L
#undef PG8_BAR
#undef PG8_SCHED
}
}
#ifndef PG8_SP2
#define PG8_SP2 true
#endif
#ifndef PG8_ALIGN
#define PG8_ALIGN true
#endif
constexpr int NWAVES = 8;
#ifndef MK_PER_PHASE
#define MK_PER_PHASE 0
#endif
constexpr int NPHASE = 16;

constexpr int BATCH = 4, T = 8192, D = 1024, M = BATCH * T, FF = 2816;
constexpr int AB_LD = 2072, C_LD = 3080;
constexpr float C2 = 0.125f * 1.4426950408889634f;
constexpr float LOG2E = 1.4426950408889634f;
constexpr int QC_QN = 0, QC_KC = 512, QC_VC = 640, QC_KS = 768, QC_VS = 896, QC_KW = 1024, QC_VW = 1152, QC_QS = 1280, QC_KSW = 1792, QC_VSW = 1920;

constexpr size_t MiB = 1u << 20, KiB = 1024;
constexpr size_t WS_CTL = 0, CTL_ZERO_BYTES = 1 * MiB;
constexpr size_t WS_RS0 = 1 * MiB;
constexpr size_t WS_PSUM = WS_RS0 + 128 * KiB;
constexpr size_t WS_GATES = WS_PSUM + 2 * MiB;
constexpr size_t WS_SCA = WS_GATES + 4 * MiB;
constexpr size_t WS_SCM = WS_SCA + 512 * KiB;
constexpr size_t WS_SCE = WS_SCM + 512 * KiB;
constexpr size_t WS_KC = WS_SCE + 512 * KiB;
constexpr size_t WS_VC = WS_KC + 512 * KiB;
constexpr size_t WS_WABG = WS_VC + 512 * KiB;
constexpr size_t WS_WCG = WS_WABG + 64 * KiB;
constexpr size_t WS_CW1K = WS_WCG + 64 * KiB;
constexpr size_t WS_CW1V = WS_CW1K + 256 * KiB;
constexpr size_t WS_CW2K = WS_CW1V + 256 * KiB;
constexpr size_t WS_CW2V = WS_CW2K + 8 * KiB;
constexpr size_t WS_CBIAS = WS_CW2V + 8 * KiB;
constexpr size_t WS_NLOC = WS_CBIAS + 4 * KiB;
constexpr size_t WS_NST = WS_NLOC + 256 * KiB;
static_assert(WS_NST + 256 * KiB <= 13 * MiB, "small region");
constexpr size_t WS_WAB = 13 * MiB;
constexpr size_t WS_WABO = WS_WAB + 4 * MiB;
constexpr size_t WS_WUP0 = WS_WABO + 2 * MiB;
constexpr size_t WS_WUP1 = WS_WUP0 + 11 * MiB;
constexpr size_t WS_WDN0 = WS_WUP1 + 11 * MiB;
constexpr size_t WS_WDN1 = WS_WDN0 + 5632 * KiB;
constexpr size_t WS_WCIN = WS_WDN1 + 5632 * KiB;
constexpr size_t WS_WCO = WS_WCIN + 6 * MiB;
static_assert(WS_WCO + 2 * MiB <= 60 * MiB, "weights region");
constexpr size_t WS_H16 = 60 * MiB;
constexpr size_t WS_A = 124 * MiB;
constexpr size_t WS_QKV0 = WS_A, WS_ATT = WS_A + 128 * MiB;
constexpr size_t WS_QKP = WS_A, WS_V1 = WS_A + 64 * MiB, WS_OG = WS_A + 128 * MiB;
constexpr size_t WS_B = 316 * MiB;
constexpr size_t WS_HID = WS_B;
constexpr size_t WS_ACCF = WS_B;
constexpr size_t WS_QKC = WS_B, WS_LT = WS_B + 64 * MiB, WS_CST = WS_B + 128 * MiB;
constexpr size_t WS_END = 492 * MiB;
static_assert(WS_HID + (size_t)M * FF * 2 <= WS_END && WS_CST + 32 * MiB <= WS_END, "d_ws map");
constexpr int CW_TMO = 0, CW_CODE = 1;
constexpr int CW_BAR = 4096;

constexpr int RING_OFF = 0, RING_BYTES = 131072;
constexpr int LDSCTL_OFF = RING_BYTES, MISC_OFF = LDSCTL_OFF + 320;
constexpr int LDS_BYTES = 147456;
static_assert(MISC_OFF + 128 <= LDS_BYTES, "LDS map");

#define GAS __attribute__((address_space(1)))
#define LAS __attribute__((address_space(3)))
typedef unsigned short bf16;
typedef unsigned v4u __attribute__((ext_vector_type(4)));
typedef unsigned v2u __attribute__((ext_vector_type(2)));
typedef float f32x4 __attribute__((ext_vector_type(4)));
typedef float f32x16 __attribute__((ext_vector_type(16)));
typedef short bf16x8 __attribute__((ext_vector_type(8)));
typedef short s16x4 __attribute__((ext_vector_type(4)));
typedef GAS unsigned gu32;
typedef GAS unsigned long long gu64;
#define RLX_AGENT __ATOMIC_RELAXED, __HIP_MEMORY_SCOPE_AGENT
#define LDS_WAIT() asm volatile("s_waitcnt lgkmcnt(0)" ::: "memory")
#define VM_WAIT() asm volatile("s_waitcnt vmcnt(0)" ::: "memory")
__device__ __forceinline__ unsigned f2bf(float f) { unsigned u = __builtin_bit_cast(unsigned, f); return (u + 0x7fffu + ((u >> 16) & 1u)) >> 16; }
__device__ __forceinline__ unsigned pk2(float lo, float hi) { return f2bf(lo) | (f2bf(hi) << 16); }
__device__ __forceinline__ float bf2f(unsigned short b) { return __builtin_bit_cast(float, (unsigned)b << 16); }
__device__ __forceinline__ float bflo(unsigned w) { return __builtin_bit_cast(float, w << 16); }
__device__ __forceinline__ float bfhi(unsigned w) { return __builtin_bit_cast(float, w & 0xffff0000u); }
__device__ __forceinline__ int crow(int r, int hi) { return (r & 3) + 8 * (r >> 2) + 4 * hi; }
__device__ __forceinline__ f32x16 mfma32(bf16x8 a, bf16x8 b, f32x16 c) { return __builtin_amdgcn_mfma_f32_32x32x16_bf16(a, b, c, 0, 0, 0); }
typedef short v4i16_t __attribute__((ext_vector_type(4)));
__device__ __forceinline__ s16x4 ds_tr(LAS unsigned char* p) { return __builtin_bit_cast(s16x4, __builtin_amdgcn_ds_read_tr16_b64_v4i16((LAS v4i16_t*)p)); }
__device__ __forceinline__ bf16x8 frag_tr(LAS unsigned char* lb, int off0, int off1) {
    const s16x4 lo = ds_tr(lb + off0), hi = ds_tr(lb + off1);
    return (bf16x8){lo[0], lo[1], lo[2], lo[3], hi[0], hi[1], hi[2], hi[3]};
}
typedef float f32x2_t __attribute__((ext_vector_type(2))); typedef __bf16 bf16x2_t __attribute__((ext_vector_type(2)));
__device__ __forceinline__ unsigned cvtpk(float lo, float hi) { f32x2_t v = {lo, hi}; bf16x2_t b = __builtin_convertvector(v, bf16x2_t); return __builtin_bit_cast(unsigned, b); }
template <int s> __device__ __forceinline__ bf16x8 pack8(const f32x16& p) {
    v4u w; w.x = cvtpk(p[8 * s + 0], p[8 * s + 1]); w.y = cvtpk(p[8 * s + 2], p[8 * s + 3]); w.z = cvtpk(p[8 * s + 4], p[8 * s + 5]); w.w = cvtpk(p[8 * s + 6], p[8 * s + 7]);
    return __builtin_bit_cast(bf16x8, w);
}
__device__ __forceinline__ float wave_sum(float v) {
#pragma unroll
    for (int o = 1; o < 64; o <<= 1) v += __shfl_xor(v, o);
    return v;
}
#define XB_TMO      128
#define XB_XCNT(j)  (256  + 64 * (j))
#define XB_XSUB(j)  (1280 + 64 * (j))
#define XB_XGEN(j)  (2304 + 64 * (j))
#define XB_TOP      3328
#define XB_TOPGEN   3392
#define XCD_BAR_WORDS 3456
#define XB_SPIN_CAP (1u << 18)

__device__ __forceinline__ unsigned xb_ld(unsigned* p)              { return __hip_atomic_load(p, __ATOMIC_RELAXED, __HIP_MEMORY_SCOPE_AGENT); }
__device__ __forceinline__ unsigned xb_add(unsigned* p, unsigned v) { return __hip_atomic_fetch_add(p, v, __ATOMIC_RELAXED, __HIP_MEMORY_SCOPE_AGENT); }
__device__ __forceinline__ unsigned xb_xcc_id() { return (unsigned)__builtin_amdgcn_s_getreg((3 << 11) | 20) & 0xFu; }
#define XB_SPIN(cond, bar) do { unsigned _sp = 0; while (cond) { __builtin_amdgcn_s_sleep(1); \
    if ((++_sp & 255u) == 0u) { if (xb_ld(&(bar)[XB_TMO])) break; if (_sp > XB_SPIN_CAP) { atomicAdd(&(bar)[XB_TMO], 1u); break; } } } } while (0)

struct XcdBarrier {
    unsigned* bar; unsigned x;
    volatile LAS unsigned* st;
};

__device__ __forceinline__ XcdBarrier xcd_barrier_post(unsigned* bar, volatile LAS unsigned* st) {
    XcdBarrier b; b.bar = bar; b.x = xb_xcc_id(); b.st = st;
    if (threadIdx.x == 0) (void)xb_add(&bar[XB_XCNT(b.x)], 1u);
    return b;
}
__device__ __forceinline__ void xcd_barrier_complete(unsigned* bar, unsigned x, unsigned& nloc, unsigned& nx) {
    const unsigned G = gridDim.x * gridDim.y * gridDim.z;
    unsigned sum, cnt, mine, sp = 0u;
    for (;;) {
        sum = 0u; cnt = 0u; mine = 0u;
#pragma unroll
        for (unsigned j = 0; j < 16; ++j) { const unsigned c = xb_ld(&bar[XB_XCNT(j)]); sum += c; cnt += (c > 0u) ? 1u : 0u; mine = (j == x) ? c : mine; }
        if (sum == G) break;
        __builtin_amdgcn_s_sleep(1);
        if ((++sp & 255u) == 0u) { if (xb_ld(&bar[XB_TMO])) break; if (sp > XB_SPIN_CAP) { atomicAdd(&bar[XB_TMO], 1u); break; } }
    }
    nloc = mine > 0u ? mine : 1u; nx = cnt > 0u ? cnt : 1u;
}

__device__ __forceinline__ void xcd_barrier(const XcdBarrier& b) {
    asm volatile("s_waitcnt vmcnt(0)" ::: "memory");
    __syncthreads();
    if (threadIdx.x == 0) {
        unsigned* bar = b.bar;
        __builtin_amdgcn_s_waitcnt(0);
        unsigned nloc = b.st[0], nx = b.st[1];
        if (nloc == 0u) { xcd_barrier_complete(bar, b.x, nloc, nx); b.st[0] = nloc; b.st[1] = nx; }
        const unsigned old = xb_add(&bar[XB_XSUB(b.x)], 1u);
        const unsigned gen = old / nloc;
        if (old + 1u == (gen + 1u) * nloc) {
            __builtin_amdgcn_fence(__ATOMIC_RELEASE, "agent");
            asm volatile("s_waitcnt vmcnt(0)" ::: "memory");
            const unsigned og = xb_add(&bar[XB_TOP], 1u);
            const unsigned tg = og / nx;
            if (og + 1u == (tg + 1u) * nx) xb_add(&bar[XB_TOPGEN], 1u);
            else XB_SPIN(xb_ld(&bar[XB_TOPGEN]) == tg, bar);
            __builtin_amdgcn_fence(__ATOMIC_ACQUIRE, "agent");
            xb_add(&bar[XB_XGEN(b.x)], 1u);
            asm volatile("s_waitcnt vmcnt(0)" ::: "memory");
        } else {
            XB_SPIN(xb_ld(&bar[XB_XGEN(b.x)]) == gen, bar);
            __builtin_amdgcn_fence(__ATOMIC_ACQUIRE, "agent");
            asm volatile("s_waitcnt vmcnt(0)" ::: "memory");
        }
    }
    __syncthreads();
}
struct Frame {
    LAS unsigned char* lds;
    volatile LAS unsigned* MISC;
    gu32* ctl;
    int tid, lane, wave;
    int vcu, G;
    unsigned char* ws;
    const float* in[23];
    float* out;
};
#define WSP(T_, off) ((T_*)(F.ws + (off)))

__device__ __forceinline__ void p0_titem(const float* W, int ldw, int c0, const float* kscale, float mul, bf16* WT, int Kd, int drow0, LAS float* scr, int kb, int lane) {
    const int k0 = 64 * kb;
#pragma unroll 8
    for (int i = 0; i < 32; ++i) { const int kk = 2 * i + (lane >> 5); float v = W[(size_t)(k0 + kk) * ldw + c0 + (lane & 31)]; if (kscale) v *= kscale[k0 + kk]; scr[kk * 33 + (lane & 31)] = v * mul; }
    LDS_WAIT(); asm volatile("" ::: "memory");
    const int c = lane & 7;
#pragma unroll
    for (int j = 0; j < 4; ++j) { const int n = (lane >> 3) + 8 * j; const LAS float* s = scr + (8 * c) * 33 + n;
        v4u o; o.x = pk2(s[0 * 33], s[1 * 33]); o.y = pk2(s[2 * 33], s[3 * 33]); o.z = pk2(s[4 * 33], s[5 * 33]); o.w = pk2(s[6 * 33], s[7 * 33]);
        *(GAS v4u*)(WT + (size_t)(drow0 + n) * Kd + k0 + 8 * c) = o; }
    LDS_WAIT(); asm volatile("" ::: "memory");
}
__device__ __forceinline__ void p0_prologue(Frame& F) {
    LAS float* scr = (LAS float*)(F.lds + RING_OFF + F.wave * 16384);
    const int gw = F.vcu * NWAVES + F.wave, NGW = F.G * NWAVES, lane = F.lane;
    const float* norm_mix = F.in[1]; const float* norm_ffn = F.in[2];
    constexpr int I_AB1 = 16 * 40, I_AB2 = 16 * 24, I_ABO = 16 * 32, I_FF = 16 * 88, I_DN = 44 * 32, I_CIN = 16 * 96, I_CO = 16 * 32, I_W1 = 32 * 2, I_W2 = 2;
    constexpr int NITEMS = I_AB1 + I_AB2 + I_ABO + 4 * I_FF + 2 * I_DN + I_CIN + I_CO + 2 * I_W1 + 2 * I_W2;
    for (int it = gw; it < NITEMS; it += NGW) {
        int r = it;
        if (r < I_AB1) { const int kb = r / 40, nb = r % 40; p0_titem(F.in[6], AB_LD, 32 * nb, norm_mix, nb < 16 ? C2 : 1.f, WSP(bf16, WS_WAB), 1024, 32 * nb, scr, kb, lane); continue; } r -= I_AB1;
        if (r < I_AB2) { const int kb = r / 24, nb = r % 24; p0_titem(F.in[6], AB_LD, 1304 + 32 * nb, norm_mix, nb < 16 ? C2 : 1.f, WSP(bf16, WS_WAB), 1024, 1280 + 32 * nb, scr, kb, lane); continue; } r -= I_AB2;
        if (r < I_ABO) { const int kb = r / 32, nb = r % 32; p0_titem(F.in[15], 1024, 32 * nb, nullptr, 1.f, WSP(bf16, WS_WABO), 1024, 32 * nb, scr, kb, lane); continue; } r -= I_ABO;
        if (r < 4 * I_FF) { const int q = r / I_FF, rr = r % I_FF, l = q >> 1, up = q & 1, kb = rr / 88, nb = rr % 88, n0 = 32 * nb;
            const float* W = (up ? F.in[4] : F.in[3]) + (size_t)l * 1024 * FF;
            p0_titem(W, FF, n0, norm_ffn + l * 1024, 1.f, WSP(bf16, l ? WS_WUP1 : WS_WUP0), 1024, 256 * (n0 / 128) + (n0 % 128) + 128 * up, scr, kb, lane); continue; } r -= 4 * I_FF;
        if (r < 2 * I_DN) { const int l = r / I_DN, rr = r % I_DN, kb = rr / 32, nb = rr % 32;
            p0_titem(F.in[5] + (size_t)l * FF * 1024, 1024, 32 * nb, nullptr, 1.f, WSP(bf16, l ? WS_WDN1 : WS_WDN0), FF, 32 * nb, scr, kb, lane); continue; } r -= 2 * I_DN;
        if (r < I_CIN) { const int kb = r / 96, nb = r % 96; p0_titem(F.in[16], C_LD, 32 * nb, norm_mix + 1024, 1.f, WSP(bf16, WS_WCIN), 1024, 32 * nb, scr, kb, lane); continue; } r -= I_CIN;
        if (r < I_CO) { const int kb = r / 32, nb = r % 32; p0_titem(F.in[21], 1024, 32 * nb, nullptr, 1.f, WSP(bf16, WS_WCO), 1024, 32 * nb, scr, kb, lane); continue; } r -= I_CO;
        if (r < 2 * I_W1) { const int kv = r / I_W1, rr = r % I_W1, kb = rr / 2, nb = rr % 2; p0_titem(F.in[kv ? 12 : 10], 64, 32 * nb, nullptr, 1.f, WSP(bf16, kv ? WS_CW1V : WS_CW1K), 2048, 32 * nb, scr, kb, lane); continue; } r -= 2 * I_W1;
        { const int kv = r / I_W2, nb = r % I_W2; p0_titem(F.in[kv ? 13 : 11], 64, 32 * nb, nullptr, 1.f, WSP(bf16, kv ? WS_CW2V : WS_CW2K), 64, 32 * nb, scr, 0, lane); }
    }
    { const int gt = (F.vcu * NWAVES + F.wave) * 64 + lane, NGT = F.G * NWAVES * 64;
      for (int i = gt; i < 2 * 32 * 1024; i += NGT) { const int which = i >> 15, n = (i >> 10) & 31, k = i & 1023; float v = 0.f;
          if (which == 0) { if (n < 24) v = F.in[6][(size_t)k * AB_LD + 1280 + n] * norm_mix[k]; WSP(bf16, WS_WABG)[n * 1024 + k] = (bf16)f2bf(v); }
          else { if (n < 8) v = F.in[16][(size_t)k * C_LD + 3072 + n] * norm_mix[1024 + k]; WSP(bf16, WS_WCG)[n * 1024 + k] = (bf16)f2bf(v); } } }
    for (int m = gw; m < M; m += NGW) {
        const GAS f32x4* xr = (const GAS f32x4*)(F.in[0] + (size_t)m * D) + lane; f32x4 v[4]; float s = 0.f;
#pragma unroll
        for (int j = 0; j < 4; ++j) { v[j] = xr[64 * j]; s += (v[j].x * v[j].x + v[j].y * v[j].y) + (v[j].z * v[j].z + v[j].w * v[j].w); }
        s = wave_sum(s);
        GAS unsigned long long* o8 = (GAS unsigned long long*)(WSP(bf16, WS_H16) + (size_t)m * D) + lane;
#pragma unroll
        for (int j = 0; j < 4; ++j) o8[64 * j] = (unsigned long long)pk2(v[j].x, v[j].y) | ((unsigned long long)pk2(v[j].z, v[j].w) << 32);
        if (lane == 0) WSP(float, WS_RS0)[m] = 1.0f / sqrtf(s * (1.0f / D) + 1e-6f);
    }
    if (F.vcu == 0) {
        __syncthreads();
        LAS float* red = (LAS float*)(F.lds + RING_OFF);
#pragma unroll
        for (int kv = 0; kv < 2; ++kv) { const float* pos = F.in[kv ? 9 : 8]; const float* w1 = F.in[kv ? 12 : 10]; float a = 0.f;
            for (int k = F.wave * 256; k < F.wave * 256 + 256; ++k) a += pos[k] * w1[(size_t)k * 64 + lane];
            red[(kv * 8 + F.wave) * 64 + lane] = a; }
        __syncthreads();
        if (F.tid < 128) { const int kv = F.tid >> 6, n = F.tid & 63; float a = 0.f;
#pragma unroll
            for (int w = 0; w < 8; ++w) a += red[(kv * 8 + w) * 64 + n];
            WSP(float, WS_CBIAS)[kv * 64 + n] = a; }
        __syncthreads();
    }
}
__device__ __forceinline__ f32x16 skinny_tile(const bf16* A, const bf16* Wt, int row0, int lane) {
    const int r32 = lane & 31, h = lane >> 5; f32x16 acc = {};
    const bf16* ap = A + (size_t)(row0 + r32) * 1024 + 8 * h; const bf16* wp = Wt + (size_t)r32 * 1024 + 8 * h;
#pragma unroll 8
    for (int s = 0; s < 64; ++s) acc = mfma32(*(const bf16x8*)(wp + 16 * s), *(const bf16x8*)(ap + 16 * s), acc);
    return acc;
}
__device__ __forceinline__ void gates0_phase(Frame& F) {
    const int gw = F.vcu * NWAVES + F.wave, NGW = F.G * NWAVES, lane = F.lane, r32 = lane & 31, h = lane >> 5;
    for (int t = gw; t < M / 32; t += NGW) {
        const f32x16 acc = skinny_tile(WSP(bf16, WS_H16), WSP(bf16, WS_WABG), 32 * t, lane);
        const int row = 32 * t + r32; const float rs = WSP(float, WS_RS0)[row]; float* g = WSP(float, WS_GATES) + (size_t)row * 32;
#pragma unroll
        for (int r = 0; r < 16; ++r) { const int c = crow(r, h); if (c < 24) g[c] = 1.0f / (1.0f + __expf(-(acc[r] * rs + F.in[7][c]))); }
    }
}
__device__ __forceinline__ void gates1_phase(Frame& F) {
    const int gw = F.vcu * NWAVES + F.wave, NGW = F.G * NWAVES, lane = F.lane, r32 = lane & 31, h = lane >> 5;
    const pg8::RowScale R{nullptr, WSP(float, WS_PSUM)};
    for (int t = gw; t < M / 32; t += NGW) {
        const f32x16 acc = skinny_tile(WSP(bf16, WS_H16), WSP(bf16, WS_WCG), 32 * t, lane);
        const int row = 32 * t + r32; const float rs = pg8::row_scale(R, row); float* g = WSP(float, WS_GATES) + (size_t)row * 32;
#pragma unroll
        for (int r = 0; r < 16; ++r) { const int c = crow(r, h);
            if (c < 4) g[c] = acc[r] * rs + F.in[19][c];
            else if (c < 8) { const float x = acc[r] * rs + F.in[20][c - 4]; g[c] = fminf(x, 0.f) - log1pf(__expf(-fabsf(x))); } }
    }
}

__device__ __forceinline__ void compress_phase(Frame& F) {
    const int lane = F.lane, r32 = lane & 31, h = lane >> 5, w = F.wave;
    LAS float* red = (LAS float*)(F.lds + RING_OFF);
    LAS unsigned char* Hs = F.lds + RING_OFF + 65536;
    for (int task = F.vcu; task < 256; task += F.G) {
        const int kv = task & 1, bg = (task >> 1) & 7, rt = task >> 4, b = bg >> 1, g = bg & 1, i0 = rt * 32;
        const bf16* raw = WSP(bf16, WS_QKV0) + (size_t)b * T * 2048 + (kv ? QC_VC : QC_KC) + g * 64;
        const bf16* w1t = WSP(bf16, kv ? WS_CW1V : WS_CW1K);
        const bf16* w2t = WSP(bf16, kv ? WS_CW2V : WS_CW2K);
        int ic = i0 + r32; if (ic > 510) ic = 510;
        f32x16 d0 = {}, d1 = {};
#pragma unroll
        for (int ll = 0; ll < 4; ++ll) { const int l = 4 * w + ll;
#pragma unroll
            for (int ss = 0; ss < 4; ++ss) { const int k = l * 64 + 16 * ss + 8 * h;
                const bf16x8 bfr = *(const bf16x8*)(raw + (size_t)(16 * ic + l) * 2048 + 16 * ss + 8 * h);
                d0 = mfma32(*(const bf16x8*)(w1t + (size_t)r32 * 2048 + k), bfr, d0);
                d1 = mfma32(*(const bf16x8*)(w1t + (size_t)(32 + r32) * 2048 + k), bfr, d1); } }
#pragma unroll
        for (int r = 0; r < 16; ++r) { red[(w * 64 + crow(r, h)) * 32 + r32] = d0[r]; red[(w * 64 + 32 + crow(r, h)) * 32 + r32] = d1[r]; }
        __syncthreads();
#pragma unroll
        for (int e = 0; e < 4; ++e) { const int idx = F.tid * 4 + e, hid = idx >> 5, i = idx & 31; float a = WSP(float, WS_CBIAS)[kv * 64 + hid];
#pragma unroll
            for (int ww = 0; ww < 8; ++ww) a += red[(ww * 64 + hid) * 32 + i];
            a = a / (1.0f + __expf(-a));
            *(LAS bf16*)(Hs + i * 144 + hid * 2) = (bf16)f2bf(a); }
        __syncthreads();
        if (w < 2) { f32x16 o = {};
#pragma unroll
            for (int s = 0; s < 4; ++s) o = mfma32(*(const bf16x8*)(w2t + (size_t)(32 * w + r32) * 64 + 16 * s + 8 * h), *(const LAS bf16x8*)(Hs + r32 * 144 + (16 * s + 8 * h) * 2), o);
            bf16* dst = WSP(bf16, kv ? WS_VC : WS_KC) + ((size_t)bg * 512 + i0 + r32) * 64 + 32 * w + 4 * h;
#pragma unroll
            for (int q = 0; q < 4; ++q) { v2u pk; pk.x = pk2(o[4 * q], o[4 * q + 1]); pk.y = pk2(o[4 * q + 2], o[4 * q + 3]); *(v2u*)(dst + 8 * q) = pk; } }
        __syncthreads();
    }
}
constexpr int AT_K = 0, AT_V = 9216, AT_IMP = 18432, AT_SEL = AT_IMP + 128 * 132 * 4, AT_END = AT_SEL + 2048;
static_assert(AT_END <= RING_BYTES, "attention LDS");
constexpr int KV_STRIDE = 144;
__device__ __forceinline__ void stage_kv(Frame& F, const bf16* Kg, const bf16* Vg, int pitch, int row0, int rmax) {
    const int row = F.tid >> 3, ch = F.tid & 7; int rr = row0 + row; rr = rr < 0 ? 0 : (rr > rmax ? rmax : rr);
    const v4u kx = *(const v4u*)(Kg + (size_t)rr * pitch + ch * 8);
    *(LAS v4u*)(F.lds + AT_K + row * KV_STRIDE + ch * 16) = kx;
    if (Vg) { const v4u vx = *(const v4u*)(Vg + (size_t)rr * pitch + ch * 8); *(LAS v4u*)(F.lds + AT_V + row * KV_STRIDE + ch * 16) = vx; }
}
__device__ __forceinline__ f32x16 qk_tile(LAS unsigned char* klb, int sub, const bf16x8 (&qf)[4]) {
    f32x16 s = {};
#pragma unroll
    for (int st = 0; st < 4; ++st) s = mfma32(*(const LAS bf16x8*)(klb + 32 * sub * KV_STRIDE + 32 * st), qf[st], s);
    return s;
}
__device__ __forceinline__ void pv_tile(LAS unsigned char* vlb, int sub, const f32x16& p, f32x16 (&o)[2]) {
    const bf16x8 p0 = pack8<0>(p), p1 = pack8<1>(p);
#pragma unroll
    for (int dt = 0; dt < 2; ++dt) {
        o[dt] = mfma32(frag_tr(vlb, (32 * sub) * KV_STRIDE + 64 * dt, (32 * sub + 8) * KV_STRIDE + 64 * dt), p0, o[dt]);
        o[dt] = mfma32(frag_tr(vlb, (32 * sub + 16) * KV_STRIDE + 64 * dt, (32 * sub + 24) * KV_STRIDE + 64 * dt), p1, o[dt]);
    }
}
__device__ __forceinline__ void osm_update(f32x16& s, float& m, float& l, f32x16 (&o)[2]) {
    float mx = s[0];
#pragma unroll
    for (int r = 1; r < 16; ++r) mx = fmaxf(mx, s[r]);
    mx = fmaxf(mx, __shfl_xor(mx, 32));
    const float mn = fmaxf(m, mx), al = __builtin_amdgcn_exp2f(m - mn);
    float sum = 0.f;
#pragma unroll
    for (int r = 0; r < 16; ++r) { s[r] = __builtin_amdgcn_exp2f(s[r] - mn); sum += s[r]; }
    l = l * al + sum; m = mn;
#pragma unroll
    for (int dt = 0; dt < 2; ++dt)
#pragma unroll
        for (int r = 0; r < 16; ++r) o[dt][r] *= al;
}
template <int MODE, int WIN>
__device__ __forceinline__ void attn_blocks(Frame& F, const bf16* Kg, const bf16* Vg, int jlo, int jhi, int tq, int tqmax_w, int tqmin_w, const unsigned (&selw)[4],
                                            const bf16x8 (&qf)[2][4], float (&m)[2], float (&l)[2], f32x16 (&o)[2][2]) {
    const int lane = F.lane, r32 = lane & 31, h = lane >> 5;
    const int trl = ((lane & 15) >> 2) * KV_STRIDE + (16 * ((lane >> 4) & 1) + 4 * (lane & 3)) * 2;
    LAS unsigned char* klb = F.lds + AT_K + r32 * KV_STRIDE + 16 * h; LAS unsigned char* vlb = F.lds + AT_V + trl + 4 * h * KV_STRIDE;
    for (int j = jlo; j <= jhi; ++j) {
        __syncthreads();
        stage_kv(F, Kg, Vg, 2048, 64 * j, T - 1);
        __syncthreads();
        bool mine = true;
        if (MODE == 0) { const int jp = j & 3; const unsigned sw = jp == 0 ? selw[0] : jp == 1 ? selw[1] : jp == 2 ? selw[2] : selw[3]; mine = ((sw >> (j >> 2)) & 1u) != 0u; }
#pragma unroll
        for (int sub = 0; sub < 2; ++sub) {
            const int kb = 64 * j + 32 * sub;
            bool any;
            if (MODE == 0) any = __any(mine && kb <= tq);
            else any = (kb <= tqmax_w) && (kb + 31 > tqmin_w - WIN);
            if (!any) continue;
#pragma unroll
            for (int hd = 0; hd < 2; ++hd) {
                f32x16 s = qk_tile(klb, sub, qf[hd]);
#pragma unroll
                for (int r = 0; r < 16; ++r) { const int key = kb + crow(r, h); bool ok = key <= tq;
                    if (MODE == 0) ok = ok && mine; else ok = ok && (tq - key < WIN);
                    s[r] = ok ? s[r] : -INFINITY; }
                osm_update(s, m[hd], l[hd], o[hd]);
                pv_tile(vlb, sub, s, o[hd]);
                __builtin_amdgcn_sched_barrier(0);
            }
        }
    }
}
__device__ __forceinline__ void accf_store(float* accf, size_t tok, int hc, const f32x16 (&o)[2], float sc, int h, bool add) {
    float* p = accf + tok * 512 + hc + 4 * h;
#pragma unroll
    for (int dt = 0; dt < 2; ++dt)
#pragma unroll
        for (int q = 0; q < 4; ++q) { f32x4 v = {o[dt][4 * q] * sc, o[dt][4 * q + 1] * sc, o[dt][4 * q + 2] * sc, o[dt][4 * q + 3] * sc};
            f32x4* d = (f32x4*)(p + 32 * dt + 8 * q); if (add) v = v + *d; *d = v; }
}
__device__ __forceinline__ void att_store(bf16* att, const float* accf, size_t tok, int hc_att, int hc_acc, const f32x16 (&o)[2], float sc, int h) {
    bf16* p = att + tok * 1024 + hc_att + 4 * h;
#pragma unroll
    for (int dt = 0; dt < 2; ++dt)
#pragma unroll
        for (int q = 0; q < 4; ++q) { f32x4 v = {o[dt][4 * q] * sc, o[dt][4 * q + 1] * sc, o[dt][4 * q + 2] * sc, o[dt][4 * q + 3] * sc};
            if (accf) v = v + *(const f32x4*)(accf + tok * 512 + hc_acc + 4 * h + 32 * dt + 8 * q);
            v2u pk; pk.x = pk2(v[0], v[1]); pk.y = pk2(v[2], v[3]); *(v2u*)(p + 32 * dt + 8 * q) = pk; }
}
__device__ __forceinline__ void nsa_unit(Frame& F, int b, int g, int n) {
    const int lane = F.lane, r32 = lane & 31, h = lane >> 5, wave = F.wave, tid = F.tid;
    const int start = n * 128, qt = wave >> 1, hp = (wave & 1) * 2;
    const int tq = start + qt * 32 + r32, tqmin_w = start + qt * 32, tqmax_w = tqmin_w + 31;
    const size_t tok = (size_t)b * T + tq;
    const bf16* qkv = WSP(bf16, WS_QKV0) + (size_t)b * T * 2048;
    const int trl = ((lane & 15) >> 2) * KV_STRIDE + (16 * ((lane >> 4) & 1) + 4 * (lane & 3)) * 2;
    LAS unsigned char* klb = F.lds + AT_K + r32 * KV_STRIDE + 16 * h; LAS unsigned char* vlb = F.lds + AT_V + trl + 4 * h * KV_STRIDE;
    LAS float* imp = (LAS float*)(F.lds + AT_IMP); LAS unsigned* sel = (LAS unsigned*)(F.lds + AT_SEL);
    bf16x8 qf[2][4];
#pragma unroll
    for (int hd = 0; hd < 2; ++hd)
#pragma unroll
        for (int s = 0; s < 4; ++s) qf[hd][s] = *(const bf16x8*)(qkv + (size_t)tq * 2048 + QC_QN + (g * 4 + hp + hd) * 64 + 16 * s + 8 * h);
    const float* gatep = WSP(float, WS_GATES) + tok * 32 + (g * 4 + hp) * 3;
    float* accf = WSP(float, WS_ACCF);
    __syncthreads();
    for (int i = tid; i < 128 * 132; i += 512) imp[i] = 0.f;
    const bf16* kcg = WSP(bf16, WS_KC) + (size_t)(b * 2 + g) * 512 * 64; const bf16* vcg = WSP(bf16, WS_VC) + (size_t)(b * 2 + g) * 512 * 64;
    const int nvalid = 8 * n + 7, nbc = (nvalid + 63) >> 6;
    float m[2] = {-1e30f, -1e30f}, l[2] = {0.f, 0.f};
    for (int jb = 0; jb < nbc; ++jb) {
        __syncthreads();
        stage_kv(F, kcg, nullptr, 64, 64 * jb, 511);
        __syncthreads();
#pragma unroll
        for (int sub = 0; sub < 2; ++sub)
#pragma unroll
            for (int hd = 0; hd < 2; ++hd) {
                f32x16 s = qk_tile(klb, sub, qf[hd]); float mx = -INFINITY;
#pragma unroll
                for (int r = 0; r < 16; ++r) { const int i = 64 * jb + 32 * sub + crow(r, h); s[r] = (16 * i + 31 <= tq) ? s[r] : -INFINITY; mx = fmaxf(mx, s[r]); }
                mx = fmaxf(mx, __shfl_xor(mx, 32));
                const float mn = fmaxf(m[hd], mx), al = __builtin_amdgcn_exp2f(m[hd] - mn); float sum = 0.f;
#pragma unroll
                for (int r = 0; r < 16; ++r) sum += __builtin_amdgcn_exp2f(s[r] - mn);
                l[hd] = l[hd] * al + sum; m[hd] = mn;
            }
    }
    float il[2];
#pragma unroll
    for (int hd = 0; hd < 2; ++hd) { const float lt = l[hd] + __shfl_xor(l[hd], 32); il[hd] = lt > 0.f ? 1.0f / lt : 0.f; }
    f32x16 o[2][2];
#pragma unroll
    for (int hd = 0; hd < 2; ++hd) { o[hd][0] = (f32x16){}; o[hd][1] = (f32x16){}; }
    float carry = 0.f;
    for (int jb = 0; jb < nbc; ++jb) {
        __syncthreads();
        stage_kv(F, kcg, vcg, 64, 64 * jb, 511);
        __syncthreads();
#pragma unroll
        for (int sub = 0; sub < 2; ++sub) {
            float ps4[4] = {0.f, 0.f, 0.f, 0.f}, sp[4] = {0.f, 0.f, 0.f, 0.f};
#pragma unroll
            for (int hd = 0; hd < 2; ++hd) {
                f32x16 s = qk_tile(klb, sub, qf[hd]);
#pragma unroll
                for (int r = 0; r < 16; ++r) { const int i = 64 * jb + 32 * sub + crow(r, h); s[r] = (16 * i + 31 <= tq) ? __builtin_amdgcn_exp2f(s[r] - m[hd]) * il[hd] : 0.f; }
#pragma unroll
                for (int q = 0; q < 4; ++q) { ps4[q] += (s[4 * q] + s[4 * q + 1]) + (s[4 * q + 2] + s[4 * q + 3]); sp[q] += s[4 * q + 3]; }
                pv_tile(vlb, sub, s, o[hd]);
            }
            float cell[4];
#pragma unroll
            for (int q = 0; q < 4; ++q) { const float rv = __shfl_xor(sp[q], 32);
                if (h == 1) cell[q] = ps4[q] + rv; else { cell[q] = ps4[q] + carry; carry = rv; } }
            const int j0 = (64 * jb + 32 * sub) / 4 + h;
#pragma unroll
            for (int q = 0; q < 4; ++q) atomicAdd((float*)&imp[(qt * 32 + r32) * 132 + j0 + 2 * q], cell[q]);
        }
    }
#pragma unroll
    for (int hd = 0; hd < 2; ++hd) accf_store(accf, tok, (g * 4 + hp + hd) * 64, o[hd], gatep[3 * hd + 0], h, false);
    __syncthreads();
    {
        const int q = tid >> 2, part = tid & 3, tq2 = start + q, cur = tq2 >> 6; unsigned bits = 0u;
        float val[32];
#pragma unroll
        for (int e = 0; e < 32; ++e) { const int j = 4 * e + part; const bool forced = (j == 0) || (j == cur) || (j == cur - 1);
            if (cur <= 15) { if (j <= cur) bits |= 1u << e; val[e] = -INFINITY; }
            else { if (forced) bits |= 1u << e; val[e] = (!forced && j >= 1 && j <= cur - 2) ? imp[q * 132 + j] : -INFINITY; } }
        if (cur > 15) {
            for (int itr = 0; itr < 13; ++itr) {
                float bv = val[0]; int be = 0;
#pragma unroll
                for (int e = 1; e < 32; ++e) if (val[e] > bv) { bv = val[e]; be = e; }
                int bj = 4 * be + part; float wv = bv; int wj = bj;
#pragma unroll
                for (int d = 1; d < 4; d <<= 1) { const float ov = __shfl_xor(wv, d); const int oj = __shfl_xor(wj, d); if (ov > wv || (ov == wv && oj < wj)) { wv = ov; wj = oj; } }
                const bool win = (wj == bj) && (wv > -INFINITY);
#pragma unroll
                for (int e = 0; e < 32; ++e) if (win && e == be) { val[e] = -INFINITY; bits |= 1u << e; }
            }
        }
        sel[q * 4 + part] = bits;
    }
    __syncthreads();
    unsigned selw[4];
#pragma unroll
    for (int p = 0; p < 4; ++p) selw[p] = sel[(qt * 32 + r32) * 4 + p];
#pragma unroll
    for (int hd = 0; hd < 2; ++hd) { o[hd][0] = (f32x16){}; o[hd][1] = (f32x16){}; m[hd] = -1e30f; l[hd] = 0.f; }
    attn_blocks<0, 0>(F, qkv + QC_KS + g * 64, qkv + QC_VS + g * 64, 0, 2 * n + 1, tq, tqmax_w, tqmin_w, selw, qf, m, l, o);
#pragma unroll
    for (int hd = 0; hd < 2; ++hd) { const float lt = l[hd] + __shfl_xor(l[hd], 32); accf_store(accf, tok, (g * 4 + hp + hd) * 64, o[hd], lt > 0.f ? gatep[3 * hd + 1] / lt : 0.f, h, true); }
#pragma unroll
    for (int hd = 0; hd < 2; ++hd) { o[hd][0] = (f32x16){}; o[hd][1] = (f32x16){}; m[hd] = -1e30f; l[hd] = 0.f; }
    attn_blocks<1, 512>(F, qkv + QC_KW + g * 64, qkv + QC_VW + g * 64, (2 * n - 8) < 0 ? 0 : (2 * n - 8), 2 * n + 1, tq, tqmax_w, tqmin_w, selw, qf, m, l, o);
#pragma unroll
    for (int hd = 0; hd < 2; ++hd) { const float lt = l[hd] + __shfl_xor(l[hd], 32);
        att_store(WSP(bf16, WS_ATT), accf, tok, (g * 4 + hp + hd) * 64, (g * 4 + hp + hd) * 64, o[hd], lt > 0.f ? gatep[3 * hd + 2] / lt : 0.f, h); }
}
__device__ __forceinline__ void swa_unit(Frame& F, int b, int g, int n) {
    const int lane = F.lane, r32 = lane & 31, h = lane >> 5, wave = F.wave;
    const int start = n * 128, qt = wave >> 1, hp = (wave & 1) * 2;
    const int tq = start + qt * 32 + r32, tqmin_w = start + qt * 32, tqmax_w = tqmin_w + 31;
    const size_t tok = (size_t)b * T + tq;
    const bf16* qkv = WSP(bf16, WS_QKV0) + (size_t)b * T * 2048;
    bf16x8 qf[2][4];
#pragma unroll
    for (int hd = 0; hd < 2; ++hd)
#pragma unroll
        for (int s = 0; s < 4; ++s) qf[hd][s] = *(const bf16x8*)(qkv + (size_t)tq * 2048 + QC_QS + (g * 4 + hp + hd) * 64 + 16 * s + 8 * h);
    f32x16 o[2][2]; float m[2], l[2]; const unsigned selw[4] = {0u, 0u, 0u, 0u};
#pragma unroll
    for (int hd = 0; hd < 2; ++hd) { o[hd][0] = (f32x16){}; o[hd][1] = (f32x16){}; m[hd] = F.in[14][g * 4 + hp + hd] * LOG2E; l[hd] = (h == 0) ? 1.0f : 0.f; }
    attn_blocks<1, 128>(F, qkv + QC_KSW + g * 64, qkv + QC_VSW + g * 64, (2 * n - 2) < 0 ? 0 : (2 * n - 2), 2 * n + 1, tq, tqmax_w, tqmin_w, selw, qf, m, l, o);
#pragma unroll
    for (int hd = 0; hd < 2; ++hd) { const float lt = l[hd] + __shfl_xor(l[hd], 32);
        att_store(WSP(bf16, WS_ATT), nullptr, tok, 512 + (g * 4 + hp + hd) * 64, 0, o[hd], 1.0f / lt, h); }
}
__device__ __forceinline__ void attention_phase(Frame& F) {
    for (int i = 0;; ++i) { const int u = i * F.G + F.vcu; if (u >= 512) break;
        const int pi = u & 255, bg = pi >> 5, s = pi & 31, n = (u < 256) ? s : 63 - s; nsa_unit(F, bg >> 1, bg & 1, n); }
    for (int i = 0;; ++i) { const int u = i * F.G + F.vcu; if (u >= 512) break; const int bg = u >> 6, n = u & 63; swa_unit(F, bg >> 1, bg & 1, n); }
    __syncthreads();
}
__device__ __forceinline__ void conv_scan_phase(Frame& F) {
    const int lane = F.lane, w = F.wave;
    if (F.vcu < 16 && F.G >= 32) {
        const int bh = F.vcu, b = bh >> 2, hh = bh & 3;
        const float* gt = WSP(float, WS_GATES) + (size_t)b * T * 32;
        LAS float* segG = (LAS float*)(F.lds + RING_OFF); LAS float* segP = segG + 8;
        float Gl[16], al[16], Pl[16]; float c = 0.f, cm = -INFINITY;
#pragma unroll
        for (int it = 0; it < 16; ++it) { const int t = 1024 * w + 64 * it + lane; const float li = gt[(size_t)t * 32 + hh]; float x = gt[(size_t)t * 32 + 4 + hh];
#pragma unroll
            for (int d = 1; d < 64; d <<= 1) { const float y = __shfl_up(x, d); if (lane >= d) x += y; }
            Gl[it] = c + x; c = __shfl(Gl[it], 63);
            al[it] = li - Gl[it]; float pm = al[it];
#pragma unroll
            for (int d = 1; d < 64; d <<= 1) { const float y = __shfl_up(pm, d); if (lane >= d) pm = fmaxf(pm, y); }
            pm = fmaxf(pm, cm); Pl[it] = pm; cm = __shfl(pm, 63); }
        if (lane == 0) { segG[w] = c; segP[w] = cm; }
        __syncthreads();
        double gc = 0.0; float mc = 0.f;
        for (int k = 0; k < w; ++k) { mc = fmaxf(mc, (float)((double)segP[k] - gc)); gc += (double)segG[k]; }
#pragma unroll
        for (int it = 0; it < 16; ++it) { const int t = 1024 * w + 64 * it + lane; const float gcf = (float)gc;
            const float a = al[it] - gcf, mv = fmaxf(mc, Pl[it] - gcf); const double mt = (gc + (double)Gl[it]) + (double)mv;
            WSP(float, WS_SCA)[bh * T + t] = a; WSP(float, WS_SCM)[bh * T + t] = mv; WSP(float, WS_SCE)[bh * T + t] = (float)exp(-mt); }
        __syncthreads();
        return;
    }
    const int first = (F.G >= 32) ? 16 : 0, nblk = F.G - first, bi = F.vcu - first;
    const int c8 = (F.tid & 127) * 8;
    const float* cw = F.in[17]; const float* cb = F.in[18];
    float wv[4][8], bv[8];
#pragma unroll
    for (int e = 0; e < 8; ++e) { bv[e] = cb[c8 + e];
#pragma unroll
        for (int k = 0; k < 4; ++k) wv[k][e] = cw[k * 1024 + c8 + e]; }
    const float ksc = (c8 >= 512) ? 0.08838834764831845f : 1.0f;
    const bf16* src = WSP(bf16, WS_QKP); bf16* dst = WSP(bf16, WS_QKC);
    for (int tok = bi * 4 + (F.tid >> 7); tok < M; tok += nblk * 4) {
        const int t = tok & (T - 1); float acc[8];
#pragma unroll
        for (int e = 0; e < 8; ++e) acc[e] = bv[e];
#pragma unroll
        for (int k = 0; k < 4; ++k) { if (t - 3 + k >= 0) { const v4u x = *(const v4u*)(src + (size_t)(tok - 3 + k) * 1024 + c8);
                acc[0] += bflo(x.x) * wv[k][0]; acc[1] += bfhi(x.x) * wv[k][1]; acc[2] += bflo(x.y) * wv[k][2]; acc[3] += bfhi(x.y) * wv[k][3];
                acc[4] += bflo(x.z) * wv[k][4]; acc[5] += bfhi(x.z) * wv[k][5]; acc[6] += bflo(x.w) * wv[k][6]; acc[7] += bfhi(x.w) * wv[k][7]; } }
#pragma unroll
        for (int e = 0; e < 8; ++e) acc[e] = acc[e] / (1.0f + __expf(-acc[e])) * ksc;
        v4u o; o.x = pk2(acc[0], acc[1]); o.y = pk2(acc[2], acc[3]); o.z = pk2(acc[4], acc[5]); o.w = pk2(acc[6], acc[7]);
        *(v4u*)(dst + (size_t)tok * 1024 + c8) = o;
    }
}
constexpr int ML_KS = 272, ML_VS = 528;
constexpr int ML_K = 0, ML_V = 64 * ML_KS;
__device__ __forceinline__ void mlstm_p1_phase(Frame& F) {
    const int lane = F.lane, r32 = lane & 31, h = lane >> 5, w = F.wave, tid = F.tid;
    LAS unsigned char* kt = F.lds + ML_K; LAS unsigned char* vt = F.lds + ML_V;
    for (int u = F.vcu; u < 512; u += F.G) {
        const int bh = u >> 5, sc = u & 31, b = bh >> 2, hh = bh & 3;
        const float mend = WSP(float, WS_SCM)[bh * T + 256 * sc + 255];
        const float* av = WSP(float, WS_SCA) + bh * T + 256 * sc;
        f32x16 acc[4]; float nacc = 0.f;
#pragma unroll
        for (int i = 0; i < 4; ++i) acc[i] = (f32x16){};
        for (int c4 = 0; c4 < 4; ++c4) {
            __syncthreads();
            { const int row = tid >> 3, ch = tid & 7; const size_t tok = (size_t)b * T + 256 * sc + 64 * c4 + row;
              const float wgt = __expf(av[64 * c4 + row] - mend);
              const bf16* kp = WSP(bf16, WS_QKC) + tok * 1024 + 512 + hh * 128 + ch * 16;
#pragma unroll
              for (int q = 0; q < 2; ++q) { const v4u x = *(const v4u*)(kp + 8 * q); v4u y;
                  y.x = pk2(bflo(x.x) * wgt, bfhi(x.x) * wgt); y.y = pk2(bflo(x.y) * wgt, bfhi(x.y) * wgt); y.z = pk2(bflo(x.z) * wgt, bfhi(x.z) * wgt); y.w = pk2(bflo(x.w) * wgt, bfhi(x.w) * wgt);
                  *(LAS v4u*)(kt + row * ML_KS + (ch * 16 + 8 * q) * 2) = y; }
              const bf16* vp = WSP(bf16, WS_V1) + tok * 1024 + hh * 256 + ch * 32;
#pragma unroll
              for (int q = 0; q < 4; ++q) *(LAS v4u*)(vt + row * ML_VS + (ch * 32 + 8 * q) * 2) = *(const v4u*)(vp + 8 * q); }
            __syncthreads();
            if (tid < 128) { float s = 0.f;
#pragma unroll 8
                for (int row = 0; row < 64; ++row) s += bf2f(*(LAS bf16*)(kt + row * ML_KS + tid * 2));
                nacc += s; }
            LAS unsigned char* klb = kt + ((lane & 15) >> 2) * ML_KS + (16 * ((lane >> 4) & 1) + 4 * (lane & 3)) * 2 + 8 * h * ML_KS;
            LAS unsigned char* vlb = vt + ((lane & 15) >> 2) * ML_VS + (16 * ((lane >> 4) & 1) + 4 * (lane & 3)) * 2 + 8 * h * ML_VS + 64 * w;
#pragma unroll
            for (int s = 0; s < 4; ++s) {
                const bf16x8 a = frag_tr(vlb, 16 * s * ML_VS, (16 * s + 4) * ML_VS);
#pragma unroll
                for (int dkt = 0; dkt < 4; ++dkt) acc[dkt] = mfma32(a, frag_tr(klb, 16 * s * ML_KS + 64 * dkt, (16 * s + 4) * ML_KS + 64 * dkt), acc[dkt]);
            }
        }
        float* lt = WSP(float, WS_LT) + (size_t)u * 32768;
#pragma unroll
        for (int dkt = 0; dkt < 4; ++dkt)
#pragma unroll
            for (int r = 0; r < 16; ++r) lt[(32 * w + crow(r, h)) * 128 + 32 * dkt + r32] = acc[dkt][r];
        if (tid < 128) WSP(float, WS_NLOC)[u * 128 + tid] = nacc;
    }
    __syncthreads();
}
__device__ __forceinline__ void mlstm_scan_phase(Frame& F) {
    const int gt = F.vcu * 512 + F.tid, NT = F.G * 512;
    for (int item = gt; item < 16 * 8192; item += NT) {
        const int bh = item >> 13, e4 = (item & 8191) * 4; f32x4 C = {0.f, 0.f, 0.f, 0.f}; float mprev = 0.f;
        const float* mx = WSP(float, WS_SCM) + bh * T;
        for (int sc = 0; sc < 32; ++sc) {
            const size_t off = ((size_t)(bh * 32 + sc)) * 32768 + e4;
            v2u pk; pk.x = pk2(C[0], C[1]); pk.y = pk2(C[2], C[3]); *(v2u*)(WSP(bf16, WS_CST) + off) = pk;
            const float mend = mx[256 * sc + 255], dec = __expf(mprev - mend); mprev = mend;
            const f32x4 L = *(const f32x4*)(WSP(float, WS_LT) + off);
            C = C * dec + L;
        }
    }
    for (int item = gt; item < 16 * 128; item += NT) {
        const int bh = item >> 7, dk = item & 127; float nn = 0.f, mprev = 0.f; const float* mx = WSP(float, WS_SCM) + bh * T;
        for (int sc = 0; sc < 32; ++sc) { const int u = bh * 32 + sc; WSP(float, WS_NST)[u * 128 + dk] = nn;
            const float mend = mx[256 * sc + 255], dec = __expf(mprev - mend); mprev = mend; nn = nn * dec + WSP(float, WS_NLOC)[u * 128 + dk]; }
    }
}
constexpr int M3_C = 0, M3_K = 128 * ML_KS, M3_V = M3_K + 32 * ML_KS, M3_A = M3_V + 32 * ML_KS, M3_N = M3_A + 1024, M3_Q = M3_N + 512, M3_END = M3_Q + 256 * ML_KS;
static_assert(M3_END <= RING_BYTES, "mlstm p3 LDS");
__device__ __forceinline__ void mlstm_p3_phase(Frame& F) {
    const int w = F.wave, tid = F.tid;
    LAS unsigned char* ct = F.lds + M3_C; LAS unsigned char* kt = F.lds + M3_K; LAS unsigned char* vt = F.lds + M3_V;
    LAS float* als = (LAS float*)(F.lds + M3_A); LAS float* nls = (LAS float*)(F.lds + M3_N);
    for (int u = F.vcu; u < 512; u += F.G) {
        int lane_ = F.lane; asm volatile("" : "+v"(lane_));
        const int r32 = lane_ & 31, h = lane_ >> 5;
        LAS unsigned char* vlb = vt + ((lane_ & 15) >> 2) * ML_KS + (16 * ((lane_ >> 4) & 1) + 4 * (lane_ & 3)) * 2 + 4 * h * ML_KS;
        LAS unsigned char* klb = kt + r32 * ML_KS + 16 * h; LAS unsigned char* clb = ct + r32 * ML_KS + 16 * h;
        LAS unsigned char* qlb = F.lds + M3_Q + (32 * w + r32) * ML_KS + 16 * h;
        const int bh = u >> 5, sc = u & 31, b = bh >> 2, hh = bh & 3;
        const size_t tok0 = (size_t)b * T + 256 * sc;
        const int tl = 32 * w + r32;
        const size_t tokq = tok0 + tl;
        const float Mt = WSP(float, WS_SCM)[bh * T + 256 * sc + tl];
        const float mprev = sc ? WSP(float, WS_SCM)[bh * T + 256 * sc - 1] : 0.f;
        const float winter = __expf(mprev - Mt);
        float dsum = 0.f, hdiv = 0.f;
#pragma unroll 1
        for (int pass = 0; pass < 2; ++pass) {
            __syncthreads();
            { const bf16* cs = WSP(bf16, WS_CST) + (size_t)u * 32768 + pass * 16384;
#pragma unroll
              for (int q = 0; q < 4; ++q) { const int idx = q * 512 + tid, row = idx >> 4, ch = idx & 15; *(LAS v4u*)(ct + row * ML_KS + ch * 16) = *(const v4u*)(cs + row * 128 + ch * 8); }
              if (pass == 0) {
#pragma unroll
                  for (int q = 0; q < 8; ++q) { const int idx = q * 512 + tid, row = idx >> 4, ch = idx & 15; *(LAS v4u*)(F.lds + M3_Q + row * ML_KS + ch * 16) = *(const v4u*)(WSP(bf16, WS_QKC) + (tok0 + row) * 1024 + hh * 128 + ch * 8); }
                  if (tid < 256) als[tid] = WSP(float, WS_SCA)[bh * T + 256 * sc + tid];
                               if (tid < 128) nls[tid] = WSP(float, WS_NST)[u * 128 + tid]; } }
            __syncthreads();
            f32x16 acc[4];
#pragma unroll
            for (int dvt = 0; dvt < 4; ++dvt) { f32x16 a = {};
#pragma unroll
                for (int s = 0; s < 8; ++s) a = mfma32(*(const LAS bf16x8*)(clb + 32 * dvt * ML_KS + 32 * s), *(const LAS bf16x8*)(qlb + 32 * s), a);
                acc[dvt] = a * winter; __builtin_amdgcn_sched_barrier(0); }
            for (int ktile = 0; ktile < 8; ++ktile) {
                __syncthreads();
                { const int row = tid >> 4, ch = tid & 15; const size_t tk = tok0 + 32 * ktile + row;
                  *(LAS v4u*)(kt + row * ML_KS + ch * 16) = *(const v4u*)(WSP(bf16, WS_QKC) + tk * 1024 + 512 + hh * 128 + ch * 8);
                  *(LAS v4u*)(vt + row * ML_KS + ch * 16) = *(const v4u*)(WSP(bf16, WS_V1) + tk * 1024 + hh * 256 + pass * 128 + ch * 8); }
                __syncthreads();
                if (ktile <= w) {
                    f32x16 s = {};
#pragma unroll
                    for (int st = 0; st < 8; ++st) s = mfma32(*(const LAS bf16x8*)(klb + 32 * st), *(const LAS bf16x8*)(qlb + 32 * st), s);
                    __builtin_amdgcn_sched_barrier(0);
                    float ds = 0.f;
#pragma unroll
                    for (int r = 0; r < 16; ++r) { const int key = 32 * ktile + crow(r, h); const float wg = __expf(als[key] - Mt); s[r] = (key <= tl) ? s[r] * wg : 0.f; ds += s[r]; }
                    if (pass == 0) dsum += ds;
                    const bf16x8 p0 = pack8<0>(s), p1 = pack8<1>(s);
#pragma unroll
                    for (int dvt = 0; dvt < 4; ++dvt) {
                        acc[dvt] = mfma32(frag_tr(vlb, 64 * dvt, 8 * ML_KS + 64 * dvt), p0, acc[dvt]);
                        acc[dvt] = mfma32(frag_tr(vlb, 16 * ML_KS + 64 * dvt, 24 * ML_KS + 64 * dvt), p1, acc[dvt]);
                        __builtin_amdgcn_sched_barrier(0);
                    }
                }
            }
            if (pass == 0) {
                float qn = 0.f;
#pragma unroll
                for (int s = 0; s < 8; ++s) { const v4u qq = *(const LAS v4u*)(qlb + 32 * s); const LAS float* np = nls + 16 * s + 8 * h;
                    qn += bflo(qq.x) * np[0] + bfhi(qq.x) * np[1] + bflo(qq.y) * np[2] + bfhi(qq.y) * np[3] + bflo(qq.z) * np[4] + bfhi(qq.z) * np[5] + bflo(qq.w) * np[6] + bfhi(qq.w) * np[7]; }
                dsum += __shfl_xor(dsum, 32); qn += __shfl_xor(qn, 32);
                const float den = winter * qn + dsum, emt = WSP(float, WS_SCE)[bh * T + 256 * sc + tl];
                hdiv = 1.0f / fmaxf(fabsf(den), emt);
            }
            const bf16* og = WSP(bf16, WS_OG) + tokq * 1024 + hh * 256 + pass * 128 + 4 * h; bf16* op = WSP(bf16, WS_QKP) + tokq * 1024 + hh * 256 + pass * 128 + 4 * h;
#pragma unroll
            for (int dvt = 0; dvt < 4; ++dvt)
#pragma unroll
                for (int q = 0; q < 4; ++q) { const v2u g2 = *(const v2u*)(og + 32 * dvt + 8 * q);
                    const float o0 = acc[dvt][4 * q] * hdiv / (1.0f + __expf(-bflo(g2.x))), o1 = acc[dvt][4 * q + 1] * hdiv / (1.0f + __expf(-bfhi(g2.x)));
                    const float o2 = acc[dvt][4 * q + 2] * hdiv / (1.0f + __expf(-bflo(g2.y))), o3 = acc[dvt][4 * q + 3] * hdiv / (1.0f + __expf(-bfhi(g2.y)));
                    v2u pk; pk.x = pk2(o0, o1); pk.y = pk2(o2, o3); *(v2u*)(op + 32 * dvt + 8 * q) = pk; __builtin_amdgcn_sched_barrier(0); }
        }
    }
    __syncthreads();
}
__device__ __forceinline__ void final_norm_phase(Frame& F) {
    const int gw = F.vcu * NWAVES + F.wave, NGW = F.G * NWAVES, lane = F.lane;
    const pg8::RowScale R{nullptr, WSP(float, WS_PSUM)};
    f32x4 gv[4];
#pragma unroll
    for (int j = 0; j < 4; ++j) gv[j] = ((const f32x4*)F.in[22])[lane + 64 * j];
    for (int m = gw; m < M; m += NGW) { const float rs = pg8::row_scale(R, m); f32x4* xr = (f32x4*)(F.out + (size_t)m * D) + lane;
#pragma unroll
        for (int j = 0; j < 4; ++j) xr[64 * j] = xr[64 * j] * rs * gv[j]; }
}
#ifndef SKIPMASK
#define SKIPMASK 0
#endif
#define RUNP(n, call) do { if (!((SKIPMASK >> (n)) & 1)) { call; } } while (0)
struct Args { const float* in[23]; float* out; unsigned char* ws; int ph_lo, ph_hi; };
__global__ void __launch_bounds__(NWAVES * 64, 2) mk_fwd(Args args) {
    extern __shared__ __attribute__((aligned(16))) unsigned char lds[];
    Frame F;
    F.lds = (LAS unsigned char*)lds;
    F.MISC = (volatile LAS unsigned*)(F.lds + MISC_OFF);
    F.tid = threadIdx.x; F.lane = F.tid & 63; F.wave = __builtin_amdgcn_readfirstlane(F.tid >> 6);
    F.G = gridDim.x; { const int bx = blockIdx.x; F.vcu = (F.G % 8 == 0) ? (bx % 8) * (F.G / 8) + bx / 8 : bx; }
    F.ws = args.ws; F.ctl = (gu32*)(args.ws + WS_CTL); F.out = args.out;
#pragma unroll
    for (int i = 0; i < 23; ++i) F.in[i] = args.in[i];
    for (int u = F.tid; u < (LDS_BYTES - LDSCTL_OFF) / 4; u += NWAVES * 64) ((LAS unsigned*)(F.lds + LDSCTL_OFF))[u] = 0u;
    __syncthreads();
    const int lo = args.ph_lo, hi = args.ph_hi;
    XcdBarrier bar; bar.bar = (unsigned*)(F.ctl + CW_BAR); bar.x = 0; bar.st = nullptr;
    if (hi - lo > 1) bar = xcd_barrier_post((unsigned*)(F.ctl + CW_BAR), F.MISC + 8);

#define IN(k) (lo <= (k) && (k) < hi)
#define SEAM(k) do { if (IN(k) && IN((k) + 1)) xcd_barrier(bar); } while (0)
#define GEMM_PH(EPI, gg, ee) do { pg8::StaticOrder S_; S_.init(M, (gg).N, F.G, (int)blockIdx.x); pg8::gemm_phase<EPI, pg8::StaticOrder, PG8_ALIGN, PG8_SP2>(F.lds + RING_OFF, gg, S_, ee); } while (0)
    if (IN(0)) { RUNP(0, p0_prologue(F)); } SEAM(0);
    if (IN(1)) { const pg8::Gemm g{WSP(bf16, WS_H16), WSP(bf16, WS_WAB), M, 2048, 1024};
        const pg8::EpiScaleBf16 e{WSP(bf16, WS_QKV0), 2048, {WSP(float, WS_RS0), nullptr}, 0, 0};
        RUNP(16, GEMM_PH(pg8::EpiScaleBf16, g, e)); RUNP(19, gates0_phase(F)); } SEAM(1);
    if (IN(2)) { RUNP(2, compress_phase(F)); } SEAM(2);
    if (IN(3)) { RUNP(3, attention_phase(F)); } SEAM(3);
    if (IN(4)) { const pg8::Gemm g{WSP(bf16, WS_ATT), WSP(bf16, WS_WABO), M, 1024, 1024};
        const pg8::EpiResid e{F.in[0], F.out, WSP(bf16, WS_H16), WSP(float, WS_PSUM), D};
        RUNP(17, GEMM_PH(pg8::EpiResid, g, e)); } SEAM(4);
    if (IN(5)) { const pg8::Gemm g{WSP(bf16, WS_H16), WSP(bf16, WS_WUP0), M, 5632, 1024};
        const pg8::EpiSwiglu e{WSP(bf16, WS_HID), FF, {nullptr, WSP(float, WS_PSUM)}};
        RUNP(18, GEMM_PH(pg8::EpiSwiglu, g, e)); } SEAM(5);
    if (IN(6)) { const pg8::Gemm g{WSP(bf16, WS_HID), WSP(bf16, WS_WDN0), M, 1024, FF};
        const pg8::EpiResid e{F.out, F.out, WSP(bf16, WS_H16), WSP(float, WS_PSUM), D};
        RUNP(17, GEMM_PH(pg8::EpiResid, g, e)); } SEAM(6);
    if (IN(7)) { const pg8::Gemm g{WSP(bf16, WS_H16), WSP(bf16, WS_WCIN), M, 3072, 1024};
        const pg8::EpiScaleBf16 e{WSP(bf16, WS_QKP), 1024, {nullptr, WSP(float, WS_PSUM)}, 1024, (size_t)(64 * MiB / 2)};
        RUNP(16, GEMM_PH(pg8::EpiScaleBf16, g, e)); RUNP(20, gates1_phase(F)); } SEAM(7);
    if (IN(8)) { RUNP(8, conv_scan_phase(F)); } SEAM(8);
    if (IN(9)) { RUNP(9, mlstm_p1_phase(F)); } SEAM(9);
    if (IN(10)) { RUNP(10, mlstm_scan_phase(F)); } SEAM(10);
    if (IN(11)) { RUNP(11, mlstm_p3_phase(F)); } SEAM(11);
    if (IN(12)) { const pg8::Gemm g{WSP(bf16, WS_QKP), WSP(bf16, WS_WCO), M, 1024, 1024};
        const pg8::EpiResid e{F.out, F.out, WSP(bf16, WS_H16), WSP(float, WS_PSUM), D};
        RUNP(17, GEMM_PH(pg8::EpiResid, g, e)); } SEAM(12);
    if (IN(13)) { const pg8::Gemm g{WSP(bf16, WS_H16), WSP(bf16, WS_WUP1), M, 5632, 1024};
        const pg8::EpiSwiglu e{WSP(bf16, WS_HID), FF, {nullptr, WSP(float, WS_PSUM)}};
        RUNP(18, GEMM_PH(pg8::EpiSwiglu, g, e)); } SEAM(13);
    if (IN(14)) { const pg8::Gemm g{WSP(bf16, WS_HID), WSP(bf16, WS_WDN1), M, 1024, FF};
        const pg8::EpiResid e{F.out, F.out, WSP(bf16, WS_H16), WSP(float, WS_PSUM), D};
        RUNP(17, GEMM_PH(pg8::EpiResid, g, e)); } SEAM(14);
    if (IN(15)) { RUNP(15, final_norm_phase(F)); }
}

extern "C" void kernel_launch(void* const* d_in, const int* in_sizes, int n_in, void* d_out, int out_size, void* d_ws, size_t ws_size, hipStream_t stream) {
    static int grid = 0;
    if (grid == 0) {
        if (n_in != 23 || in_sizes[0] != M * D || out_size != M * D || ws_size < WS_END) { fprintf(stderr, "kernel_launch: shape/workspace mismatch (n_in %d, in0 %d, out %d, ws %zu, need %zu); nothing launched\n", n_in, n_in > 0 ? in_sizes[0] : -1, out_size, ws_size, (size_t)WS_END); grid = -1; return; }
        int dev = 0, cus = 0, per_cu = 0;
        if (hipGetDevice(&dev) != hipSuccess || hipDeviceGetAttribute(&cus, hipDeviceAttributeMultiprocessorCount, dev) != hipSuccess) { grid = -1; return; }
        if (hipFuncSetAttribute((const void*)mk_fwd, hipFuncAttributeMaxDynamicSharedMemorySize, LDS_BYTES) != hipSuccess) { fprintf(stderr, "kernel_launch: hipFuncSetAttribute failed\n"); grid = -1; return; }
        if (hipOccupancyMaxActiveBlocksPerMultiprocessor(&per_cu, (const void*)mk_fwd, NWAVES * 64, LDS_BYTES) != hipSuccess || per_cu < 1) { fprintf(stderr, "kernel_launch: occupancy query says %d blocks per CU\n", per_cu); per_cu = 1; }
        (void)hipGetLastError();
        grid = cus;
    }
    if (grid < 0) return;
    if (hipMemsetAsync((char*)d_ws + WS_CTL, 0, CTL_ZERO_BYTES, stream) != hipSuccess) { fprintf(stderr, "kernel_launch: memset failed\n"); return; }
    Args a{};
    for (int i = 0; i < 23; ++i) a.in[i] = (const float*)d_in[i];
    a.out = (float*)d_out; a.ws = (unsigned char*)d_ws;
#if MK_PER_PHASE
    for (int p = 0; p < NPHASE; ++p) { a.ph_lo = p; a.ph_hi = p + 1; hipLaunchKernelGGL(mk_fwd, dim3(grid), dim3(NWAVES * 64), LDS_BYTES, stream, a); }
#else
    a.ph_lo = 0; a.ph_hi = NPHASE;
    hipLaunchKernelGGL(mk_fwd, dim3(grid), dim3(NWAVES * 64), LDS_BYTES, stream, a);
#endif
    const hipError_t le = hipPeekAtLastError();
    if (le != hipSuccess) fprintf(stderr, "kernel_launch: launch failed: %s\n", hipGetErrorName(le));
}
```

```cpp
#include <hip/hip_runtime.h>
#include <cstdio>
#include <cstdint>
#include <cmath>
#define DUPMASK 0

namespace pg8 {
#define PG8_LAS __attribute__((address_space(3)))
typedef unsigned short bf16_t;
typedef short bf16x8 __attribute__((ext_vector_type(8)));
typedef float f32x4 __attribute__((ext_vector_type(4)));
typedef unsigned u32x4 __attribute__((ext_vector_type(4)));
constexpr int BM = 256, BK = 64, HALF = 128, HTB = HALF * BK * 2  , STAGE_BYTES = 8 * HTB, NXCD = 8, WGM = 8;

__host__ __device__ __forceinline__ int lds_byte(int r, int c) { const int st = (r >> 4) * 2 + (c >> 5), rr = r & 15, cc = c & 31, ob = rr * 64 + cc * 2; return st * 1024 + (ob ^ (((ob >> 9) & 1) << 5)); }
__host__ __device__ __forceinline__ void stage_rc(int b, int& R, int& C) { const int st = b / 1024, sb = b % 1024, swz = sb ^ (((sb >> 9) & 1) << 5); R = (st >> 1) * 16 + swz / 64; C = (st & 1) * 32 + (swz % 64) / 2; }
__host__ __device__ __forceinline__ int perm32(int rho) { const int n = rho >> 4, i = rho & 15; return 8 * (i >> 2) + 4 * n + (i & 3); }

struct Unit { int pm, pn; };
struct Gemm { const bf16_t* A; const bf16_t* Bt; int M, N, K; };

struct StaticOrder {
    int nM, nN, nwg, G, c;
    __host__ __device__ void init(int M, int N, int G_, int c_) { nM = M / BM; nN = N / BM; nwg = nM * nN; G = G_; c = c_; }
    __host__ __device__ bool next(int i, Unit& u) const {
        const long L = (long)i * G + c; if (L >= nwg) return false;
        int wgid = (int)L; { const int q = nwg / NXCD, r = nwg % NXCD, xcd = wgid % NXCD, off = wgid / NXCD; wgid = (xcd < r ? xcd * (q + 1) : r * (q + 1) + (xcd - r) * q) + off; }
        const int nig = WGM * nN, gid = wgid / nig, fm = gid * WGM, gsz = (nM - fm) < WGM ? (nM - fm) : WGM;
        u.pm = fm + ((wgid % nig) % gsz); u.pn = (wgid % nig) / gsz; return true;
    }
    __device__ __forceinline__ void a_ready(const Unit&) const {}
    __device__ __forceinline__ void done(const Unit&) const {}
};

__device__ __forceinline__ unsigned cvt_pk_bf16(float lo, float hi) { unsigned r; asm volatile("v_cvt_pk_bf16_f32 %0, %1, %2" : "=v"(r) : "v"(lo), "v"(hi)); return r; }
typedef float f32x2 __attribute__((ext_vector_type(2)));
constexpr int MROWS = 32768;
constexpr float RMS_EPS_F = 1e-6f;
struct RowScale { const float* rs; const float* ss; };
__device__ __forceinline__ float row_scale(const RowScale& R, int row) {
    if (R.ss) return 1.0f / sqrtf(R.ss[row] * (1.0f / 1024.0f) + RMS_EPS_F);
    return R.rs[row];
}
struct EpiScaleBf16 {
    static constexpr bool PERM = true, AFTER_DRAIN = false;
    bf16_t* O; int ldc; RowScale R; int split_cols; size_t split_stride;
    __device__ __forceinline__ void operator()(const f32x4 (&acc)[2][2][4][2], const Unit& u, int wr, int wc, int fr, int fq) const {
        const int row0 = u.pm * BM + wr * 64 + fr; int colt = u.pn * BM; bf16_t* base = O;
        if (split_cols) { const int t = colt / split_cols; base += (size_t)t * split_stride; colt -= t * split_cols; }
        const int col0 = colt + wc * 32 + 8 * fq;
#pragma unroll
        for (int ai = 0; ai < 2; ++ai)
#pragma unroll
            for (int m = 0; m < 4; ++m) { const int row = row0 + ai * HALF + m * 16; const float sc = row_scale(R, row); bf16_t* rowp = base + (size_t)row * ldc + col0;
#pragma unroll
                for (int bj = 0; bj < 2; ++bj) { f32x4 v0 = acc[ai][bj][m][0] * sc, v1 = acc[ai][bj][m][1] * sc;
                    u32x4 w; w.x = cvt_pk_bf16(v0[0], v0[1]); w.y = cvt_pk_bf16(v0[2], v0[3]); w.z = cvt_pk_bf16(v1[0], v1[1]); w.w = cvt_pk_bf16(v1[2], v1[3]);
                    *(u32x4*)(rowp + bj * HALF) = w; } }
    }
};
struct EpiSwiglu {
    static constexpr bool PERM = true, AFTER_DRAIN = false;
    bf16_t* O; int ldc; RowScale R;
    __device__ __forceinline__ void operator()(const f32x4 (&acc)[2][2][4][2], const Unit& u, int wr, int wc, int fr, int fq) const {
        const int row0 = u.pm * BM + wr * 64 + fr; const int col0 = u.pn * HALF + wc * 32 + 8 * fq;
#pragma unroll
        for (int ai = 0; ai < 2; ++ai)
#pragma unroll
            for (int m = 0; m < 4; ++m) { const int row = row0 + ai * HALF + m * 16; const float sc = row_scale(R, row); bf16_t* rowp = O + (size_t)row * ldc + col0;
                float o[8];
#pragma unroll
                for (int n = 0; n < 2; ++n)
#pragma unroll
                    for (int e = 0; e < 4; ++e) { const float g = acc[ai][0][m][n][e] * sc, up = acc[ai][1][m][n][e] * sc; o[n * 4 + e] = g * up / (1.0f + __expf(-g)); }
                u32x4 w; w.x = cvt_pk_bf16(o[0], o[1]); w.y = cvt_pk_bf16(o[2], o[3]); w.z = cvt_pk_bf16(o[4], o[5]); w.w = cvt_pk_bf16(o[6], o[7]);
                *(u32x4*)rowp = w; }
    }
};
struct EpiResid {
    static constexpr bool PERM = false, AFTER_DRAIN = false;
    const float* basef; bf16_t* h16; float* ss; int ldc;
    __device__ __forceinline__ void operator()(const f32x4 (&acc)[2][2][4][2], const Unit& u, int wr, int wc, int fr, int fq) const {
        typedef unsigned u32x2v __attribute__((ext_vector_type(2)));
        const int row0 = u.pm * BM + wr * 64 + fr, col0 = u.pn * BM + wc * 32 + 4 * fq;
#pragma unroll
        for (int ai = 0; ai < 2; ++ai) {
            f32x4 pre[4][2][2];
#pragma unroll
            for (int m = 0; m < 4; ++m) { const size_t off = (size_t)(row0 + ai * HALF + m * 16) * ldc + col0;
#pragma unroll
                for (int bj = 0; bj < 2; ++bj)
#pragma unroll
                    for (int n = 0; n < 2; ++n) {
                        if (basef) pre[m][bj][n] = *(const f32x4*)(basef + off + bj * HALF + n * 16);
                        else { const u32x2v w = *(const u32x2v*)(h16 + off + bj * HALF + n * 16);
                            pre[m][bj][n] = (f32x4){__builtin_bit_cast(float, w.x << 16), __builtin_bit_cast(float, w.x & 0xffff0000u), __builtin_bit_cast(float, w.y << 16), __builtin_bit_cast(float, w.y & 0xffff0000u)}; } } }
#pragma unroll
            for (int m = 0; m < 4; ++m) { const int row = row0 + ai * HALF + m * 16; const size_t off = (size_t)row * ldc + col0; float sq = 0.f;
#pragma unroll
                for (int bj = 0; bj < 2; ++bj)
#pragma unroll
                    for (int n = 0; n < 2; ++n) { const f32x4 o = pre[m][bj][n] + acc[ai][bj][m][n];
                        sq += (o[0] * o[0] + o[1] * o[1]) + (o[2] * o[2] + o[3] * o[3]);
                        u32x2v w; w.x = cvt_pk_bf16(o[0], o[1]); w.y = cvt_pk_bf16(o[2], o[3]); *(u32x2v*)(h16 + off + bj * HALF + n * 16) = w; }
                sq += __shfl_xor(sq, 16); sq += __shfl_xor(sq, 32);
                if (fq == 0) atomicAdd(ss + row, sq); }
        }
    }
};
template <class Epi, class Sched, bool ALIGN_EPI = false, bool SP2 = false>
__device__ __forceinline__ void gemm_phase(PG8_LAS unsigned char* lds, const Gemm g, const Sched& S, const Epi& E) {
    const int tid = threadIdx.x, wid = __builtin_amdgcn_readfirstlane(tid >> 6), lane = tid & 63, wr = wid >> 2, wc = wid & 3, fr = lane & 15, fq = lane >> 4;
    const int K = g.K, nt = K / BK;
    unsigned voffA[2], voffB[2];
#pragma unroll
    for (int i = 0; i < 2; ++i) { int R, C; stage_rc(tid * 16 + i * 8192, R, C); const int Rb = Epi::PERM ? ((R & ~31) + perm32(R & 31)) : R;
        voffA[i] = (unsigned)(R * K + C) * 2u; voffB[i] = (unsigned)(Rb * K + C) * 2u; }
    const size_t kstep = (size_t)(BK * 2);
    const size_t hstep = (size_t)HALF * K * 2;
    const size_t tstep = 2 * hstep;
    const unsigned ldsw = (unsigned)wid * 1024u;
    const int aoff = lds_byte(wr * 64 + fr, fq * 8), boff = lds_byte(wc * 32 + fr, fq * 8);
#define PG8_SA(b, h) (((b) * 2 + (h)) * HTB)
#define PG8_SB(b, h) ((4 + (b) * 2 + (h)) * HTB)
#define PG8_STAGE(bufoff, gbase, voff) do { _Pragma("unroll") for (int _i = 0; _i < 2; ++_i) \
        __builtin_amdgcn_global_load_lds((const unsigned*)((const char*)(gbase) + (voff)[_i]), (PG8_LAS unsigned*)(lds + (bufoff) + ldsw + _i * 8192), 16, 0, 0); } while (0)
#define PG8_LDA(dst, b, h) do { _Pragma("unroll") for (int m = 0; m < 4; ++m) _Pragma("unroll") for (int k = 0; k < 2; ++k) dst[m][k] = *(const PG8_LAS bf16x8*)(lds + PG8_SA(b, h) + aoff + m * 2048 + k * 1024); } while (0)
#define PG8_LDB(dst, b, h) do { _Pragma("unroll") for (int n = 0; n < 2; ++n) _Pragma("unroll") for (int k = 0; k < 2; ++k) dst[n][k] = *(const PG8_LAS bf16x8*)(lds + PG8_SB(b, h) + boff + n * 2048 + k * 1024); } while (0)
#define PG8_MMA(ai, bj, At, Bt) do { __builtin_amdgcn_s_setprio(1); _Pragma("unroll") for (int m = 0; m < 4; ++m) _Pragma("unroll") for (int n = 0; n < 2; ++n) _Pragma("unroll") for (int k = 0; k < 2; ++k) \
        acc[ai][bj][m][n] = __builtin_amdgcn_mfma_f32_16x16x32_bf16(Bt[n][k], At[m][k], acc[ai][bj][m][n], 0, 0, 0); __builtin_amdgcn_s_setprio(0); } while (0)
#define PG8_WAIT_V(n) asm volatile("s_waitcnt vmcnt(" #n ")" ::: "memory")
#define PG8_WAIT_L(n) asm volatile("s_waitcnt lgkmcnt(" #n ")" ::: "memory")
#define PG8_BAR __builtin_amdgcn_s_barrier()
#define PG8_SCHED __builtin_amdgcn_sched_barrier(0)
    Unit cur, nxt; int ui = 0;
    if (!S.next(0, cur)) return;
    f32x4 acc[2][2][4][2];
#pragma unroll
    for (int a = 0; a < 2; ++a)
#pragma unroll
        for (int b = 0; b < 2; ++b)
#pragma unroll
            for (int m = 0; m < 4; ++m)
#pragma unroll
                for (int n = 0; n < 2; ++n) acc[a][b][m][n] = (f32x4){0.f, 0.f, 0.f, 0.f};
    bf16x8 At[4][2], B0[2][2], B1[2][2];
    const char* cA = (const char*)g.A + (size_t)cur.pm * tstep; const char* cB = (const char*)g.Bt + (size_t)cur.pn * tstep;
    S.a_ready(cur);
    if constexpr (SP2) {
        PG8_STAGE(PG8_SB(0, 0), cB, voffB); PG8_STAGE(PG8_SB(0, 1), cB + hstep, voffB); PG8_STAGE(PG8_SA(0, 0), cA, voffA); PG8_STAGE(PG8_SA(0, 1), cA + hstep, voffA);
        if (wr == 1) PG8_BAR;
        PG8_WAIT_V(2); PG8_BAR;
        PG8_STAGE(PG8_SB(1, 0), cB + kstep, voffB); PG8_STAGE(PG8_SA(1, 0), cA + kstep, voffA); PG8_STAGE(PG8_SB(1, 1), cB + hstep + kstep, voffB);
        PG8_WAIT_V(6); PG8_BAR;
    } else {
        PG8_STAGE(PG8_SB(0, 0), cB, voffB); PG8_STAGE(PG8_SA(0, 0), cA, voffA); PG8_STAGE(PG8_SB(0, 1), cB + hstep, voffB); PG8_STAGE(PG8_SA(0, 1), cA + hstep, voffA);
        if (wr == 1) PG8_BAR;
        PG8_WAIT_V(4); PG8_BAR;
        PG8_STAGE(PG8_SB(1, 0), cB + kstep, voffB); PG8_STAGE(PG8_SA(1, 0), cA + kstep, voffA); PG8_STAGE(PG8_SB(1, 1), cB + hstep + kstep, voffB);
        PG8_WAIT_V(6); PG8_BAR;
    }
    for (;;) {
        const bool has_next = S.next(ui + 1, nxt);
        const char* nA = has_next ? (const char*)g.A + (size_t)nxt.pm * tstep : cA; const char* nB = has_next ? (const char*)g.Bt + (size_t)nxt.pn * tstep : cB;
        for (int t = 0; t < nt; t += 2) {
            const bool last = (t == nt - 2);
            const char* a1 = cA + (size_t)(t + 1) * kstep;
            const char* a2 = last ? nA : cA + (size_t)(t + 2) * kstep; const char* b2 = last ? nB : cB + (size_t)(t + 2) * kstep;
            const char* a3 = a2 + kstep; const char* b3 = b2 + kstep;
            if (last && has_next) S.a_ready(nxt);
            if constexpr (SP2) {
            PG8_LDB(B0, 0, 0); PG8_LDB(B1, 0, 1); PG8_SCHED; PG8_LDA(At, 0, 0); PG8_STAGE(PG8_SA(1, 1), a1 + hstep, voffA);
            PG8_WAIT_V(8); PG8_WAIT_L(0); PG8_BAR; PG8_MMA(0, 0, At, B0); PG8_MMA(0, 1, At, B1); PG8_BAR; PG8_SCHED;
            PG8_LDA(At, 0, 1); PG8_STAGE(PG8_SB(0, 0), b2, voffB); PG8_STAGE(PG8_SB(0, 1), b2 + hstep, voffB); PG8_STAGE(PG8_SA(0, 0), a2, voffA);
            PG8_WAIT_V(8); PG8_WAIT_L(0); PG8_BAR; PG8_MMA(1, 0, At, B0); PG8_MMA(1, 1, At, B1); PG8_BAR; PG8_SCHED;
            PG8_LDB(B0, 1, 0); PG8_LDB(B1, 1, 1); PG8_SCHED; PG8_LDA(At, 1, 0); PG8_STAGE(PG8_SA(0, 1), a2 + hstep, voffA);
            PG8_WAIT_V(8); PG8_WAIT_L(0); PG8_BAR; PG8_MMA(0, 0, At, B0); PG8_MMA(0, 1, At, B1); PG8_BAR; PG8_SCHED;
            PG8_LDA(At, 1, 1); PG8_STAGE(PG8_SB(1, 0), b3, voffB); PG8_STAGE(PG8_SB(1, 1), b3 + hstep, voffB); PG8_STAGE(PG8_SA(1, 0), a3, voffA);
            PG8_WAIT_V(8); PG8_WAIT_L(0); PG8_BAR; PG8_MMA(1, 0, At, B0); PG8_MMA(1, 1, At, B1); PG8_BAR; PG8_SCHED;
            } else {
            PG8_LDB(B0, 0, 0); PG8_SCHED; PG8_LDA(At, 0, 0); PG8_STAGE(PG8_SA(1, 1), a1 + hstep, voffA);
            PG8_WAIT_L(8); PG8_BAR; PG8_WAIT_L(0); PG8_MMA(0, 0, At, B0); PG8_BAR; PG8_SCHED;
            PG8_LDB(B1, 0, 1); PG8_STAGE(PG8_SB(0, 0), b2, voffB);
            PG8_BAR; PG8_WAIT_L(0); PG8_MMA(0, 1, At, B1); PG8_BAR;
            PG8_LDA(At, 0, 1); PG8_STAGE(PG8_SA(0, 0), a2, voffA);
            PG8_BAR; PG8_WAIT_L(0); PG8_MMA(1, 0, At, B0); PG8_BAR; PG8_SCHED;
            PG8_STAGE(PG8_SB(0, 1), b2 + hstep, voffB);
            PG8_WAIT_V(6); PG8_BAR; PG8_MMA(1, 1, At, B1); PG8_BAR;
            PG8_LDB(B0, 1, 0); PG8_SCHED; PG8_LDA(At, 1, 0); PG8_STAGE(PG8_SA(0, 1), a2 + hstep, voffA);
            PG8_WAIT_L(8); PG8_BAR; PG8_WAIT_L(0); PG8_MMA(0, 0, At, B0); PG8_BAR; PG8_SCHED;
            PG8_LDB(B1, 1, 1); PG8_STAGE(PG8_SB(1, 0), b3, voffB);
            PG8_BAR; PG8_WAIT_L(0); PG8_MMA(0, 1, At, B1); PG8_BAR;
            PG8_LDA(At, 1, 1); PG8_STAGE(PG8_SA(1, 0), a3, voffA);
            PG8_BAR; PG8_WAIT_L(0); PG8_MMA(1, 0, At, B0); PG8_BAR; PG8_SCHED;
            PG8_STAGE(PG8_SB(1, 1), b3 + hstep, voffB);
            PG8_WAIT_V(6); PG8_BAR; PG8_MMA(1, 1, At, B1); PG8_BAR;
            }
        }
        if constexpr (ALIGN_EPI) { if (wr == 0) PG8_BAR; }
        if constexpr (!Epi::AFTER_DRAIN) { E(acc, cur, wr, wc, fr, fq); S.done(cur); }
        if (!has_next) break;
#pragma unroll
        for (int a = 0; a < 2; ++a)
#pragma unroll
            for (int b = 0; b < 2; ++b)
#pragma unroll
                for (int m = 0; m < 4; ++m)
#pragma unroll
                    for (int n = 0; n < 2; ++n) acc[a][b][m][n] = (f32x4){0.f, 0.f, 0.f, 0.f};
        cur = nxt; cA = nA; cB = nB; ++ui;
        if constexpr (ALIGN_EPI) { if (wr == 1) PG8_BAR; }
    }
    PG8_WAIT_V(0);
    if constexpr (!ALIGN_EPI) { if (wr == 0) PG8_BAR; }
    PG8_BAR;
    if constexpr (Epi::AFTER_DRAIN) { E.fused(acc, cur, wr, wc, fr, fq, lds, wid, lane); S.done(cur); }
#undef PG8_SA
#undef PG8_SB
#undef PG8_STAGE
#undef PG8_LDA
#undef PG8_LDB
#undef PG8_MMA
#undef PG8_WAIT_V
#undef PG8_WAIT_L
#undef PG8_BAR
#undef PG8_SCHED
}
}
#ifndef PG8_SP2
#define PG8_SP2 true
#endif
#ifndef PG8_ALIGN
#define PG8_ALIGN true
#endif
constexpr int NWAVES = 8;
#ifndef MK_PER_PHASE
#define MK_PER_PHASE 0
#endif
constexpr int NPHASE = 16;

constexpr int BATCH = 4, T = 8192, D = 1024, M = BATCH * T, FF = 2816;
constexpr int AB_LD = 2072, C_LD = 3080;
constexpr float C2 = 0.125f * 1.4426950408889634f;
constexpr float LOG2E = 1.4426950408889634f;
constexpr int QC_QN = 0, QC_KC = 512, QC_VC = 640, QC_KS = 768, QC_VS = 896, QC_KW = 1024, QC_VW = 1152, QC_QS = 1280, QC_KSW = 1792, QC_VSW = 1920;

constexpr size_t MiB = 1u << 20, KiB = 1024;
constexpr size_t WS_CTL = 0, CTL_ZERO_BYTES = 1 * MiB;
constexpr size_t WS_RS0 = 1 * MiB;
constexpr size_t WS_PSUM = WS_RS0 + 128 * KiB;
constexpr size_t WS_GATES = WS_PSUM + 2 * MiB;
constexpr size_t WS_SCA = WS_GATES + 4 * MiB;
constexpr size_t WS_SCM = WS_SCA + 512 * KiB;
constexpr size_t WS_SCE = WS_SCM + 512 * KiB;
constexpr size_t WS_KC = WS_SCE + 512 * KiB;
constexpr size_t WS_VC = WS_KC + 512 * KiB;
constexpr size_t WS_WABG = WS_VC + 512 * KiB;
constexpr size_t WS_WCG = WS_WABG + 64 * KiB;
constexpr size_t WS_CW1K = WS_WCG + 64 * KiB;
constexpr size_t WS_CW1V = WS_CW1K + 256 * KiB;
constexpr size_t WS_CW2K = WS_CW1V + 256 * KiB;
constexpr size_t WS_CW2V = WS_CW2K + 8 * KiB;
constexpr size_t WS_CBIAS = WS_CW2V + 8 * KiB;
constexpr size_t WS_NLOC = WS_CBIAS + 4 * KiB;
constexpr size_t WS_NST = WS_NLOC + 256 * KiB;
static_assert(WS_NST + 256 * KiB <= 13 * MiB, "small region");
constexpr size_t WS_WAB = 13 * MiB;
constexpr size_t WS_WABO = WS_WAB + 4 * MiB;
constexpr size_t WS_WUP0 = WS_WABO + 2 * MiB;
constexpr size_t WS_WUP1 = WS_WUP0 + 11 * MiB;
constexpr size_t WS_WDN0 = WS_WUP1 + 11 * MiB;
constexpr size_t WS_WDN1 = WS_WDN0 + 5632 * KiB;
constexpr size_t WS_WCIN = WS_WDN1 + 5632 * KiB;
constexpr size_t WS_WCO = WS_WCIN + 6 * MiB;
static_assert(WS_WCO + 2 * MiB <= 60 * MiB, "weights region");
constexpr size_t WS_H16 = 60 * MiB;
constexpr size_t WS_A = 124 * MiB;
constexpr size_t WS_QKV0 = WS_A, WS_ATT = WS_A + 128 * MiB;
constexpr size_t WS_QKP = WS_A, WS_V1 = WS_A + 64 * MiB, WS_OG = WS_A + 128 * MiB;
constexpr size_t WS_B = 316 * MiB;
constexpr size_t WS_HID = WS_B;
constexpr size_t WS_ACCF = WS_B;
constexpr size_t WS_QKC = WS_B, WS_LT = WS_B + 64 * MiB, WS_CST = WS_B + 128 * MiB;
constexpr size_t WS_END = 492 * MiB;
static_assert(WS_HID + (size_t)M * FF * 2 <= WS_END && WS_CST + 32 * MiB <= WS_END, "d_ws map");
constexpr int CW_TMO = 0, CW_CODE = 1;
constexpr int CW_BAR = 4096;

constexpr int RING_OFF = 0, RING_BYTES = 131072;
constexpr int LDSCTL_OFF = RING_BYTES, MISC_OFF = LDSCTL_OFF + 320;
constexpr int LDS_BYTES = 147456;
static_assert(MISC_OFF + 128 <= LDS_BYTES, "LDS map");

#define GAS __attribute__((address_space(1)))
#define LAS __attribute__((address_space(3)))
typedef unsigned short bf16;
typedef unsigned v4u __attribute__((ext_vector_type(4)));
typedef unsigned v2u __attribute__((ext_vector_type(2)));
typedef float f32x4 __attribute__((ext_vector_type(4)));
typedef float f32x16 __attribute__((ext_vector_type(16)));
typedef short bf16x8 __attribute__((ext_vector_type(8)));
typedef short s16x4 __attribute__((ext_vector_type(4)));
typedef GAS unsigned gu32;
typedef GAS unsigned long long gu64;
#define RLX_AGENT __ATOMIC_RELAXED, __HIP_MEMORY_SCOPE_AGENT
#define LDS_WAIT() asm volatile("s_waitcnt lgkmcnt(0)" ::: "memory")
#define VM_WAIT() asm volatile("s_waitcnt vmcnt(0)" ::: "memory")
__device__ __forceinline__ unsigned f2bf(float f) { unsigned u = __builtin_bit_cast(unsigned, f); return (u + 0x7fffu + ((u >> 16) & 1u)) >> 16; }
__device__ __forceinline__ unsigned pk2(float lo, float hi) { return f2bf(lo) | (f2bf(hi) << 16); }
__device__ __forceinline__ float bf2f(unsigned short b) { return __builtin_bit_cast(float, (unsigned)b << 16); }
__device__ __forceinline__ float bflo(unsigned w) { return __builtin_bit_cast(float, w << 16); }
__device__ __forceinline__ float bfhi(unsigned w) { return __builtin_bit_cast(float, w & 0xffff0000u); }
__device__ __forceinline__ int crow(int r, int hi) { return (r & 3) + 8 * (r >> 2) + 4 * hi; }
__device__ __forceinline__ f32x16 mfma32(bf16x8 a, bf16x8 b, f32x16 c) { return __builtin_amdgcn_mfma_f32_32x32x16_bf16(a, b, c, 0, 0, 0); }
typedef short v4i16_t __attribute__((ext_vector_type(4)));
__device__ __forceinline__ s16x4 ds_tr(LAS unsigned char* p) { return __builtin_bit_cast(s16x4, __builtin_amdgcn_ds_read_tr16_b64_v4i16((LAS v4i16_t*)p)); }
__device__ __forceinline__ bf16x8 frag_tr(LAS unsigned char* lb, int off0, int off1) {
    const s16x4 lo = ds_tr(lb + off0), hi = ds_tr(lb + off1);
    return (bf16x8){lo[0], lo[1], lo[2], lo[3], hi[0], hi[1], hi[2], hi[3]};
}
typedef float f32x2_t __attribute__((ext_vector_type(2))); typedef __bf16 bf16x2_t __attribute__((ext_vector_type(2)));
__device__ __forceinline__ unsigned cvtpk(float lo, float hi) { f32x2_t v = {lo, hi}; bf16x2_t b = __builtin_convertvector(v, bf16x2_t); return __builtin_bit_cast(unsigned, b); }
template <int s> __device__ __forceinline__ bf16x8 pack8(const f32x16& p) {
    v4u w; w.x = cvtpk(p[8 * s + 0], p[8 * s + 1]); w.y = cvtpk(p[8 * s + 2], p[8 * s + 3]); w.z = cvtpk(p[8 * s + 4], p[8 * s + 5]); w.w = cvtpk(p[8 * s + 6], p[8 * s + 7]);
    return __builtin_bit_cast(bf16x8, w);
}
__device__ __forceinline__ float wave_sum(float v) {
#pragma unroll
    for (int o = 1; o < 64; o <<= 1) v += __shfl_xor(v, o);
    return v;
}
#define XB_TMO      128
#define XB_XCNT(j)  (256  + 64 * (j))
#define XB_XSUB(j)  (1280 + 64 * (j))
#define XB_XGEN(j)  (2304 + 64 * (j))
#define XB_TOP      3328
#define XB_TOPGEN   3392
#define XCD_BAR_WORDS 3456
#define XB_SPIN_CAP (1u << 18)

__device__ __forceinline__ unsigned xb_ld(unsigned* p)              { return __hip_atomic_load(p, __ATOMIC_RELAXED, __HIP_MEMORY_SCOPE_AGENT); }
__device__ __forceinline__ unsigned xb_add(unsigned* p, unsigned v) { return __hip_atomic_fetch_add(p, v, __ATOMIC_RELAXED, __HIP_MEMORY_SCOPE_AGENT); }
__device__ __forceinline__ unsigned xb_xcc_id() { return (unsigned)__builtin_amdgcn_s_getreg((3 << 11) | 20) & 0xFu; }
#define XB_SPIN(cond, bar) do { unsigned _sp = 0; while (cond) { __builtin_amdgcn_s_sleep(1); \
    if ((++_sp & 255u) == 0u) { if (xb_ld(&(bar)[XB_TMO])) break; if (_sp > XB_SPIN_CAP) { atomicAdd(&(bar)[XB_TMO], 1u); break; } } } } while (0)

struct XcdBarrier {
    unsigned* bar; unsigned x;
    volatile LAS unsigned* st;
};

__device__ __forceinline__ XcdBarrier xcd_barrier_post(unsigned* bar, volatile LAS unsigned* st) {
    XcdBarrier b; b.bar = bar; b.x = xb_xcc_id(); b.st = st;
    if (threadIdx.x == 0) (void)xb_add(&bar[XB_XCNT(b.x)], 1u);
    return b;
}
__device__ __forceinline__ void xcd_barrier_complete(unsigned* bar, unsigned x, unsigned& nloc, unsigned& nx) {
    const unsigned G = gridDim.x * gridDim.y * gridDim.z;
    unsigned sum, cnt, mine, sp = 0u;
    for (;;) {
        sum = 0u; cnt = 0u; mine = 0u;
#pragma unroll
        for (unsigned j = 0; j < 16; ++j) { const unsigned c = xb_ld(&bar[XB_XCNT(j)]); sum += c; cnt += (c > 0u) ? 1u : 0u; mine = (j == x) ? c : mine; }
        if (sum == G) break;
        __builtin_amdgcn_s_sleep(1);
        if ((++sp & 255u) == 0u) { if (xb_ld(&bar[XB_TMO])) break; if (sp > XB_SPIN_CAP) { atomicAdd(&bar[XB_TMO], 1u); break; } }
    }
    nloc = mine > 0u ? mine : 1u; nx = cnt > 0u ? cnt : 1u;
}

__device__ __forceinline__ void xcd_barrier(const XcdBarrier& b) {
    asm volatile("s_waitcnt vmcnt(0)" ::: "memory");
    __syncthreads();
    if (threadIdx.x == 0) {
        unsigned* bar = b.bar;
        __builtin_amdgcn_s_waitcnt(0);
        unsigned nloc = b.st[0], nx = b.st[1];
        if (nloc == 0u) { xcd_barrier_complete(bar, b.x, nloc, nx); b.st[0] = nloc; b.st[1] = nx; }
        const unsigned old = xb_add(&bar[XB_XSUB(b.x)], 1u);
        const unsigned gen = old / nloc;
        if (old + 1u == (gen + 1u) * nloc) {
            __builtin_amdgcn_fence(__ATOMIC_RELEASE, "agent");
            asm volatile("s_waitcnt vmcnt(0)" ::: "memory");
            const unsigned og = xb_add(&bar[XB_TOP], 1u);
            const unsigned tg = og / nx;
            if (og + 1u == (tg + 1u) * nx) xb_add(&bar[XB_TOPGEN], 1u);
            else XB_SPIN(xb_ld(&bar[XB_TOPGEN]) == tg, bar);
            __builtin_amdgcn_fence(__ATOMIC_ACQUIRE, "agent");
            xb_add(&bar[XB_XGEN(b.x)], 1u);
            asm volatile("s_waitcnt vmcnt(0)" ::: "memory");
        } else {
            XB_SPIN(xb_ld(&bar[XB_XGEN(b.x)]) == gen, bar);
            __builtin_amdgcn_fence(__ATOMIC_ACQUIRE, "agent");
            asm volatile("s_waitcnt vmcnt(0)" ::: "memory");
        }
    }
    __syncthreads();
}
struct Frame {
    LAS unsigned char* lds;
    volatile LAS unsigned* MISC;
    gu32* ctl;
    int tid, lane, wave;
    int vcu, G;
    unsigned char* ws;
    const float* in[23];
    float* out;
};
#define WSP(T_, off) ((T_*)(F.ws + (off)))

__device__ __forceinline__ void p0_titem(const float* W, int ldw, int c0, const float* kscale, float mul, bf16* WT, int Kd, int drow0, LAS float* scr, int kb, int lane) {
    const int k0 = 64 * kb; f32x4 v[8];
    if ((c0 & 3) == 0 && (ldw & 3) == 0) {
#pragma unroll
        for (int i = 0; i < 8; ++i) { const int kk = 8 * i + (lane >> 3); v[i] = *(const f32x4*)(W + (size_t)(k0 + kk) * ldw + c0 + 4 * (lane & 7)); }
    } else {
#pragma unroll
        for (int i = 0; i < 8; ++i) { const int kk = 8 * i + (lane >> 3); const float* p = W + (size_t)(k0 + kk) * ldw + c0 + 4 * (lane & 7); v[i] = (f32x4){p[0], p[1], p[2], p[3]}; }
    }
#pragma unroll
    for (int i = 0; i < 8; ++i) { const int kk = 8 * i + (lane >> 3); const float sc = (kscale ? kscale[k0 + kk] : 1.0f) * mul; LAS float* d = scr + kk * 33 + 4 * (lane & 7);
        d[0] = v[i][0] * sc; d[1] = v[i][1] * sc; d[2] = v[i][2] * sc; d[3] = v[i][3] * sc; }
    LDS_WAIT(); asm volatile("" ::: "memory");
    const int c = lane & 7;
#pragma unroll
    for (int j = 0; j < 4; ++j) { const int n = (lane >> 3) + 8 * j; const LAS float* s = scr + (8 * c) * 33 + n;
        v4u o; o.x = pk2(s[0 * 33], s[1 * 33]); o.y = pk2(s[2 * 33], s[3 * 33]); o.z = pk2(s[4 * 33], s[5 * 33]); o.w = pk2(s[6 * 33], s[7 * 33]);
        *(GAS v4u*)(WT + (size_t)(drow0 + n) * Kd + k0 + 8 * c) = o; }
    LDS_WAIT(); asm volatile("" ::: "memory");
}
__device__ __forceinline__ void p0_prologue(Frame& F) {
    LAS float* scr = (LAS float*)(F.lds + RING_OFF + F.wave * 16384);
    const int gw = F.vcu * NWAVES + F.wave, NGW = F.G * NWAVES, lane = F.lane;
    const float* norm_mix = F.in[1]; const float* norm_ffn = F.in[2];
    constexpr int I_AB1 = 16 * 40, I_AB2 = 16 * 24, I_ABO = 16 * 32, I_FF = 16 * 88, I_DN = 44 * 32, I_CIN = 16 * 96, I_CO = 16 * 32, I_W1 = 32 * 2, I_W2 = 2;
    constexpr int NITEMS = I_AB1 + I_AB2 + I_ABO + 4 * I_FF + 2 * I_DN + I_CIN + I_CO + 2 * I_W1 + 2 * I_W2;
    for (int it = gw; it < NITEMS; it += NGW) {
        int r = it;
        if (r < I_AB1) { const int kb = r / 40, nb = r % 40; p0_titem(F.in[6], AB_LD, 32 * nb, norm_mix, nb < 16 ? C2 : 1.f, WSP(bf16, WS_WAB), 1024, 32 * nb, scr, kb, lane); continue; } r -= I_AB1;
        if (r < I_AB2) { const int kb = r / 24, nb = r % 24; p0_titem(F.in[6], AB_LD, 1304 + 32 * nb, norm_mix, nb < 16 ? C2 : 1.f, WSP(bf16, WS_WAB), 1024, 1280 + 32 * nb, scr, kb, lane); continue; } r -= I_AB2;
        if (r < I_ABO) { const int kb = r / 32, nb = r % 32; p0_titem(F.in[15], 1024, 32 * nb, nullptr, 1.f, WSP(bf16, WS_WABO), 1024, 32 * nb, scr, kb, lane); continue; } r -= I_ABO;
        if (r < 4 * I_FF) { const int q = r / I_FF, rr = r % I_FF, l = q >> 1, up = q & 1, kb = rr / 88, nb = rr % 88, n0 = 32 * nb;
            const float* W = (up ? F.in[4] : F.in[3]) + (size_t)l * 1024 * FF;
            p0_titem(W, FF, n0, norm_ffn + l * 1024, 1.f, WSP(bf16, l ? WS_WUP1 : WS_WUP0), 1024, 256 * (n0 / 128) + (n0 % 128) + 128 * up, scr, kb, lane); continue; } r -= 4 * I_FF;
        if (r < 2 * I_DN) { const int l = r / I_DN, rr = r % I_DN, kb = rr / 32, nb = rr % 32;
            p0_titem(F.in[5] + (size_t)l * FF * 1024, 1024, 32 * nb, nullptr, 1.f, WSP(bf16, l ? WS_WDN1 : WS_WDN0), FF, 32 * nb, scr, kb, lane); continue; } r -= 2 * I_DN;
        if (r < I_CIN) { const int kb = r / 96, nb = r % 96; p0_titem(F.in[16], C_LD, 32 * nb, norm_mix + 1024, 1.f, WSP(bf16, WS_WCIN), 1024, 32 * nb, scr, kb, lane); continue; } r -= I_CIN;
        if (r < I_CO) { const int kb = r / 32, nb = r % 32; p0_titem(F.in[21], 1024, 32 * nb, nullptr, 1.f, WSP(bf16, WS_WCO), 1024, 32 * nb, scr, kb, lane); continue; } r -= I_CO;
        if (r < 2 * I_W1) { const int kv = r / I_W1, rr = r % I_W1, kb = rr / 2, nb = rr % 2; p0_titem(F.in[kv ? 12 : 10], 64, 32 * nb, nullptr, 1.f, WSP(bf16, kv ? WS_CW1V : WS_CW1K), 2048, 32 * nb, scr, kb, lane); continue; } r -= 2 * I_W1;
        { const int kv = r / I_W2, nb = r % I_W2; p0_titem(F.in[kv ? 13 : 11], 64, 32 * nb, nullptr, 1.f, WSP(bf16, kv ? WS_CW2V : WS_CW2K), 64, 32 * nb, scr, 0, lane); }
    }
    { const int gt = (F.vcu * NWAVES + F.wave) * 64 + lane, NGT = F.G * NWAVES * 64;
      for (int i = gt; i < 2 * 32 * 1024; i += NGT) { const int which = i >> 15, n = (i >> 10) & 31, k = i & 1023; float v = 0.f;
          if (which == 0) { if (n < 24) v = F.in[6][(size_t)k * AB_LD + 1280 + n] * norm_mix[k]; WSP(bf16, WS_WABG)[n * 1024 + k] = (bf16)f2bf(v); }
          else { if (n < 8) v = F.in[16][(size_t)k * C_LD + 3072 + n] * norm_mix[1024 + k]; WSP(bf16, WS_WCG)[n * 1024 + k] = (bf16)f2bf(v); } } }
    { const int gt = (F.vcu * NWAVES + F.wave) * 64 + lane, NGT = F.G * NWAVES * 64; for (int i = gt; i < 4 * M; i += NGT) WSP(float, WS_PSUM)[i] = 0.f; }
    for (int m = gw; m < M; m += 2 * NGW) {
        const GAS f32x4* xr0 = (const GAS f32x4*)(F.in[0] + (size_t)m * D) + lane; const GAS f32x4* xr1 = (const GAS f32x4*)(F.in[0] + (size_t)(m + NGW) * D) + lane;
        f32x4 v[4], u[4]; float s = 0.f, s2 = 0.f;
#pragma unroll
        for (int j = 0; j < 4; ++j) { v[j] = xr0[64 * j]; u[j] = xr1[64 * j]; }
#pragma unroll
        for (int j = 0; j < 4; ++j) { s += (v[j].x * v[j].x + v[j].y * v[j].y) + (v[j].z * v[j].z + v[j].w * v[j].w); s2 += (u[j].x * u[j].x + u[j].y * u[j].y) + (u[j].z * u[j].z + u[j].w * u[j].w); }
        s = wave_sum(s); s2 = wave_sum(s2);
        GAS unsigned long long* o0 = (GAS unsigned long long*)(WSP(bf16, WS_H16) + (size_t)m * D) + lane; GAS unsigned long long* o1 = (GAS unsigned long long*)(WSP(bf16, WS_H16) + (size_t)(m + NGW) * D) + lane;
#pragma unroll
        for (int j = 0; j < 4; ++j) { o0[64 * j] = (unsigned long long)pk2(v[j].x, v[j].y) | ((unsigned long long)pk2(v[j].z, v[j].w) << 32); o1[64 * j] = (unsigned long long)pk2(u[j].x, u[j].y) | ((unsigned long long)pk2(u[j].z, u[j].w) << 32); }
        if (lane == 0) { WSP(float, WS_RS0)[m] = 1.0f / sqrtf(s * (1.0f / D) + 1e-6f); WSP(float, WS_RS0)[m + NGW] = 1.0f / sqrtf(s2 * (1.0f / D) + 1e-6f); }
    }
    if (F.vcu == 0) {
        __syncthreads();
        LAS float* red = (LAS float*)(F.lds + RING_OFF);
#pragma unroll
        for (int kv = 0; kv < 2; ++kv) { const float* pos = F.in[kv ? 9 : 8]; const float* w1 = F.in[kv ? 12 : 10]; float a = 0.f;
            for (int k = F.wave * 256; k < F.wave * 256 + 256; ++k) a += pos[k] * w1[(size_t)k * 64 + lane];
            red[(kv * 8 + F.wave) * 64 + lane] = a; }
        __syncthreads();
        if (F.tid < 128) { const int kv = F.tid >> 6, n = F.tid & 63; float a = 0.f;
#pragma unroll
            for (int w = 0; w < 8; ++w) a += red[(kv * 8 + w) * 64 + n];
            WSP(float, WS_CBIAS)[kv * 64 + n] = a; }
        __syncthreads();
    }
}
__device__ __forceinline__ f32x16 skinny_tile(const bf16* A, const bf16* Wt, int row0, int lane) {
    const int r32 = lane & 31, h = lane >> 5; f32x16 acc = {};
    const bf16* ap = A + (size_t)(row0 + r32) * 1024 + 8 * h; const bf16* wp = Wt + (size_t)r32 * 1024 + 8 * h;
#pragma unroll 8
    for (int s = 0; s < 64; ++s) acc = mfma32(*(const bf16x8*)(wp + 16 * s), *(const bf16x8*)(ap + 16 * s), acc);
    return acc;
}
__device__ __forceinline__ void gates0_phase(Frame& F) {
    const int gw = F.vcu * NWAVES + F.wave, NGW = F.G * NWAVES, lane = F.lane, r32 = lane & 31, h = lane >> 5;
    for (int t = gw; t < M / 32; t += NGW) {
        const f32x16 acc = skinny_tile(WSP(bf16, WS_H16), WSP(bf16, WS_WABG), 32 * t, lane);
        const int row = 32 * t + r32; const float rs = WSP(float, WS_RS0)[row]; float* g = WSP(float, WS_GATES) + (size_t)row * 32;
#pragma unroll
        for (int r = 0; r < 16; ++r) { const int c = crow(r, h); if (c < 24) g[c] = 1.0f / (1.0f + __expf(-(acc[r] * rs + F.in[7][c]))); }
    }
}
__device__ __forceinline__ void gates1_phase(Frame& F) {
    const int gw = F.vcu * NWAVES + F.wave, NGW = F.G * NWAVES, lane = F.lane, r32 = lane & 31, h = lane >> 5;
    const pg8::RowScale R{nullptr, WSP(float, WS_PSUM) + 1 * M};
    for (int t = gw; t < M / 32; t += NGW) {
        const f32x16 acc = skinny_tile(WSP(bf16, WS_H16), WSP(bf16, WS_WCG), 32 * t, lane);
        const int row = 32 * t + r32; const float rs = pg8::row_scale(R, row); float* g = WSP(float, WS_GATES) + (size_t)row * 32;
#pragma unroll
        for (int r = 0; r < 16; ++r) { const int c = crow(r, h);
            if (c < 4) g[c] = acc[r] * rs + F.in[19][c];
            else if (c < 8) { const float x = acc[r] * rs + F.in[20][c - 4]; g[c] = fminf(x, 0.f) - log1pf(__expf(-fabsf(x))); } }
    }
}

__device__ __forceinline__ void compress_phase(Frame& F) {
    const int lane = F.lane, r32 = lane & 31, h = lane >> 5, w = F.wave;
    LAS float* red = (LAS float*)(F.lds + RING_OFF);
    LAS unsigned char* Hs = F.lds + RING_OFF + 65536;
    for (int task = F.vcu; task < 256; task += F.G) {
        const int kv = task & 1, bg = (task >> 1) & 7, rt = task >> 4, b = bg >> 1, g = bg & 1, i0 = rt * 32;
        const bf16* raw = WSP(bf16, WS_QKV0) + (size_t)b * T * 2048 + (kv ? QC_VC : QC_KC) + g * 64;
        const bf16* w1t = WSP(bf16, kv ? WS_CW1V : WS_CW1K);
        const bf16* w2t = WSP(bf16, kv ? WS_CW2V : WS_CW2K);
        int ic = i0 + r32; if (ic > 510) ic = 510;
        f32x16 d0 = {}, d1 = {};
#pragma unroll
        for (int ll = 0; ll < 4; ++ll) { const int l = 4 * w + ll;
#pragma unroll
            for (int ss = 0; ss < 4; ++ss) { const int k = l * 64 + 16 * ss + 8 * h;
                const bf16x8 bfr = *(const bf16x8*)(raw + (size_t)(16 * ic + l) * 2048 + 16 * ss + 8 * h);
                d0 = mfma32(*(const bf16x8*)(w1t + (size_t)r32 * 2048 + k), bfr, d0);
                d1 = mfma32(*(const bf16x8*)(w1t + (size_t)(32 + r32) * 2048 + k), bfr, d1); } }
#pragma unroll
        for (int r = 0; r < 16; ++r) { red[(w * 64 + crow(r, h)) * 32 + r32] = d0[r]; red[(w * 64 + 32 + crow(r, h)) * 32 + r32] = d1[r]; }
        __syncthreads();
#pragma unroll
        for (int e = 0; e < 4; ++e) { const int idx = F.tid * 4 + e, hid = idx >> 5, i = idx & 31; float a = WSP(float, WS_CBIAS)[kv * 64 + hid];
#pragma unroll
            for (int ww = 0; ww < 8; ++ww) a += red[(ww * 64 + hid) * 32 + i];
            a = a / (1.0f + __expf(-a));
            *(LAS bf16*)(Hs + i * 144 + hid * 2) = (bf16)f2bf(a); }
        __syncthreads();
        if (w < 2) { f32x16 o = {};
#pragma unroll
            for (int s = 0; s < 4; ++s) o = mfma32(*(const bf16x8*)(w2t + (size_t)(32 * w + r32) * 64 + 16 * s + 8 * h), *(const LAS bf16x8*)(Hs + r32 * 144 + (16 * s + 8 * h) * 2), o);
            bf16* dst = WSP(bf16, kv ? WS_VC : WS_KC) + ((size_t)bg * 512 + i0 + r32) * 64 + 32 * w + 4 * h;
#pragma unroll
            for (int q = 0; q < 4; ++q) { v2u pk; pk.x = pk2(o[4 * q], o[4 * q + 1]); pk.y = pk2(o[4 * q + 2], o[4 * q + 3]); *(v2u*)(dst + 8 * q) = pk; } }
        __syncthreads();
    }
}
constexpr int AT_K = 0, AT_V = 9216, AT_BUF = 18432, AT_IMP = 2 * AT_BUF, AT_SEL = AT_IMP + 128 * 132 * 4, AT_END = AT_SEL + 2048;
static_assert(AT_END <= RING_BYTES, "attention LDS");
constexpr int KV_STRIDE = 144;
__device__ __forceinline__ void stage_load(Frame& F, const bf16* Kg, const bf16* Vg, int pitch, int row0, int rmax, v4u& kx, v4u& vx) {
    const int row = F.tid >> 3, ch = F.tid & 7; int rr = row0 + row; rr = rr < 0 ? 0 : (rr > rmax ? rmax : rr);
    kx = *(const v4u*)(Kg + (size_t)rr * pitch + ch * 8);
    if (Vg) vx = *(const v4u*)(Vg + (size_t)rr * pitch + ch * 8);
}
__device__ __forceinline__ void stage_write(Frame& F, int boff, bool hasv, const v4u& kx, const v4u& vx) {
    const int row = F.tid >> 3, ch = F.tid & 7;
    *(LAS v4u*)(F.lds + boff + AT_K + row * KV_STRIDE + ch * 16) = kx;
    if (hasv) *(LAS v4u*)(F.lds + boff + AT_V + row * KV_STRIDE + ch * 16) = vx;
}
__device__ __forceinline__ f32x16 qk_tile(LAS unsigned char* klb, int sub, const bf16x8 (&qf)[4]) {
    f32x16 s = {};
#pragma unroll
    for (int st = 0; st < 4; ++st) s = mfma32(*(const LAS bf16x8*)(klb + 32 * sub * KV_STRIDE + 32 * st), qf[st], s);
    return s;
}
__device__ __forceinline__ void pv_tile(LAS unsigned char* vlb, int sub, const f32x16& p, f32x16 (&o)[2]) {
    const bf16x8 p0 = pack8<0>(p), p1 = pack8<1>(p);
#pragma unroll
    for (int dt = 0; dt < 2; ++dt) {
        o[dt] = mfma32(frag_tr(vlb, (32 * sub) * KV_STRIDE + 64 * dt, (32 * sub + 8) * KV_STRIDE + 64 * dt), p0, o[dt]);
        o[dt] = mfma32(frag_tr(vlb, (32 * sub + 16) * KV_STRIDE + 64 * dt, (32 * sub + 24) * KV_STRIDE + 64 * dt), p1, o[dt]);
    }
}
constexpr float THRL = 6.0f, NEGBIG = -1e30f;
struct HeadState { float m, l; bool started; f32x16 o[2]; };
__device__ __forceinline__ void hs_init(HeadState& S, float m0, float l0, bool started) {
    S.m = m0; S.l = l0; S.started = started; S.o[0] = (f32x16){}; S.o[1] = (f32x16){};
}
__device__ __forceinline__ void osm_tile(f32x16& s, HeadState& S) {
    float mx = fmaxf(fmaxf(s[0], s[1]), fmaxf(s[2], s[3]));
#pragma unroll
    for (int r = 4; r < 16; r += 4) mx = fmaxf(mx, fmaxf(fmaxf(s[r], s[r + 1]), fmaxf(s[r + 2], s[r + 3])));
    { const auto rr = __builtin_amdgcn_permlane32_swap(__float_as_uint(mx), __float_as_uint(mx), false, false); mx = fmaxf(__uint_as_float(rr[0]), __uint_as_float(rr[1])); }
    const bool has = mx > -1e29f, need = has && (mx > THRL || !S.started);
    if (__any(need)) {
        const float dl = need ? mx : 0.f, f = (need && S.started) ? __builtin_amdgcn_exp2f(-dl) : 1.0f;
        S.m += dl; S.l *= f; S.started = S.started || has;
#pragma unroll
        for (int r = 0; r < 16; ++r) s[r] -= dl;
#pragma unroll
        for (int dt = 0; dt < 2; ++dt)
#pragma unroll
            for (int r = 0; r < 16; ++r) S.o[dt][r] *= f;
    }
    float sum = 0.f;
#pragma unroll
    for (int r = 0; r < 16; ++r) { s[r] = __builtin_amdgcn_exp2f(s[r]); sum += s[r]; }
    S.l += sum;
}
constexpr int RG_SLOT = 16384, RG_V = 8192, RG_NSLOT = 4;
static_assert(RG_NSLOT * RG_SLOT <= AT_SEL, "the DMA ring may overlay the dead importance table, never the selection words");
template <int MODE, int WIN>
__device__ __forceinline__ void attn_blocks(Frame& F, const bf16* Kg, const bf16* Vg, int jlo, int jhi, int tq, int tqmax_w, int tqmin_w, const unsigned (&selw)[4],
                                            const bf16x8 (&qf)[2][4], HeadState (&H)[2]) {
    const int lane = F.lane, r32 = lane & 31, h = lane >> 5;
    int koff[4];
#pragma unroll
    for (int st = 0; st < 4; ++st) koff[st] = r32 * 128 + (((2 * st + h) ^ (r32 & 7)) << 4);
    const int vl = 4 * h + ((lane & 15) >> 2), vlow = (2 * ((lane >> 4) & 1) + ((lane & 3) >> 1)) ^ (vl & 3);
    int voff[2];
#pragma unroll
    for (int dt = 0; dt < 2; ++dt) voff[dt] = RG_V + vl * 128 + ((((4 * dt) ^ (vl & 4)) | vlow) << 4) + 8 * (lane & 1);
    const int drow = 8 * F.wave + (lane >> 3), dch = (lane & 7) ^ (lane >> 3);
    const bf16* ksrc = Kg + (size_t)drow * 2048 + dch * 8; const bf16* vsrc = Vg + (size_t)drow * 2048 + dch * 8;
    LAS unsigned char* ring = F.lds + F.wave * 1024;
#define RG_ISSUE(blk, slot) do { const size_t go_ = (size_t)(blk) * (64 * 2048); \
        __builtin_amdgcn_global_load_lds((const unsigned*)(ksrc + go_), (LAS unsigned*)(ring + (slot) * RG_SLOT), 16, 0, 0); \
        __builtin_amdgcn_global_load_lds((const unsigned*)(vsrc + go_), (LAS unsigned*)(ring + (slot) * RG_SLOT + RG_V), 16, 0, 0); } while (0)
    __syncthreads();
#pragma unroll
    for (int d = 0; d < 3; ++d) { const int jb = jlo + d > jhi ? jhi : jlo + d; RG_ISSUE(jb, d); }
    for (int j = jlo; j <= jhi; ++j) {
        const int slot = (j - jlo) & 3;
        asm volatile("s_waitcnt vmcnt(4)" ::: "memory");
        __builtin_amdgcn_s_barrier(); asm volatile("" ::: "memory");
        { const int jn = j + 3 > jhi ? jhi : j + 3; RG_ISSUE(jn, (slot + 3) & 3); }
        __builtin_amdgcn_sched_barrier(0);
        LAS unsigned char* sb = F.lds + slot * RG_SLOT;
        bool mine = true;
        if (MODE == 0) { const int jp = j & 3; const unsigned sw = jp == 0 ? selw[0] : jp == 1 ? selw[1] : jp == 2 ? selw[2] : selw[3]; mine = ((sw >> (j >> 2)) & 1u) != 0u; }
        if (MODE == 0 && !__any(mine)) continue;
#pragma unroll
        for (int sub = 0; sub < 2; ++sub) {
            const int kb = 64 * j + 32 * sub;
            const bool any = (kb <= tqmax_w) && (MODE == 0 || kb + 31 > tqmin_w - WIN);
            if (!any) continue;
            bf16x8 kf[4];
#pragma unroll
            for (int st = 0; st < 4; ++st) kf[st] = *(const LAS bf16x8*)(sb + koff[st] + sub * 4096);
            f32x16 s[2];
#pragma unroll
            for (int hd = 0; hd < 2; ++hd) {
                const float c0 = (MODE == 0 && !mine) ? NEGBIG : -H[hd].m;
#pragma unroll
                for (int r = 0; r < 16; ++r) s[hd][r] = c0;
#pragma unroll
                for (int st = 0; st < 4; ++st) s[hd] = mfma32(kf[st], qf[hd][st], s[hd]);
            }
            bf16x8 vf[4];
#pragma unroll
            for (int dt = 0; dt < 2; ++dt) {
                vf[2 * dt] = frag_tr(sb + voff[dt], sub * 4096, sub * 4096 + 8 * 128);
                vf[2 * dt + 1] = frag_tr(sb + voff[dt], sub * 4096 + 16 * 128, sub * 4096 + 24 * 128); }
            const bool edge = (kb + 31 > tqmin_w) || (MODE == 1 && kb <= tqmax_w - WIN);
            if (edge) {
#pragma unroll
                for (int r = 0; r < 16; ++r) { const int key = kb + crow(r, h); bool ok = key <= tq; if (MODE == 1) ok = ok && (tq - key < WIN);
                    s[0][r] = ok ? s[0][r] : NEGBIG; s[1][r] = ok ? s[1][r] : NEGBIG; }
            }
#pragma unroll
            for (int hd = 0; hd < 2; ++hd) {
                osm_tile(s[hd], H[hd]);
                const bf16x8 p0 = pack8<0>(s[hd]), p1 = pack8<1>(s[hd]);
#pragma unroll
                for (int dt = 0; dt < 2; ++dt) { H[hd].o[dt] = mfma32(vf[2 * dt], p0, H[hd].o[dt]); H[hd].o[dt] = mfma32(vf[2 * dt + 1], p1, H[hd].o[dt]); }
            }
            __builtin_amdgcn_sched_barrier(0);
        }
    }
    asm volatile("s_waitcnt vmcnt(0)" ::: "memory");
    __syncthreads();
#undef RG_ISSUE
}
__device__ __forceinline__ void accf_store(float* accw, int lane, const f32x16 (&o)[2], float sc, bool add) {
#pragma unroll
    for (int dt = 0; dt < 2; ++dt)
#pragma unroll
        for (int q = 0; q < 4; ++q) { f32x4 v = {o[dt][4 * q] * sc, o[dt][4 * q + 1] * sc, o[dt][4 * q + 2] * sc, o[dt][4 * q + 3] * sc};
            f32x4* d = (f32x4*)accw + (dt * 4 + q) * 64 + lane; if (add) v = v + *d; *d = v; }
}
__device__ __forceinline__ void att_store(bf16* att, const float* accw, int lane, size_t tok, int hc_att, const f32x16 (&o)[2], float sc, int h) {
    bf16* p = att + tok * 1024 + hc_att + 4 * h;
#pragma unroll
    for (int dt = 0; dt < 2; ++dt)
#pragma unroll
        for (int q = 0; q < 4; ++q) { f32x4 v = {o[dt][4 * q] * sc, o[dt][4 * q + 1] * sc, o[dt][4 * q + 2] * sc, o[dt][4 * q + 3] * sc};
            if (accw) v = v + *((const f32x4*)accw + (dt * 4 + q) * 64 + lane);
            v2u pk; pk.x = pk2(v[0], v[1]); pk.y = pk2(v[2], v[3]); *(v2u*)(p + 32 * dt + 8 * q) = pk; }
}
__device__ __forceinline__ void nsa_unit(Frame& F, int b, int g, int n) {
    const int lane = F.lane, r32 = lane & 31, h = lane >> 5, wave = F.wave, tid = F.tid;
    const int start = n * 128, qt = wave >> 1, hp = (wave & 1) * 2;
    const int tq = start + qt * 32 + r32, tqmin_w = start + qt * 32, tqmax_w = tqmin_w + 31;
    const size_t tok = (size_t)b * T + tq;
    const bf16* qkv = WSP(bf16, WS_QKV0) + (size_t)b * T * 2048;
    const int trl = ((lane & 15) >> 2) * KV_STRIDE + (16 * ((lane >> 4) & 1) + 4 * (lane & 3)) * 2;
    LAS unsigned char* klb0 = F.lds + AT_K + r32 * KV_STRIDE + 16 * h; LAS unsigned char* vlb0 = F.lds + AT_V + trl + 4 * h * KV_STRIDE;
    LAS float* imp = (LAS float*)(F.lds + AT_IMP); LAS unsigned* sel = (LAS unsigned*)(F.lds + AT_SEL);
    bf16x8 qf[2][4];
#pragma unroll
    for (int hd = 0; hd < 2; ++hd)
#pragma unroll
        for (int s = 0; s < 4; ++s) qf[hd][s] = *(const bf16x8*)(qkv + (size_t)tq * 2048 + QC_QN + (g * 4 + hp + hd) * 64 + 16 * s + 8 * h);
    const float* gatep = WSP(float, WS_GATES) + tok * 32 + (g * 4 + hp) * 3;
    float* accf = WSP(float, WS_ACCF) + (((size_t)((b * 2 + g) * 64 + n) * 8 + wave) * 2) * 2048;
    __syncthreads();
    for (int i = tid; i < 128 * 132; i += 512) imp[i] = 0.f;
    const bf16* kcg = WSP(bf16, WS_KC) + (size_t)(b * 2 + g) * 512 * 64; const bf16* vcg = WSP(bf16, WS_VC) + (size_t)(b * 2 + g) * 512 * 64;
    const int nvalid = 8 * n + 7, nbc = (nvalid + 63) >> 6;
    float m[2] = {-1e30f, -1e30f}, l[2] = {0.f, 0.f};
    v4u kx, vx = {0u, 0u, 0u, 0u};
    __syncthreads();
    stage_load(F, kcg, nullptr, 64, 0, 511, kx, vx);
    for (int jb = 0; jb < nbc; ++jb) {
        const int boff = (jb & 1) * AT_BUF;
        stage_write(F, boff, false, kx, vx);
        __syncthreads();
        if (jb + 1 < nbc) stage_load(F, kcg, nullptr, 64, 64 * (jb + 1), 511, kx, vx);
        LAS unsigned char* klb = klb0 + boff;
#pragma unroll
        for (int sub = 0; sub < 2; ++sub)
#pragma unroll
            for (int hd = 0; hd < 2; ++hd) {
                f32x16 s = qk_tile(klb, sub, qf[hd]); float mx = -INFINITY;
#pragma unroll
                for (int r = 0; r < 16; ++r) { const int i = 64 * jb + 32 * sub + crow(r, h); s[r] = (16 * i + 31 <= tq) ? s[r] : -INFINITY; mx = fmaxf(mx, s[r]); }
                mx = fmaxf(mx, __shfl_xor(mx, 32));
                const float mn = fmaxf(m[hd], mx), al = __builtin_amdgcn_exp2f(m[hd] - mn); float sum = 0.f;
#pragma unroll
                for (int r = 0; r < 16; ++r) sum += __builtin_amdgcn_exp2f(s[r] - mn);
                l[hd] = l[hd] * al + sum; m[hd] = mn;
            }
    }
    float il[2];
#pragma unroll
    for (int hd = 0; hd < 2; ++hd) { const float lt = l[hd] + __shfl_xor(l[hd], 32); il[hd] = lt > 0.f ? 1.0f / lt : 0.f; }
    f32x16 o[2][2];
#pragma unroll
    for (int hd = 0; hd < 2; ++hd) { o[hd][0] = (f32x16){}; o[hd][1] = (f32x16){}; }
    float carry = 0.f;
    __syncthreads();
    stage_load(F, kcg, vcg, 64, 0, 511, kx, vx);
    for (int jb = 0; jb < nbc; ++jb) {
        const int boff = (jb & 1) * AT_BUF;
        stage_write(F, boff, true, kx, vx);
        __syncthreads();
        if (jb + 1 < nbc) stage_load(F, kcg, vcg, 64, 64 * (jb + 1), 511, kx, vx);
        LAS unsigned char* klb = klb0 + boff; LAS unsigned char* vlb = vlb0 + boff;
#pragma unroll
        for (int sub = 0; sub < 2; ++sub) {
            float ps4[4] = {0.f, 0.f, 0.f, 0.f}, sp[4] = {0.f, 0.f, 0.f, 0.f};
#pragma unroll
            for (int hd = 0; hd < 2; ++hd) {
                f32x16 s = qk_tile(klb, sub, qf[hd]);
#pragma unroll
                for (int r = 0; r < 16; ++r) { const int i = 64 * jb + 32 * sub + crow(r, h); s[r] = (16 * i + 31 <= tq) ? __builtin_amdgcn_exp2f(s[r] - m[hd]) * il[hd] : 0.f; }
#pragma unroll
                for (int q = 0; q < 4; ++q) { ps4[q] += (s[4 * q] + s[4 * q + 1]) + (s[4 * q + 2] + s[4 * q + 3]); sp[q] += s[4 * q + 3]; }
                pv_tile(vlb, sub, s, o[hd]);
            }
            float cell[4];
#pragma unroll
            for (int q = 0; q < 4; ++q) { const float rv = __shfl_xor(sp[q], 32);
                if (h == 1) cell[q] = ps4[q] + rv; else { cell[q] = ps4[q] + carry; carry = rv; } }
            const int j0 = (64 * jb + 32 * sub) / 4 + h;
#pragma unroll
            for (int q = 0; q < 4; ++q) atomicAdd((float*)&imp[(qt * 32 + r32) * 132 + j0 + 2 * q], cell[q]);
        }
    }
#pragma unroll
    for (int hd = 0; hd < 2; ++hd) accf_store(accf + hd * 2048, lane, o[hd], gatep[3 * hd + 0], false);
    __syncthreads();
    {
        const int q = tid >> 2, part = tid & 3, tq2 = start + q, cur = tq2 >> 6; unsigned bits = 0u;
        float val[32];
#pragma unroll
        for (int e = 0; e < 32; ++e) { const int j = 4 * e + part; const bool forced = (j == 0) || (j == cur) || (j == cur - 1);
            if (cur <= 15) { if (j <= cur) bits |= 1u << e; val[e] = -INFINITY; }
            else { if (forced) bits |= 1u << e; val[e] = (!forced && j >= 1 && j <= cur - 2) ? imp[q * 132 + j] : -INFINITY; } }
        if (cur > 15) {
            for (int itr = 0; itr < 13; ++itr) {
                float bv = val[0]; int be = 0;
#pragma unroll
                for (int e = 1; e < 32; ++e) if (val[e] > bv) { bv = val[e]; be = e; }
                int bj = 4 * be + part; float wv = bv; int wj = bj;
#pragma unroll
                for (int d = 1; d < 4; d <<= 1) { const float ov = __shfl_xor(wv, d); const int oj = __shfl_xor(wj, d); if (ov > wv || (ov == wv && oj < wj)) { wv = ov; wj = oj; } }
                const bool win = (wj == bj) && (wv > -INFINITY);
#pragma unroll
                for (int e = 0; e < 32; ++e) if (win && e == be) { val[e] = -INFINITY; bits |= 1u << e; }
            }
        }
        sel[q * 4 + part] = bits;
    }
    __syncthreads();
    unsigned selw[4];
#pragma unroll
    for (int p = 0; p < 4; ++p) selw[p] = sel[(qt * 32 + r32) * 4 + p];
    {
        HeadState H[2]; hs_init(H[0], 0.f, 0.f, false); hs_init(H[1], 0.f, 0.f, false);
#ifdef PROBE_SEL
        attn_blocks<0, 0>(F, qkv + QC_KS + g * 64, qkv + QC_VS + g * 64, 0, 2 * n + 1, tq, tqmax_w, tqmin_w, selw, qf, H); hs_init(H[0], 0.f, 0.f, false); hs_init(H[1], 0.f, 0.f, false);
#endif
        attn_blocks<0, 0>(F, qkv + QC_KS + g * 64, qkv + QC_VS + g * 64, 0, 2 * n + 1, tq, tqmax_w, tqmin_w, selw, qf, H);
#pragma unroll
        for (int hd = 0; hd < 2; ++hd) { const float lt = H[hd].l + __shfl_xor(H[hd].l, 32); accf_store(accf + hd * 2048, lane, H[hd].o, lt > 0.f ? gatep[3 * hd + 1] / lt : 0.f, true); }
    }
    {
        HeadState H[2]; hs_init(H[0], 0.f, 0.f, false); hs_init(H[1], 0.f, 0.f, false);
        attn_blocks<1, 512>(F, qkv + QC_KW + g * 64, qkv + QC_VW + g * 64, (2 * n - 8) < 0 ? 0 : (2 * n - 8), 2 * n + 1, tq, tqmax_w, tqmin_w, selw, qf, H);
#pragma unroll
        for (int hd = 0; hd < 2; ++hd) { const float lt = H[hd].l + __shfl_xor(H[hd].l, 32);
            att_store(WSP(bf16, WS_ATT), accf + hd * 2048, lane, tok, (g * 4 + hp + hd) * 64, H[hd].o, lt > 0.f ? gatep[3 * hd + 2] / lt : 0.f, h); }
    }
}
__device__ __forceinline__ void swa_unit(Frame& F, int b, int g, int n) {
    const int lane = F.lane, r32 = lane & 31, h = lane >> 5, wave = F.wave;
    const int start = n * 128, qt = wave >> 1, hp = (wave & 1) * 2;
    const int tq = start + qt * 32 + r32, tqmin_w = start + qt * 32, tqmax_w = tqmin_w + 31;
    const size_t tok = (size_t)b * T + tq;
    const bf16* qkv = WSP(bf16, WS_QKV0) + (size_t)b * T * 2048;
    bf16x8 qf[2][4];
#pragma unroll
    for (int hd = 0; hd < 2; ++hd)
#pragma unroll
        for (int s = 0; s < 4; ++s) qf[hd][s] = *(const bf16x8*)(qkv + (size_t)tq * 2048 + QC_QS + (g * 4 + hp + hd) * 64 + 16 * s + 8 * h);
    const unsigned selw[4] = {0u, 0u, 0u, 0u};
    HeadState H[2];
#pragma unroll
    for (int hd = 0; hd < 2; ++hd) hs_init(H[hd], F.in[14][g * 4 + hp + hd] * LOG2E, (h == 0) ? 1.0f : 0.f, true);
    attn_blocks<1, 128>(F, qkv + QC_KSW + g * 64, qkv + QC_VSW + g * 64, (2 * n - 2) < 0 ? 0 : (2 * n - 2), 2 * n + 1, tq, tqmax_w, tqmin_w, selw, qf, H);
#pragma unroll
    for (int hd = 0; hd < 2; ++hd) { const float lt = H[hd].l + __shfl_xor(H[hd].l, 32);
        att_store(WSP(bf16, WS_ATT), nullptr, lane, tok, 512 + (g * 4 + hp + hd) * 64, H[hd].o, 1.0f / lt, h); }
}
__device__ __forceinline__ void attention_phase(Frame& F) {
    for (int i = 0;; ++i) { const int u = i * F.G + F.vcu; if (u >= 512) break;
        const int pi = u & 255, bg = pi >> 5, s = pi & 31, n = (u < 256) ? s : 63 - s; nsa_unit(F, bg >> 1, bg & 1, n); }
    for (int i = 0;; ++i) { const int u = i * F.G + F.vcu; if (u >= 512) break; const int bg = u >> 6, n = u & 63; swa_unit(F, bg >> 1, bg & 1, n); }
    __syncthreads();
}
__device__ __forceinline__ void conv_scan_phase(Frame& F) {
    const int lane = F.lane, w = F.wave;
    if (F.vcu < 16 && F.G >= 32) {
        const int bh = F.vcu, b = bh >> 2, hh = bh & 3;
        const float* gt = WSP(float, WS_GATES) + (size_t)b * T * 32;
        LAS float* segG = (LAS float*)(F.lds + RING_OFF); LAS float* segP = segG + 8;
        float Gl[16], al[16], Pl[16]; float c = 0.f, cm = -INFINITY;
#pragma unroll
        for (int it = 0; it < 16; ++it) { const int t = 1024 * w + 64 * it + lane; const float li = gt[(size_t)t * 32 + hh]; float x = gt[(size_t)t * 32 + 4 + hh];
#pragma unroll
            for (int d = 1; d < 64; d <<= 1) { const float y = __shfl_up(x, d); if (lane >= d) x += y; }
            Gl[it] = c + x; c = __shfl(Gl[it], 63);
            al[it] = li - Gl[it]; float pm = al[it];
#pragma unroll
            for (int d = 1; d < 64; d <<= 1) { const float y = __shfl_up(pm, d); if (lane >= d) pm = fmaxf(pm, y); }
            pm = fmaxf(pm, cm); Pl[it] = pm; cm = __shfl(pm, 63); }
        if (lane == 0) { segG[w] = c; segP[w] = cm; }
        __syncthreads();
        double gc = 0.0; float mc = 0.f;
        for (int k = 0; k < w; ++k) { mc = fmaxf(mc, (float)((double)segP[k] - gc)); gc += (double)segG[k]; }
#pragma unroll
        for (int it = 0; it < 16; ++it) { const int t = 1024 * w + 64 * it + lane; const float gcf = (float)gc;
            const float a = al[it] - gcf, mv = fmaxf(mc, Pl[it] - gcf); const double mt = (gc + (double)Gl[it]) + (double)mv;
            WSP(float, WS_SCA)[bh * T + t] = a; WSP(float, WS_SCM)[bh * T + t] = mv; WSP(float, WS_SCE)[bh * T + t] = (float)exp(-mt); }
        __syncthreads();
        return;
    }
    const int first = (F.G >= 32) ? 16 : 0, nblk = F.G - first, bi = F.vcu - first;
    const int c8 = (F.tid & 127) * 8;
    const float* cw = F.in[17]; const float* cb = F.in[18];
    float wv[4][8], bv[8];
#pragma unroll
    for (int e = 0; e < 8; ++e) { bv[e] = cb[c8 + e];
#pragma unroll
        for (int k = 0; k < 4; ++k) wv[k][e] = cw[k * 1024 + c8 + e]; }
    const float ksc = (c8 >= 512) ? 0.08838834764831845f : 1.0f;
    const bf16* src = WSP(bf16, WS_QKP); bf16* dst = WSP(bf16, WS_QKC);
    for (int tok0 = bi * 4 + (F.tid >> 7); tok0 < M; tok0 += nblk * 8) {
        v4u x[2][4]; bool okt[2];
#pragma unroll
        for (int uu = 0; uu < 2; ++uu) { const int tok = tok0 + uu * nblk * 4; okt[uu] = tok < M; const int t = tok & (T - 1);
#pragma unroll
            for (int k = 0; k < 4; ++k) { x[uu][k] = (v4u){0u, 0u, 0u, 0u}; if (okt[uu] && t - 3 + k >= 0) x[uu][k] = *(const v4u*)(src + (size_t)(tok - 3 + k) * 1024 + c8); } }
#pragma unroll
        for (int uu = 0; uu < 2; ++uu) { if (!okt[uu]) continue; const int tok = tok0 + uu * nblk * 4; float acc[8];
#pragma unroll
            for (int e = 0; e < 8; ++e) acc[e] = bv[e];
#pragma unroll
            for (int k = 0; k < 4; ++k) { const v4u xx = x[uu][k];
                acc[0] += bflo(xx.x) * wv[k][0]; acc[1] += bfhi(xx.x) * wv[k][1]; acc[2] += bflo(xx.y) * wv[k][2]; acc[3] += bfhi(xx.y) * wv[k][3];
                acc[4] += bflo(xx.z) * wv[k][4]; acc[5] += bfhi(xx.z) * wv[k][5]; acc[6] += bflo(xx.w) * wv[k][6]; acc[7] += bfhi(xx.w) * wv[k][7]; }
#pragma unroll
            for (int e = 0; e < 8; ++e) acc[e] = acc[e] / (1.0f + __expf(-acc[e])) * ksc;
            v4u o; o.x = pk2(acc[0], acc[1]); o.y = pk2(acc[2], acc[3]); o.z = pk2(acc[4], acc[5]); o.w = pk2(acc[6], acc[7]);
            *(v4u*)(dst + (size_t)tok * 1024 + c8) = o; }
    }
}
constexpr int ML_KS = 272, ML_VS = 528;
constexpr int ML_K = 0, ML_V = 64 * ML_KS;
__device__ __forceinline__ void mlstm_p1_phase(Frame& F) {
    const int lane = F.lane, r32 = lane & 31, h = lane >> 5, w = F.wave, tid = F.tid;
    LAS unsigned char* kt = F.lds + ML_K; LAS unsigned char* vt = F.lds + ML_V;
    for (int u = F.vcu; u < 512; u += F.G) {
        const int bh = u >> 5, sc = u & 31, b = bh >> 2, hh = bh & 3;
        const float mend = WSP(float, WS_SCM)[bh * T + 256 * sc + 255];
        const float* av = WSP(float, WS_SCA) + bh * T + 256 * sc;
        f32x16 acc[4]; float nacc = 0.f;
#pragma unroll
        for (int i = 0; i < 4; ++i) acc[i] = (f32x16){};
        for (int c4 = 0; c4 < 4; ++c4) {
            __syncthreads();
            { const int row = tid >> 3, ch = tid & 7; const size_t tok = (size_t)b * T + 256 * sc + 64 * c4 + row;
              const float wgt = __expf(av[64 * c4 + row] - mend);
              const bf16* kp = WSP(bf16, WS_QKC) + tok * 1024 + 512 + hh * 128 + ch * 16;
#pragma unroll
              for (int q = 0; q < 2; ++q) { const v4u x = *(const v4u*)(kp + 8 * q); v4u y;
                  y.x = pk2(bflo(x.x) * wgt, bfhi(x.x) * wgt); y.y = pk2(bflo(x.y) * wgt, bfhi(x.y) * wgt); y.z = pk2(bflo(x.z) * wgt, bfhi(x.z) * wgt); y.w = pk2(bflo(x.w) * wgt, bfhi(x.w) * wgt);
                  *(LAS v4u*)(kt + row * ML_KS + (ch * 16 + 8 * q) * 2) = y; }
              const bf16* vp = WSP(bf16, WS_V1) + tok * 1024 + hh * 256 + ch * 32;
#pragma unroll
              for (int q = 0; q < 4; ++q) *(LAS v4u*)(vt + row * ML_VS + (ch * 32 + 8 * q) * 2) = *(const v4u*)(vp + 8 * q); }
            __syncthreads();
            if (tid < 128) { float s = 0.f;
#pragma unroll 8
                for (int row = 0; row < 64; ++row) s += bf2f(*(LAS bf16*)(kt + row * ML_KS + tid * 2));
                nacc += s; }
            LAS unsigned char* klb = kt + ((lane & 15) >> 2) * ML_KS + (16 * ((lane >> 4) & 1) + 4 * (lane & 3)) * 2 + 8 * h * ML_KS;
            LAS unsigned char* vlb = vt + ((lane & 15) >> 2) * ML_VS + (16 * ((lane >> 4) & 1) + 4 * (lane & 3)) * 2 + 8 * h * ML_VS + 64 * w;
#pragma unroll
            for (int s = 0; s < 4; ++s) {
                const bf16x8 a = frag_tr(vlb, 16 * s * ML_VS, (16 * s + 4) * ML_VS);
#pragma unroll
                for (int dkt = 0; dkt < 4; ++dkt) acc[dkt] = mfma32(a, frag_tr(klb, 16 * s * ML_KS + 64 * dkt, (16 * s + 4) * ML_KS + 64 * dkt), acc[dkt]);
            }
        }
        float* lt = WSP(float, WS_LT) + (size_t)u * 32768;
#pragma unroll
        for (int dkt = 0; dkt < 4; ++dkt)
#pragma unroll
            for (int r = 0; r < 16; ++r) lt[(32 * w + crow(r, h)) * 128 + 32 * dkt + r32] = acc[dkt][r];
        if (tid < 128) WSP(float, WS_NLOC)[u * 128 + tid] = nacc;
    }
    __syncthreads();
}
__device__ __forceinline__ void mlstm_scan_phase(Frame& F) {
    const int gt = F.vcu * 512 + F.tid, NT = F.G * 512;
    for (int item = gt; item < 16 * 8192; item += NT) {
        const int bh = item >> 13, e4 = (item & 8191) * 4; f32x4 C = {0.f, 0.f, 0.f, 0.f}; float mprev = 0.f;
        const float* mx = WSP(float, WS_SCM) + bh * T;
#pragma unroll 8
        for (int sc = 0; sc < 32; ++sc) {
            const size_t off = ((size_t)(bh * 32 + sc)) * 32768 + e4;
            v2u pk; pk.x = pk2(C[0], C[1]); pk.y = pk2(C[2], C[3]); *(v2u*)(WSP(bf16, WS_CST) + off) = pk;
            const float mend = mx[256 * sc + 255], dec = __expf(mprev - mend); mprev = mend;
            const f32x4 L = *(const f32x4*)(WSP(float, WS_LT) + off);
            C = C * dec + L;
        }
    }
    for (int item = gt; item < 16 * 128; item += NT) {
        const int bh = item >> 7, dk = item & 127; float nn = 0.f, mprev = 0.f; const float* mx = WSP(float, WS_SCM) + bh * T;
        for (int sc = 0; sc < 32; ++sc) { const int u = bh * 32 + sc; WSP(float, WS_NST)[u * 128 + dk] = nn;
            const float mend = mx[256 * sc + 255], dec = __expf(mprev - mend); mprev = mend; nn = nn * dec + WSP(float, WS_NLOC)[u * 128 + dk]; }
    }
}
constexpr int M3_C = 0, M3_K = 128 * ML_KS, M3_V = M3_K + 32 * ML_KS, M3_A = M3_V + 32 * ML_KS, M3_N = M3_A + 1024, M3_Q = M3_N + 512, M3_END = M3_Q + 256 * ML_KS;
static_assert(M3_END <= RING_BYTES, "mlstm p3 LDS");
__device__ __forceinline__ void mlstm_p3_phase(Frame& F) {
    const int w = F.wave, tid = F.tid;
    LAS unsigned char* ct = F.lds + M3_C; LAS unsigned char* kt = F.lds + M3_K; LAS unsigned char* vt = F.lds + M3_V;
    LAS float* als = (LAS float*)(F.lds + M3_A); LAS float* nls = (LAS float*)(F.lds + M3_N);
    for (int u = F.vcu; u < 512; u += F.G) {
        int lane_ = F.lane; asm volatile("" : "+v"(lane_));
        const int r32 = lane_ & 31, h = lane_ >> 5;
        LAS unsigned char* vlb = vt + ((lane_ & 15) >> 2) * ML_KS + (16 * ((lane_ >> 4) & 1) + 4 * (lane_ & 3)) * 2 + 4 * h * ML_KS;
        LAS unsigned char* klb = kt + r32 * ML_KS + 16 * h; LAS unsigned char* clb = ct + r32 * ML_KS + 16 * h;
        LAS unsigned char* qlb = F.lds + M3_Q + (32 * w + r32) * ML_KS + 16 * h;
        const int bh = u >> 5, sc = u & 31, b = bh >> 2, hh = bh & 3;
        const size_t tok0 = (size_t)b * T + 256 * sc;
        const int tl = 32 * w + r32;
        const size_t tokq = tok0 + tl;
        const float Mt = WSP(float, WS_SCM)[bh * T + 256 * sc + tl];
        const float mprev = sc ? WSP(float, WS_SCM)[bh * T + 256 * sc - 1] : 0.f;
        const float winter = __expf(mprev - Mt);
        float dsum = 0.f, hdiv = 0.f;
#pragma unroll 1
        for (int pass = 0; pass < 2; ++pass) {
            __syncthreads();
            { const bf16* cs = WSP(bf16, WS_CST) + (size_t)u * 32768 + pass * 16384;
#pragma unroll
              for (int q = 0; q < 4; ++q) { const int idx = q * 512 + tid, row = idx >> 4, ch = idx & 15; *(LAS v4u*)(ct + row * ML_KS + ch * 16) = *(const v4u*)(cs + row * 128 + ch * 8); }
              if (pass == 0) {
#pragma unroll
                  for (int q = 0; q < 8; ++q) { const int idx = q * 512 + tid, row = idx >> 4, ch = idx & 15; *(LAS v4u*)(F.lds + M3_Q + row * ML_KS + ch * 16) = *(const v4u*)(WSP(bf16, WS_QKC) + (tok0 + row) * 1024 + hh * 128 + ch * 8); }
                  if (tid < 256) als[tid] = WSP(float, WS_SCA)[bh * T + 256 * sc + tid];
                               if (tid < 128) nls[tid] = WSP(float, WS_NST)[u * 128 + tid]; } }
            __syncthreads();
            f32x16 acc[4];
#pragma unroll
            for (int dvt = 0; dvt < 4; ++dvt) { f32x16 a = {};
#pragma unroll
                for (int s = 0; s < 8; ++s) a = mfma32(*(const LAS bf16x8*)(clb + 32 * dvt * ML_KS + 32 * s), *(const LAS bf16x8*)(qlb + 32 * s), a);
                acc[dvt] = a * winter; __builtin_amdgcn_sched_barrier(0); }
            for (int ktile = 0; ktile < 8; ++ktile) {
                __syncthreads();
                { const int row = tid >> 4, ch = tid & 15; const size_t tk = tok0 + 32 * ktile + row;
                  *(LAS v4u*)(kt + row * ML_KS + ch * 16) = *(const v4u*)(WSP(bf16, WS_QKC) + tk * 1024 + 512 + hh * 128 + ch * 8);
                  *(LAS v4u*)(vt + row * ML_KS + ch * 16) = *(const v4u*)(WSP(bf16, WS_V1) + tk * 1024 + hh * 256 + pass * 128 + ch * 8); }
                __syncthreads();
                if (ktile <= w) {
                    f32x16 s = {};
#pragma unroll
                    for (int st = 0; st < 8; ++st) s = mfma32(*(const LAS bf16x8*)(klb + 32 * st), *(const LAS bf16x8*)(qlb + 32 * st), s);
                    __builtin_amdgcn_sched_barrier(0);
                    float ds = 0.f;
#pragma unroll
                    for (int r = 0; r < 16; ++r) { const int key = 32 * ktile + crow(r, h); const float wg = __expf(als[key] - Mt); s[r] = (key <= tl) ? s[r] * wg : 0.f; ds += s[r]; }
                    if (pass == 0) dsum += ds;
                    const bf16x8 p0 = pack8<0>(s), p1 = pack8<1>(s);
#pragma unroll
                    for (int dvt = 0; dvt < 4; ++dvt) {
                        acc[dvt] = mfma32(frag_tr(vlb, 64 * dvt, 8 * ML_KS + 64 * dvt), p0, acc[dvt]);
                        acc[dvt] = mfma32(frag_tr(vlb, 16 * ML_KS + 64 * dvt, 24 * ML_KS + 64 * dvt), p1, acc[dvt]);
                        __builtin_amdgcn_sched_barrier(0);
                    }
                }
            }
            if (pass == 0) {
                float qn = 0.f;
#pragma unroll
                for (int s = 0; s < 8; ++s) { const v4u qq = *(const LAS v4u*)(qlb + 32 * s); const LAS float* np = nls + 16 * s + 8 * h;
                    qn += bflo(qq.x) * np[0] + bfhi(qq.x) * np[1] + bflo(qq.y) * np[2] + bfhi(qq.y) * np[3] + bflo(qq.z) * np[4] + bfhi(qq.z) * np[5] + bflo(qq.w) * np[6] + bfhi(qq.w) * np[7]; }
                dsum += __shfl_xor(dsum, 32); qn += __shfl_xor(qn, 32);
                const float den = winter * qn + dsum, emt = WSP(float, WS_SCE)[bh * T + 256 * sc + tl];
                hdiv = 1.0f / fmaxf(fabsf(den), emt);
            }
            const bf16* og = WSP(bf16, WS_OG) + tokq * 1024 + hh * 256 + pass * 128 + 4 * h; bf16* op = WSP(bf16, WS_QKP) + tokq * 1024 + hh * 256 + pass * 128 + 4 * h;
#pragma unroll
            for (int dvt = 0; dvt < 4; ++dvt)
#pragma unroll
                for (int q = 0; q < 4; ++q) { const v2u g2 = *(const v2u*)(og + 32 * dvt + 8 * q);
                    const float o0 = acc[dvt][4 * q] * hdiv / (1.0f + __expf(-bflo(g2.x))), o1 = acc[dvt][4 * q + 1] * hdiv / (1.0f + __expf(-bfhi(g2.x)));
                    const float o2 = acc[dvt][4 * q + 2] * hdiv / (1.0f + __expf(-bflo(g2.y))), o3 = acc[dvt][4 * q + 3] * hdiv / (1.0f + __expf(-bfhi(g2.y)));
                    v2u pk; pk.x = pk2(o0, o1); pk.y = pk2(o2, o3); *(v2u*)(op + 32 * dvt + 8 * q) = pk; __builtin_amdgcn_sched_barrier(0); }
        }
    }
    __syncthreads();
}
__device__ __forceinline__ void final_norm_phase(Frame& F) {
    const int gw = F.vcu * NWAVES + F.wave, NGW = F.G * NWAVES, lane = F.lane;
    const pg8::RowScale R{nullptr, WSP(float, WS_PSUM) + 3 * M};
    f32x4 gv[4];
#pragma unroll
    for (int j = 0; j < 4; ++j) gv[j] = ((const f32x4*)F.in[22])[lane + 64 * j];
    for (int m = gw; m < M; m += 2 * NGW) {
        const int m1 = m + NGW; const float rs0 = pg8::row_scale(R, m), rs1 = pg8::row_scale(R, m1);
        const v2u* h0 = (const v2u*)(WSP(bf16, WS_H16) + (size_t)m * D) + lane; const v2u* h1 = (const v2u*)(WSP(bf16, WS_H16) + (size_t)m1 * D) + lane;
        f32x4* x0 = (f32x4*)(F.out + (size_t)m * D) + lane; f32x4* x1 = (f32x4*)(F.out + (size_t)m1 * D) + lane;
        v2u w0[4], w1[4];
#pragma unroll
        for (int j = 0; j < 4; ++j) { w0[j] = h0[64 * j]; w1[j] = h1[64 * j]; }
#pragma unroll
        for (int j = 0; j < 4; ++j) { const f32x4 a0 = {bflo(w0[j].x), bfhi(w0[j].x), bflo(w0[j].y), bfhi(w0[j].y)}, a1 = {bflo(w1[j].x), bfhi(w1[j].x), bflo(w1[j].y), bfhi(w1[j].y)};
            x0[64 * j] = a0 * rs0 * gv[j]; x1[64 * j] = a1 * rs1 * gv[j]; } }
}
#ifndef SKIPMASK
#define SKIPMASK 0
#endif
#ifndef DUPMASK
#define DUPMASK 0

#endif
#define RUNP(n, call) do { if (!((SKIPMASK >> (n)) & 1)) { call; if ((DUPMASK >> (n)) & 1) { __syncthreads(); call; } } } while (0)
struct Args { const float* in[23]; float* out; unsigned char* ws; int ph_lo, ph_hi; };
__global__ void __launch_bounds__(NWAVES * 64, 2) mk_fwd(Args args) {
    extern __shared__ __attribute__((aligned(16))) unsigned char lds[];
    Frame F;
    F.lds = (LAS unsigned char*)lds;
    F.MISC = (volatile LAS unsigned*)(F.lds + MISC_OFF);
    F.tid = threadIdx.x; F.lane = F.tid & 63; F.wave = __builtin_amdgcn_readfirstlane(F.tid >> 6);
    F.G = gridDim.x; { const int bx = blockIdx.x; F.vcu = (F.G % 8 == 0) ? (bx % 8) * (F.G / 8) + bx / 8 : bx; }
    F.ws = args.ws; F.ctl = (gu32*)(args.ws + WS_CTL); F.out = args.out;
#pragma unroll
    for (int i = 0; i < 23; ++i) F.in[i] = args.in[i];
    for (int u = F.tid; u < (LDS_BYTES - LDSCTL_OFF) / 4; u += NWAVES * 64) ((LAS unsigned*)(F.lds + LDSCTL_OFF))[u] = 0u;
    __syncthreads();
    const int lo = args.ph_lo, hi = args.ph_hi;
    XcdBarrier bar; bar.bar = (unsigned*)(F.ctl + CW_BAR); bar.x = 0; bar.st = nullptr;
    if (hi - lo > 1) bar = xcd_barrier_post((unsigned*)(F.ctl + CW_BAR), F.MISC + 8);

#define IN(k) (lo <= (k) && (k) < hi)
#define SEAM(k) do { if (IN(k) && IN((k) + 1)) xcd_barrier(bar); } while (0)
#define GEMM_PH(EPI, gg, ee) do { pg8::StaticOrder S_; S_.init(M, (gg).N, F.G, (int)blockIdx.x); pg8::gemm_phase<EPI, pg8::StaticOrder, PG8_ALIGN, PG8_SP2>(F.lds + RING_OFF, gg, S_, ee); } while (0)
    if (IN(0)) { RUNP(0, p0_prologue(F)); } SEAM(0);
    if (IN(1)) { const pg8::Gemm g{WSP(bf16, WS_H16), WSP(bf16, WS_WAB), M, 2048, 1024};
        const pg8::EpiScaleBf16 e{WSP(bf16, WS_QKV0), 2048, {WSP(float, WS_RS0), nullptr}, 0, 0};
        RUNP(21, GEMM_PH(pg8::EpiScaleBf16, g, e)); RUNP(19, gates0_phase(F)); } SEAM(1);
    if (IN(2)) { RUNP(2, compress_phase(F)); } SEAM(2);
    if (IN(3)) { RUNP(3, attention_phase(F)); } SEAM(3);
    if (IN(4)) { const pg8::Gemm g{WSP(bf16, WS_ATT), WSP(bf16, WS_WABO), M, 1024, 1024};
        const pg8::EpiResid e{F.in[0], WSP(bf16, WS_H16), WSP(float, WS_PSUM) + 0 * M, D};
        RUNP(22, GEMM_PH(pg8::EpiResid, g, e)); } SEAM(4);
    if (IN(5)) { const pg8::Gemm g{WSP(bf16, WS_H16), WSP(bf16, WS_WUP0), M, 5632, 1024};
        const pg8::EpiSwiglu e{WSP(bf16, WS_HID), FF, {nullptr, WSP(float, WS_PSUM) + 0 * M}};
        RUNP(23, GEMM_PH(pg8::EpiSwiglu, g, e)); } SEAM(5);
    if (IN(6)) { const pg8::Gemm g{WSP(bf16, WS_HID), WSP(bf16, WS_WDN0), M, 1024, FF};
        const pg8::EpiResid e{nullptr, WSP(bf16, WS_H16), WSP(float, WS_PSUM) + 1 * M, D};
        RUNP(17, GEMM_PH(pg8::EpiResid, g, e)); } SEAM(6);
    if (IN(7)) { const pg8::Gemm g{WSP(bf16, WS_H16), WSP(bf16, WS_WCIN), M, 3072, 1024};
        const pg8::EpiScaleBf16 e{WSP(bf16, WS_QKP), 1024, {nullptr, WSP(float, WS_PSUM) + 1 * M}, 1024, (size_t)(64 * MiB / 2)};
        RUNP(24, GEMM_PH(pg8::EpiScaleBf16, g, e)); RUNP(20, gates1_phase(F)); } SEAM(7);
    if (IN(8)) { RUNP(8, conv_scan_phase(F)); } SEAM(8);
    if (IN(9)) { RUNP(9, mlstm_p1_phase(F)); } SEAM(9);
    if (IN(10)) { RUNP(10, mlstm_scan_phase(F)); } SEAM(10);
    if (IN(11)) { RUNP(11, mlstm_p3_phase(F)); } SEAM(11);
    if (IN(12)) { const pg8::Gemm g{WSP(bf16, WS_QKP), WSP(bf16, WS_WCO), M, 1024, 1024};
        const pg8::EpiResid e{nullptr, WSP(bf16, WS_H16), WSP(float, WS_PSUM) + 2 * M, D};
        RUNP(17, GEMM_PH(pg8::EpiResid, g, e)); } SEAM(12);
    if (IN(13)) { const pg8::Gemm g{WSP(bf16, WS_H16), WSP(bf16, WS_WUP1), M, 5632, 1024};
        const pg8::EpiSwiglu e{WSP(bf16, WS_HID), FF, {nullptr, WSP(float, WS_PSUM) + 2 * M}};
        RUNP(18, GEMM_PH(pg8::EpiSwiglu, g, e)); } SEAM(13);
    if (IN(14)) { const pg8::Gemm g{WSP(bf16, WS_HID), WSP(bf16, WS_WDN1), M, 1024, FF};
        const pg8::EpiResid e{nullptr, WSP(bf16, WS_H16), WSP(float, WS_PSUM) + 3 * M, D};
        RUNP(17, GEMM_PH(pg8::EpiResid, g, e)); } SEAM(14);
    if (IN(15)) { RUNP(15, final_norm_phase(F)); }
}

extern "C" void kernel_launch(void* const* d_in, const int* in_sizes, int n_in, void* d_out, int out_size, void* d_ws, size_t ws_size, hipStream_t stream) {
    static int grid = 0;
    if (grid == 0) {
        if (n_in != 23 || in_sizes[0] != M * D || out_size != M * D || ws_size < WS_END) { fprintf(stderr, "kernel_launch: shape/workspace mismatch (n_in %d, in0 %d, out %d, ws %zu, need %zu); nothing launched\n", n_in, n_in > 0 ? in_sizes[0] : -1, out_size, ws_size, (size_t)WS_END); grid = -1; return; }
        int dev = 0, cus = 0, per_cu = 0;
        if (hipGetDevice(&dev) != hipSuccess || hipDeviceGetAttribute(&cus, hipDeviceAttributeMultiprocessorCount, dev) != hipSuccess) { grid = -1; return; }
        if (hipFuncSetAttribute((const void*)mk_fwd, hipFuncAttributeMaxDynamicSharedMemorySize, LDS_BYTES) != hipSuccess) { fprintf(stderr, "kernel_launch: hipFuncSetAttribute failed\n"); grid = -1; return; }
        if (hipOccupancyMaxActiveBlocksPerMultiprocessor(&per_cu, (const void*)mk_fwd, NWAVES * 64, LDS_BYTES) != hipSuccess || per_cu < 1) { fprintf(stderr, "kernel_launch: occupancy query says %d blocks per CU\n", per_cu); per_cu = 1; }
        (void)hipGetLastError();
        grid = cus;
    }
    if (grid < 0) return;
    if (hipMemsetAsync((char*)d_ws + WS_CTL, 0, CTL_ZERO_BYTES, stream) != hipSuccess) { fprintf(stderr, "kernel_launch: memset failed\n"); return; }
    Args a{};
    for (int i = 0; i < 23; ++i) a.in[i] = (const float*)d_in[i];
    a.out = (float*)d_out; a.ws = (unsigned char*)d_ws;
#if MK_PER_PHASE
    for (int p = 0; p < NPHASE; ++p) { a.ph_lo = p; a.ph_hi = p + 1; hipLaunchKernelGGL(mk_fwd, dim3(grid), dim3(NWAVES * 64), LDS_BYTES, stream, a); }
#else
    a.ph_lo = 0; a.ph_hi = NPHASE;
    hipLaunchKernelGGL(mk_fwd, dim3(grid), dim3(NWAVES * 64), LDS_BYTES, stream, a);
#endif
    const hipError_t le = hipPeekAtLastError();
    if (le != hipSuccess) fprintf(stderr, "kernel_launch: launch failed: %s\n", hipGetErrorName(le));
}
```

```cpp
#include <hip/hip_runtime.h>
#include <cstdio>
#include <cstdint>
#include <cmath>
#define DUPMASK 0

namespace pg8 {
#define PG8_LAS __attribute__((address_space(3)))
typedef unsigned short bf16_t;
typedef short bf16x8 __attribute__((ext_vector_type(8)));
typedef float f32x4 __attribute__((ext_vector_type(4)));
typedef unsigned u32x4 __attribute__((ext_vector_type(4)));
constexpr int BM = 256, BK = 64, HALF = 128, HTB = HALF * BK * 2  , STAGE_BYTES = 8 * HTB, NXCD = 8, WGM = 8;

__host__ __device__ __forceinline__ int lds_byte(int r, int c) { const int st = (r >> 4) * 2 + (c >> 5), rr = r & 15, cc = c & 31, ob = rr * 64 + cc * 2; return st * 1024 + (ob ^ (((ob >> 9) & 1) << 5)); }
__host__ __device__ __forceinline__ void stage_rc(int b, int& R, int& C) { const int st = b / 1024, sb = b % 1024, swz = sb ^ (((sb >> 9) & 1) << 5); R = (st >> 1) * 16 + swz / 64; C = (st & 1) * 32 + (swz % 64) / 2; }
__host__ __device__ __forceinline__ int perm32(int rho) { const int n = rho >> 4, i = rho & 15; return 8 * (i >> 2) + 4 * n + (i & 3); }

struct Unit { int pm, pn; };
struct Gemm { const bf16_t* A; const bf16_t* Bt; int M, N, K; };

struct StaticOrder {
    int nM, nN, nwg, G, c;
    __host__ __device__ void init(int M, int N, int G_, int c_) { nM = M / BM; nN = N / BM; nwg = nM * nN; G = G_; c = c_; }
    __host__ __device__ bool next(int i, Unit& u) const {
        const long L = (long)i * G + c; if (L >= nwg) return false;
        int wgid = (int)L; { const int q = nwg / NXCD, r = nwg % NXCD, xcd = wgid % NXCD, off = wgid / NXCD; wgid = (xcd < r ? xcd * (q + 1) : r * (q + 1) + (xcd - r) * q) + off; }
        const int nig = WGM * nN, gid = wgid / nig, fm = gid * WGM, gsz = (nM - fm) < WGM ? (nM - fm) : WGM;
        u.pm = fm + ((wgid % nig) % gsz); u.pn = (wgid % nig) / gsz; return true;
    }
    __device__ __forceinline__ void a_ready(const Unit&) const {}
    __device__ __forceinline__ void done(const Unit&) const {}
};

__device__ __forceinline__ unsigned cvt_pk_bf16(float lo, float hi) { unsigned r; asm volatile("v_cvt_pk_bf16_f32 %0, %1, %2" : "=v"(r) : "v"(lo), "v"(hi)); return r; }
typedef float f32x2 __attribute__((ext_vector_type(2)));
constexpr int MROWS = 32768;
constexpr float RMS_EPS_F = 1e-6f;
struct RowScale { const float* rs; const float* ss; };
__device__ __forceinline__ float row_scale(const RowScale& R, int row) {
    if (R.ss) return 1.0f / sqrtf(R.ss[row] * (1.0f / 1024.0f) + RMS_EPS_F);
    return R.rs[row];
}
struct EpiScaleBf16 {
    static constexpr bool PERM = true, AFTER_DRAIN = false;
    bf16_t* O; int ldc; RowScale R; int split_cols; size_t split_stride;
    __device__ __forceinline__ void operator()(const f32x4 (&acc)[2][2][4][2], const Unit& u, int wr, int wc, int fr, int fq) const {
        const int row0 = u.pm * BM + wr * 64 + fr; int colt = u.pn * BM; bf16_t* base = O;
        if (split_cols) { const int t = colt / split_cols; base += (size_t)t * split_stride; colt -= t * split_cols; }
        const int col0 = colt + wc * 32 + 8 * fq;
#pragma unroll
        for (int ai = 0; ai < 2; ++ai)
#pragma unroll
            for (int m = 0; m < 4; ++m) { const int row = row0 + ai * HALF + m * 16; const float sc = row_scale(R, row); bf16_t* rowp = base + (size_t)row * ldc + col0;
#pragma unroll
                for (int bj = 0; bj < 2; ++bj) { f32x4 v0 = acc[ai][bj][m][0] * sc, v1 = acc[ai][bj][m][1] * sc;
                    u32x4 w; w.x = cvt_pk_bf16(v0[0], v0[1]); w.y = cvt_pk_bf16(v0[2], v0[3]); w.z = cvt_pk_bf16(v1[0], v1[1]); w.w = cvt_pk_bf16(v1[2], v1[3]);
                    *(u32x4*)(rowp + bj * HALF) = w; } }
    }
};
struct EpiSwiglu {
    static constexpr bool PERM = true, AFTER_DRAIN = false;
    bf16_t* O; int ldc; RowScale R;
    __device__ __forceinline__ void operator()(const f32x4 (&acc)[2][2][4][2], const Unit& u, int wr, int wc, int fr, int fq) const {
        const int row0 = u.pm * BM + wr * 64 + fr; const int col0 = u.pn * HALF + wc * 32 + 8 * fq;
#pragma unroll
        for (int ai = 0; ai < 2; ++ai)
#pragma unroll
            for (int m = 0; m < 4; ++m) { const int row = row0 + ai * HALF + m * 16; const float sc = row_scale(R, row); bf16_t* rowp = O + (size_t)row * ldc + col0;
                float o[8];
#pragma unroll
                for (int n = 0; n < 2; ++n)
#pragma unroll
                    for (int e = 0; e < 4; ++e) { const float g = acc[ai][0][m][n][e] * sc, up = acc[ai][1][m][n][e] * sc; o[n * 4 + e] = g * up / (1.0f + __expf(-g)); }
                u32x4 w; w.x = cvt_pk_bf16(o[0], o[1]); w.y = cvt_pk_bf16(o[2], o[3]); w.z = cvt_pk_bf16(o[4], o[5]); w.w = cvt_pk_bf16(o[6], o[7]);
                *(u32x4*)rowp = w; }
    }
};
struct EpiResid {
    static constexpr bool PERM = false, AFTER_DRAIN = false;
    const float* basef; bf16_t* h16; float* ss; int ldc;
    __device__ __forceinline__ void operator()(const f32x4 (&acc)[2][2][4][2], const Unit& u, int wr, int wc, int fr, int fq) const {
        typedef unsigned u32x2v __attribute__((ext_vector_type(2)));
        const int row0 = u.pm * BM + wr * 64 + fr, col0 = u.pn * BM + wc * 32 + 4 * fq;
#pragma unroll
        for (int ai = 0; ai < 2; ++ai) {
            f32x4 pre[4][2][2];
#pragma unroll
            for (int m = 0; m < 4; ++m) { const size_t off = (size_t)(row0 + ai * HALF + m * 16) * ldc + col0;
#pragma unroll
                for (int bj = 0; bj < 2; ++bj)
#pragma unroll
                    for (int n = 0; n < 2; ++n) {
                        if (basef) pre[m][bj][n] = *(const f32x4*)(basef + off + bj * HALF + n * 16);
                        else { const u32x2v w = *(const u32x2v*)(h16 + off + bj * HALF + n * 16);
                            pre[m][bj][n] = (f32x4){__builtin_bit_cast(float, w.x << 16), __builtin_bit_cast(float, w.x & 0xffff0000u), __builtin_bit_cast(float, w.y << 16), __builtin_bit_cast(float, w.y & 0xffff0000u)}; } } }
#pragma unroll
            for (int m = 0; m < 4; ++m) { const int row = row0 + ai * HALF + m * 16; const size_t off = (size_t)row * ldc + col0; float sq = 0.f;
#pragma unroll
                for (int bj = 0; bj < 2; ++bj)
#pragma unroll
                    for (int n = 0; n < 2; ++n) { const f32x4 o = pre[m][bj][n] + acc[ai][bj][m][n];
                        sq += (o[0] * o[0] + o[1] * o[1]) + (o[2] * o[2] + o[3] * o[3]);
                        u32x2v w; w.x = cvt_pk_bf16(o[0], o[1]); w.y = cvt_pk_bf16(o[2], o[3]); *(u32x2v*)(h16 + off + bj * HALF + n * 16) = w; }
                sq += __shfl_xor(sq, 16); sq += __shfl_xor(sq, 32);
                if (fq == 0) atomicAdd(ss + row, sq); }
        }
    }
};
template <class Epi, class Sched, bool ALIGN_EPI = false, bool SP2 = false>
__device__ __forceinline__ void gemm_phase(PG8_LAS unsigned char* lds, const Gemm g, const Sched& S, const Epi& E) {
    const int tid = threadIdx.x, wid = __builtin_amdgcn_readfirstlane(tid >> 6), lane = tid & 63, wr = wid >> 2, wc = wid & 3, fr = lane & 15, fq = lane >> 4;
    const int K = g.K, nt = K / BK;
    unsigned voffA[2], voffB[2];
#pragma unroll
    for (int i = 0; i < 2; ++i) { int R, C; stage_rc(tid * 16 + i * 8192, R, C); const int Rb = Epi::PERM ? ((R & ~31) + perm32(R & 31)) : R;
        voffA[i] = (unsigned)(R * K + C) * 2u; voffB[i] = (unsigned)(Rb * K + C) * 2u; }
    const size_t kstep = (size_t)(BK * 2);
    const size_t hstep = (size_t)HALF * K * 2;
    const size_t tstep = 2 * hstep;
    const unsigned ldsw = (unsigned)wid * 1024u;
    const int aoff = lds_byte(wr * 64 + fr, fq * 8), boff = lds_byte(wc * 32 + fr, fq * 8);
#define PG8_SA(b, h) (((b) * 2 + (h)) * HTB)
#define PG8_SB(b, h) ((4 + (b) * 2 + (h)) * HTB)
#define PG8_STAGE(bufoff, gbase, voff) do { _Pragma("unroll") for (int _i = 0; _i < 2; ++_i) \
        __builtin_amdgcn_global_load_lds((const unsigned*)((const char*)(gbase) + (voff)[_i]), (PG8_LAS unsigned*)(lds + (bufoff) + ldsw + _i * 8192), 16, 0, 0); } while (0)
#define PG8_LDA(dst, b, h) do { _Pragma("unroll") for (int m = 0; m < 4; ++m) _Pragma("unroll") for (int k = 0; k < 2; ++k) dst[m][k] = *(const PG8_LAS bf16x8*)(lds + PG8_SA(b, h) + aoff + m * 2048 + k * 1024); } while (0)
#define PG8_LDB(dst, b, h) do { _Pragma("unroll") for (int n = 0; n < 2; ++n) _Pragma("unroll") for (int k = 0; k < 2; ++k) dst[n][k] = *(const PG8_LAS bf16x8*)(lds + PG8_SB(b, h) + boff + n * 2048 + k * 1024); } while (0)
#define PG8_MMA(ai, bj, At, Bt) do { __builtin_amdgcn_s_setprio(1); _Pragma("unroll") for (int m = 0; m < 4; ++m) _Pragma("unroll") for (int n = 0; n < 2; ++n) _Pragma("unroll") for (int k = 0; k < 2; ++k) \
        acc[ai][bj][m][n] = __builtin_amdgcn_mfma_f32_16x16x32_bf16(Bt[n][k], At[m][k], acc[ai][bj][m][n], 0, 0, 0); __builtin_amdgcn_s_setprio(0); } while (0)
#define PG8_WAIT_V(n) asm volatile("s_waitcnt vmcnt(" #n ")" ::: "memory")
#define PG8_WAIT_L(n) asm volatile("s_waitcnt lgkmcnt(" #n ")" ::: "memory")
#define PG8_BAR __builtin_amdgcn_s_barrier()
#define PG8_SCHED __builtin_amdgcn_sched_barrier(0)
    Unit cur, nxt; int ui = 0;
    if (!S.next(0, cur)) return;
    f32x4 acc[2][2][4][2];
#pragma unroll
    for (int a = 0; a < 2; ++a)
#pragma unroll
        for (int b = 0; b < 2; ++b)
#pragma unroll
            for (int m = 0; m < 4; ++m)
#pragma unroll
                for (int n = 0; n < 2; ++n) acc[a][b][m][n] = (f32x4){0.f, 0.f, 0.f, 0.f};
    bf16x8 At[4][2], B0[2][2], B1[2][2];
    const char* cA = (const char*)g.A + (size_t)cur.pm * tstep; const char* cB = (const char*)g.Bt + (size_t)cur.pn * tstep;
    S.a_ready(cur);
    if constexpr (SP2) {
        PG8_STAGE(PG8_SB(0, 0), cB, voffB); PG8_STAGE(PG8_SB(0, 1), cB + hstep, voffB); PG8_STAGE(PG8_SA(0, 0), cA, voffA); PG8_STAGE(PG8_SA(0, 1), cA + hstep, voffA);
        if (wr == 1) PG8_BAR;
        PG8_WAIT_V(2); PG8_BAR;
        PG8_STAGE(PG8_SB(1, 0), cB + kstep, voffB); PG8_STAGE(PG8_SA(1, 0), cA + kstep, voffA); PG8_STAGE(PG8_SB(1, 1), cB + hstep + kstep, voffB);
        PG8_WAIT_V(6); PG8_BAR;
    } else {
        PG8_STAGE(PG8_SB(0, 0), cB, voffB); PG8_STAGE(PG8_SA(0, 0), cA, voffA); PG8_STAGE(PG8_SB(0, 1), cB + hstep, voffB); PG8_STAGE(PG8_SA(0, 1), cA + hstep, voffA);
        if (wr == 1) PG8_BAR;
        PG8_WAIT_V(4); PG8_BAR;
        PG8_STAGE(PG8_SB(1, 0), cB + kstep, voffB); PG8_STAGE(PG8_SA(1, 0), cA + kstep, voffA); PG8_STAGE(PG8_SB(1, 1), cB + hstep + kstep, voffB);
        PG8_WAIT_V(6); PG8_BAR;
    }
    for (;;) {
        const bool has_next = S.next(ui + 1, nxt);
        const char* nA = has_next ? (const char*)g.A + (size_t)nxt.pm * tstep : cA; const char* nB = has_next ? (const char*)g.Bt + (size_t)nxt.pn * tstep : cB;
        for (int t = 0; t < nt; t += 2) {
            const bool last = (t == nt - 2);
            const char* a1 = cA + (size_t)(t + 1) * kstep;
            const char* a2 = last ? nA : cA + (size_t)(t + 2) * kstep; const char* b2 = last ? nB : cB + (size_t)(t + 2) * kstep;
            const char* a3 = a2 + kstep; const char* b3 = b2 + kstep;
            if (last && has_next) S.a_ready(nxt);
            if constexpr (SP2) {
            PG8_LDB(B0, 0, 0); PG8_LDB(B1, 0, 1); PG8_SCHED; PG8_LDA(At, 0, 0); PG8_STAGE(PG8_SA(1, 1), a1 + hstep, voffA);
            PG8_WAIT_V(8); PG8_WAIT_L(0); PG8_BAR; PG8_MMA(0, 0, At, B0); PG8_MMA(0, 1, At, B1); PG8_BAR; PG8_SCHED;
            PG8_LDA(At, 0, 1); PG8_STAGE(PG8_SB(0, 0), b2, voffB); PG8_STAGE(PG8_SB(0, 1), b2 + hstep, voffB); PG8_STAGE(PG8_SA(0, 0), a2, voffA);
            PG8_WAIT_V(8); PG8_WAIT_L(0); PG8_BAR; PG8_MMA(1, 0, At, B0); PG8_MMA(1, 1, At, B1); PG8_BAR; PG8_SCHED;
            PG8_LDB(B0, 1, 0); PG8_LDB(B1, 1, 1); PG8_SCHED; PG8_LDA(At, 1, 0); PG8_STAGE(PG8_SA(0, 1), a2 + hstep, voffA);
            PG8_WAIT_V(8); PG8_WAIT_L(0); PG8_BAR; PG8_MMA(0, 0, At, B0); PG8_MMA(0, 1, At, B1); PG8_BAR; PG8_SCHED;
            PG8_LDA(At, 1, 1); PG8_STAGE(PG8_SB(1, 0), b3, voffB); PG8_STAGE(PG8_SB(1, 1), b3 + hstep, voffB); PG8_STAGE(PG8_SA(1, 0), a3, voffA);
            PG8_WAIT_V(8); PG8_WAIT_L(0); PG8_BAR; PG8_MMA(1, 0, At, B0); PG8_MMA(1, 1, At, B1); PG8_BAR; PG8_SCHED;
            } else {
            PG8_LDB(B0, 0, 0); PG8_SCHED; PG8_LDA(At, 0, 0); PG8_STAGE(PG8_SA(1, 1), a1 + hstep, voffA);
            PG8_WAIT_L(8); PG8_BAR; PG8_WAIT_L(0); PG8_MMA(0, 0, At, B0); PG8_BAR; PG8_SCHED;
            PG8_LDB(B1, 0, 1); PG8_STAGE(PG8_SB(0, 0), b2, voffB);
            PG8_BAR; PG8_WAIT_L(0); PG8_MMA(0, 1, At, B1); PG8_BAR;
            PG8_LDA(At, 0, 1); PG8_STAGE(PG8_SA(0, 0), a2, voffA);
            PG8_BAR; PG8_WAIT_L(0); PG8_MMA(1, 0, At, B0); PG8_BAR; PG8_SCHED;
            PG8_STAGE(PG8_SB(0, 1), b2 + hstep, voffB);
            PG8_WAIT_V(6); PG8_BAR; PG8_MMA(1, 1, At, B1); PG8_BAR;
            PG8_LDB(B0, 1, 0); PG8_SCHED; PG8_LDA(At, 1, 0); PG8_STAGE(PG8_SA(0, 1), a2 + hstep, voffA);
            PG8_WAIT_L(8); PG8_BAR; PG8_WAIT_L(0); PG8_MMA(0, 0, At, B0); PG8_BAR; PG8_SCHED;
            PG8_LDB(B1, 1, 1); PG8_STAGE(PG8_SB(1, 0), b3, voffB);
            PG8_BAR; PG8_WAIT_L(0); PG8_MMA(0, 1, At, B1); PG8_BAR;
            PG8_LDA(At, 1, 1); PG8_STAGE(PG8_SA(1, 0), a3, voffA);
            PG8_BAR; PG8_WAIT_L(0); PG8_MMA(1, 0, At, B0); PG8_BAR; PG8_SCHED;
            PG8_STAGE(PG8_SB(1, 1), b3 + hstep, voffB);
            PG8_WAIT_V(6); PG8_BAR; PG8_MMA(1, 1, At, B1); PG8_BAR;
            }
        }
        if constexpr (ALIGN_EPI) { if (wr == 0) PG8_BAR; }
        if constexpr (!Epi::AFTER_DRAIN) { E(acc, cur, wr, wc, fr, fq); S.done(cur); }
        if (!has_next) break;
#pragma unroll
        for (int a = 0; a < 2; ++a)
#pragma unroll
            for (int b = 0; b < 2; ++b)
#pragma unroll
                for (int m = 0; m < 4; ++m)
#pragma unroll
                    for (int n = 0; n < 2; ++n) acc[a][b][m][n] = (f32x4){0.f, 0.f, 0.f, 0.f};
        cur = nxt; cA = nA; cB = nB; ++ui;
        if constexpr (ALIGN_EPI) { if (wr == 1) PG8_BAR; }
    }
    PG8_WAIT_V(0);
    if constexpr (!ALIGN_EPI) { if (wr == 0) PG8_BAR; }
    PG8_BAR;
    if constexpr (Epi::AFTER_DRAIN) { E.fused(acc, cur, wr, wc, fr, fq, lds, wid, lane); S.done(cur); }
#undef PG8_SA
#undef PG8_SB
#undef PG8_STAGE
#undef PG8_LDA
#undef PG8_LDB
#undef PG8_MMA
#undef PG8_WAIT_V
#undef PG8_WAIT_L
#undef PG8_BAR
#undef PG8_SCHED
}
}
#ifndef PG8_SP2
#define PG8_SP2 true
#endif
#ifndef PG8_ALIGN
#define PG8_ALIGN true
#endif
constexpr int NWAVES = 8;
#ifndef MK_PER_PHASE
#define MK_PER_PHASE 0
#endif
constexpr int NPHASE = 16;

constexpr int BATCH = 4, T = 8192, D = 1024, M = BATCH * T, FF = 2816;
constexpr int AB_LD = 2072, C_LD = 3080;
constexpr float C2 = 0.125f * 1.4426950408889634f;
constexpr float LOG2E = 1.4426950408889634f;
constexpr int QC_QN = 0, QC_KC = 512, QC_VC = 640, QC_KS = 768, QC_VS = 896, QC_KW = 1024, QC_VW = 1152, QC_QS = 1280, QC_KSW = 1792, QC_VSW = 1920;

constexpr size_t MiB = 1u << 20, KiB = 1024;
constexpr size_t WS_CTL = 0, CTL_ZERO_BYTES = 1 * MiB;
constexpr size_t WS_RS0 = 1 * MiB;
constexpr size_t WS_PSUM = WS_RS0 + 128 * KiB;
constexpr size_t WS_GATES = WS_PSUM + 2 * MiB;
constexpr size_t WS_SCA = WS_GATES + 4 * MiB;
constexpr size_t WS_SCM = WS_SCA + 512 * KiB;
constexpr size_t WS_SCE = WS_SCM + 512 * KiB;
constexpr size_t WS_KC = WS_SCE + 512 * KiB;
constexpr size_t WS_VC = WS_KC + 512 * KiB;
constexpr size_t WS_WABG = WS_VC + 512 * KiB;
constexpr size_t WS_WCG = WS_WABG + 64 * KiB;
constexpr size_t WS_CW1K = WS_WCG + 64 * KiB;
constexpr size_t WS_CW1V = WS_CW1K + 256 * KiB;
constexpr size_t WS_CW2K = WS_CW1V + 256 * KiB;
constexpr size_t WS_CW2V = WS_CW2K + 8 * KiB;
constexpr size_t WS_CBIAS = WS_CW2V + 8 * KiB;
constexpr size_t WS_NLOC = WS_CBIAS + 4 * KiB;
constexpr size_t WS_NST = WS_NLOC + 256 * KiB;
static_assert(WS_NST + 256 * KiB <= 13 * MiB, "small region");
constexpr size_t WS_WAB = 13 * MiB;
constexpr size_t WS_WABO = WS_WAB + 4 * MiB;
constexpr size_t WS_WUP0 = WS_WABO + 2 * MiB;
constexpr size_t WS_WUP1 = WS_WUP0 + 11 * MiB;
constexpr size_t WS_WDN0 = WS_WUP1 + 11 * MiB;
constexpr size_t WS_WDN1 = WS_WDN0 + 5632 * KiB;
constexpr size_t WS_WCIN = WS_WDN1 + 5632 * KiB;
constexpr size_t WS_WCO = WS_WCIN + 6 * MiB;
static_assert(WS_WCO + 2 * MiB <= 60 * MiB, "weights region");
constexpr size_t WS_H16 = 60 * MiB;
constexpr size_t WS_A = 124 * MiB;
constexpr size_t WS_QKV0 = WS_A, WS_ATT = WS_A + 128 * MiB;
constexpr size_t WS_QKP = WS_A, WS_V1 = WS_A + 64 * MiB, WS_OG = WS_A + 128 * MiB;
constexpr size_t WS_B = 316 * MiB;
constexpr size_t WS_HID = WS_B;
constexpr size_t WS_ACCF = WS_B;
constexpr size_t WS_QKC = WS_B, WS_LT = WS_B + 64 * MiB, WS_CST = WS_B + 128 * MiB;
constexpr size_t WS_END = 492 * MiB;
static_assert(WS_HID + (size_t)M * FF * 2 <= WS_END && WS_CST + 32 * MiB <= WS_END, "d_ws map");
constexpr int CW_TMO = 0, CW_CODE = 1;
constexpr int CW_BAR = 4096;

constexpr int RING_OFF = 0, RING_BYTES = 131072;
constexpr int LDS_BYTES = 147456;
constexpr int LDSCTL_OFF = LDS_BYTES - 1024, MISC_OFF = LDSCTL_OFF + 320;
static_assert(MISC_OFF + 128 <= LDS_BYTES, "LDS map");

#define GAS __attribute__((address_space(1)))
#define LAS __attribute__((address_space(3)))
typedef unsigned short bf16;
typedef unsigned v4u __attribute__((ext_vector_type(4)));
typedef unsigned v2u __attribute__((ext_vector_type(2)));
typedef float f32x4 __attribute__((ext_vector_type(4)));
typedef float f32x16 __attribute__((ext_vector_type(16)));
typedef short bf16x8 __attribute__((ext_vector_type(8)));
typedef short s16x4 __attribute__((ext_vector_type(4)));
typedef GAS unsigned gu32;
typedef GAS unsigned long long gu64;
#define RLX_AGENT __ATOMIC_RELAXED, __HIP_MEMORY_SCOPE_AGENT
#define LDS_WAIT() asm volatile("s_waitcnt lgkmcnt(0)" ::: "memory")
#define VM_WAIT() asm volatile("s_waitcnt vmcnt(0)" ::: "memory")
__device__ __forceinline__ unsigned f2bf(float f) { unsigned u = __builtin_bit_cast(unsigned, f); return (u + 0x7fffu + ((u >> 16) & 1u)) >> 16; }
__device__ __forceinline__ unsigned pk2(float lo, float hi) { return f2bf(lo) | (f2bf(hi) << 16); }
__device__ __forceinline__ float bf2f(unsigned short b) { return __builtin_bit_cast(float, (unsigned)b << 16); }
__device__ __forceinline__ float bflo(unsigned w) { return __builtin_bit_cast(float, w << 16); }
__device__ __forceinline__ float bfhi(unsigned w) { return __builtin_bit_cast(float, w & 0xffff0000u); }
__device__ __forceinline__ int crow(int r, int hi) { return (r & 3) + 8 * (r >> 2) + 4 * hi; }
__device__ __forceinline__ f32x16 mfma32(bf16x8 a, bf16x8 b, f32x16 c) { return __builtin_amdgcn_mfma_f32_32x32x16_bf16(a, b, c, 0, 0, 0); }
typedef short v4i16_t __attribute__((ext_vector_type(4)));
__device__ __forceinline__ s16x4 ds_tr(LAS unsigned char* p) { return __builtin_bit_cast(s16x4, __builtin_amdgcn_ds_read_tr16_b64_v4i16((LAS v4i16_t*)p)); }
__device__ __forceinline__ bf16x8 frag_tr(LAS unsigned char* lb, int off0, int off1) {
    const s16x4 lo = ds_tr(lb + off0), hi = ds_tr(lb + off1);
    return (bf16x8){lo[0], lo[1], lo[2], lo[3], hi[0], hi[1], hi[2], hi[3]};
}
typedef float f32x2_t __attribute__((ext_vector_type(2))); typedef __bf16 bf16x2_t __attribute__((ext_vector_type(2)));
__device__ __forceinline__ unsigned cvtpk(float lo, float hi) { f32x2_t v = {lo, hi}; bf16x2_t b = __builtin_convertvector(v, bf16x2_t); return __builtin_bit_cast(unsigned, b); }
template <int s> __device__ __forceinline__ bf16x8 pack8(const f32x16& p) {
    v4u w; w.x = cvtpk(p[8 * s + 0], p[8 * s + 1]); w.y = cvtpk(p[8 * s + 2], p[8 * s + 3]); w.z = cvtpk(p[8 * s + 4], p[8 * s + 5]); w.w = cvtpk(p[8 * s + 6], p[8 * s + 7]);
    return __builtin_bit_cast(bf16x8, w);
}
__device__ __forceinline__ float wave_sum(float v) {
#pragma unroll
    for (int o = 1; o < 64; o <<= 1) v += __shfl_xor(v, o);
    return v;
}
#define XB_TMO      128
#define XB_XCNT(j)  (256  + 64 * (j))
#define XB_XSUB(j)  (1280 + 64 * (j))
#define XB_XGEN(j)  (2304 + 64 * (j))
#define XB_TOP      3328
#define XB_TOPGEN   3392
#define XCD_BAR_WORDS 3456
#define XB_SPIN_CAP (1u << 18)

__device__ __forceinline__ unsigned xb_ld(unsigned* p)              { return __hip_atomic_load(p, __ATOMIC_RELAXED, __HIP_MEMORY_SCOPE_AGENT); }
__device__ __forceinline__ unsigned xb_add(unsigned* p, unsigned v) { return __hip_atomic_fetch_add(p, v, __ATOMIC_RELAXED, __HIP_MEMORY_SCOPE_AGENT); }
__device__ __forceinline__ unsigned xb_xcc_id() { return (unsigned)__builtin_amdgcn_s_getreg((3 << 11) | 20) & 0xFu; }
#define XB_SPIN(cond, bar) do { unsigned _sp = 0; while (cond) { __builtin_amdgcn_s_sleep(1); \
    if ((++_sp & 255u) == 0u) { if (xb_ld(&(bar)[XB_TMO])) break; if (_sp > XB_SPIN_CAP) { atomicAdd(&(bar)[XB_TMO], 1u); break; } } } } while (0)

struct XcdBarrier {
    unsigned* bar; unsigned x;
    volatile LAS unsigned* st;
};

__device__ __forceinline__ XcdBarrier xcd_barrier_post(unsigned* bar, volatile LAS unsigned* st) {
    XcdBarrier b; b.bar = bar; b.x = xb_xcc_id(); b.st = st;
    if (threadIdx.x == 0) (void)xb_add(&bar[XB_XCNT(b.x)], 1u);
    return b;
}
__device__ __forceinline__ void xcd_barrier_complete(unsigned* bar, unsigned x, unsigned& nloc, unsigned& nx) {
    const unsigned G = gridDim.x * gridDim.y * gridDim.z;
    unsigned sum, cnt, mine, sp = 0u;
    for (;;) {
        sum = 0u; cnt = 0u; mine = 0u;
#pragma unroll
        for (unsigned j = 0; j < 16; ++j) { const unsigned c = xb_ld(&bar[XB_XCNT(j)]); sum += c; cnt += (c > 0u) ? 1u : 0u; mine = (j == x) ? c : mine; }
        if (sum == G) break;
        __builtin_amdgcn_s_sleep(1);
        if ((++sp & 255u) == 0u) { if (xb_ld(&bar[XB_TMO])) break; if (sp > XB_SPIN_CAP) { atomicAdd(&bar[XB_TMO], 1u); break; } }
    }
    nloc = mine > 0u ? mine : 1u; nx = cnt > 0u ? cnt : 1u;
}

__device__ __forceinline__ void xcd_barrier(const XcdBarrier& b) {
    asm volatile("s_waitcnt vmcnt(0)" ::: "memory");
    __syncthreads();
    if (threadIdx.x == 0) {
        unsigned* bar = b.bar;
        __builtin_amdgcn_s_waitcnt(0);
        unsigned nloc = b.st[0], nx = b.st[1];
        if (nloc == 0u) { xcd_barrier_complete(bar, b.x, nloc, nx); b.st[0] = nloc; b.st[1] = nx; }
        const unsigned old = xb_add(&bar[XB_XSUB(b.x)], 1u);
        const unsigned gen = old / nloc;
        if (old + 1u == (gen + 1u) * nloc) {
            __builtin_amdgcn_fence(__ATOMIC_RELEASE, "agent");
            asm volatile("s_waitcnt vmcnt(0)" ::: "memory");
            const unsigned og = xb_add(&bar[XB_TOP], 1u);
            const unsigned tg = og / nx;
            if (og + 1u == (tg + 1u) * nx) xb_add(&bar[XB_TOPGEN], 1u);
            else XB_SPIN(xb_ld(&bar[XB_TOPGEN]) == tg, bar);
            __builtin_amdgcn_fence(__ATOMIC_ACQUIRE, "agent");
            xb_add(&bar[XB_XGEN(b.x)], 1u);
            asm volatile("s_waitcnt vmcnt(0)" ::: "memory");
        } else {
            XB_SPIN(xb_ld(&bar[XB_XGEN(b.x)]) == gen, bar);
            __builtin_amdgcn_fence(__ATOMIC_ACQUIRE, "agent");
            asm volatile("s_waitcnt vmcnt(0)" ::: "memory");
        }
    }
    __syncthreads();
}
struct Frame {
    LAS unsigned char* lds;
    volatile LAS unsigned* MISC;
    gu32* ctl;
    int tid, lane, wave;
    int vcu, G;
    unsigned char* ws;
    const float* in[23];
    float* out;
};
#define WSP(T_, off) ((T_*)(F.ws + (off)))

__device__ __forceinline__ void p0_titem(const float* W, int ldw, int c0, const float* kscale, float mul, bf16* WT, int Kd, int drow0, LAS float* scr, int kb, int lane) {
    const int k0 = 64 * kb; f32x4 v[8];
    if ((c0 & 3) == 0 && (ldw & 3) == 0) {
#pragma unroll
        for (int i = 0; i < 8; ++i) { const int kk = 8 * i + (lane >> 3); v[i] = *(const f32x4*)(W + (size_t)(k0 + kk) * ldw + c0 + 4 * (lane & 7)); }
    } else {
#pragma unroll
        for (int i = 0; i < 8; ++i) { const int kk = 8 * i + (lane >> 3); const float* p = W + (size_t)(k0 + kk) * ldw + c0 + 4 * (lane & 7); v[i] = (f32x4){p[0], p[1], p[2], p[3]}; }
    }
#pragma unroll
    for (int i = 0; i < 8; ++i) { const int kk = 8 * i + (lane >> 3); const float sc = (kscale ? kscale[k0 + kk] : 1.0f) * mul; LAS float* d = scr + kk * 33 + 4 * (lane & 7);
        d[0] = v[i][0] * sc; d[1] = v[i][1] * sc; d[2] = v[i][2] * sc; d[3] = v[i][3] * sc; }
    LDS_WAIT(); asm volatile("" ::: "memory");
    const int c = lane & 7;
#pragma unroll
    for (int j = 0; j < 4; ++j) { const int n = (lane >> 3) + 8 * j; const LAS float* s = scr + (8 * c) * 33 + n;
        v4u o; o.x = pk2(s[0 * 33], s[1 * 33]); o.y = pk2(s[2 * 33], s[3 * 33]); o.z = pk2(s[4 * 33], s[5 * 33]); o.w = pk2(s[6 * 33], s[7 * 33]);
        *(GAS v4u*)(WT + (size_t)(drow0 + n) * Kd + k0 + 8 * c) = o; }
    LDS_WAIT(); asm volatile("" ::: "memory");
}
__device__ __forceinline__ void p0_prologue(Frame& F) {
    LAS float* scr = (LAS float*)(F.lds + RING_OFF + F.wave * 16384);
    const int gw = F.vcu * NWAVES + F.wave, NGW = F.G * NWAVES, lane = F.lane;
    const float* norm_mix = F.in[1]; const float* norm_ffn = F.in[2];
    constexpr int I_AB1 = 16 * 40, I_AB2 = 16 * 24, I_ABO = 16 * 32, I_FF = 16 * 88, I_DN = 44 * 32, I_CIN = 16 * 96, I_CO = 16 * 32, I_W1 = 32 * 2, I_W2 = 2;
    constexpr int NITEMS = I_AB1 + I_AB2 + I_ABO + 4 * I_FF + 2 * I_DN + I_CIN + I_CO + 2 * I_W1 + 2 * I_W2;
    for (int it = gw; it < NITEMS; it += NGW) {
        int r = it;
        if (r < I_AB1) { const int kb = r / 40, nb = r % 40; p0_titem(F.in[6], AB_LD, 32 * nb, norm_mix, nb < 16 ? C2 : 1.f, WSP(bf16, WS_WAB), 1024, 32 * nb, scr, kb, lane); continue; } r -= I_AB1;
        if (r < I_AB2) { const int kb = r / 24, nb = r % 24; p0_titem(F.in[6], AB_LD, 1304 + 32 * nb, norm_mix, nb < 16 ? C2 : 1.f, WSP(bf16, WS_WAB), 1024, 1280 + 32 * nb, scr, kb, lane); continue; } r -= I_AB2;
        if (r < I_ABO) { const int kb = r / 32, nb = r % 32; p0_titem(F.in[15], 1024, 32 * nb, nullptr, 1.f, WSP(bf16, WS_WABO), 1024, 32 * nb, scr, kb, lane); continue; } r -= I_ABO;
        if (r < 4 * I_FF) { const int q = r / I_FF, rr = r % I_FF, l = q >> 1, up = q & 1, kb = rr / 88, nb = rr % 88, n0 = 32 * nb;
            const float* W = (up ? F.in[4] : F.in[3]) + (size_t)l * 1024 * FF;
            p0_titem(W, FF, n0, norm_ffn + l * 1024, 1.f, WSP(bf16, l ? WS_WUP1 : WS_WUP0), 1024, 256 * (n0 / 128) + (n0 % 128) + 128 * up, scr, kb, lane); continue; } r -= 4 * I_FF;
        if (r < 2 * I_DN) { const int l = r / I_DN, rr = r % I_DN, kb = rr / 32, nb = rr % 32;
            p0_titem(F.in[5] + (size_t)l * FF * 1024, 1024, 32 * nb, nullptr, 1.f, WSP(bf16, l ? WS_WDN1 : WS_WDN0), FF, 32 * nb, scr, kb, lane); continue; } r -= 2 * I_DN;
        if (r < I_CIN) { const int kb = r / 96, nb = r % 96; p0_titem(F.in[16], C_LD, 32 * nb, norm_mix + 1024, 1.f, WSP(bf16, WS_WCIN), 1024, 32 * nb, scr, kb, lane); continue; } r -= I_CIN;
        if (r < I_CO) { const int kb = r / 32, nb = r % 32; p0_titem(F.in[21], 1024, 32 * nb, nullptr, 1.f, WSP(bf16, WS_WCO), 1024, 32 * nb, scr, kb, lane); continue; } r -= I_CO;
        if (r < 2 * I_W1) { const int kv = r / I_W1, rr = r % I_W1, kb = rr / 2, nb = rr % 2; p0_titem(F.in[kv ? 12 : 10], 64, 32 * nb, nullptr, 1.f, WSP(bf16, kv ? WS_CW1V : WS_CW1K), 2048, 32 * nb, scr, kb, lane); continue; } r -= 2 * I_W1;
        { const int kv = r / I_W2, nb = r % I_W2; p0_titem(F.in[kv ? 13 : 11], 64, 32 * nb, nullptr, 1.f, WSP(bf16, kv ? WS_CW2V : WS_CW2K), 64, 32 * nb, scr, 0, lane); }
    }
    { const int gt = (F.vcu * NWAVES + F.wave) * 64 + lane, NGT = F.G * NWAVES * 64;
      for (int i = gt; i < 2 * 32 * 1024; i += NGT) { const int which = i >> 15, n = (i >> 10) & 31, k = i & 1023; float v = 0.f;
          if (which == 0) { if (n < 24) v = F.in[6][(size_t)k * AB_LD + 1280 + n] * norm_mix[k]; WSP(bf16, WS_WABG)[n * 1024 + k] = (bf16)f2bf(v); }
          else { if (n < 8) v = F.in[16][(size_t)k * C_LD + 3072 + n] * norm_mix[1024 + k]; WSP(bf16, WS_WCG)[n * 1024 + k] = (bf16)f2bf(v); } } }
    { const int gt = (F.vcu * NWAVES + F.wave) * 64 + lane, NGT = F.G * NWAVES * 64; for (int i = gt; i < 4 * M; i += NGT) WSP(float, WS_PSUM)[i] = 0.f; }
    for (int m = gw; m < M; m += 2 * NGW) {
        const GAS f32x4* xr0 = (const GAS f32x4*)(F.in[0] + (size_t)m * D) + lane; const GAS f32x4* xr1 = (const GAS f32x4*)(F.in[0] + (size_t)(m + NGW) * D) + lane;
        f32x4 v[4], u[4]; float s = 0.f, s2 = 0.f;
#pragma unroll
        for (int j = 0; j < 4; ++j) { v[j] = xr0[64 * j]; u[j] = xr1[64 * j]; }
#pragma unroll
        for (int j = 0; j < 4; ++j) { s += (v[j].x * v[j].x + v[j].y * v[j].y) + (v[j].z * v[j].z + v[j].w * v[j].w); s2 += (u[j].x * u[j].x + u[j].y * u[j].y) + (u[j].z * u[j].z + u[j].w * u[j].w); }
        s = wave_sum(s); s2 = wave_sum(s2);
        GAS unsigned long long* o0 = (GAS unsigned long long*)(WSP(bf16, WS_H16) + (size_t)m * D) + lane; GAS unsigned long long* o1 = (GAS unsigned long long*)(WSP(bf16, WS_H16) + (size_t)(m + NGW) * D) + lane;
#pragma unroll
        for (int j = 0; j < 4; ++j) { o0[64 * j] = (unsigned long long)pk2(v[j].x, v[j].y) | ((unsigned long long)pk2(v[j].z, v[j].w) << 32); o1[64 * j] = (unsigned long long)pk2(u[j].x, u[j].y) | ((unsigned long long)pk2(u[j].z, u[j].w) << 32); }
        if (lane == 0) { WSP(float, WS_RS0)[m] = 1.0f / sqrtf(s * (1.0f / D) + 1e-6f); WSP(float, WS_RS0)[m + NGW] = 1.0f / sqrtf(s2 * (1.0f / D) + 1e-6f); }
    }
    if (F.vcu == 0) {
        __syncthreads();
        LAS float* red = (LAS float*)(F.lds + RING_OFF);
#pragma unroll
        for (int kv = 0; kv < 2; ++kv) { const float* pos = F.in[kv ? 9 : 8]; const float* w1 = F.in[kv ? 12 : 10]; float a = 0.f;
            for (int k = F.wave * 256; k < F.wave * 256 + 256; ++k) a += pos[k] * w1[(size_t)k * 64 + lane];
            red[(kv * 8 + F.wave) * 64 + lane] = a; }
        __syncthreads();
        if (F.tid < 128) { const int kv = F.tid >> 6, n = F.tid & 63; float a = 0.f;
#pragma unroll
            for (int w = 0; w < 8; ++w) a += red[(kv * 8 + w) * 64 + n];
            WSP(float, WS_CBIAS)[kv * 64 + n] = a; }
        __syncthreads();
    }
}
typedef float f32x4v __attribute__((ext_vector_type(4)));
__device__ __forceinline__ void skinny_tile16(const bf16* A, const bf16* Wt, int row0, int lane, f32x4v (&acc)[2]) {
    const int i16 = lane & 15, kq = lane >> 4; acc[0] = (f32x4v){0.f, 0.f, 0.f, 0.f}; acc[1] = acc[0];
    const bf16* ap = A + (size_t)(row0 + i16) * 1024 + 8 * kq; const bf16* w0 = Wt + (size_t)i16 * 1024 + 8 * kq; const bf16* w1 = w0 + 16 * 1024;
#pragma unroll 8
    for (int s = 0; s < 32; ++s) { const bf16x8 x = *(const bf16x8*)(ap + 32 * s);
        acc[0] = __builtin_amdgcn_mfma_f32_16x16x32_bf16(*(const bf16x8*)(w0 + 32 * s), x, acc[0], 0, 0, 0);
        acc[1] = __builtin_amdgcn_mfma_f32_16x16x32_bf16(*(const bf16x8*)(w1 + 32 * s), x, acc[1], 0, 0, 0); }
}
__device__ __forceinline__ void gates0_phase(Frame& F) {
    const int gw = F.vcu * NWAVES + F.wave, NGW = F.G * NWAVES, lane = F.lane, i16 = lane & 15, cg = lane >> 4;
    for (int t = gw; t < M / 16; t += NGW) {
        f32x4v acc[2]; skinny_tile16(WSP(bf16, WS_H16), WSP(bf16, WS_WABG), 16 * t, lane, acc);
        const int row = 16 * t + i16; const float rs = WSP(float, WS_RS0)[row]; float* g = WSP(float, WS_GATES) + (size_t)row * 32;
#pragma unroll
        for (int tt = 0; tt < 2; ++tt) { const int c0 = 16 * tt + 4 * cg; if (c0 < 24) { f32x4v o;
#pragma unroll
                for (int r = 0; r < 4; ++r) o[r] = 1.0f / (1.0f + __expf(-(acc[tt][r] * rs + F.in[7][c0 + r])));
                *(f32x4v*)(g + c0) = o; } }
    }
}
__device__ __forceinline__ void gates1_phase(Frame& F) {
    const int gw = F.vcu * NWAVES + F.wave, NGW = F.G * NWAVES, lane = F.lane, i16 = lane & 15, cg = lane >> 4;
    const pg8::RowScale R{nullptr, WSP(float, WS_PSUM) + 1 * M};
    for (int t = gw; t < M / 16; t += NGW) {
        f32x4v acc[2]; skinny_tile16(WSP(bf16, WS_H16), WSP(bf16, WS_WCG), 16 * t, lane, acc);
        const int row = 16 * t + i16; const float rs = pg8::row_scale(R, row); float* g = WSP(float, WS_GATES) + (size_t)row * 32;
        if (cg < 2) { f32x4v o;
#pragma unroll
            for (int r = 0; r < 4; ++r) { const float x = acc[0][r] * rs + (cg == 0 ? F.in[19][r] : F.in[20][r]); o[r] = cg == 0 ? x : fminf(x, 0.f) - log1pf(__expf(-fabsf(x))); }
            *(f32x4v*)(g + 4 * cg) = o; }
    }
}

__device__ __forceinline__ void compress_phase(Frame& F) {
    const int lane = F.lane, r32 = lane & 31, h = lane >> 5, w = F.wave;
    LAS float* red = (LAS float*)(F.lds + RING_OFF);
    LAS unsigned char* Hs = F.lds + RING_OFF + 65536;
    for (int task = F.vcu; task < 256; task += F.G) {
        const int kv = task & 1, bg = (task >> 1) & 7, rt = task >> 4, b = bg >> 1, g = bg & 1, i0 = rt * 32;
        const bf16* raw = WSP(bf16, WS_QKV0) + (size_t)b * T * 2048 + (kv ? QC_VC : QC_KC) + g * 64;
        const bf16* w1t = WSP(bf16, kv ? WS_CW1V : WS_CW1K);
        const bf16* w2t = WSP(bf16, kv ? WS_CW2V : WS_CW2K);
        int ic = i0 + r32; if (ic > 510) ic = 510;
        f32x16 d0 = {}, d1 = {};
#pragma unroll
        for (int ll = 0; ll < 4; ++ll) { const int l = 4 * w + ll;
#pragma unroll
            for (int ss = 0; ss < 4; ++ss) { const int k = l * 64 + 16 * ss + 8 * h;
                const bf16x8 bfr = *(const bf16x8*)(raw + (size_t)(16 * ic + l) * 2048 + 16 * ss + 8 * h);
                d0 = mfma32(*(const bf16x8*)(w1t + (size_t)r32 * 2048 + k), bfr, d0);
                d1 = mfma32(*(const bf16x8*)(w1t + (size_t)(32 + r32) * 2048 + k), bfr, d1); } }
#pragma unroll
        for (int r = 0; r < 16; ++r) { red[(w * 64 + crow(r, h)) * 32 + r32] = d0[r]; red[(w * 64 + 32 + crow(r, h)) * 32 + r32] = d1[r]; }
        __syncthreads();
#pragma unroll
        for (int e = 0; e < 4; ++e) { const int idx = F.tid * 4 + e, hid = idx >> 5, i = idx & 31; float a = WSP(float, WS_CBIAS)[kv * 64 + hid];
#pragma unroll
            for (int ww = 0; ww < 8; ++ww) a += red[(ww * 64 + hid) * 32 + i];
            a = a / (1.0f + __expf(-a));
            *(LAS bf16*)(Hs + i * 144 + hid * 2) = (bf16)f2bf(a); }
        __syncthreads();
        if (w < 2) { f32x16 o = {};
#pragma unroll
            for (int s = 0; s < 4; ++s) o = mfma32(*(const bf16x8*)(w2t + (size_t)(32 * w + r32) * 64 + 16 * s + 8 * h), *(const LAS bf16x8*)(Hs + r32 * 144 + (16 * s + 8 * h) * 2), o);
            bf16* dst = WSP(bf16, kv ? WS_VC : WS_KC) + ((size_t)bg * 512 + i0 + r32) * 64 + 32 * w + 4 * h;
#pragma unroll
            for (int q = 0; q < 4; ++q) { v2u pk; pk.x = pk2(o[4 * q], o[4 * q + 1]); pk.y = pk2(o[4 * q + 2], o[4 * q + 3]); *(v2u*)(dst + 8 * q) = pk; } }
        __syncthreads();
    }
}
constexpr int AT_K = 0, AT_V = 9216, AT_BUF = 18432, AT_IMP = 2 * AT_BUF, AT_SEL = AT_IMP + 128 * 132 * 4, AT_OVF = AT_SEL + 2048, AT_END = AT_OVF + 16;
static_assert(AT_END <= RING_BYTES, "attention LDS");
constexpr int KV_STRIDE = 144;
__device__ __forceinline__ void stage_load(Frame& F, const bf16* Kg, const bf16* Vg, int pitch, int row0, int rmax, v4u& kx, v4u& vx) {
    const int row = F.tid >> 3, ch = F.tid & 7; int rr = row0 + row; rr = rr < 0 ? 0 : (rr > rmax ? rmax : rr);
    kx = *(const v4u*)(Kg + (size_t)rr * pitch + ch * 8);
    if (Vg) vx = *(const v4u*)(Vg + (size_t)rr * pitch + ch * 8);
}
__device__ __forceinline__ void stage_write(Frame& F, int boff, bool hasv, const v4u& kx, const v4u& vx) {
    const int row = F.tid >> 3, ch = F.tid & 7;
    *(LAS v4u*)(F.lds + boff + AT_K + row * KV_STRIDE + ch * 16) = kx;
    if (hasv) *(LAS v4u*)(F.lds + boff + AT_V + row * KV_STRIDE + ch * 16) = vx;
}
__device__ __forceinline__ f32x16 qk_tile(LAS unsigned char* klb, int sub, const bf16x8 (&qf)[4]) {
    f32x16 s = {};
#pragma unroll
    for (int st = 0; st < 4; ++st) s = mfma32(*(const LAS bf16x8*)(klb + 32 * sub * KV_STRIDE + 32 * st), qf[st], s);
    return s;
}
__device__ __forceinline__ void pv_tile(LAS unsigned char* vlb, int sub, const f32x16& p, f32x16 (&o)[2]) {
    const bf16x8 p0 = pack8<0>(p), p1 = pack8<1>(p);
#pragma unroll
    for (int dt = 0; dt < 2; ++dt) {
        o[dt] = mfma32(frag_tr(vlb, (32 * sub) * KV_STRIDE + 64 * dt, (32 * sub + 8) * KV_STRIDE + 64 * dt), p0, o[dt]);
        o[dt] = mfma32(frag_tr(vlb, (32 * sub + 16) * KV_STRIDE + 64 * dt, (32 * sub + 24) * KV_STRIDE + 64 * dt), p1, o[dt]);
    }
}
constexpr float THRL = 6.0f, OVFL = 1073741824.0f  , NEGBIG = -1e30f;
struct HeadState { float m, l; f32x16 o[2]; };
__device__ __forceinline__ void hs_init(HeadState& S, float l0) { S.m = 0.f; S.l = l0; S.o[0] = (f32x16){}; S.o[1] = (f32x16){}; }
__device__ __forceinline__ void osm_tile(f32x16& s, HeadState& S) {
    float mx = fmaxf(fmaxf(s[0], s[1]), fmaxf(s[2], s[3]));
#pragma unroll
    for (int r = 4; r < 16; r += 4) mx = fmaxf(mx, fmaxf(fmaxf(s[r], s[r + 1]), fmaxf(s[r + 2], s[r + 3])));
    { const auto rr = __builtin_amdgcn_permlane32_swap(__float_as_uint(mx), __float_as_uint(mx), false, false); mx = fmaxf(__uint_as_float(rr[0]), __uint_as_float(rr[1])); }
    const bool need = mx > THRL;
    if (__any(need)) {
        const float dl = need ? mx : 0.f, f = __builtin_amdgcn_exp2f(-dl);
        S.m += dl; S.l *= f;
#pragma unroll
        for (int r = 0; r < 16; ++r) s[r] -= dl;
#pragma unroll
        for (int dt = 0; dt < 2; ++dt)
#pragma unroll
            for (int r = 0; r < 16; ++r) S.o[dt][r] *= f;
    }
    float sum = 0.f;
#pragma unroll
    for (int r = 0; r < 16; ++r) { s[r] = __builtin_amdgcn_exp2f(s[r]); sum += s[r]; }
    S.l += sum;
}
template <int MODE, int WIN>
__device__ __forceinline__ f32x16 qk_masked(const bf16x8 (&kf)[4], const bf16x8 (&qf)[4], float c0, bool edge, int kb, int tq, int h) {
    f32x16 s;
#pragma unroll
    for (int r = 0; r < 16; ++r) s[r] = c0;
#pragma unroll
    for (int st = 0; st < 4; ++st) s = mfma32(kf[st], qf[st], s);
    if (edge) {
#pragma unroll
        for (int r = 0; r < 16; ++r) { const int key = kb + crow(r, h); bool ok = key <= tq; if (MODE == 1) ok = ok && (tq - key < WIN); s[r] = ok ? s[r] : NEGBIG; }
    }
    return s;
}
constexpr int RG_SLOT = 32768, RG_V = 16384, RG_NSLOT = 3;
static_assert(RG_NSLOT * RG_SLOT <= AT_SEL, "the DMA ring may overlay the dead importance table, never the selection words");
template <int MODE, int WIN, bool GEN>
__device__ __forceinline__ void attn_blocks(Frame& F, const bf16* Kg, const bf16* Vg, int jlo, int jhi, int tq, int tqmax_w, int tqmin_w, const LAS unsigned* selp,
                                            const bf16x8 (&qf)[2][4], HeadState (&H)[2], LAS unsigned* ovfw) {
    int lane = F.lane; asm volatile("" : "+v"(lane));
    const int r32 = lane & 31, h = lane >> 5;
    int koff[4];
#pragma unroll
    for (int st = 0; st < 4; ++st) koff[st] = r32 * 128 + (((2 * st + h) ^ (r32 & 7)) << 4);
    const int vl = 4 * h + ((lane & 15) >> 2), vlow = (2 * ((lane >> 4) & 1) + ((lane & 3) >> 1)) ^ (vl & 3);
    int voff[2];
#pragma unroll
    for (int dt = 0; dt < 2; ++dt) voff[dt] = RG_V + vl * 128 + ((((4 * dt) ^ (vl & 4)) | vlow) << 4) + 8 * (lane & 1);
    const int drow = 16 * F.wave + (lane >> 3), dch = (lane & 7) ^ (lane >> 3);
    const bf16* ksrc = Kg + (size_t)drow * 2048 + dch * 8; const bf16* vsrc = Vg + (size_t)drow * 2048 + dch * 8;
    const unsigned ring0 = (unsigned)(size_t)F.lds + (unsigned)F.wave * 2048u;
#define RG_GLDS(gsrc, ldsdst) do { unsigned keep_; asm volatile("s_mov_b32 %0, m0\n\ts_mov_b32 m0, %2\n\ts_nop 0\n\tglobal_load_lds_dwordx4 %1, off\n\ts_mov_b32 m0, %0" : "=&s"(keep_) : "v"(gsrc), "s"(ldsdst) : "memory"); } while (0)
#define RG_ISSUE(blk, slot) do { const size_t go_ = (size_t)(blk) * (128 * 2048); const unsigned ld_ = (unsigned)__builtin_amdgcn_readfirstlane((int)(ring0 + (unsigned)(slot) * RG_SLOT)); \
        RG_GLDS(ksrc + go_, ld_); RG_GLDS(ksrc + go_ + 8 * 2048, ld_ + 1024); RG_GLDS(vsrc + go_, ld_ + RG_V); RG_GLDS(vsrc + go_ + 8 * 2048, ld_ + RG_V + 1024); } while (0)
    bool ovf = false;
    __syncthreads();
    const int Jlo = jlo >> 1, Jhi = jhi >> 1;
#pragma unroll
    for (int d = 0; d < 2; ++d) { const int jb = Jlo + d > Jhi ? Jhi : Jlo + d; RG_ISSUE(jb, d); }
    int slot = 0;
    for (int J = Jlo; J <= Jhi; ++J) {
        asm volatile("s_waitcnt vmcnt(4)" ::: "memory");
        __builtin_amdgcn_s_barrier(); asm volatile("" ::: "memory");
        { const int jn = J + 2 > Jhi ? Jhi : J + 2; const int sn = slot == 0 ? 2 : slot - 1; RG_ISSUE(jn, sn); }
        __builtin_amdgcn_sched_barrier(0);
        LAS unsigned char* sb = F.lds + slot * RG_SLOT; slot = slot == 2 ? 0 : slot + 1;
        bool mine0 = true, mine1 = true;
        if (MODE == 0) { const int j0 = 2 * J, j1 = 2 * J + 1; const unsigned sw0 = selp[j0 & 3], sw1 = selp[j1 & 3]; mine0 = ((sw0 >> (j0 >> 2)) & 1u) != 0u; mine1 = ((sw1 >> (j1 >> 2)) & 1u) != 0u; }
        const bool anym0 = MODE != 0 || __any(mine0), anym1 = MODE != 0 || __any(mine1);
#pragma unroll
        for (int sub = 0; sub < 4; ++sub) {
            const int kb = 128 * J + 32 * sub;
            const bool mine = sub < 2 ? mine0 : mine1;
            const bool any = (sub < 2 ? anym0 : anym1) && (kb <= tqmax_w) && (MODE == 0 || kb + 31 > tqmin_w - WIN);
            if (!any) continue;
            bf16x8 kf[4];
#pragma unroll
            for (int st = 0; st < 4; ++st) kf[st] = *(const LAS bf16x8*)(sb + koff[st] + sub * 4096);
            const bool edge = (kb + 31 > tqmin_w) || (MODE == 1 && kb <= tqmax_w - WIN);
            bf16x8 vf[4];
#pragma unroll
            for (int dt = 0; dt < 2; ++dt) {
                vf[2 * dt] = frag_tr(sb + voff[dt], sub * 4096, sub * 4096 + 8 * 128);
                vf[2 * dt + 1] = frag_tr(sb + voff[dt], sub * 4096 + 16 * 128, sub * 4096 + 24 * 128); }
            if (!GEN) {
#define SB_() __builtin_amdgcn_sched_barrier(0)
#define EXP4(S, B, SUM) do { S[B] = __builtin_amdgcn_exp2f(S[B]); S[B + 1] = __builtin_amdgcn_exp2f(S[B + 1]); S[B + 2] = __builtin_amdgcn_exp2f(S[B + 2]); S[B + 3] = __builtin_amdgcn_exp2f(S[B + 3]); \
                    SUM += (S[B] + S[B + 1]) + (S[B + 2] + S[B + 3]); } while (0)
                const float c0 = (MODE == 0 && !mine) ? NEGBIG : 0.f;
                f32x16 cinit;
                if (edge) {
#pragma unroll
                    for (int r = 0; r < 16; ++r) { const int key = kb + crow(r, h); bool ok = key <= tq; if (MODE == 1) ok = ok && (tq - key < WIN); cinit[r] = ok ? c0 : NEGBIG; }
                } else {
#pragma unroll
                    for (int r = 0; r < 16; ++r) cinit[r] = c0;
                }
                SB_();
                f32x16 s0 = mfma32(kf[0], qf[0][0], cinit);
#pragma unroll
                for (int st = 1; st < 4; ++st) s0 = mfma32(kf[st], qf[0][st], s0);
                SB_();
                float sum0 = 0.f, sum1 = 0.f;
                f32x16 s1 = mfma32(kf[0], qf[1][0], cinit); SB_(); EXP4(s0, 0, sum0); SB_();
                s1 = mfma32(kf[1], qf[1][1], s1); SB_(); EXP4(s0, 4, sum0); SB_();
                s1 = mfma32(kf[2], qf[1][2], s1); SB_(); EXP4(s0, 8, sum0); SB_();
                s1 = mfma32(kf[3], qf[1][3], s1); SB_(); EXP4(s0, 12, sum0); SB_();
                const bf16x8 pa0 = pack8<0>(s0), pa1 = pack8<1>(s0);
                SB_();
                H[0].o[0] = mfma32(vf[0], pa0, H[0].o[0]); SB_(); EXP4(s1, 0, sum1); SB_();
                H[0].o[0] = mfma32(vf[1], pa1, H[0].o[0]); SB_(); EXP4(s1, 4, sum1); SB_();
                H[0].o[1] = mfma32(vf[2], pa0, H[0].o[1]); SB_(); EXP4(s1, 8, sum1); SB_();
                H[0].o[1] = mfma32(vf[3], pa1, H[0].o[1]); SB_(); EXP4(s1, 12, sum1); SB_();
                const bf16x8 pb0 = pack8<0>(s1), pb1 = pack8<1>(s1);
                SB_();
                H[1].o[0] = mfma32(vf[0], pb0, H[1].o[0]); H[1].o[0] = mfma32(vf[1], pb1, H[1].o[0]);
                H[1].o[1] = mfma32(vf[2], pb0, H[1].o[1]); H[1].o[1] = mfma32(vf[3], pb1, H[1].o[1]);
                H[0].l += sum0; H[1].l += sum1; ovf = ovf || !(sum0 <= OVFL) || !(sum1 <= OVFL);
#undef SB_
#undef EXP4
            } else {
                f32x16 s[2];
#pragma unroll
                for (int hd = 0; hd < 2; ++hd) { s[hd] = qk_masked<MODE, WIN>(kf, qf[hd], (MODE == 0 && !mine) ? NEGBIG : -H[hd].m, edge, kb, tq, h); osm_tile(s[hd], H[hd]); }
#pragma unroll
                for (int hd = 0; hd < 2; ++hd) {
                    const bf16x8 p0 = pack8<0>(s[hd]), p1 = pack8<1>(s[hd]);
#pragma unroll
                    for (int dt = 0; dt < 2; ++dt) { H[hd].o[dt] = mfma32(vf[2 * dt], p0, H[hd].o[dt]); H[hd].o[dt] = mfma32(vf[2 * dt + 1], p1, H[hd].o[dt]); }
                }
            }
            __builtin_amdgcn_sched_barrier(0);
        }
    }
    asm volatile("s_waitcnt vmcnt(0)" ::: "memory");
    if (!GEN) { if (__any(ovf) && lane == 0) *ovfw = 1u; }
    __syncthreads();
#undef RG_ISSUE
#undef RG_GLDS
}
__device__ __forceinline__ void accf_store(float* accw, int lane, const f32x16 (&o)[2], float sc, bool add) {
#pragma unroll
    for (int dt = 0; dt < 2; ++dt)
#pragma unroll
        for (int q = 0; q < 4; ++q) { f32x4 v = {o[dt][4 * q] * sc, o[dt][4 * q + 1] * sc, o[dt][4 * q + 2] * sc, o[dt][4 * q + 3] * sc};
            f32x4* d = (f32x4*)accw + (dt * 4 + q) * 64 + lane; if (add) v = v + *d; *d = v; }
}
__device__ __forceinline__ void att_store(bf16* att, const float* accw, int lane, size_t tok, int hc_att, const f32x16 (&o)[2], float sc, int h) {
    bf16* p = att + tok * 1024 + hc_att + 4 * h;
#pragma unroll
    for (int dt = 0; dt < 2; ++dt)
#pragma unroll
        for (int q = 0; q < 4; ++q) { f32x4 v = {o[dt][4 * q] * sc, o[dt][4 * q + 1] * sc, o[dt][4 * q + 2] * sc, o[dt][4 * q + 3] * sc};
            if (accw) v = v + *((const f32x4*)accw + (dt * 4 + q) * 64 + lane);
            v2u pk; pk.x = pk2(v[0], v[1]); pk.y = pk2(v[2], v[3]); *(v2u*)(p + 32 * dt + 8 * q) = pk; }
}
__device__ __forceinline__ void nsa_unit(Frame& F, int b, int g, int n) {
    int lane = F.lane, tid = F.tid; asm volatile("" : "+v"(lane), "+v"(tid));
    const int r32 = lane & 31, h = lane >> 5, wave = F.wave;
    const int start = n * 128, qt = wave >> 1, hp = (wave & 1) * 2;
    const int tq = start + qt * 32 + r32, tqmin_w = start + qt * 32, tqmax_w = tqmin_w + 31;
    const size_t tok = (size_t)b * T + tq;
    const bf16* qkv = WSP(bf16, WS_QKV0) + (size_t)b * T * 2048;
    const int trl = ((lane & 15) >> 2) * KV_STRIDE + (16 * ((lane >> 4) & 1) + 4 * (lane & 3)) * 2;
    LAS unsigned char* klb0 = F.lds + AT_K + r32 * KV_STRIDE + 16 * h; LAS unsigned char* vlb0 = F.lds + AT_V + trl + 4 * h * KV_STRIDE;
    LAS float* imp = (LAS float*)(F.lds + AT_IMP); LAS unsigned* sel = (LAS unsigned*)(F.lds + AT_SEL);
    bf16x8 qf[2][4];
#pragma unroll
    for (int hd = 0; hd < 2; ++hd)
#pragma unroll
        for (int s = 0; s < 4; ++s) qf[hd][s] = *(const bf16x8*)(qkv + (size_t)tq * 2048 + QC_QN + (g * 4 + hp + hd) * 64 + 16 * s + 8 * h);
#define GATEP (WSP(float, WS_GATES) + ((size_t)b * T + tq) * 32 + (g * 4 + hp) * 3)
#define ACCFP (WSP(float, WS_ACCF) + (((size_t)((b * 2 + g) * 64 + n) * 8 + wave) * 2) * 2048)
    __syncthreads();
    for (int i = tid; i < 128 * 132; i += 512) imp[i] = 0.f;
    LAS unsigned* ovfw = (LAS unsigned*)(F.lds + AT_OVF); if (tid < 2) ovfw[tid] = 0u;
    const bf16* kcg = WSP(bf16, WS_KC) + (size_t)(b * 2 + g) * 512 * 64; const bf16* vcg = WSP(bf16, WS_VC) + (size_t)(b * 2 + g) * 512 * 64;
    const int nvalid = 8 * n + 7, nbc = (nvalid + 63) >> 6;
    float m[2] = {-1e30f, -1e30f}, l[2] = {0.f, 0.f};
    v4u kx, vx = {0u, 0u, 0u, 0u};
    __syncthreads();
    stage_load(F, kcg, nullptr, 64, 0, 511, kx, vx);
    for (int jb = 0; jb < nbc; ++jb) {
        const int boff = (jb & 1) * AT_BUF;
        stage_write(F, boff, false, kx, vx);
        __syncthreads();
        if (jb + 1 < nbc) stage_load(F, kcg, nullptr, 64, 64 * (jb + 1), 511, kx, vx);
        LAS unsigned char* klb = klb0 + boff;
#pragma unroll
        for (int sub = 0; sub < 2; ++sub)
#pragma unroll
            for (int hd = 0; hd < 2; ++hd) {
                f32x16 s = qk_tile(klb, sub, qf[hd]); float mx = -INFINITY;
#pragma unroll
                for (int r = 0; r < 16; ++r) { const int i = 64 * jb + 32 * sub + crow(r, h); s[r] = (16 * i + 31 <= tq) ? s[r] : -INFINITY; mx = fmaxf(mx, s[r]); }
                mx = fmaxf(mx, __shfl_xor(mx, 32));
                const float mn = fmaxf(m[hd], mx), al = __builtin_amdgcn_exp2f(m[hd] - mn); float sum = 0.f;
#pragma unroll
                for (int r = 0; r < 16; ++r) sum += __builtin_amdgcn_exp2f(s[r] - mn);
                l[hd] = l[hd] * al + sum; m[hd] = mn;
            }
    }
    float il[2];
#pragma unroll
    for (int hd = 0; hd < 2; ++hd) { const float lt = l[hd] + __shfl_xor(l[hd], 32); il[hd] = lt > 0.f ? 1.0f / lt : 0.f; }
    f32x16 o[2][2];
#pragma unroll
    for (int hd = 0; hd < 2; ++hd) { o[hd][0] = (f32x16){}; o[hd][1] = (f32x16){}; }
    float carry = 0.f;
    __syncthreads();
    stage_load(F, kcg, vcg, 64, 0, 511, kx, vx);
    for (int jb = 0; jb < nbc; ++jb) {
        const int boff = (jb & 1) * AT_BUF;
        stage_write(F, boff, true, kx, vx);
        __syncthreads();
        if (jb + 1 < nbc) stage_load(F, kcg, vcg, 64, 64 * (jb + 1), 511, kx, vx);
        LAS unsigned char* klb = klb0 + boff; LAS unsigned char* vlb = vlb0 + boff;
#pragma unroll
        for (int sub = 0; sub < 2; ++sub) {
            float ps4[4] = {0.f, 0.f, 0.f, 0.f}, sp[4] = {0.f, 0.f, 0.f, 0.f};
#pragma unroll
            for (int hd = 0; hd < 2; ++hd) {
                f32x16 s = qk_tile(klb, sub, qf[hd]);
#pragma unroll
                for (int r = 0; r < 16; ++r) { const int i = 64 * jb + 32 * sub + crow(r, h); s[r] = (16 * i + 31 <= tq) ? __builtin_amdgcn_exp2f(s[r] - m[hd]) * il[hd] : 0.f; }
#pragma unroll
                for (int q = 0; q < 4; ++q) { ps4[q] += (s[4 * q] + s[4 * q + 1]) + (s[4 * q + 2] + s[4 * q + 3]); sp[q] += s[4 * q + 3]; }
                pv_tile(vlb, sub, s, o[hd]);
            }
            float cell[4];
#pragma unroll
            for (int q = 0; q < 4; ++q) { const float rv = __shfl_xor(sp[q], 32);
                if (h == 1) cell[q] = ps4[q] + rv; else { cell[q] = ps4[q] + carry; carry = rv; } }
            const int j0 = (64 * jb + 32 * sub) / 4 + h;
#pragma unroll
            for (int q = 0; q < 4; ++q) atomicAdd((float*)&imp[(qt * 32 + r32) * 132 + j0 + 2 * q], cell[q]);
        }
    }
#pragma unroll
    for (int hd = 0; hd < 2; ++hd) accf_store(ACCFP + hd * 2048, lane, o[hd], GATEP[3 * hd + 0], false);
    __syncthreads();
    {
        const int q = tid >> 2, part = tid & 3, tq2 = start + q, cur = tq2 >> 6; unsigned bits = 0u;
        float val[32];
#pragma unroll
        for (int e = 0; e < 32; ++e) { const int j = 4 * e + part; const bool forced = (j == 0) || (j == cur) || (j == cur - 1);
            if (cur <= 15) { if (j <= cur) bits |= 1u << e; val[e] = -INFINITY; }
            else { if (forced) bits |= 1u << e; val[e] = (!forced && j >= 1 && j <= cur - 2) ? imp[q * 132 + j] : -INFINITY; } }
        if (cur > 15) {
            for (int itr = 0; itr < 13; ++itr) {
                float bv = val[0]; int be = 0;
#pragma unroll
                for (int e = 1; e < 32; ++e) if (val[e] > bv) { bv = val[e]; be = e; }
                int bj = 4 * be + part; float wv = bv; int wj = bj;
#pragma unroll
                for (int d = 1; d < 4; d <<= 1) { const float ov = __shfl_xor(wv, d); const int oj = __shfl_xor(wj, d); if (ov > wv || (ov == wv && oj < wj)) { wv = ov; wj = oj; } }
                const bool win = (wj == bj) && (wv > -INFINITY);
#pragma unroll
                for (int e = 0; e < 32; ++e) if (win && e == be) { val[e] = -INFINITY; bits |= 1u << e; }
            }
        }
        sel[q * 4 + part] = bits;
    }
    __syncthreads();
    const LAS unsigned* selp = sel + (qt * 32 + r32) * 4;
    {
        HeadState H[2]; hs_init(H[0], 0.f); hs_init(H[1], 0.f);
        attn_blocks<0, 0, false>(F, qkv + QC_KS + g * 64, qkv + QC_VS + g * 64, 0, 2 * n + 1, tq, tqmax_w, tqmin_w, selp, qf, H, ovfw + 0);
        if (ovfw[0]) { hs_init(H[0], 0.f); hs_init(H[1], 0.f); attn_blocks<0, 0, true>(F, qkv + QC_KS + g * 64, qkv + QC_VS + g * 64, 0, 2 * n + 1, tq, tqmax_w, tqmin_w, selp, qf, H, ovfw + 0); }
#pragma unroll
        for (int hd = 0; hd < 2; ++hd) { const float lt = H[hd].l + __shfl_xor(H[hd].l, 32); accf_store(ACCFP + hd * 2048, lane, H[hd].o, lt > 0.f ? GATEP[3 * hd + 1] / lt : 0.f, true); }
    }
    {
        HeadState H[2]; hs_init(H[0], 0.f); hs_init(H[1], 0.f);
        attn_blocks<1, 512, false>(F, qkv + QC_KW + g * 64, qkv + QC_VW + g * 64, (2 * n - 8) < 0 ? 0 : (2 * n - 8), 2 * n + 1, tq, tqmax_w, tqmin_w, selp, qf, H, ovfw + 1);
        if (ovfw[1]) { hs_init(H[0], 0.f); hs_init(H[1], 0.f); attn_blocks<1, 512, true>(F, qkv + QC_KW + g * 64, qkv + QC_VW + g * 64, (2 * n - 8) < 0 ? 0 : (2 * n - 8), 2 * n + 1, tq, tqmax_w, tqmin_w, selp, qf, H, ovfw + 1); }
#pragma unroll
        for (int hd = 0; hd < 2; ++hd) { const float lt = H[hd].l + __shfl_xor(H[hd].l, 32);
            att_store(WSP(bf16, WS_ATT), ACCFP + hd * 2048, lane, tok, (g * 4 + hp + hd) * 64, H[hd].o, lt > 0.f ? GATEP[3 * hd + 2] / lt : 0.f, h); }
    }
}
__device__ __forceinline__ void swa_unit(Frame& F, int b, int g, int n) {
    const int lane = F.lane, r32 = lane & 31, h = lane >> 5, wave = F.wave;
    const int start = n * 128, qt = wave >> 1, hp = (wave & 1) * 2;
    const int tq = start + qt * 32 + r32, tqmin_w = start + qt * 32, tqmax_w = tqmin_w + 31;
    const size_t tok = (size_t)b * T + tq;
    const bf16* qkv = WSP(bf16, WS_QKV0) + (size_t)b * T * 2048;
    bf16x8 qf[2][4];
#pragma unroll
    for (int hd = 0; hd < 2; ++hd)
#pragma unroll
        for (int s = 0; s < 4; ++s) qf[hd][s] = *(const bf16x8*)(qkv + (size_t)tq * 2048 + QC_QS + (g * 4 + hp + hd) * 64 + 16 * s + 8 * h);
    const LAS unsigned* selp = (const LAS unsigned*)(F.lds + AT_SEL);
    HeadState H[2];
#pragma unroll
    for (int hd = 0; hd < 2; ++hd) hs_init(H[hd], (h == 0) ? __builtin_amdgcn_exp2f(F.in[14][g * 4 + hp + hd] * LOG2E) : 0.f);
    LAS unsigned* ovfw = (LAS unsigned*)(F.lds + AT_OVF);
    __syncthreads(); if (F.tid == 0) ovfw[2] = 0u; __syncthreads();
    attn_blocks<1, 128, false>(F, qkv + QC_KSW + g * 64, qkv + QC_VSW + g * 64, (2 * n - 2) < 0 ? 0 : (2 * n - 2), 2 * n + 1, tq, tqmax_w, tqmin_w, selp, qf, H, ovfw + 2);
    if (ovfw[2]) {
#pragma unroll
        for (int hd = 0; hd < 2; ++hd) hs_init(H[hd], (h == 0) ? __builtin_amdgcn_exp2f(F.in[14][g * 4 + hp + hd] * LOG2E) : 0.f);
        attn_blocks<1, 128, true>(F, qkv + QC_KSW + g * 64, qkv + QC_VSW + g * 64, (2 * n - 2) < 0 ? 0 : (2 * n - 2), 2 * n + 1, tq, tqmax_w, tqmin_w, selp, qf, H, ovfw + 2); }
#pragma unroll
    for (int hd = 0; hd < 2; ++hd) { const float lt = H[hd].l + __shfl_xor(H[hd].l, 32);
        att_store(WSP(bf16, WS_ATT), nullptr, lane, tok, 512 + (g * 4 + hp + hd) * 64, H[hd].o, 1.0f / lt, h); }
}
__device__ __forceinline__ void attention_phase(Frame& F) {
    for (int i = 0;; ++i) { const int u = i * F.G + F.vcu; if (u >= 512) break;
        const int pi = u & 255, bg = pi >> 5, s = pi & 31, n = (u < 256) ? s : 63 - s; nsa_unit(F, bg >> 1, bg & 1, n); }
    for (int i = 0;; ++i) { const int u = i * F.G + F.vcu; if (u >= 512) break; const int bg = u >> 6, n = u & 63; swa_unit(F, bg >> 1, bg & 1, n); }
    __syncthreads();
}
__device__ __forceinline__ void conv_scan_phase(Frame& F) {
    const int lane = F.lane, w = F.wave;
    if (F.vcu < 16 && F.G >= 32) {
        const int bh = F.vcu, b = bh >> 2, hh = bh & 3;
        const float* gt = WSP(float, WS_GATES) + (size_t)b * T * 32;
        LAS float* segG = (LAS float*)(F.lds + RING_OFF); LAS float* segP = segG + 8;
        float Gl[16], al[16], Pl[16]; float c = 0.f, cm = -INFINITY;
#pragma unroll
        for (int it = 0; it < 16; ++it) { const int t = 1024 * w + 64 * it + lane; const float li = gt[(size_t)t * 32 + hh]; float x = gt[(size_t)t * 32 + 4 + hh];
#pragma unroll
            for (int d = 1; d < 64; d <<= 1) { const float y = __shfl_up(x, d); if (lane >= d) x += y; }
            Gl[it] = c + x; c = __shfl(Gl[it], 63);
            al[it] = li - Gl[it]; float pm = al[it];
#pragma unroll
            for (int d = 1; d < 64; d <<= 1) { const float y = __shfl_up(pm, d); if (lane >= d) pm = fmaxf(pm, y); }
            pm = fmaxf(pm, cm); Pl[it] = pm; cm = __shfl(pm, 63); }
        if (lane == 0) { segG[w] = c; segP[w] = cm; }
        __syncthreads();
        double gc = 0.0; float mc = 0.f;
        for (int k = 0; k < w; ++k) { mc = fmaxf(mc, (float)((double)segP[k] - gc)); gc += (double)segG[k]; }
#pragma unroll
        for (int it = 0; it < 16; ++it) { const int t = 1024 * w + 64 * it + lane; const float gcf = (float)gc;
            const float a = al[it] - gcf, mv = fmaxf(mc, Pl[it] - gcf); const double mt = (gc + (double)Gl[it]) + (double)mv;
            WSP(float, WS_SCA)[bh * T + t] = a; WSP(float, WS_SCM)[bh * T + t] = mv; WSP(float, WS_SCE)[bh * T + t] = (float)exp(-mt); }
        __syncthreads();
        return;
    }
    const int first = (F.G >= 32) ? 16 : 0, nblk = F.G - first, bi = F.vcu - first;
    const int c8 = (F.tid & 127) * 8;
    const float* cw = F.in[17]; const float* cb = F.in[18];
    float wv[4][8], bv[8];
#pragma unroll
    for (int e = 0; e < 8; ++e) { bv[e] = cb[c8 + e];
#pragma unroll
        for (int k = 0; k < 4; ++k) wv[k][e] = cw[k * 1024 + c8 + e]; }
    const float ksc = (c8 >= 512) ? 0.08838834764831845f : 1.0f;
    const bf16* src = WSP(bf16, WS_QKP); bf16* dst = WSP(bf16, WS_QKC);
    for (int tok0 = bi * 4 + (F.tid >> 7); tok0 < M; tok0 += nblk * 8) {
        v4u x[2][4]; bool okt[2];
#pragma unroll
        for (int uu = 0; uu < 2; ++uu) { const int tok = tok0 + uu * nblk * 4; okt[uu] = tok < M; const int t = tok & (T - 1);
#pragma unroll
            for (int k = 0; k < 4; ++k) { x[uu][k] = (v4u){0u, 0u, 0u, 0u}; if (okt[uu] && t - 3 + k >= 0) x[uu][k] = *(const v4u*)(src + (size_t)(tok - 3 + k) * 1024 + c8); } }
#pragma unroll
        for (int uu = 0; uu < 2; ++uu) { if (!okt[uu]) continue; const int tok = tok0 + uu * nblk * 4; float acc[8];
#pragma unroll
            for (int e = 0; e < 8; ++e) acc[e] = bv[e];
#pragma unroll
            for (int k = 0; k < 4; ++k) { const v4u xx = x[uu][k];
                acc[0] += bflo(xx.x) * wv[k][0]; acc[1] += bfhi(xx.x) * wv[k][1]; acc[2] += bflo(xx.y) * wv[k][2]; acc[3] += bfhi(xx.y) * wv[k][3];
                acc[4] += bflo(xx.z) * wv[k][4]; acc[5] += bfhi(xx.z) * wv[k][5]; acc[6] += bflo(xx.w) * wv[k][6]; acc[7] += bfhi(xx.w) * wv[k][7]; }
#pragma unroll
            for (int e = 0; e < 8; ++e) acc[e] = acc[e] / (1.0f + __expf(-acc[e])) * ksc;
            v4u o; o.x = pk2(acc[0], acc[1]); o.y = pk2(acc[2], acc[3]); o.z = pk2(acc[4], acc[5]); o.w = pk2(acc[6], acc[7]);
            *(v4u*)(dst + (size_t)tok * 1024 + c8) = o; }
    }
}
constexpr int ML_KS = 272, ML_VS = 528;
constexpr int ML_K = 0, ML_V = 64 * ML_KS;
__device__ __forceinline__ void mlstm_p1_phase(Frame& F) {
    const int lane = F.lane, r32 = lane & 31, h = lane >> 5, w = F.wave, tid = F.tid;
    LAS unsigned char* kt = F.lds + ML_K; LAS unsigned char* vt = F.lds + ML_V;
    const int row = tid >> 3, ch = tid & 7;
    for (int u = F.vcu; u < 512; u += F.G) {
        const int bh = u >> 5, sc = u & 31, b = bh >> 2, hh = bh & 3;
        const float mend = WSP(float, WS_SCM)[bh * T + 256 * sc + 255];
        const float* av = WSP(float, WS_SCA) + bh * T + 256 * sc;
        const bf16* kp0 = WSP(bf16, WS_QKC) + ((size_t)b * T + 256 * sc + row) * 1024 + 512 + hh * 128 + ch * 16;
        const bf16* vp0 = WSP(bf16, WS_V1) + ((size_t)b * T + 256 * sc + row) * 1024 + hh * 256 + ch * 32;
        f32x16 acc[4]; float nacc = 0.f;
#pragma unroll
        for (int i = 0; i < 4; ++i) acc[i] = (f32x16){};
        v4u kx[2], vx[4]; float wgt;
#pragma unroll
        for (int q = 0; q < 2; ++q) kx[q] = *(const v4u*)(kp0 + 8 * q);
#pragma unroll
        for (int q = 0; q < 4; ++q) vx[q] = *(const v4u*)(vp0 + 8 * q);
        wgt = __expf(av[row] - mend);
        for (int c4 = 0; c4 < 4; ++c4) {
            __syncthreads();
#pragma unroll
            for (int q = 0; q < 2; ++q) { const v4u x = kx[q]; v4u y;
                y.x = pk2(bflo(x.x) * wgt, bfhi(x.x) * wgt); y.y = pk2(bflo(x.y) * wgt, bfhi(x.y) * wgt); y.z = pk2(bflo(x.z) * wgt, bfhi(x.z) * wgt); y.w = pk2(bflo(x.w) * wgt, bfhi(x.w) * wgt);
                *(LAS v4u*)(kt + row * ML_KS + (ch * 16 + 8 * q) * 2) = y; }
#pragma unroll
            for (int q = 0; q < 4; ++q) *(LAS v4u*)(vt + row * ML_VS + (ch * 32 + 8 * q) * 2) = vx[q];
            __syncthreads();
            if (c4 < 3) { const size_t adv = (size_t)(64 * (c4 + 1)) * 1024;
#pragma unroll
                for (int q = 0; q < 2; ++q) kx[q] = *(const v4u*)(kp0 + adv + 8 * q);
#pragma unroll
                for (int q = 0; q < 4; ++q) vx[q] = *(const v4u*)(vp0 + adv + 8 * q);
                wgt = __expf(av[64 * (c4 + 1) + row] - mend); }
            if (tid < 128) { float s = 0.f;
#pragma unroll 8
                for (int rr = 0; rr < 64; ++rr) s += bf2f(*(LAS bf16*)(kt + rr * ML_KS + tid * 2));
                nacc += s; }
            LAS unsigned char* klb = kt + ((lane & 15) >> 2) * ML_KS + (16 * ((lane >> 4) & 1) + 4 * (lane & 3)) * 2 + 8 * h * ML_KS;
            LAS unsigned char* vlb = vt + ((lane & 15) >> 2) * ML_VS + (16 * ((lane >> 4) & 1) + 4 * (lane & 3)) * 2 + 8 * h * ML_VS + 64 * w;
#pragma unroll
            for (int s = 0; s < 4; ++s) {
                const bf16x8 av8 = frag_tr(vlb, 16 * s * ML_VS, (16 * s + 4) * ML_VS);
#pragma unroll
                for (int dkt = 0; dkt < 4; ++dkt) acc[dkt] = mfma32(av8, frag_tr(klb, 16 * s * ML_KS + 64 * dkt, (16 * s + 4) * ML_KS + 64 * dkt), acc[dkt]);
            }
        }
        float* lt = WSP(float, WS_LT) + (size_t)u * 32768;
#pragma unroll
        for (int dkt = 0; dkt < 4; ++dkt)
#pragma unroll
            for (int r = 0; r < 16; ++r) lt[(32 * w + crow(r, h)) * 128 + 32 * dkt + r32] = acc[dkt][r];
        if (tid < 128) WSP(float, WS_NLOC)[u * 128 + tid] = nacc;
    }
    __syncthreads();
}
__device__ __forceinline__ void mlstm_scan_phase(Frame& F) {
    const int gt = F.vcu * 512 + F.tid, NT = F.G * 512;
    for (int item = gt; item < 16 * 8192; item += NT) {
        const int bh = item >> 13, e4 = (item & 8191) * 4; f32x4 C = {0.f, 0.f, 0.f, 0.f}; float mprev = 0.f;
        const float* mx = WSP(float, WS_SCM) + bh * T;
#pragma unroll 8
        for (int sc = 0; sc < 32; ++sc) {
            const size_t off = ((size_t)(bh * 32 + sc)) * 32768 + e4;
            v2u pk; pk.x = pk2(C[0], C[1]); pk.y = pk2(C[2], C[3]); *(v2u*)(WSP(bf16, WS_CST) + off) = pk;
            const float mend = mx[256 * sc + 255], dec = __expf(mprev - mend); mprev = mend;
            const f32x4 L = *(const f32x4*)(WSP(float, WS_LT) + off);
            C = C * dec + L;
        }
    }
    for (int item = gt; item < 16 * 128; item += NT) {
        const int bh = item >> 7, dk = item & 127; float nn = 0.f, mprev = 0.f; const float* mx = WSP(float, WS_SCM) + bh * T;
        for (int sc = 0; sc < 32; ++sc) { const int u = bh * 32 + sc; WSP(float, WS_NST)[u * 128 + dk] = nn;
            const float mend = mx[256 * sc + 255], dec = __expf(mprev - mend); mprev = mend; nn = nn * dec + WSP(float, WS_NLOC)[u * 128 + dk]; }
    }
}
constexpr int M3_C = 0, M3_K = 128 * ML_KS, M3_V = M3_K + 32 * ML_KS, M3_KV2 = 64 * ML_KS  , M3_A = M3_K + 2 * M3_KV2, M3_N = M3_A + 1024, M3_Q = M3_N + 512, M3_END = M3_Q + 256 * ML_KS;
static_assert(M3_END <= LDSCTL_OFF, "mlstm p3 LDS");
__device__ __forceinline__ void mlstm_p3_phase(Frame& F) {
    const int w = F.wave, tid = F.tid;
    LAS unsigned char* ct = F.lds + M3_C; LAS unsigned char* kt = F.lds + M3_K; LAS unsigned char* vt = F.lds + M3_V;
    LAS float* als = (LAS float*)(F.lds + M3_A); LAS float* nls = (LAS float*)(F.lds + M3_N);
    for (int u = F.vcu; u < 512; u += F.G) {
        int lane_ = F.lane; asm volatile("" : "+v"(lane_));
        const int r32 = lane_ & 31, h = lane_ >> 5;
        LAS unsigned char* vlb0 = vt + ((lane_ & 15) >> 2) * ML_KS + (16 * ((lane_ >> 4) & 1) + 4 * (lane_ & 3)) * 2 + 4 * h * ML_KS;
        LAS unsigned char* klb0 = kt + r32 * ML_KS + 16 * h; LAS unsigned char* clb = ct + r32 * ML_KS + 16 * h;
        LAS unsigned char* qlb = F.lds + M3_Q + (32 * w + r32) * ML_KS + 16 * h;
        const int bh = u >> 5, sc = u & 31, b = bh >> 2, hh = bh & 3;
        const size_t tok0 = (size_t)b * T + 256 * sc;
        const int tl = 32 * w + r32;
        const size_t tokq = tok0 + tl;
        const float Mt = WSP(float, WS_SCM)[bh * T + 256 * sc + tl];
        const float mprev = sc ? WSP(float, WS_SCM)[bh * T + 256 * sc - 1] : 0.f;
        const float winter = __expf(mprev - Mt);
        float dsum = 0.f, hdiv = 0.f;
#pragma unroll 1
        for (int pass = 0; pass < 2; ++pass) {
            __syncthreads();
            { const bf16* cs = WSP(bf16, WS_CST) + (size_t)u * 32768 + pass * 16384;
#pragma unroll
              for (int q = 0; q < 4; ++q) { const int idx = q * 512 + tid, row = idx >> 4, ch = idx & 15; *(LAS v4u*)(ct + row * ML_KS + ch * 16) = *(const v4u*)(cs + row * 128 + ch * 8); }
              if (pass == 0) {
#pragma unroll
                  for (int q = 0; q < 8; ++q) { const int idx = q * 512 + tid, row = idx >> 4, ch = idx & 15; *(LAS v4u*)(F.lds + M3_Q + row * ML_KS + ch * 16) = *(const v4u*)(WSP(bf16, WS_QKC) + (tok0 + row) * 1024 + hh * 128 + ch * 8); }
                  if (tid < 256) als[tid] = WSP(float, WS_SCA)[bh * T + 256 * sc + tid];
                               if (tid < 128) nls[tid] = WSP(float, WS_NST)[u * 128 + tid]; } }
            __syncthreads();
            f32x16 acc[4];
#pragma unroll
            for (int dvt = 0; dvt < 4; ++dvt) { f32x16 a = {};
#pragma unroll
                for (int s = 0; s < 8; ++s) a = mfma32(*(const LAS bf16x8*)(clb + 32 * dvt * ML_KS + 32 * s), *(const LAS bf16x8*)(qlb + 32 * s), a);
                acc[dvt] = a * winter; __builtin_amdgcn_sched_barrier(0); }
            const int srow = tid >> 4, sch = tid & 15;
            const bf16* kg = WSP(bf16, WS_QKC) + (tok0 + srow) * 1024 + 512 + hh * 128 + sch * 8; const bf16* vg = WSP(bf16, WS_V1) + (tok0 + srow) * 1024 + hh * 256 + pass * 128 + sch * 8;
            v4u kx = *(const v4u*)kg, vx = *(const v4u*)vg;
            for (int ktile = 0; ktile < 8; ++ktile) {
                const int boff = (ktile & 1) * M3_KV2;
                *(LAS v4u*)(kt + boff + srow * ML_KS + sch * 16) = kx; *(LAS v4u*)(vt + boff + srow * ML_KS + sch * 16) = vx;
                __syncthreads();
                if (ktile < 7) { kx = *(const v4u*)(kg + (size_t)(32 * (ktile + 1)) * 1024); vx = *(const v4u*)(vg + (size_t)(32 * (ktile + 1)) * 1024); }
                LAS unsigned char* klb = klb0 + boff; LAS unsigned char* vlb = vlb0 + boff;
                if (ktile <= w) {
                    f32x16 s = {};
#pragma unroll
                    for (int st = 0; st < 8; ++st) s = mfma32(*(const LAS bf16x8*)(klb + 32 * st), *(const LAS bf16x8*)(qlb + 32 * st), s);
                    __builtin_amdgcn_sched_barrier(0);
                    float ds = 0.f;
#pragma unroll
                    for (int r = 0; r < 16; ++r) { const int key = 32 * ktile + crow(r, h); const float wg = __expf(als[key] - Mt); s[r] = (key <= tl) ? s[r] * wg : 0.f; ds += s[r]; }
                    if (pass == 0) dsum += ds;
                    const bf16x8 p0 = pack8<0>(s), p1 = pack8<1>(s);
#pragma unroll
                    for (int dvt = 0; dvt < 4; ++dvt) {
                        acc[dvt] = mfma32(frag_tr(vlb, 64 * dvt, 8 * ML_KS + 64 * dvt), p0, acc[dvt]);
                        acc[dvt] = mfma32(frag_tr(vlb, 16 * ML_KS + 64 * dvt, 24 * ML_KS + 64 * dvt), p1, acc[dvt]);
                        __builtin_amdgcn_sched_barrier(0);
                    }
                }
            }
            if (pass == 0) {
                float qn = 0.f;
#pragma unroll
                for (int s = 0; s < 8; ++s) { const v4u qq = *(const LAS v4u*)(qlb + 32 * s); const LAS float* np = nls + 16 * s + 8 * h;
                    qn += bflo(qq.x) * np[0] + bfhi(qq.x) * np[1] + bflo(qq.y) * np[2] + bfhi(qq.y) * np[3] + bflo(qq.z) * np[4] + bfhi(qq.z) * np[5] + bflo(qq.w) * np[6] + bfhi(qq.w) * np[7]; }
                dsum += __shfl_xor(dsum, 32); qn += __shfl_xor(qn, 32);
                const float den = winter * qn + dsum, emt = WSP(float, WS_SCE)[bh * T + 256 * sc + tl];
                hdiv = 1.0f / fmaxf(fabsf(den), emt);
            }
            const bf16* og = WSP(bf16, WS_OG) + tokq * 1024 + hh * 256 + pass * 128 + 4 * h; bf16* op = WSP(bf16, WS_QKP) + tokq * 1024 + hh * 256 + pass * 128 + 4 * h;
#pragma unroll
            for (int dvt = 0; dvt < 4; ++dvt)
#pragma unroll
                for (int q = 0; q < 4; ++q) { const v2u g2 = *(const v2u*)(og + 32 * dvt + 8 * q);
                    const float o0 = acc[dvt][4 * q] * hdiv / (1.0f + __expf(-bflo(g2.x))), o1 = acc[dvt][4 * q + 1] * hdiv / (1.0f + __expf(-bfhi(g2.x)));
                    const float o2 = acc[dvt][4 * q + 2] * hdiv / (1.0f + __expf(-bflo(g2.y))), o3 = acc[dvt][4 * q + 3] * hdiv / (1.0f + __expf(-bfhi(g2.y)));
                    v2u pk; pk.x = pk2(o0, o1); pk.y = pk2(o2, o3); *(v2u*)(op + 32 * dvt + 8 * q) = pk; __builtin_amdgcn_sched_barrier(0); }
        }
    }
    __syncthreads();
}
__device__ __forceinline__ void final_norm_phase(Frame& F) {
    const int gw = F.vcu * NWAVES + F.wave, NGW = F.G * NWAVES, lane = F.lane;
    const pg8::RowScale R{nullptr, WSP(float, WS_PSUM) + 3 * M};
    f32x4 gv[4];
#pragma unroll
    for (int j = 0; j < 4; ++j) gv[j] = ((const f32x4*)F.in[22])[lane + 64 * j];
    for (int m = gw; m < M; m += 2 * NGW) {
        const int m1 = m + NGW; const float rs0 = pg8::row_scale(R, m), rs1 = pg8::row_scale(R, m1);
        const v2u* h0 = (const v2u*)(WSP(bf16, WS_H16) + (size_t)m * D) + lane; const v2u* h1 = (const v2u*)(WSP(bf16, WS_H16) + (size_t)m1 * D) + lane;
        f32x4* x0 = (f32x4*)(F.out + (size_t)m * D) + lane; f32x4* x1 = (f32x4*)(F.out + (size_t)m1 * D) + lane;
        v2u w0[4], w1[4];
#pragma unroll
        for (int j = 0; j < 4; ++j) { w0[j] = h0[64 * j]; w1[j] = h1[64 * j]; }
#pragma unroll
        for (int j = 0; j < 4; ++j) { const f32x4 a0 = {bflo(w0[j].x), bfhi(w0[j].x), bflo(w0[j].y), bfhi(w0[j].y)}, a1 = {bflo(w1[j].x), bfhi(w1[j].x), bflo(w1[j].y), bfhi(w1[j].y)};
            x0[64 * j] = a0 * rs0 * gv[j]; x1[64 * j] = a1 * rs1 * gv[j]; } }
}
#ifndef SKIPMASK
#define SKIPMASK 0
#endif
#ifndef DUPMASK
#define DUPMASK 0

#endif
#define RUNP(n, call) do { if (!((SKIPMASK >> (n)) & 1)) { call; if ((DUPMASK >> (n)) & 1) { __syncthreads(); call; } } } while (0)
struct Args { const float* in[23]; float* out; unsigned char* ws; int ph_lo, ph_hi; };
__global__ void __launch_bounds__(NWAVES * 64, 2) mk_fwd(Args args) {
    extern __shared__ __attribute__((aligned(16))) unsigned char lds[];
    Frame F;
    F.lds = (LAS unsigned char*)lds;
    F.MISC = (volatile LAS unsigned*)(F.lds + MISC_OFF);
    F.tid = threadIdx.x; F.lane = F.tid & 63; F.wave = __builtin_amdgcn_readfirstlane(F.tid >> 6);
    F.G = gridDim.x; { const int bx = blockIdx.x; F.vcu = (F.G % 8 == 0) ? (bx % 8) * (F.G / 8) + bx / 8 : bx; }
    F.ws = args.ws; F.ctl = (gu32*)(args.ws + WS_CTL); F.out = args.out;
#pragma unroll
    for (int i = 0; i < 23; ++i) F.in[i] = args.in[i];
    for (int u = F.tid; u < (LDS_BYTES - LDSCTL_OFF) / 4; u += NWAVES * 64) ((LAS unsigned*)(F.lds + LDSCTL_OFF))[u] = 0u;
    __syncthreads();
    const int lo = args.ph_lo, hi = args.ph_hi;
    XcdBarrier bar; bar.bar = (unsigned*)(F.ctl + CW_BAR); bar.x = 0; bar.st = nullptr;
    if (hi - lo > 1) bar = xcd_barrier_post((unsigned*)(F.ctl + CW_BAR), F.MISC + 8);

#define IN(k) (lo <= (k) && (k) < hi)
#define SEAM(k) do { if (IN(k) && IN((k) + 1)) xcd_barrier(bar); } while (0)
#define GEMM_PH(EPI, gg, ee) do { pg8::StaticOrder S_; S_.init(M, (gg).N, F.G, (int)blockIdx.x); pg8::gemm_phase<EPI, pg8::StaticOrder, PG8_ALIGN, PG8_SP2>(F.lds + RING_OFF, gg, S_, ee); } while (0)
    if (IN(0)) { RUNP(0, p0_prologue(F)); } SEAM(0);
    if (IN(1)) { const pg8::Gemm g{WSP(bf16, WS_H16), WSP(bf16, WS_WAB), M, 2048, 1024};
        const pg8::EpiScaleBf16 e{WSP(bf16, WS_QKV0), 2048, {WSP(float, WS_RS0), nullptr}, 0, 0};
        RUNP(21, GEMM_PH(pg8::EpiScaleBf16, g, e)); RUNP(19, gates0_phase(F)); } SEAM(1);
    if (IN(2)) { RUNP(2, compress_phase(F)); } SEAM(2);
    if (IN(3)) { RUNP(3, attention_phase(F)); } SEAM(3);
    if (IN(4)) { const pg8::Gemm g{WSP(bf16, WS_ATT), WSP(bf16, WS_WABO), M, 1024, 1024};
        const pg8::EpiResid e{F.in[0], WSP(bf16, WS_H16), WSP(float, WS_PSUM) + 0 * M, D};
        RUNP(22, GEMM_PH(pg8::EpiResid, g, e)); } SEAM(4);
    if (IN(5)) { const pg8::Gemm g{WSP(bf16, WS_H16), WSP(bf16, WS_WUP0), M, 5632, 1024};
        const pg8::EpiSwiglu e{WSP(bf16, WS_HID), FF, {nullptr, WSP(float, WS_PSUM) + 0 * M}};
        RUNP(23, GEMM_PH(pg8::EpiSwiglu, g, e)); } SEAM(5);
    if (IN(6)) { const pg8::Gemm g{WSP(bf16, WS_HID), WSP(bf16, WS_WDN0), M, 1024, FF};
        const pg8::EpiResid e{nullptr, WSP(bf16, WS_H16), WSP(float, WS_PSUM) + 1 * M, D};
        RUNP(17, GEMM_PH(pg8::EpiResid, g, e)); } SEAM(6);
    if (IN(7)) { const pg8::Gemm g{WSP(bf16, WS_H16), WSP(bf16, WS_WCIN), M, 3072, 1024};
        const pg8::EpiScaleBf16 e{WSP(bf16, WS_QKP), 1024, {nullptr, WSP(float, WS_PSUM) + 1 * M}, 1024, (size_t)(64 * MiB / 2)};
        RUNP(24, GEMM_PH(pg8::EpiScaleBf16, g, e)); RUNP(20, gates1_phase(F)); } SEAM(7);
    if (IN(8)) { RUNP(8, conv_scan_phase(F)); } SEAM(8);
    if (IN(9)) { RUNP(9, mlstm_p1_phase(F)); } SEAM(9);
    if (IN(10)) { RUNP(10, mlstm_scan_phase(F)); } SEAM(10);
    if (IN(11)) { RUNP(11, mlstm_p3_phase(F)); } SEAM(11);
    if (IN(12)) { const pg8::Gemm g{WSP(bf16, WS_QKP), WSP(bf16, WS_WCO), M, 1024, 1024};
        const pg8::EpiResid e{nullptr, WSP(bf16, WS_H16), WSP(float, WS_PSUM) + 2 * M, D};
        RUNP(17, GEMM_PH(pg8::EpiResid, g, e)); } SEAM(12);
    if (IN(13)) { const pg8::Gemm g{WSP(bf16, WS_H16), WSP(bf16, WS_WUP1), M, 5632, 1024};
        const pg8::EpiSwiglu e{WSP(bf16, WS_HID), FF, {nullptr, WSP(float, WS_PSUM) + 2 * M}};
        RUNP(18, GEMM_PH(pg8::EpiSwiglu, g, e)); } SEAM(13);
    if (IN(14)) { const pg8::Gemm g{WSP(bf16, WS_HID), WSP(bf16, WS_WDN1), M, 1024, FF};
        const pg8::EpiResid e{nullptr, WSP(bf16, WS_H16), WSP(float, WS_PSUM) + 3 * M, D};
        RUNP(17, GEMM_PH(pg8::EpiResid, g, e)); } SEAM(14);
    if (IN(15)) { RUNP(15, final_norm_phase(F)); }
}

extern "C" void kernel_launch(void* const* d_in, const int* in_sizes, int n_in, void* d_out, int out_size, void* d_ws, size_t ws_size, hipStream_t stream) {
    static int grid = 0;
    if (grid == 0) {
        if (n_in != 23 || in_sizes[0] != M * D || out_size != M * D || ws_size < WS_END) { fprintf(stderr, "kernel_launch: shape/workspace mismatch (n_in %d, in0 %d, out %d, ws %zu, need %zu); nothing launched\n", n_in, n_in > 0 ? in_sizes[0] : -1, out_size, ws_size, (size_t)WS_END); grid = -1; return; }
        int dev = 0, cus = 0, per_cu = 0;
        if (hipGetDevice(&dev) != hipSuccess || hipDeviceGetAttribute(&cus, hipDeviceAttributeMultiprocessorCount, dev) != hipSuccess) { grid = -1; return; }
        if (hipFuncSetAttribute((const void*)mk_fwd, hipFuncAttributeMaxDynamicSharedMemorySize, LDS_BYTES) != hipSuccess) { fprintf(stderr, "kernel_launch: hipFuncSetAttribute failed\n"); grid = -1; return; }
        if (hipOccupancyMaxActiveBlocksPerMultiprocessor(&per_cu, (const void*)mk_fwd, NWAVES * 64, LDS_BYTES) != hipSuccess || per_cu < 1) { fprintf(stderr, "kernel_launch: occupancy query says %d blocks per CU\n", per_cu); per_cu = 1; }
        (void)hipGetLastError();
        grid = cus;
    }
    if (grid < 0) return;
    if (hipMemsetAsync((char*)d_ws + WS_CTL, 0, CTL_ZERO_BYTES, stream) != hipSuccess) { fprintf(stderr, "kernel_launch: memset failed\n"); return; }
    Args a{};
    for (int i = 0; i < 23; ++i) a.in[i] = (const float*)d_in[i];
    a.out = (float*)d_out; a.ws = (unsigned char*)d_ws;
#if MK_PER_PHASE
    for (int p = 0; p < NPHASE; ++p) { a.ph_lo = p; a.ph_hi = p + 1; hipLaunchKernelGGL(mk_fwd, dim3(grid), dim3(NWAVES * 64), LDS_BYTES, stream, a); }
#else
    a.ph_lo = 0; a.ph_hi = NPHASE;
    hipLaunchKernelGGL(mk_fwd, dim3(grid), dim3(NWAVES * 64), LDS_BYTES, stream, a);
#endif
    const hipError_t le = hipPeekAtLastError();
    if (le != hipSuccess) fprintf(stderr, "kernel_launch: launch failed: %s\n", hipGetErrorName(le));
}
```

```cpp
#include <hip/hip_runtime.h>
#include <cstdio>
#include <cstdint>
#include <cmath>
#define DUPMASK 0

namespace pg8 {
#define PG8_LAS __attribute__((address_space(3)))
typedef unsigned short bf16_t;
typedef short bf16x8 __attribute__((ext_vector_type(8)));
typedef float f32x4 __attribute__((ext_vector_type(4)));
typedef unsigned u32x4 __attribute__((ext_vector_type(4)));
constexpr int BM = 256, BK = 64, HALF = 128, HTB = HALF * BK * 2  , STAGE_BYTES = 8 * HTB, NXCD = 8, WGM = 8;

__host__ __device__ __forceinline__ int lds_byte(int r, int c) { const int st = (r >> 4) * 2 + (c >> 5), rr = r & 15, cc = c & 31, ob = rr * 64 + cc * 2; return st * 1024 + (ob ^ (((ob >> 9) & 1) << 5)); }
__host__ __device__ __forceinline__ void stage_rc(int b, int& R, int& C) { const int st = b / 1024, sb = b % 1024, swz = sb ^ (((sb >> 9) & 1) << 5); R = (st >> 1) * 16 + swz / 64; C = (st & 1) * 32 + (swz % 64) / 2; }
__host__ __device__ __forceinline__ int perm32(int rho) { const int n = rho >> 4, i = rho & 15; return 8 * (i >> 2) + 4 * n + (i & 3); }

struct Unit { int pm, pn; };
struct Gemm { const bf16_t* A; const bf16_t* Bt; int M, N, K; };

struct StaticOrder {
    int nM, nN, nwg, G, c;
    __host__ __device__ __forceinline__ void init(int M, int N, int G_, int c_) { nM = M / BM; nN = N / BM; nwg = nM * nN; G = G_; c = c_; }
    __host__ __device__ __forceinline__ bool next(int i, Unit& u) const {
        const long L = (long)i * G + c; if (L >= nwg) return false;
        int wgid = (int)L; { const int q = nwg / NXCD, r = nwg % NXCD, xcd = wgid % NXCD, off = wgid / NXCD; wgid = (xcd < r ? xcd * (q + 1) : r * (q + 1) + (xcd - r) * q) + off; }
        const int nig = WGM * nN, gid = wgid / nig, fm = gid * WGM, gsz = (nM - fm) < WGM ? (nM - fm) : WGM;
        u.pm = fm + ((wgid % nig) % gsz); u.pn = (wgid % nig) / gsz; return true;
    }
    __device__ __forceinline__ void a_ready(const Unit&) const {}
    __device__ __forceinline__ void done(const Unit&) const {}
};

__device__ __forceinline__ unsigned cvt_pk_bf16(float lo, float hi) { unsigned r; asm volatile("v_cvt_pk_bf16_f32 %0, %1, %2" : "=v"(r) : "v"(lo), "v"(hi)); return r; }
typedef float f32x2 __attribute__((ext_vector_type(2)));
constexpr int MROWS = 32768;
constexpr float RMS_EPS_F = 1e-6f;
struct RowScale { const float* rs; const float* ss; };
__device__ __forceinline__ float row_scale(const RowScale& R, int row) {
    if (R.ss) return 1.0f / sqrtf(R.ss[row] * (1.0f / 1024.0f) + RMS_EPS_F);
    return R.rs[row];
}
struct EpiScaleBf16 {
    static constexpr bool PERM = true, AFTER_DRAIN = false;
    bf16_t* O; int ldc; const PG8_LAS float* rsl; int split_cols; size_t split_stride;
    __device__ __forceinline__ void operator()(const f32x4 (&acc)[2][2][4][2], const Unit& u, int ui, int wr, int wc, int fr, int fq) const {
        const int row0 = u.pm * BM + wr * 64 + fr; int colt = u.pn * BM; bf16_t* base = O; const PG8_LAS float* rsu = rsl + ui * BM + wr * 64 + fr;
        if (split_cols) { const int t = colt / split_cols; base += (size_t)t * split_stride; colt -= t * split_cols; }
        const int col0 = colt + wc * 32 + 8 * fq;
#pragma unroll
        for (int ai = 0; ai < 2; ++ai)
#pragma unroll
            for (int m = 0; m < 4; ++m) { const int row = row0 + ai * HALF + m * 16; const float sc = rsu[ai * HALF + m * 16]; bf16_t* rowp = base + (size_t)row * ldc + col0;
#pragma unroll
                for (int bj = 0; bj < 2; ++bj) { f32x4 v0 = acc[ai][bj][m][0] * sc, v1 = acc[ai][bj][m][1] * sc;
                    u32x4 w; w.x = cvt_pk_bf16(v0[0], v0[1]); w.y = cvt_pk_bf16(v0[2], v0[3]); w.z = cvt_pk_bf16(v1[0], v1[1]); w.w = cvt_pk_bf16(v1[2], v1[3]);
                    *(u32x4*)(rowp + bj * HALF) = w; } }
    }
};
struct EpiSwiglu {
    static constexpr bool PERM = true, AFTER_DRAIN = false;
    bf16_t* O; int ldc; const PG8_LAS float* rsl;
    __device__ __forceinline__ void operator()(const f32x4 (&acc)[2][2][4][2], const Unit& u, int ui, int wr, int wc, int fr, int fq) const {
        const int row0 = u.pm * BM + wr * 64 + fr; const int col0 = u.pn * HALF + wc * 32 + 8 * fq; const PG8_LAS float* rsu = rsl + ui * BM + wr * 64 + fr;
#pragma unroll
        for (int ai = 0; ai < 2; ++ai)
#pragma unroll
            for (int m = 0; m < 4; ++m) { const int row = row0 + ai * HALF + m * 16; const float sc = rsu[ai * HALF + m * 16]; bf16_t* rowp = O + (size_t)row * ldc + col0;
                float o[8];
#pragma unroll
                for (int n = 0; n < 2; ++n)
#pragma unroll
                    for (int e = 0; e < 4; ++e) { const float g = acc[ai][0][m][n][e] * sc, up = acc[ai][1][m][n][e] * sc; o[n * 4 + e] = g * up * __builtin_amdgcn_rcpf(1.0f + __expf(-g)); }
                u32x4 w; w.x = cvt_pk_bf16(o[0], o[1]); w.y = cvt_pk_bf16(o[2], o[3]); w.z = cvt_pk_bf16(o[4], o[5]); w.w = cvt_pk_bf16(o[6], o[7]);
                *(u32x4*)rowp = w; }
    }
};
struct EpiResid {
    static constexpr bool PERM = true, AFTER_DRAIN = false;
    const float* basef; bf16_t* h16; float* ss; int ldc;
    __device__ __forceinline__ void operator()(const f32x4 (&acc)[2][2][4][2], const Unit& u, int ui, int wr, int wc, int fr, int fq) const {
        const int row0 = u.pm * BM + wr * 64 + fr, col0 = u.pn * BM + wc * 32 + 8 * fq;
        if (basef) {
#pragma unroll
            for (int ai = 0; ai < 2; ++ai) {
                f32x4 pre[4][2][2];
#pragma unroll
                for (int m = 0; m < 4; ++m) { const size_t off = (size_t)(row0 + ai * HALF + m * 16) * ldc + col0;
#pragma unroll
                    for (int bj = 0; bj < 2; ++bj)
#pragma unroll
                        for (int n = 0; n < 2; ++n) pre[m][bj][n] = *(const f32x4*)(basef + off + bj * HALF + n * 4); }
#pragma unroll
                for (int m = 0; m < 4; ++m) { const int row = row0 + ai * HALF + m * 16; const size_t off = (size_t)row * ldc + col0; float sq = 0.f;
#pragma unroll
                    for (int bj = 0; bj < 2; ++bj) { const f32x4 o0 = pre[m][bj][0] + acc[ai][bj][m][0], o1 = pre[m][bj][1] + acc[ai][bj][m][1];
                        sq += ((o0[0] * o0[0] + o0[1] * o0[1]) + (o0[2] * o0[2] + o0[3] * o0[3])) + ((o1[0] * o1[0] + o1[1] * o1[1]) + (o1[2] * o1[2] + o1[3] * o1[3]));
                        u32x4 w; w.x = cvt_pk_bf16(o0[0], o0[1]); w.y = cvt_pk_bf16(o0[2], o0[3]); w.z = cvt_pk_bf16(o1[0], o1[1]); w.w = cvt_pk_bf16(o1[2], o1[3]);
                        *(u32x4*)(h16 + off + bj * HALF) = w; }
                    sq += __shfl_xor(sq, 16); sq += __shfl_xor(sq, 32);
                    if (fq == 0) atomicAdd(ss + row, sq); }
            }
        } else {
            u32x4 pre[2][4][2];
#pragma unroll
            for (int ai = 0; ai < 2; ++ai)
#pragma unroll
                for (int m = 0; m < 4; ++m) { const size_t off = (size_t)(row0 + ai * HALF + m * 16) * ldc + col0;
#pragma unroll
                    for (int bj = 0; bj < 2; ++bj) pre[ai][m][bj] = *(const u32x4*)(h16 + off + bj * HALF); }
#pragma unroll
            for (int ai = 0; ai < 2; ++ai)
#pragma unroll
                for (int m = 0; m < 4; ++m) { const int row = row0 + ai * HALF + m * 16; const size_t off = (size_t)row * ldc + col0; float sq = 0.f;
#pragma unroll
                    for (int bj = 0; bj < 2; ++bj) { const u32x4 pw = pre[ai][m][bj];
                        const f32x4 o0 = (f32x4){__builtin_bit_cast(float, pw.x << 16), __builtin_bit_cast(float, pw.x & 0xffff0000u), __builtin_bit_cast(float, pw.y << 16), __builtin_bit_cast(float, pw.y & 0xffff0000u)} + acc[ai][bj][m][0];
                        const f32x4 o1 = (f32x4){__builtin_bit_cast(float, pw.z << 16), __builtin_bit_cast(float, pw.z & 0xffff0000u), __builtin_bit_cast(float, pw.w << 16), __builtin_bit_cast(float, pw.w & 0xffff0000u)} + acc[ai][bj][m][1];
                        sq += ((o0[0] * o0[0] + o0[1] * o0[1]) + (o0[2] * o0[2] + o0[3] * o0[3])) + ((o1[0] * o1[0] + o1[1] * o1[1]) + (o1[2] * o1[2] + o1[3] * o1[3]));
                        u32x4 w; w.x = cvt_pk_bf16(o0[0], o0[1]); w.y = cvt_pk_bf16(o0[2], o0[3]); w.z = cvt_pk_bf16(o1[0], o1[1]); w.w = cvt_pk_bf16(o1[2], o1[3]);
                        *(u32x4*)(h16 + off + bj * HALF) = w; }
                    sq += __shfl_xor(sq, 16); sq += __shfl_xor(sq, 32);
                    if (fq == 0) atomicAdd(ss + row, sq); }
        }
    }
};
template <class Epi, class Sched, bool ALIGN_EPI = false, bool SP2 = false>
__device__ __forceinline__ void gemm_phase(PG8_LAS unsigned char* lds, const Gemm g, const Sched& S, const Epi& E) {
    const int tid = threadIdx.x, wid = __builtin_amdgcn_readfirstlane(tid >> 6), lane = tid & 63, wr = wid >> 2, wc = wid & 3, fr = lane & 15, fq = lane >> 4;
    const int K = g.K, nt = K / BK;
    unsigned voffA[2], voffB[2];
#pragma unroll
    for (int i = 0; i < 2; ++i) { int R, C; stage_rc(tid * 16 + i * 8192, R, C); const int Rb = Epi::PERM ? ((R & ~31) + perm32(R & 31)) : R;
        voffA[i] = (unsigned)(R * K + C) * 2u; voffB[i] = (unsigned)(Rb * K + C) * 2u; }
    const size_t kstep = (size_t)(BK * 2);
    const size_t hstep = (size_t)HALF * K * 2;
    const size_t tstep = 2 * hstep;
    const unsigned ldsw = (unsigned)wid * 1024u;
    const int aoff = lds_byte(wr * 64 + fr, fq * 8), boff = lds_byte(wc * 32 + fr, fq * 8);
#define PG8_SA(b, h) (((b) * 2 + (h)) * HTB)
#define PG8_SB(b, h) ((4 + (b) * 2 + (h)) * HTB)
#define PG8_STAGE(bufoff, gbase, voff) do { _Pragma("unroll") for (int _i = 0; _i < 2; ++_i) \
        __builtin_amdgcn_global_load_lds((const unsigned*)((const char*)(gbase) + (voff)[_i]), (PG8_LAS unsigned*)(lds + (bufoff) + ldsw + _i * 8192), 16, 0, 0); } while (0)
#define PG8_LDA(dst, b, h) do { _Pragma("unroll") for (int m = 0; m < 4; ++m) _Pragma("unroll") for (int k = 0; k < 2; ++k) dst[m][k] = *(const PG8_LAS bf16x8*)(lds + PG8_SA(b, h) + aoff + m * 2048 + k * 1024); } while (0)
#define PG8_LDB(dst, b, h) do { _Pragma("unroll") for (int n = 0; n < 2; ++n) _Pragma("unroll") for (int k = 0; k < 2; ++k) dst[n][k] = *(const PG8_LAS bf16x8*)(lds + PG8_SB(b, h) + boff + n * 2048 + k * 1024); } while (0)
#define PG8_MMA(ai, bj, At, Bt) do { __builtin_amdgcn_s_setprio(1); _Pragma("unroll") for (int m = 0; m < 4; ++m) _Pragma("unroll") for (int n = 0; n < 2; ++n) _Pragma("unroll") for (int k = 0; k < 2; ++k) \
        acc[ai][bj][m][n] = __builtin_amdgcn_mfma_f32_16x16x32_bf16(Bt[n][k], At[m][k], acc[ai][bj][m][n], 0, 0, 0); __builtin_amdgcn_s_setprio(0); } while (0)
#define PG8_WAIT_V(n) asm volatile("s_waitcnt vmcnt(" #n ")" ::: "memory")
#define PG8_WAIT_L(n) asm volatile("s_waitcnt lgkmcnt(" #n ")" ::: "memory")
#define PG8_BAR __builtin_amdgcn_s_barrier()
#define PG8_SCHED __builtin_amdgcn_sched_barrier(0)
    Unit cur, nxt; int ui = 0;
    if (!S.next(0, cur)) return;
    f32x4 acc[2][2][4][2];
#pragma unroll
    for (int a = 0; a < 2; ++a)
#pragma unroll
        for (int b = 0; b < 2; ++b)
#pragma unroll
            for (int m = 0; m < 4; ++m)
#pragma unroll
                for (int n = 0; n < 2; ++n) acc[a][b][m][n] = (f32x4){0.f, 0.f, 0.f, 0.f};
    bf16x8 At[4][2], B0[2][2], B1[2][2];
    const char* cA = (const char*)g.A + (size_t)cur.pm * tstep; const char* cB = (const char*)g.Bt + (size_t)cur.pn * tstep;
    S.a_ready(cur);
    if constexpr (SP2) {
        PG8_STAGE(PG8_SB(0, 0), cB, voffB); PG8_STAGE(PG8_SB(0, 1), cB + hstep, voffB); PG8_STAGE(PG8_SA(0, 0), cA, voffA); PG8_STAGE(PG8_SA(0, 1), cA + hstep, voffA);
        if (wr == 1) PG8_BAR;
        PG8_WAIT_V(2); PG8_BAR;
        PG8_STAGE(PG8_SB(1, 0), cB + kstep, voffB); PG8_STAGE(PG8_SA(1, 0), cA + kstep, voffA); PG8_STAGE(PG8_SB(1, 1), cB + hstep + kstep, voffB);
        PG8_WAIT_V(6); PG8_BAR;
    } else {
        PG8_STAGE(PG8_SB(0, 0), cB, voffB); PG8_STAGE(PG8_SA(0, 0), cA, voffA); PG8_STAGE(PG8_SB(0, 1), cB + hstep, voffB); PG8_STAGE(PG8_SA(0, 1), cA + hstep, voffA);
        if (wr == 1) PG8_BAR;
        PG8_WAIT_V(4); PG8_BAR;
        PG8_STAGE(PG8_SB(1, 0), cB + kstep, voffB); PG8_STAGE(PG8_SA(1, 0), cA + kstep, voffA); PG8_STAGE(PG8_SB(1, 1), cB + hstep + kstep, voffB);
        PG8_WAIT_V(6); PG8_BAR;
    }
    for (;;) {
        const bool has_next = S.next(ui + 1, nxt);
        const char* nA = has_next ? (const char*)g.A + (size_t)nxt.pm * tstep : cA; const char* nB = has_next ? (const char*)g.Bt + (size_t)nxt.pn * tstep : cB;
        for (int t = 0; t < nt; t += 2) {
            const bool last = (t == nt - 2);
            const char* a1 = cA + (size_t)(t + 1) * kstep;
            const char* a2 = last ? nA : cA + (size_t)(t + 2) * kstep; const char* b2 = last ? nB : cB + (size_t)(t + 2) * kstep;
            const char* a3 = a2 + kstep; const char* b3 = b2 + kstep;
            if (last && has_next) S.a_ready(nxt);
            if constexpr (SP2) {
            PG8_LDB(B0, 0, 0); PG8_LDB(B1, 0, 1); PG8_SCHED; PG8_LDA(At, 0, 0); PG8_STAGE(PG8_SA(1, 1), a1 + hstep, voffA);
            PG8_WAIT_V(8); PG8_WAIT_L(0); PG8_BAR; PG8_MMA(0, 0, At, B0); PG8_MMA(0, 1, At, B1); PG8_BAR; PG8_SCHED;
            PG8_LDA(At, 0, 1); PG8_STAGE(PG8_SB(0, 0), b2, voffB); PG8_STAGE(PG8_SB(0, 1), b2 + hstep, voffB); PG8_STAGE(PG8_SA(0, 0), a2, voffA);
            PG8_WAIT_V(8); PG8_WAIT_L(0); PG8_BAR; PG8_MMA(1, 0, At, B0); PG8_MMA(1, 1, At, B1); PG8_BAR; PG8_SCHED;
            PG8_LDB(B0, 1, 0); PG8_LDB(B1, 1, 1); PG8_SCHED; PG8_LDA(At, 1, 0); PG8_STAGE(PG8_SA(0, 1), a2 + hstep, voffA);
            PG8_WAIT_V(8); PG8_WAIT_L(0); PG8_BAR; PG8_MMA(0, 0, At, B0); PG8_MMA(0, 1, At, B1); PG8_BAR; PG8_SCHED;
            PG8_LDA(At, 1, 1); PG8_STAGE(PG8_SB(1, 0), b3, voffB); PG8_STAGE(PG8_SB(1, 1), b3 + hstep, voffB); PG8_STAGE(PG8_SA(1, 0), a3, voffA);
            PG8_WAIT_V(8); PG8_WAIT_L(0); PG8_BAR; PG8_MMA(1, 0, At, B0); PG8_MMA(1, 1, At, B1); PG8_BAR; PG8_SCHED;
            } else {
            PG8_LDB(B0, 0, 0); PG8_SCHED; PG8_LDA(At, 0, 0); PG8_STAGE(PG8_SA(1, 1), a1 + hstep, voffA);
            PG8_WAIT_L(8); PG8_BAR; PG8_WAIT_L(0); PG8_MMA(0, 0, At, B0); PG8_BAR; PG8_SCHED;
            PG8_LDB(B1, 0, 1); PG8_STAGE(PG8_SB(0, 0), b2, voffB);
            PG8_BAR; PG8_WAIT_L(0); PG8_MMA(0, 1, At, B1); PG8_BAR;
            PG8_LDA(At, 0, 1); PG8_STAGE(PG8_SA(0, 0), a2, voffA);
            PG8_BAR; PG8_WAIT_L(0); PG8_MMA(1, 0, At, B0); PG8_BAR; PG8_SCHED;
            PG8_STAGE(PG8_SB(0, 1), b2 + hstep, voffB);
            PG8_WAIT_V(6); PG8_BAR; PG8_MMA(1, 1, At, B1); PG8_BAR;
            PG8_LDB(B0, 1, 0); PG8_SCHED; PG8_LDA(At, 1, 0); PG8_STAGE(PG8_SA(0, 1), a2 + hstep, voffA);
            PG8_WAIT_L(8); PG8_BAR; PG8_WAIT_L(0); PG8_MMA(0, 0, At, B0); PG8_BAR; PG8_SCHED;
            PG8_LDB(B1, 1, 1); PG8_STAGE(PG8_SB(1, 0), b3, voffB);
            PG8_BAR; PG8_WAIT_L(0); PG8_MMA(0, 1, At, B1); PG8_BAR;
            PG8_LDA(At, 1, 1); PG8_STAGE(PG8_SA(1, 0), a3, voffA);
            PG8_BAR; PG8_WAIT_L(0); PG8_MMA(1, 0, At, B0); PG8_BAR; PG8_SCHED;
            PG8_STAGE(PG8_SB(1, 1), b3 + hstep, voffB);
            PG8_WAIT_V(6); PG8_BAR; PG8_MMA(1, 1, At, B1); PG8_BAR;
            }
        }
        if constexpr (ALIGN_EPI) { if (wr == 0) PG8_BAR; }
        if constexpr (!Epi::AFTER_DRAIN) { E(acc, cur, ui, wr, wc, fr, fq); S.done(cur); }
        if (!has_next) break;
#pragma unroll
        for (int a = 0; a < 2; ++a)
#pragma unroll
            for (int b = 0; b < 2; ++b)
#pragma unroll
                for (int m = 0; m < 4; ++m)
#pragma unroll
                    for (int n = 0; n < 2; ++n) acc[a][b][m][n] = (f32x4){0.f, 0.f, 0.f, 0.f};
        cur = nxt; cA = nA; cB = nB; ++ui;
        if constexpr (ALIGN_EPI) { if (wr == 1) PG8_BAR; }
    }
    PG8_WAIT_V(0);
    if constexpr (!ALIGN_EPI) { if (wr == 0) PG8_BAR; }
    PG8_BAR;
    if constexpr (Epi::AFTER_DRAIN) { E.fused(acc, cur, wr, wc, fr, fq, lds, wid, lane); S.done(cur); }
#undef PG8_SA
#undef PG8_SB
#undef PG8_STAGE
#undef PG8_LDA
#undef PG8_LDB
#undef PG8_MMA
#undef PG8_WAIT_V
#undef PG8_WAIT_L
#undef PG8_BAR
#undef PG8_SCHED
}
}
#ifndef PG8_SP2
#define PG8_SP2 true
#endif
#ifndef PG8_ALIGN
#define PG8_ALIGN true
#endif
constexpr int NWAVES = 8;
#ifndef MK_PER_PHASE
#define MK_PER_PHASE 0
#endif
constexpr int NPHASE = 16;

constexpr int BATCH = 4, T = 8192, D = 1024, M = BATCH * T, FF = 2816;
constexpr int AB_LD = 2072, C_LD = 3080;
constexpr float C2 = 0.125f * 1.4426950408889634f;
constexpr float LOG2E = 1.4426950408889634f;
constexpr int QC_QN = 0, QC_KC = 512, QC_VC = 640, QC_KS = 768, QC_VS = 896, QC_KW = 1024, QC_VW = 1152, QC_QS = 1280, QC_KSW = 1792, QC_VSW = 1920;

constexpr size_t MiB = 1u << 20, KiB = 1024;
constexpr size_t WS_CTL = 0, CTL_ZERO_BYTES = 1 * MiB;
constexpr size_t WS_RS0 = 1 * MiB;
constexpr size_t WS_PSUM = WS_RS0 + 128 * KiB;
constexpr size_t WS_GATES = WS_PSUM + 2 * MiB;
constexpr size_t WS_SCA = WS_GATES + 4 * MiB;
constexpr size_t WS_SCM = WS_SCA + 512 * KiB;
constexpr size_t WS_SCE = WS_SCM + 512 * KiB;
constexpr size_t WS_KC = WS_SCE + 512 * KiB;
constexpr size_t WS_VC = WS_KC + 512 * KiB;
constexpr size_t WS_WABG = WS_VC + 512 * KiB;
constexpr size_t WS_WCG = WS_WABG + 64 * KiB;
constexpr size_t WS_CW1K = WS_WCG + 64 * KiB;
constexpr size_t WS_CW1V = WS_CW1K + 256 * KiB;
constexpr size_t WS_CW2K = WS_CW1V + 256 * KiB;
constexpr size_t WS_CW2V = WS_CW2K + 8 * KiB;
constexpr size_t WS_CBIAS = WS_CW2V + 8 * KiB;
constexpr size_t WS_NLOC = WS_CBIAS + 4 * KiB;
constexpr size_t WS_NST = WS_NLOC + 256 * KiB;
static_assert(WS_NST + 256 * KiB <= 13 * MiB, "small region");
constexpr size_t WS_WAB = 13 * MiB;
constexpr size_t WS_WABO = WS_WAB + 4 * MiB;
constexpr size_t WS_WUP0 = WS_WABO + 2 * MiB;
constexpr size_t WS_WUP1 = WS_WUP0 + 11 * MiB;
constexpr size_t WS_WDN0 = WS_WUP1 + 11 * MiB;
constexpr size_t WS_WDN1 = WS_WDN0 + 5632 * KiB;
constexpr size_t WS_WCIN = WS_WDN1 + 5632 * KiB;
constexpr size_t WS_WCO = WS_WCIN + 6 * MiB;
static_assert(WS_WCO + 2 * MiB <= 60 * MiB, "weights region");
constexpr size_t WS_H16 = 60 * MiB;
constexpr size_t WS_A = 124 * MiB;
constexpr size_t WS_QKV0 = WS_A, WS_ATT = WS_A + 128 * MiB;
constexpr size_t WS_QKP = WS_A, WS_V1 = WS_A + 64 * MiB, WS_OG = WS_A + 128 * MiB;
constexpr size_t WS_B = 316 * MiB;
constexpr size_t WS_HID = WS_B;
constexpr size_t WS_ACCF = WS_B;
constexpr size_t WS_CBPART = WS_B;
constexpr size_t WS_QKC = WS_B, WS_LT = WS_B + 64 * MiB, WS_CST = WS_B + 128 * MiB;
constexpr size_t WS_END = 492 * MiB;
static_assert(WS_HID + (size_t)M * FF * 2 <= WS_END && WS_CST + 32 * MiB <= WS_END, "d_ws map");
constexpr int CW_TMO = 0, CW_CODE = 1, CW_CBIAS = 1024, CW_QUEUE = 2048;
constexpr int CW_BAR = 4096;

constexpr int RING_OFF = 0, RING_BYTES = 131072;
constexpr int LDS_BYTES = 147456;
constexpr int LDSCTL_OFF = LDS_BYTES - 1024, MISC_OFF = LDSCTL_OFF + 320;
static_assert(MISC_OFF + 128 <= LDS_BYTES, "LDS map");

#define GAS __attribute__((address_space(1)))
#define LAS __attribute__((address_space(3)))
typedef unsigned short bf16;
typedef unsigned v4u __attribute__((ext_vector_type(4)));
typedef unsigned v2u __attribute__((ext_vector_type(2)));
typedef float f32x4 __attribute__((ext_vector_type(4)));
typedef float f32x16 __attribute__((ext_vector_type(16)));
typedef short bf16x8 __attribute__((ext_vector_type(8)));
typedef short s16x4 __attribute__((ext_vector_type(4)));
typedef GAS unsigned gu32;
typedef GAS unsigned long long gu64;
#define RLX_AGENT __ATOMIC_RELAXED, __HIP_MEMORY_SCOPE_AGENT
#define LDS_WAIT() asm volatile("s_waitcnt lgkmcnt(0)" ::: "memory")
#define VM_WAIT() asm volatile("s_waitcnt vmcnt(0)" ::: "memory")
__device__ __forceinline__ unsigned f2bf(float f) { unsigned u = __builtin_bit_cast(unsigned, f); return (u + 0x7fffu + ((u >> 16) & 1u)) >> 16; }
__device__ __forceinline__ unsigned pk2(float lo, float hi) { return f2bf(lo) | (f2bf(hi) << 16); }
__device__ __forceinline__ float bf2f(unsigned short b) { return __builtin_bit_cast(float, (unsigned)b << 16); }
__device__ __forceinline__ float bflo(unsigned w) { return __builtin_bit_cast(float, w << 16); }
__device__ __forceinline__ float bfhi(unsigned w) { return __builtin_bit_cast(float, w & 0xffff0000u); }
__device__ __forceinline__ int crow(int r, int hi) { return (r & 3) + 8 * (r >> 2) + 4 * hi; }
__device__ __forceinline__ f32x16 mfma32(bf16x8 a, bf16x8 b, f32x16 c) { return __builtin_amdgcn_mfma_f32_32x32x16_bf16(a, b, c, 0, 0, 0); }
typedef short v4i16_t __attribute__((ext_vector_type(4)));
__device__ __forceinline__ s16x4 ds_tr(LAS unsigned char* p) { return __builtin_bit_cast(s16x4, __builtin_amdgcn_ds_read_tr16_b64_v4i16((LAS v4i16_t*)p)); }
__device__ __forceinline__ bf16x8 frag_tr(LAS unsigned char* lb, int off0, int off1) {
    const s16x4 lo = ds_tr(lb + off0), hi = ds_tr(lb + off1);
    return (bf16x8){lo[0], lo[1], lo[2], lo[3], hi[0], hi[1], hi[2], hi[3]};
}
typedef float f32x2_t __attribute__((ext_vector_type(2))); typedef __bf16 bf16x2_t __attribute__((ext_vector_type(2)));
__device__ __forceinline__ unsigned cvtpk(float lo, float hi) { f32x2_t v = {lo, hi}; bf16x2_t b = __builtin_convertvector(v, bf16x2_t); return __builtin_bit_cast(unsigned, b); }
template <int s> __device__ __forceinline__ bf16x8 pack8(const f32x16& p) {
    v4u w; w.x = cvtpk(p[8 * s + 0], p[8 * s + 1]); w.y = cvtpk(p[8 * s + 2], p[8 * s + 3]); w.z = cvtpk(p[8 * s + 4], p[8 * s + 5]); w.w = cvtpk(p[8 * s + 6], p[8 * s + 7]);
    return __builtin_bit_cast(bf16x8, w);
}
__device__ __forceinline__ float wave_sum(float v) {
#pragma unroll
    for (int o = 1; o < 64; o <<= 1) v += __shfl_xor(v, o);
    return v;
}
#define XB_TMO      128
#define XB_XCNT(j)  (256  + 64 * (j))
#define XB_XSUB(j)  (1280 + 64 * (j))
#define XB_XGEN(j)  (2304 + 64 * (j))
#define XB_TOP      3328
#define XB_TOPGEN   3392
#define XCD_BAR_WORDS 3456
#define XB_SPIN_CAP (1u << 18)

__device__ __forceinline__ unsigned xb_ld(unsigned* p)              { return __hip_atomic_load(p, __ATOMIC_RELAXED, __HIP_MEMORY_SCOPE_AGENT); }
__device__ __forceinline__ unsigned xb_add(unsigned* p, unsigned v) { return __hip_atomic_fetch_add(p, v, __ATOMIC_RELAXED, __HIP_MEMORY_SCOPE_AGENT); }
__device__ __forceinline__ unsigned xb_xcc_id() { return (unsigned)__builtin_amdgcn_s_getreg((3 << 11) | 20) & 0xFu; }
#define XB_SPIN(cond, bar) do { unsigned _sp = 0; while (cond) { __builtin_amdgcn_s_sleep(1); \
    if ((++_sp & 255u) == 0u) { if (xb_ld(&(bar)[XB_TMO])) break; if (_sp > XB_SPIN_CAP) { atomicAdd(&(bar)[XB_TMO], 1u); break; } } } } while (0)

struct XcdBarrier {
    unsigned* bar; unsigned x;
    volatile LAS unsigned* st;
};

__device__ __forceinline__ XcdBarrier xcd_barrier_post(unsigned* bar, volatile LAS unsigned* st) {
    XcdBarrier b; b.bar = bar; b.x = xb_xcc_id(); b.st = st;
    if (threadIdx.x == 0) (void)xb_add(&bar[XB_XCNT(b.x)], 1u);
    return b;
}
__device__ __forceinline__ void xcd_barrier_complete(unsigned* bar, unsigned x, unsigned& nloc, unsigned& nx) {
    const unsigned G = gridDim.x * gridDim.y * gridDim.z;
    unsigned sum, cnt, mine, sp = 0u;
    for (;;) {
        sum = 0u; cnt = 0u; mine = 0u;
#pragma unroll
        for (unsigned j = 0; j < 16; ++j) { const unsigned c = xb_ld(&bar[XB_XCNT(j)]); sum += c; cnt += (c > 0u) ? 1u : 0u; mine = (j == x) ? c : mine; }
        if (sum == G) break;
        __builtin_amdgcn_s_sleep(1);
        if ((++sp & 255u) == 0u) { if (xb_ld(&bar[XB_TMO])) break; if (sp > XB_SPIN_CAP) { atomicAdd(&bar[XB_TMO], 1u); break; } }
    }
    nloc = mine > 0u ? mine : 1u; nx = cnt > 0u ? cnt : 1u;
}

__device__ __forceinline__ void xcd_barrier(const XcdBarrier& b) {
    asm volatile("s_waitcnt vmcnt(0)" ::: "memory");
    __syncthreads();
    if (threadIdx.x == 0) {
        unsigned* bar = b.bar;
        __builtin_amdgcn_s_waitcnt(0);
        unsigned nloc = b.st[0], nx = b.st[1];
        if (nloc == 0u) { xcd_barrier_complete(bar, b.x, nloc, nx); b.st[0] = nloc; b.st[1] = nx; }
        const unsigned old = xb_add(&bar[XB_XSUB(b.x)], 1u);
        const unsigned gen = old / nloc;
        if (old + 1u == (gen + 1u) * nloc) {
            __builtin_amdgcn_fence(__ATOMIC_RELEASE, "agent");
            asm volatile("s_waitcnt vmcnt(0)" ::: "memory");
            const unsigned og = xb_add(&bar[XB_TOP], 1u);
            const unsigned tg = og / nx;
            if (og + 1u == (tg + 1u) * nx) xb_add(&bar[XB_TOPGEN], 1u);
            else XB_SPIN(xb_ld(&bar[XB_TOPGEN]) == tg, bar);
            __builtin_amdgcn_fence(__ATOMIC_ACQUIRE, "agent");
            xb_add(&bar[XB_XGEN(b.x)], 1u);
            asm volatile("s_waitcnt vmcnt(0)" ::: "memory");
        } else {
            XB_SPIN(xb_ld(&bar[XB_XGEN(b.x)]) == gen, bar);
            __builtin_amdgcn_fence(__ATOMIC_ACQUIRE, "agent");
            asm volatile("s_waitcnt vmcnt(0)" ::: "memory");
        }
    }
    __syncthreads();
}
struct Frame {
    LAS unsigned char* lds;
    volatile LAS unsigned* MISC;
    gu32* ctl;
    int tid, lane, wave;
    int vcu, G;
    unsigned char* ws;
    const float* in[23];
    float* out;
};
#define WSP(T_, off) ((T_*)(F.ws + (off)))

__device__ __forceinline__ void p0_titem(const float* W, int ldw, int c0, const float* kscale, float mul, bf16* WT, int Kd, int drow0, LAS float* scr, int kb, int lane) {
    const int k0 = 64 * kb; f32x4 v[8];
    if ((c0 & 3) == 0 && (ldw & 3) == 0) {
#pragma unroll
        for (int i = 0; i < 8; ++i) { const int kk = 8 * i + (lane >> 3); v[i] = *(const f32x4*)(W + (size_t)(k0 + kk) * ldw + c0 + 4 * (lane & 7)); }
    } else {
#pragma unroll
        for (int i = 0; i < 8; ++i) { const int kk = 8 * i + (lane >> 3); const float* p = W + (size_t)(k0 + kk) * ldw + c0 + 4 * (lane & 7); v[i] = (f32x4){p[0], p[1], p[2], p[3]}; }
    }
#pragma unroll
    for (int i = 0; i < 8; ++i) { const int kk = 8 * i + (lane >> 3); const float sc = (kscale ? kscale[k0 + kk] : 1.0f) * mul; LAS float* d = scr + kk * 33 + 4 * (lane & 7);
        d[0] = v[i][0] * sc; d[1] = v[i][1] * sc; d[2] = v[i][2] * sc; d[3] = v[i][3] * sc; }
    LDS_WAIT(); asm volatile("" ::: "memory");
    const int c = lane & 7;
#pragma unroll
    for (int j = 0; j < 4; ++j) { const int n = (lane >> 3) + 8 * j; const LAS float* s = scr + (8 * c) * 33 + n;
        v4u o; o.x = pk2(s[0 * 33], s[1 * 33]); o.y = pk2(s[2 * 33], s[3 * 33]); o.z = pk2(s[4 * 33], s[5 * 33]); o.w = pk2(s[6 * 33], s[7 * 33]);
        *(GAS v4u*)(WT + (size_t)(drow0 + n) * Kd + k0 + 8 * c) = o; }
    LDS_WAIT(); asm volatile("" ::: "memory");
}
__device__ __forceinline__ void p0_prologue(Frame& F) {
    LAS float* scr = (LAS float*)(F.lds + RING_OFF + F.wave * 16384);
    const int gw = F.vcu * NWAVES + F.wave, NGW = F.G * NWAVES, lane = F.lane;
    const float* norm_mix = F.in[1]; const float* norm_ffn = F.in[2];
    constexpr int I_AB1 = 16 * 40, I_AB2 = 16 * 24, I_ABO = 16 * 32, I_FF = 16 * 88, I_DN = 44 * 32, I_CIN = 16 * 96, I_CO = 16 * 32, I_W1 = 32 * 2, I_W2 = 2;
    constexpr int NITEMS = I_AB1 + I_AB2 + I_ABO + 4 * I_FF + 2 * I_DN + I_CIN + I_CO + 2 * I_W1 + 2 * I_W2;
    for (int it = gw; it < NITEMS; it += NGW) {
        int r = it;
        if (r < I_AB1) { const int kb = r / 40, nb = r % 40; p0_titem(F.in[6], AB_LD, 32 * nb, norm_mix, nb < 16 ? C2 : 1.f, WSP(bf16, WS_WAB), 1024, 32 * nb, scr, kb, lane); continue; } r -= I_AB1;
        if (r < I_AB2) { const int kb = r / 24, nb = r % 24; p0_titem(F.in[6], AB_LD, 1304 + 32 * nb, norm_mix, nb < 16 ? C2 : 1.f, WSP(bf16, WS_WAB), 1024, 1280 + 32 * nb, scr, kb, lane); continue; } r -= I_AB2;
        if (r < I_ABO) { const int kb = r / 32, nb = r % 32; p0_titem(F.in[15], 1024, 32 * nb, nullptr, 1.f, WSP(bf16, WS_WABO), 1024, 32 * nb, scr, kb, lane); continue; } r -= I_ABO;
        if (r < 4 * I_FF) { const int q = r / I_FF, rr = r % I_FF, l = q >> 1, up = q & 1, kb = rr / 88, nb = rr % 88, n0 = 32 * nb;
            const float* W = (up ? F.in[4] : F.in[3]) + (size_t)l * 1024 * FF;
            p0_titem(W, FF, n0, norm_ffn + l * 1024, 1.f, WSP(bf16, l ? WS_WUP1 : WS_WUP0), 1024, 256 * (n0 / 128) + (n0 % 128) + 128 * up, scr, kb, lane); continue; } r -= 4 * I_FF;
        if (r < 2 * I_DN) { const int l = r / I_DN, rr = r % I_DN, kb = rr / 32, nb = rr % 32;
            p0_titem(F.in[5] + (size_t)l * FF * 1024, 1024, 32 * nb, nullptr, 1.f, WSP(bf16, l ? WS_WDN1 : WS_WDN0), FF, 32 * nb, scr, kb, lane); continue; } r -= 2 * I_DN;
        if (r < I_CIN) { const int kb = r / 96, nb = r % 96; p0_titem(F.in[16], C_LD, 32 * nb, norm_mix + 1024, 1.f, WSP(bf16, WS_WCIN), 1024, 32 * nb, scr, kb, lane); continue; } r -= I_CIN;
        if (r < I_CO) { const int kb = r / 32, nb = r % 32; p0_titem(F.in[21], 1024, 32 * nb, nullptr, 1.f, WSP(bf16, WS_WCO), 1024, 32 * nb, scr, kb, lane); continue; } r -= I_CO;
        if (r < 2 * I_W1) { const int kv = r / I_W1, rr = r % I_W1, kb = rr / 2, nb = rr % 2; p0_titem(F.in[kv ? 12 : 10], 64, 32 * nb, nullptr, 1.f, WSP(bf16, kv ? WS_CW1V : WS_CW1K), 2048, 32 * nb, scr, kb, lane); continue; } r -= 2 * I_W1;
        { const int kv = r / I_W2, nb = r % I_W2; p0_titem(F.in[kv ? 13 : 11], 64, 32 * nb, nullptr, 1.f, WSP(bf16, kv ? WS_CW2V : WS_CW2K), 64, 32 * nb, scr, 0, lane); }
    }
    { const int gt = (F.vcu * NWAVES + F.wave) * 64 + lane, NGT = F.G * NWAVES * 64;
      for (int i = gt; i < 2 * 32 * 1024; i += NGT) { const int which = i >> 15, n = (i >> 10) & 31, k = i & 1023; float v = 0.f;
          if (which == 0) { if (n < 24) v = F.in[6][(size_t)k * AB_LD + 1280 + n] * norm_mix[k]; WSP(bf16, WS_WABG)[n * 1024 + k] = (bf16)f2bf(v); }
          else { if (n < 8) v = F.in[16][(size_t)k * C_LD + 3072 + n] * norm_mix[1024 + k]; WSP(bf16, WS_WCG)[n * 1024 + k] = (bf16)f2bf(v); } } }
    { const int gt = (F.vcu * NWAVES + F.wave) * 64 + lane, NGT = F.G * NWAVES * 64; for (int i = gt; i < 4 * M; i += NGT) WSP(float, WS_PSUM)[i] = 0.f; }
    for (int m = gw; m < M; m += 4 * NGW) {
        f32x4 v[4][4]; float s[4];
#pragma unroll
        for (int q = 0; q < 4; ++q) { const GAS f32x4* xr = (const GAS f32x4*)(F.in[0] + (size_t)(m + q * NGW) * D) + lane;
#pragma unroll
            for (int j = 0; j < 4; ++j) v[q][j] = xr[64 * j]; }
#pragma unroll
        for (int q = 0; q < 4; ++q) { float t = 0.f;
#pragma unroll
            for (int j = 0; j < 4; ++j) t += (v[q][j].x * v[q][j].x + v[q][j].y * v[q][j].y) + (v[q][j].z * v[q][j].z + v[q][j].w * v[q][j].w);
            s[q] = wave_sum(t); }
#pragma unroll
        for (int q = 0; q < 4; ++q) { GAS unsigned long long* o8 = (GAS unsigned long long*)(WSP(bf16, WS_H16) + (size_t)(m + q * NGW) * D) + lane;
#pragma unroll
            for (int j = 0; j < 4; ++j) o8[64 * j] = (unsigned long long)pk2(v[q][j].x, v[q][j].y) | ((unsigned long long)pk2(v[q][j].z, v[q][j].w) << 32);
            if (lane == 0) WSP(float, WS_RS0)[m + q * NGW] = 1.0f / sqrtf(s[q] * (1.0f / D) + 1e-6f); }
    }
    if (gw < 256) { const int kv = gw >> 7, k0 = (gw & 127) * 16; const float* pos = F.in[kv ? 9 : 8]; const float* w1 = F.in[kv ? 12 : 10]; float acc = 0.f;
#pragma unroll
        for (int k = 0; k < 16; ++k) acc += pos[k0 + k] * w1[(size_t)(k0 + k) * 64 + lane];
        WSP(float, WS_CBPART)[gw * 64 + lane] = acc; }
}
typedef float f32x4v __attribute__((ext_vector_type(4)));
__device__ __forceinline__ void skinny_tile16(const bf16* A, const bf16* Wt, int row0, int lane, f32x4v (&acc)[2]) {
    const int i16 = lane & 15, kq = lane >> 4; acc[0] = (f32x4v){0.f, 0.f, 0.f, 0.f}; acc[1] = acc[0];
    const bf16* ap = A + (size_t)(row0 + i16) * 1024 + 8 * kq; const bf16* w0 = Wt + (size_t)i16 * 1024 + 8 * kq; const bf16* w1 = w0 + 16 * 1024;
#pragma unroll 8
    for (int s = 0; s < 32; ++s) { const bf16x8 x = *(const bf16x8*)(ap + 32 * s);
        acc[0] = __builtin_amdgcn_mfma_f32_16x16x32_bf16(*(const bf16x8*)(w0 + 32 * s), x, acc[0], 0, 0, 0);
        acc[1] = __builtin_amdgcn_mfma_f32_16x16x32_bf16(*(const bf16x8*)(w1 + 32 * s), x, acc[1], 0, 0, 0); }
}
__device__ __forceinline__ void gates0_phase(Frame& F) {
    const int gw = F.vcu * NWAVES + F.wave, NGW = F.G * NWAVES, lane = F.lane, i16 = lane & 15, cg = lane >> 4;
    for (int t = gw; t < M / 16; t += NGW) {
        f32x4v acc[2]; skinny_tile16(WSP(bf16, WS_H16), WSP(bf16, WS_WABG), 16 * t, lane, acc);
        const int row = 16 * t + i16; const float rs = WSP(float, WS_RS0)[row]; float* g = WSP(float, WS_GATES) + (size_t)row * 32;
#pragma unroll
        for (int tt = 0; tt < 2; ++tt) { const int c0 = 16 * tt + 4 * cg; if (c0 < 24) { f32x4v o;
#pragma unroll
                for (int r = 0; r < 4; ++r) o[r] = 1.0f / (1.0f + __expf(-(acc[tt][r] * rs + F.in[7][c0 + r])));
                *(f32x4v*)(g + c0) = o; } }
    }
}
__device__ __forceinline__ void gates1_phase(Frame& F) {
    const int gw = F.vcu * NWAVES + F.wave, NGW = F.G * NWAVES, lane = F.lane, i16 = lane & 15, cg = lane >> 4;
    const pg8::RowScale R{nullptr, WSP(float, WS_PSUM) + 1 * M};
    for (int t = gw; t < M / 16; t += NGW) {
        f32x4v acc[2]; skinny_tile16(WSP(bf16, WS_H16), WSP(bf16, WS_WCG), 16 * t, lane, acc);
        const int row = 16 * t + i16; const float rs = pg8::row_scale(R, row); float* g = WSP(float, WS_GATES) + (size_t)row * 32;
        if (cg < 2) { f32x4v o;
#pragma unroll
            for (int r = 0; r < 4; ++r) { const float x = acc[0][r] * rs + (cg == 0 ? F.in[19][r] : F.in[20][r]); o[r] = cg == 0 ? x : fminf(x, 0.f) - log1pf(__expf(-fabsf(x))); }
            *(f32x4v*)(g + 4 * cg) = o; }
    }
}

__device__ __forceinline__ void compress_phase(Frame& F) {
    const int lane = F.lane, r32 = lane & 31, h = lane >> 5, w = F.wave;
    LAS float* red = (LAS float*)(F.lds + RING_OFF);
    LAS unsigned char* Hs = F.lds + RING_OFF + 65536;
    LAS float* cb = (LAS float*)(F.lds + RING_OFF + 65536 + 8192);
    if (F.tid < 128) { const float* pp = WSP(float, WS_CBPART) + (F.tid >> 6) * 128 * 64 + (F.tid & 63); float s = 0.f;
#pragma unroll 16
        for (int q = 0; q < 128; ++q) s += pp[q * 64];
        cb[F.tid] = s; }
    __syncthreads();
    for (int task = F.vcu; task < 256; task += F.G) {
        const int kv = task & 1, bg = (task >> 1) & 7, rt = task >> 4, b = bg >> 1, g = bg & 1, i0 = rt * 32;
        const bf16* raw = WSP(bf16, WS_QKV0) + (size_t)b * T * 2048 + (kv ? QC_VC : QC_KC) + g * 64;
        const bf16* w1t = WSP(bf16, kv ? WS_CW1V : WS_CW1K);
        const bf16* w2t = WSP(bf16, kv ? WS_CW2V : WS_CW2K);
        int ic = i0 + r32; if (ic > 510) ic = 510;
        f32x16 d0 = {}, d1 = {};
#pragma unroll
        for (int ll = 0; ll < 4; ++ll) { const int l = 4 * w + ll;
#pragma unroll
            for (int ss = 0; ss < 4; ++ss) { const int k = l * 64 + 16 * ss + 8 * h;
                const bf16x8 bfr = *(const bf16x8*)(raw + (size_t)(16 * ic + l) * 2048 + 16 * ss + 8 * h);
                d0 = mfma32(*(const bf16x8*)(w1t + (size_t)r32 * 2048 + k), bfr, d0);
                d1 = mfma32(*(const bf16x8*)(w1t + (size_t)(32 + r32) * 2048 + k), bfr, d1); } }
#pragma unroll
        for (int r = 0; r < 16; ++r) { red[(w * 64 + crow(r, h)) * 32 + r32] = d0[r]; red[(w * 64 + 32 + crow(r, h)) * 32 + r32] = d1[r]; }
        __syncthreads();
#pragma unroll
        for (int e = 0; e < 4; ++e) { const int idx = F.tid * 4 + e, hid = idx >> 5, i = idx & 31; float a = cb[kv * 64 + hid];
#pragma unroll
            for (int ww = 0; ww < 8; ++ww) a += red[(ww * 64 + hid) * 32 + i];
            a = a / (1.0f + __expf(-a));
            *(LAS bf16*)(Hs + i * 144 + hid * 2) = (bf16)f2bf(a); }
        __syncthreads();
        if (w < 2) { f32x16 o = {};
#pragma unroll
            for (int s = 0; s < 4; ++s) o = mfma32(*(const bf16x8*)(w2t + (size_t)(32 * w + r32) * 64 + 16 * s + 8 * h), *(const LAS bf16x8*)(Hs + r32 * 144 + (16 * s + 8 * h) * 2), o);
            bf16* dst = WSP(bf16, kv ? WS_VC : WS_KC) + ((size_t)bg * 512 + i0 + r32) * 64 + 32 * w + 4 * h;
#pragma unroll
            for (int q = 0; q < 4; ++q) { v2u pk; pk.x = pk2(o[4 * q], o[4 * q + 1]); pk.y = pk2(o[4 * q + 2], o[4 * q + 3]); *(v2u*)(dst + 8 * q) = pk; } }
        __syncthreads();
    }
}
constexpr int AT_K = 0, AT_V = 9216, AT_BUF = 18432, AT_IMP = 49152  , AT_SEL = AT_IMP + 128 * 132 * 4, AT_OVF = AT_SEL + 2048, AT_END = AT_OVF + 32;
static_assert(AT_END <= RING_BYTES, "attention LDS");
constexpr int KV_STRIDE = 144;
__device__ __forceinline__ void stage_load(Frame& F, const bf16* Kg, const bf16* Vg, int pitch, int row0, int rmax, v4u& kx, v4u& vx) {
    const int row = F.tid >> 3, ch = F.tid & 7; int rr = row0 + row; rr = rr < 0 ? 0 : (rr > rmax ? rmax : rr);
    kx = *(const v4u*)(Kg + (size_t)rr * pitch + ch * 8);
    if (Vg) vx = *(const v4u*)(Vg + (size_t)rr * pitch + ch * 8);
}
__device__ __forceinline__ void stage_write(Frame& F, int boff, bool hasv, const v4u& kx, const v4u& vx) {
    const int row = F.tid >> 3, ch = F.tid & 7;
    *(LAS v4u*)(F.lds + boff + AT_K + row * KV_STRIDE + ch * 16) = kx;
    if (hasv) *(LAS v4u*)(F.lds + boff + AT_V + row * KV_STRIDE + ch * 16) = vx;
}
__device__ __forceinline__ f32x16 qk_tile(LAS unsigned char* klb, int sub, const bf16x8 (&qf)[4]) {
    f32x16 s = {};
#pragma unroll
    for (int st = 0; st < 4; ++st) s = mfma32(*(const LAS bf16x8*)(klb + 32 * sub * KV_STRIDE + 32 * st), qf[st], s);
    return s;
}
__device__ __forceinline__ void pv_tile(LAS unsigned char* vlb, int sub, const f32x16& p, f32x16 (&o)[2]) {
    const bf16x8 p0 = pack8<0>(p), p1 = pack8<1>(p);
#pragma unroll
    for (int dt = 0; dt < 2; ++dt) {
        o[dt] = mfma32(frag_tr(vlb, (32 * sub) * KV_STRIDE + 64 * dt, (32 * sub + 8) * KV_STRIDE + 64 * dt), p0, o[dt]);
        o[dt] = mfma32(frag_tr(vlb, (32 * sub + 16) * KV_STRIDE + 64 * dt, (32 * sub + 24) * KV_STRIDE + 64 * dt), p1, o[dt]);
    }
}
constexpr float THRL = 6.0f, OVFL = 1073741824.0f  , NEGBIG = -1e30f;
struct HeadState { float m, l; f32x16 o[2]; };
__device__ __forceinline__ void hs_init(HeadState& S, float l0) { S.m = 0.f; S.l = l0; S.o[0] = (f32x16){}; S.o[1] = (f32x16){}; }
__device__ __forceinline__ void osm_tile(f32x16& s, HeadState& S) {
    float mx = fmaxf(fmaxf(s[0], s[1]), fmaxf(s[2], s[3]));
#pragma unroll
    for (int r = 4; r < 16; r += 4) mx = fmaxf(mx, fmaxf(fmaxf(s[r], s[r + 1]), fmaxf(s[r + 2], s[r + 3])));
    { const auto rr = __builtin_amdgcn_permlane32_swap(__float_as_uint(mx), __float_as_uint(mx), false, false); mx = fmaxf(__uint_as_float(rr[0]), __uint_as_float(rr[1])); }
    const bool need = mx > THRL;
    if (__any(need)) {
        const float dl = need ? mx : 0.f, f = __builtin_amdgcn_exp2f(-dl);
        S.m += dl; S.l *= f;
#pragma unroll
        for (int r = 0; r < 16; ++r) s[r] -= dl;
#pragma unroll
        for (int dt = 0; dt < 2; ++dt)
#pragma unroll
            for (int r = 0; r < 16; ++r) S.o[dt][r] *= f;
    }
    float sum = 0.f;
#pragma unroll
    for (int r = 0; r < 16; ++r) { s[r] = __builtin_amdgcn_exp2f(s[r]); sum += s[r]; }
    S.l += sum;
}
template <int MODE, int WIN>
__device__ __forceinline__ f32x16 qk_masked(const bf16x8 (&kf)[4], const bf16x8 (&qf)[4], float c0, bool edge, int kb, int tq, int h) {
    f32x16 s;
#pragma unroll
    for (int r = 0; r < 16; ++r) s[r] = c0;
#pragma unroll
    for (int st = 0; st < 4; ++st) s = mfma32(kf[st], qf[st], s);
    if (edge) {
#pragma unroll
        for (int r = 0; r < 16; ++r) { const int key = kb + crow(r, h); bool ok = key <= tq; if (MODE == 1) ok = ok && (tq - key < WIN); s[r] = ok ? s[r] : NEGBIG; }
    }
    return s;
}
constexpr int RG_SLOT = 32768, RG_V = 16384, RG_NSLOT = 3;
static_assert(RG_NSLOT * RG_SLOT <= AT_SEL, "the DMA ring may overlay the dead importance table, never the selection words");
template <int MODE, int WIN, bool GEN>
__device__ __forceinline__ void attn_blocks(Frame& F, const bf16* Kg, const bf16* Vg, int jlo, int jhi, int tq, int tqmax_w, int tqmin_w, const LAS unsigned* selp,
                                            const bf16x8 (&qf)[2][4], HeadState (&H)[2], LAS unsigned* ovfw) {
    int lane = F.lane; asm volatile("" : "+v"(lane));
    const int r32 = lane & 31, h = lane >> 5;
    int koff[4];
#pragma unroll
    for (int st = 0; st < 4; ++st) koff[st] = r32 * 128 + (((2 * st + h) ^ (r32 & 7)) << 4);
    const int vl = 4 * h + ((lane & 15) >> 2), vlow = (2 * ((lane >> 4) & 1) + ((lane & 3) >> 1)) ^ (vl & 3);
    int voff[2];
#pragma unroll
    for (int dt = 0; dt < 2; ++dt) voff[dt] = RG_V + vl * 128 + ((((4 * dt) ^ (vl & 4)) | vlow) << 4) + 8 * (lane & 1);
    const int drow = 16 * F.wave + (lane >> 3), dch = (lane & 7) ^ (lane >> 3);
    const bf16* ksrc = Kg + (size_t)drow * 2048 + dch * 8; const bf16* vsrc = Vg + (size_t)drow * 2048 + dch * 8;
    const unsigned ring0 = (unsigned)(size_t)F.lds + (unsigned)F.wave * 2048u;
#define RG_GLDS(gsrc, ldsdst) do { unsigned keep_; asm volatile("s_mov_b32 %0, m0\n\ts_mov_b32 m0, %2\n\ts_nop 0\n\tglobal_load_lds_dwordx4 %1, off\n\ts_mov_b32 m0, %0" : "=&s"(keep_) : "v"(gsrc), "s"(ldsdst) : "memory"); } while (0)
#define RG_ISSUE(blk, slot) do { const size_t go_ = (size_t)(blk) * (128 * 2048); const unsigned ld_ = (unsigned)__builtin_amdgcn_readfirstlane((int)(ring0 + (unsigned)(slot) * RG_SLOT)); \
        RG_GLDS(ksrc + go_, ld_); RG_GLDS(ksrc + go_ + 8 * 2048, ld_ + 1024); RG_GLDS(vsrc + go_, ld_ + RG_V); RG_GLDS(vsrc + go_ + 8 * 2048, ld_ + RG_V + 1024); } while (0)
    bool ovf = false;
    __syncthreads();
    const int Jlo = jlo >> 1, Jhi = jhi >> 1;
#pragma unroll
    for (int d = 0; d < 2; ++d) { const int jb = Jlo + d > Jhi ? Jhi : Jlo + d; RG_ISSUE(jb, d); }
    int slot = 0;
    for (int J = Jlo; J <= Jhi; ++J) {
        asm volatile("s_waitcnt vmcnt(4)" ::: "memory");
        __builtin_amdgcn_s_barrier(); asm volatile("" ::: "memory");
        { const int jn = J + 2 > Jhi ? Jhi : J + 2; const int sn = slot == 0 ? 2 : slot - 1; RG_ISSUE(jn, sn); }
        __builtin_amdgcn_sched_barrier(0);
        LAS unsigned char* sb = F.lds + slot * RG_SLOT; slot = slot == 2 ? 0 : slot + 1;
        bool mine0 = true, mine1 = true;
        if (MODE == 0) { const int j0 = 2 * J, j1 = 2 * J + 1; const unsigned sw0 = selp[j0 & 3], sw1 = selp[j1 & 3]; mine0 = ((sw0 >> (j0 >> 2)) & 1u) != 0u; mine1 = ((sw1 >> (j1 >> 2)) & 1u) != 0u; }
        const bool anym0 = MODE != 0 || __any(mine0), anym1 = MODE != 0 || __any(mine1);
#pragma unroll
        for (int sub = 0; sub < 4; ++sub) {
            const int kb = 128 * J + 32 * sub;
            const bool mine = sub < 2 ? mine0 : mine1;
            const bool any = (sub < 2 ? anym0 : anym1) && (kb <= tqmax_w) && (MODE == 0 || kb + 31 > tqmin_w - WIN);
            if (!any) continue;
            bf16x8 kf[4];
#pragma unroll
            for (int st = 0; st < 4; ++st) kf[st] = *(const LAS bf16x8*)(sb + koff[st] + sub * 4096);
            const bool edge = (kb + 31 > tqmin_w) || (MODE == 1 && kb <= tqmax_w - WIN);
            bf16x8 vf[4];
#pragma unroll
            for (int dt = 0; dt < 2; ++dt) {
                vf[2 * dt] = frag_tr(sb + voff[dt], sub * 4096, sub * 4096 + 8 * 128);
                vf[2 * dt + 1] = frag_tr(sb + voff[dt], sub * 4096 + 16 * 128, sub * 4096 + 24 * 128); }
            if (!GEN) {
#define SB_() __builtin_amdgcn_sched_barrier(0)
#define EXP4(S, B, SUM) do { S[B] = __builtin_amdgcn_exp2f(S[B]); S[B + 1] = __builtin_amdgcn_exp2f(S[B + 1]); S[B + 2] = __builtin_amdgcn_exp2f(S[B + 2]); S[B + 3] = __builtin_amdgcn_exp2f(S[B + 3]); \
                    SUM += (S[B] + S[B + 1]) + (S[B + 2] + S[B + 3]); } while (0)
                const float c0 = (MODE == 0 && !mine) ? NEGBIG : 0.f;
                f32x16 cinit;
                if (edge) {
#pragma unroll
                    for (int r = 0; r < 16; ++r) { const int key = kb + crow(r, h); bool ok = key <= tq; if (MODE == 1) ok = ok && (tq - key < WIN); cinit[r] = ok ? c0 : NEGBIG; }
                } else {
#pragma unroll
                    for (int r = 0; r < 16; ++r) cinit[r] = c0;
                }
                SB_();
                f32x16 s0 = mfma32(kf[0], qf[0][0], cinit);
#pragma unroll
                for (int st = 1; st < 4; ++st) s0 = mfma32(kf[st], qf[0][st], s0);
                SB_();
                float sum0 = 0.f, sum1 = 0.f;
                f32x16 s1 = mfma32(kf[0], qf[1][0], cinit); SB_(); EXP4(s0, 0, sum0); SB_();
                s1 = mfma32(kf[1], qf[1][1], s1); SB_(); EXP4(s0, 4, sum0); SB_();
                s1 = mfma32(kf[2], qf[1][2], s1); SB_(); EXP4(s0, 8, sum0); SB_();
                s1 = mfma32(kf[3], qf[1][3], s1); SB_(); EXP4(s0, 12, sum0); SB_();
                const bf16x8 pa0 = pack8<0>(s0), pa1 = pack8<1>(s0);
                SB_();
                H[0].o[0] = mfma32(vf[0], pa0, H[0].o[0]); SB_(); EXP4(s1, 0, sum1); SB_();
                H[0].o[0] = mfma32(vf[1], pa1, H[0].o[0]); SB_(); EXP4(s1, 4, sum1); SB_();
                H[0].o[1] = mfma32(vf[2], pa0, H[0].o[1]); SB_(); EXP4(s1, 8, sum1); SB_();
                H[0].o[1] = mfma32(vf[3], pa1, H[0].o[1]); SB_(); EXP4(s1, 12, sum1); SB_();
                const bf16x8 pb0 = pack8<0>(s1), pb1 = pack8<1>(s1);
                SB_();
                H[1].o[0] = mfma32(vf[0], pb0, H[1].o[0]); H[1].o[0] = mfma32(vf[1], pb1, H[1].o[0]);
                H[1].o[1] = mfma32(vf[2], pb0, H[1].o[1]); H[1].o[1] = mfma32(vf[3], pb1, H[1].o[1]);
                H[0].l += sum0; H[1].l += sum1; ovf = ovf || !(sum0 <= OVFL) || !(sum1 <= OVFL);
#undef SB_
#undef EXP4
            } else {
                f32x16 s[2];
#pragma unroll
                for (int hd = 0; hd < 2; ++hd) { s[hd] = qk_masked<MODE, WIN>(kf, qf[hd], (MODE == 0 && !mine) ? NEGBIG : -H[hd].m, edge, kb, tq, h); osm_tile(s[hd], H[hd]); }
#pragma unroll
                for (int hd = 0; hd < 2; ++hd) {
                    const bf16x8 p0 = pack8<0>(s[hd]), p1 = pack8<1>(s[hd]);
#pragma unroll
                    for (int dt = 0; dt < 2; ++dt) { H[hd].o[dt] = mfma32(vf[2 * dt], p0, H[hd].o[dt]); H[hd].o[dt] = mfma32(vf[2 * dt + 1], p1, H[hd].o[dt]); }
                }
            }
            __builtin_amdgcn_sched_barrier(0);
        }
    }
    asm volatile("s_waitcnt vmcnt(0)" ::: "memory");
    if (!GEN) { if (__any(ovf) && lane == 0) *ovfw = 1u; }
    __syncthreads();
#undef RG_ISSUE
#undef RG_GLDS
}
__device__ __forceinline__ void accf_store(float* accw, int lane, const f32x16 (&o)[2], float sc, bool add) {
#pragma unroll
    for (int dt = 0; dt < 2; ++dt)
#pragma unroll
        for (int q = 0; q < 4; ++q) { f32x4 v = {o[dt][4 * q] * sc, o[dt][4 * q + 1] * sc, o[dt][4 * q + 2] * sc, o[dt][4 * q + 3] * sc};
            f32x4* d = (f32x4*)accw + (dt * 4 + q) * 64 + lane; if (add) v = v + *d; *d = v; }
}
constexpr int AT_OST = 272;
__device__ __forceinline__ void att_stage(LAS unsigned char* scr, int hd, const float* accw, int lane, const f32x16 (&o)[2], float sc, int h) {
    const int r32 = lane & 31;
#pragma unroll
    for (int dt = 0; dt < 2; ++dt)
#pragma unroll
        for (int q = 0; q < 4; ++q) { f32x4 v = {o[dt][4 * q] * sc, o[dt][4 * q + 1] * sc, o[dt][4 * q + 2] * sc, o[dt][4 * q + 3] * sc};
            if (accw) v = v + *((const f32x4*)accw + (dt * 4 + q) * 64 + lane);
            v2u pk; pk.x = pk2(v[0], v[1]); pk.y = pk2(v[2], v[3]); *(LAS v2u*)(scr + r32 * AT_OST + hd * 128 + (32 * dt + 8 * q + 4 * h) * 2) = pk; }
}
__device__ __forceinline__ void att_flush(LAS unsigned char* scr, bf16* att, size_t tok0, int hc, int lane) {
    LDS_WAIT(); asm volatile("" ::: "memory");
#pragma unroll
    for (int i = 0; i < 8; ++i) { const int idx = i * 64 + lane, row = idx >> 4, ch = idx & 15;
        *(v4u*)(att + (tok0 + row) * 1024 + hc + (ch >> 3) * 64 + (ch & 7) * 8) = *(const LAS v4u*)(scr + row * AT_OST + ch * 16); }
    LDS_WAIT(); asm volatile("" ::: "memory");
}
template <int PASS>
__device__ __forceinline__ void cmp_pass(Frame& F, const bf16* kcg, const bf16* vcg, int nvalid, int tq, int tqmax_w, int tqmin_w, const bf16x8 (&qf)[2][4],
                                         float (&l)[2], const float (&lg)[2], f32x16 (&o)[2][2], LAS float* improw, LAS unsigned* ovfw) {
    int lane = F.lane; asm volatile("" : "+v"(lane));
    const int r32 = lane & 31, h = lane >> 5;
    int koff[4];
#pragma unroll
    for (int st = 0; st < 4; ++st) koff[st] = r32 * 128 + (((2 * st + h) ^ (r32 & 7)) << 4);
    const int vl = 4 * h + ((lane & 15) >> 2), vlow = (2 * ((lane >> 4) & 1) + ((lane & 3) >> 1)) ^ (vl & 3);
    int voff[2];
    constexpr int CM_SLOT = 16384, CM_V = 8192; static_assert(3 * CM_SLOT <= AT_IMP, "compressed-branch ring below the importance table");
#pragma unroll
    for (int dt = 0; dt < 2; ++dt) voff[dt] = CM_V + vl * 128 + ((((4 * dt) ^ (vl & 4)) | vlow) << 4) + 8 * (lane & 1);
    const int drow = 8 * F.wave + (lane >> 3), dch = (lane & 7) ^ (lane >> 3);
    const bf16* ksrc = kcg + (size_t)drow * 64 + dch * 8; const bf16* vsrc = vcg + (size_t)drow * 64 + dch * 8;
    const unsigned ring0 = (unsigned)(size_t)F.lds + (unsigned)F.wave * 1024u;
#define RG_GLDS(gsrc, ldsdst) do { unsigned keep_; asm volatile("s_mov_b32 %0, m0\n\ts_mov_b32 m0, %2\n\ts_nop 0\n\tglobal_load_lds_dwordx4 %1, off\n\ts_mov_b32 m0, %0" : "=&s"(keep_) : "v"(gsrc), "s"(ldsdst) : "memory"); } while (0)
#define CM_ISSUE(blk, slot) do { const size_t go_ = (size_t)(blk) * (64 * 64); const unsigned ld_ = (unsigned)__builtin_amdgcn_readfirstlane((int)(ring0 + (unsigned)(slot) * CM_SLOT)); \
        RG_GLDS(ksrc + go_, ld_); if (PASS == 2) RG_GLDS(vsrc + go_, ld_ + CM_V); } while (0)
    const int ilim = tq >= 31 ? (tq - 31) >> 4 : -1, ilmax = tqmax_w >= 31 ? (tqmax_w - 31) >> 4 : -1, ilmin = tqmin_w >= 31 ? (tqmin_w - 31) >> 4 : -1;
    bool ovf = false; float carry = 0.f;
    __syncthreads();
    const int Jhi = (nvalid - 1) >> 6;
#pragma unroll
    for (int d = 0; d < 2; ++d) { const int jb = d > Jhi ? Jhi : d; CM_ISSUE(jb, d); }
    int slot = 0;
    for (int J = 0; J <= Jhi; ++J) {
        if (PASS == 2) asm volatile("s_waitcnt vmcnt(2)" ::: "memory"); else asm volatile("s_waitcnt vmcnt(1)" ::: "memory");
        __builtin_amdgcn_s_barrier(); asm volatile("" ::: "memory");
        { const int jn = J + 2 > Jhi ? Jhi : J + 2; const int sn = slot == 0 ? 2 : slot - 1; CM_ISSUE(jn, sn); }
        __builtin_amdgcn_sched_barrier(0);
        LAS unsigned char* sb = F.lds + slot * CM_SLOT; slot = slot == 2 ? 0 : slot + 1;
#pragma unroll
        for (int sub = 0; sub < 2; ++sub) {
            const int kb = 64 * J + 32 * sub;
            if (kb > ilmax) continue;
            bf16x8 kf[4];
#pragma unroll
            for (int st = 0; st < 4; ++st) kf[st] = *(const LAS bf16x8*)(sb + koff[st] + sub * 4096);
            const bool edge = kb + 31 > ilmin;
            f32x16 s[2];
#pragma unroll
            for (int hd = 0; hd < 2; ++hd) { const float c0 = PASS == 2 ? lg[hd] : 0.f;
                if (edge) {
#pragma unroll
                    for (int r = 0; r < 16; ++r) s[hd][r] = (kb + crow(r, h) <= ilim) ? c0 : NEGBIG;
                } else {
#pragma unroll
                    for (int r = 0; r < 16; ++r) s[hd][r] = c0;
                }
#pragma unroll
                for (int st = 0; st < 4; ++st) s[hd] = mfma32(kf[st], qf[hd][st], s[hd]); }
            if (PASS == 1) {
#pragma unroll
                for (int hd = 0; hd < 2; ++hd) { float sum = 0.f;
#pragma unroll
                    for (int r = 0; r < 16; ++r) sum += __builtin_amdgcn_exp2f(s[hd][r]);
                    l[hd] += sum; ovf = ovf || !(sum <= OVFL); }
            } else {
                bf16x8 vf[4];
#pragma unroll
                for (int dt = 0; dt < 2; ++dt) {
                    vf[2 * dt] = frag_tr(sb + voff[dt], sub * 4096, sub * 4096 + 8 * 128);
                    vf[2 * dt + 1] = frag_tr(sb + voff[dt], sub * 4096 + 16 * 128, sub * 4096 + 24 * 128); }
                float ps4[4] = {0.f, 0.f, 0.f, 0.f}, sp[4] = {0.f, 0.f, 0.f, 0.f};
#pragma unroll
                for (int hd = 0; hd < 2; ++hd) {
#pragma unroll
                    for (int r = 0; r < 16; ++r) s[hd][r] = __builtin_amdgcn_exp2f(s[hd][r]);
#pragma unroll
                    for (int q = 0; q < 4; ++q) { ps4[q] += (s[hd][4 * q] + s[hd][4 * q + 1]) + (s[hd][4 * q + 2] + s[hd][4 * q + 3]); sp[q] += s[hd][4 * q + 3]; }
                    const bf16x8 p0 = pack8<0>(s[hd]), p1 = pack8<1>(s[hd]);
#pragma unroll
                    for (int dt = 0; dt < 2; ++dt) { o[hd][dt] = mfma32(vf[2 * dt], p0, o[hd][dt]); o[hd][dt] = mfma32(vf[2 * dt + 1], p1, o[hd][dt]); }
                }
                float cell[4];
#pragma unroll
                for (int q = 0; q < 4; ++q) { const auto rr = __builtin_amdgcn_permlane32_swap(__float_as_uint(sp[q]), __float_as_uint(sp[q]), false, false);
                    const float rv = __uint_as_float(h ? rr[0] : rr[1]);
                    if (h == 1) cell[q] = ps4[q] + rv; else { cell[q] = ps4[q] + carry; carry = rv; } }
#pragma unroll
                for (int q = 0; q < 4; ++q) atomicAdd((float*)&improw[kb / 4 + h + 2 * q], cell[q]);
            }
            __builtin_amdgcn_sched_barrier(0);
        }
    }
    asm volatile("s_waitcnt vmcnt(0)" ::: "memory");
    if (PASS == 1) { if (__any(ovf) && lane == 0) *ovfw = 1u; }
    __syncthreads();
#undef CM_ISSUE
#undef RG_GLDS
}
__device__ __forceinline__ void nsa_unit(Frame& F, int b, int g, int n) {
    int lane = F.lane, tid = F.tid; asm volatile("" : "+v"(lane), "+v"(tid));
    const int r32 = lane & 31, h = lane >> 5, wave = F.wave;
    const int start = n * 128, qt = wave >> 1, hp = (wave & 1) * 2;
    const int tq = start + qt * 32 + r32, tqmin_w = start + qt * 32, tqmax_w = tqmin_w + 31;
    const size_t tok = (size_t)b * T + tq;
    const bf16* qkv = WSP(bf16, WS_QKV0) + (size_t)b * T * 2048;
    const int trl = ((lane & 15) >> 2) * KV_STRIDE + (16 * ((lane >> 4) & 1) + 4 * (lane & 3)) * 2;
    LAS unsigned char* klb0 = F.lds + AT_K + r32 * KV_STRIDE + 16 * h; LAS unsigned char* vlb0 = F.lds + AT_V + trl + 4 * h * KV_STRIDE;
    LAS float* imp = (LAS float*)(F.lds + AT_IMP); LAS unsigned* sel = (LAS unsigned*)(F.lds + AT_SEL);
    bf16x8 qf[2][4];
#pragma unroll
    for (int hd = 0; hd < 2; ++hd)
#pragma unroll
        for (int s = 0; s < 4; ++s) qf[hd][s] = *(const bf16x8*)(qkv + (size_t)tq * 2048 + QC_QN + (g * 4 + hp + hd) * 64 + 16 * s + 8 * h);
#define GATEP (WSP(float, WS_GATES) + ((size_t)b * T + tq) * 32 + (g * 4 + hp) * 3)
#define ACCFP (WSP(float, WS_ACCF) + (((size_t)((b * 2 + g) * 64 + n) * 8 + wave) * 2) * 2048)
    __syncthreads();
    for (int i = tid; i < 128 * 132; i += 512) imp[i] = 0.f;
    LAS unsigned* ovfw = (LAS unsigned*)(F.lds + AT_OVF); if (tid < 4) ovfw[tid] = 0u;
    const bf16* kcg = WSP(bf16, WS_KC) + (size_t)(b * 2 + g) * 512 * 64; const bf16* vcg = WSP(bf16, WS_VC) + (size_t)(b * 2 + g) * 512 * 64;
    const int nvalid = 8 * n + 7, nbc = (nvalid + 63) >> 6;
    f32x16 o[2][2];
#pragma unroll
    for (int hd = 0; hd < 2; ++hd) { o[hd][0] = (f32x16){}; o[hd][1] = (f32x16){}; }
    LAS float* improw = imp + (qt * 32 + r32) * 132;
    { float lf[2] = {0.f, 0.f}; const float lgd[2] = {0.f, 0.f};
      cmp_pass<1>(F, kcg, vcg, nvalid, tq, tqmax_w, tqmin_w, qf, lf, lgd, o, improw, ovfw + 3);
      if (!ovfw[3]) {
          float lg[2];
#pragma unroll
          for (int hd = 0; hd < 2; ++hd) { const float lt = lf[hd] + __shfl_xor(lf[hd], 32); lg[hd] = lt > 0.f ? -__log2f(lt) : NEGBIG; }
          cmp_pass<2>(F, kcg, vcg, nvalid, tq, tqmax_w, tqmin_w, qf, lf, lg, o, improw, ovfw + 3);
      } else {
    float m[2] = {-1e30f, -1e30f}, l[2] = {0.f, 0.f};
    v4u kx, vx = {0u, 0u, 0u, 0u};
    __syncthreads();
    stage_load(F, kcg, nullptr, 64, 0, 511, kx, vx);
    for (int jb = 0; jb < nbc; ++jb) {
        const int boff = (jb & 1) * AT_BUF;
        stage_write(F, boff, false, kx, vx);
        __syncthreads();
        if (jb + 1 < nbc) stage_load(F, kcg, nullptr, 64, 64 * (jb + 1), 511, kx, vx);
        LAS unsigned char* klb = klb0 + boff;
#pragma unroll
        for (int sub = 0; sub < 2; ++sub)
#pragma unroll
            for (int hd = 0; hd < 2; ++hd) {
                f32x16 s = qk_tile(klb, sub, qf[hd]); float mx = -INFINITY;
#pragma unroll
                for (int r = 0; r < 16; ++r) { const int i = 64 * jb + 32 * sub + crow(r, h); s[r] = (16 * i + 31 <= tq) ? s[r] : -INFINITY; mx = fmaxf(mx, s[r]); }
                mx = fmaxf(mx, __shfl_xor(mx, 32));
                const float mn = fmaxf(m[hd], mx), al = __builtin_amdgcn_exp2f(m[hd] - mn); float sum = 0.f;
#pragma unroll
                for (int r = 0; r < 16; ++r) sum += __builtin_amdgcn_exp2f(s[r] - mn);
                l[hd] = l[hd] * al + sum; m[hd] = mn;
            }
    }
    float il[2];
#pragma unroll
    for (int hd = 0; hd < 2; ++hd) { const float lt = l[hd] + __shfl_xor(l[hd], 32); il[hd] = lt > 0.f ? 1.0f / lt : 0.f; }
    float carry = 0.f;
    __syncthreads();
    stage_load(F, kcg, vcg, 64, 0, 511, kx, vx);
    for (int jb = 0; jb < nbc; ++jb) {
        const int boff = (jb & 1) * AT_BUF;
        stage_write(F, boff, true, kx, vx);
        __syncthreads();
        if (jb + 1 < nbc) stage_load(F, kcg, vcg, 64, 64 * (jb + 1), 511, kx, vx);
        LAS unsigned char* klb = klb0 + boff; LAS unsigned char* vlb = vlb0 + boff;
#pragma unroll
        for (int sub = 0; sub < 2; ++sub) {
            float ps4[4] = {0.f, 0.f, 0.f, 0.f}, sp[4] = {0.f, 0.f, 0.f, 0.f};
#pragma unroll
            for (int hd = 0; hd < 2; ++hd) {
                f32x16 s = qk_tile(klb, sub, qf[hd]);
#pragma unroll
                for (int r = 0; r < 16; ++r) { const int i = 64 * jb + 32 * sub + crow(r, h); s[r] = (16 * i + 31 <= tq) ? __builtin_amdgcn_exp2f(s[r] - m[hd]) * il[hd] : 0.f; }
#pragma unroll
                for (int q = 0; q < 4; ++q) { ps4[q] += (s[4 * q] + s[4 * q + 1]) + (s[4 * q + 2] + s[4 * q + 3]); sp[q] += s[4 * q + 3]; }
                pv_tile(vlb, sub, s, o[hd]);
            }
            float cell[4];
#pragma unroll
            for (int q = 0; q < 4; ++q) { const float rv = __shfl_xor(sp[q], 32);
                if (h == 1) cell[q] = ps4[q] + rv; else { cell[q] = ps4[q] + carry; carry = rv; } }
            const int j0 = (64 * jb + 32 * sub) / 4 + h;
#pragma unroll
            for (int q = 0; q < 4; ++q) atomicAdd((float*)&imp[(qt * 32 + r32) * 132 + j0 + 2 * q], cell[q]);
        }
    }
      }
    }
#pragma unroll
    for (int hd = 0; hd < 2; ++hd) accf_store(ACCFP + hd * 2048, lane, o[hd], GATEP[3 * hd + 0], false);
    __syncthreads();
    {
        const int q = tid >> 2, part = tid & 3, tq2 = start + q, cur = tq2 >> 6; unsigned bits = 0u;
        float val[32];
#pragma unroll
        for (int e = 0; e < 32; ++e) { const int j = 4 * e + part; const bool forced = (j == 0) || (j == cur) || (j == cur - 1);
            if (cur <= 15) { if (j <= cur) bits |= 1u << e; val[e] = -INFINITY; }
            else { if (forced) bits |= 1u << e; val[e] = (!forced && j >= 1 && j <= cur - 2) ? imp[q * 132 + j] : -INFINITY; } }
        if (cur > 15) {
            for (int itr = 0; itr < 13; ++itr) {
                float bv = val[0]; int be = 0;
#pragma unroll
                for (int e = 1; e < 32; ++e) if (val[e] > bv) { bv = val[e]; be = e; }
                int bj = 4 * be + part; float wv = bv; int wj = bj;
#pragma unroll
                for (int d = 1; d < 4; d <<= 1) { const float ov = __shfl_xor(wv, d); const int oj = __shfl_xor(wj, d); if (ov > wv || (ov == wv && oj < wj)) { wv = ov; wj = oj; } }
                const bool win = (wj == bj) && (wv > -INFINITY);
#pragma unroll
                for (int e = 0; e < 32; ++e) if (win && e == be) { val[e] = -INFINITY; bits |= 1u << e; }
            }
        }
        sel[q * 4 + part] = bits;
    }
    __syncthreads();
    const LAS unsigned* selp = sel + (qt * 32 + r32) * 4;
    {
        HeadState H[2]; hs_init(H[0], 0.f); hs_init(H[1], 0.f);
        attn_blocks<0, 0, false>(F, qkv + QC_KS + g * 64, qkv + QC_VS + g * 64, 0, 2 * n + 1, tq, tqmax_w, tqmin_w, selp, qf, H, ovfw + 0);
        if (ovfw[0]) { hs_init(H[0], 0.f); hs_init(H[1], 0.f); attn_blocks<0, 0, true>(F, qkv + QC_KS + g * 64, qkv + QC_VS + g * 64, 0, 2 * n + 1, tq, tqmax_w, tqmin_w, selp, qf, H, ovfw + 0); }
#pragma unroll
        for (int hd = 0; hd < 2; ++hd) { const float lt = H[hd].l + __shfl_xor(H[hd].l, 32); accf_store(ACCFP + hd * 2048, lane, H[hd].o, lt > 0.f ? GATEP[3 * hd + 1] / lt : 0.f, true); }
    }
    {
        HeadState H[2]; hs_init(H[0], 0.f); hs_init(H[1], 0.f);
        attn_blocks<1, 512, false>(F, qkv + QC_KW + g * 64, qkv + QC_VW + g * 64, (2 * n - 8) < 0 ? 0 : (2 * n - 8), 2 * n + 1, tq, tqmax_w, tqmin_w, selp, qf, H, ovfw + 1);
        if (ovfw[1]) { hs_init(H[0], 0.f); hs_init(H[1], 0.f); attn_blocks<1, 512, true>(F, qkv + QC_KW + g * 64, qkv + QC_VW + g * 64, (2 * n - 8) < 0 ? 0 : (2 * n - 8), 2 * n + 1, tq, tqmax_w, tqmin_w, selp, qf, H, ovfw + 1); }
        LAS unsigned char* scr = F.lds + wave * (32 * AT_OST);
#pragma unroll
        for (int hd = 0; hd < 2; ++hd) { const float lt = H[hd].l + __shfl_xor(H[hd].l, 32);
            att_stage(scr, hd, ACCFP + hd * 2048, lane, H[hd].o, lt > 0.f ? GATEP[3 * hd + 2] / lt : 0.f, h); }
        att_flush(scr, WSP(bf16, WS_ATT), (size_t)b * T + tqmin_w, (g * 4 + hp) * 64, lane);
    }
}
__device__ __forceinline__ void swa_unit(Frame& F, int b, int g, int n) {
    int lane = F.lane; asm volatile("" : "+v"(lane));
    const int r32 = lane & 31, h = lane >> 5, wave = F.wave;
    const int start = n * 128, qt = wave >> 1, hp = (wave & 1) * 2;
    const int tq = start + qt * 32 + r32, tqmin_w = start + qt * 32, tqmax_w = tqmin_w + 31;
    const size_t tok = (size_t)b * T + tq;
    const bf16* qkv = WSP(bf16, WS_QKV0) + (size_t)b * T * 2048;
    bf16x8 qf[2][4];
#pragma unroll
    for (int hd = 0; hd < 2; ++hd)
#pragma unroll
        for (int s = 0; s < 4; ++s) qf[hd][s] = *(const bf16x8*)(qkv + (size_t)tq * 2048 + QC_QS + (g * 4 + hp + hd) * 64 + 16 * s + 8 * h);
    const LAS unsigned* selp = (const LAS unsigned*)(F.lds + AT_SEL);
    HeadState H[2];
#pragma unroll
    for (int hd = 0; hd < 2; ++hd) hs_init(H[hd], (h == 0) ? __builtin_amdgcn_exp2f(F.in[14][g * 4 + hp + hd] * LOG2E) : 0.f);
    LAS unsigned* ovfw = (LAS unsigned*)(F.lds + AT_OVF);
    __syncthreads(); if (F.tid == 0) ovfw[2] = 0u; __syncthreads();
    attn_blocks<1, 128, false>(F, qkv + QC_KSW + g * 64, qkv + QC_VSW + g * 64, (2 * n - 2) < 0 ? 0 : (2 * n - 2), 2 * n + 1, tq, tqmax_w, tqmin_w, selp, qf, H, ovfw + 2);
    if (ovfw[2]) {
#pragma unroll
        for (int hd = 0; hd < 2; ++hd) hs_init(H[hd], (h == 0) ? __builtin_amdgcn_exp2f(F.in[14][g * 4 + hp + hd] * LOG2E) : 0.f);
        attn_blocks<1, 128, true>(F, qkv + QC_KSW + g * 64, qkv + QC_VSW + g * 64, (2 * n - 2) < 0 ? 0 : (2 * n - 2), 2 * n + 1, tq, tqmax_w, tqmin_w, selp, qf, H, ovfw + 2); }
    LAS unsigned char* scr = F.lds + wave * (32 * AT_OST);
#pragma unroll
    for (int hd = 0; hd < 2; ++hd) { const float lt = H[hd].l + __shfl_xor(H[hd].l, 32); att_stage(scr, hd, nullptr, lane, H[hd].o, 1.0f / lt, h); }
    att_flush(scr, WSP(bf16, WS_ATT), (size_t)b * T + tqmin_w, 512 + (g * 4 + hp) * 64, lane);
}
__device__ __forceinline__ void attention_phase(Frame& F) {
    const int q = (int)(((long)F.vcu * 8) / F.G);
    LAS unsigned* slotw = (LAS unsigned*)(F.lds + AT_OVF + 28);
    for (;;) {
        __syncthreads();
        if (F.tid == 0) *slotw = __hip_atomic_fetch_add((unsigned*)(F.ctl + CW_QUEUE + 64 * q), 1u, __ATOMIC_RELAXED, __HIP_MEMORY_SCOPE_AGENT);
        __syncthreads();
        const unsigned idx = *slotw;
        if (idx >= 128u) break;
        if (idx < 64u) nsa_unit(F, q >> 1, q & 1, 63 - (int)idx);
        else swa_unit(F, q >> 1, q & 1, (int)idx - 64);
    }
    __syncthreads();
}
__device__ __forceinline__ void conv_scan_phase(Frame& F) {
    const int lane = F.lane, w = F.wave;
    if (F.vcu < 16 && F.G >= 32) {
        const int bh = F.vcu, b = bh >> 2, hh = bh & 3;
        const float* gt = WSP(float, WS_GATES) + (size_t)b * T * 32;
        LAS float* segG = (LAS float*)(F.lds + RING_OFF); LAS float* segP = segG + 8;
        float Gl[16], al[16], Pl[16]; float c = 0.f, cm = -INFINITY;
#pragma unroll
        for (int it = 0; it < 16; ++it) { const int t = 1024 * w + 64 * it + lane; const float li = gt[(size_t)t * 32 + hh]; float x = gt[(size_t)t * 32 + 4 + hh];
#pragma unroll
            for (int d = 1; d < 64; d <<= 1) { const float y = __shfl_up(x, d); if (lane >= d) x += y; }
            Gl[it] = c + x; c = __shfl(Gl[it], 63);
            al[it] = li - Gl[it]; float pm = al[it];
#pragma unroll
            for (int d = 1; d < 64; d <<= 1) { const float y = __shfl_up(pm, d); if (lane >= d) pm = fmaxf(pm, y); }
            pm = fmaxf(pm, cm); Pl[it] = pm; cm = __shfl(pm, 63); }
        if (lane == 0) { segG[w] = c; segP[w] = cm; }
        __syncthreads();
        double gc = 0.0; float mc = 0.f;
        for (int k = 0; k < w; ++k) { mc = fmaxf(mc, (float)((double)segP[k] - gc)); gc += (double)segG[k]; }
#pragma unroll
        for (int it = 0; it < 16; ++it) { const int t = 1024 * w + 64 * it + lane; const float gcf = (float)gc;
            const float a = al[it] - gcf, mv = fmaxf(mc, Pl[it] - gcf); const double mt = (gc + (double)Gl[it]) + (double)mv;
            WSP(float, WS_SCA)[bh * T + t] = a; WSP(float, WS_SCM)[bh * T + t] = mv; WSP(float, WS_SCE)[bh * T + t] = (float)exp(-mt); }
        __syncthreads();
        return;
    }
    const int first = (F.G >= 32) ? 16 : 0, nblk = F.G - first, bi = F.vcu - first;
    const int c8 = (F.tid & 127) * 8;
    const float* cw = F.in[17]; const float* cb = F.in[18];
    float wv[4][8], bv[8];
#pragma unroll
    for (int e = 0; e < 8; ++e) { bv[e] = cb[c8 + e];
#pragma unroll
        for (int k = 0; k < 4; ++k) wv[k][e] = cw[k * 1024 + c8 + e]; }
    const float ksc = (c8 >= 512) ? 0.08838834764831845f : 1.0f;
    const bf16* src = WSP(bf16, WS_QKP); bf16* dst = WSP(bf16, WS_QKC);
    for (int tok0 = bi * 4 + (F.tid >> 7); tok0 < M; tok0 += nblk * 16) {
        v4u x[4][4]; bool okt[4];
#pragma unroll
        for (int uu = 0; uu < 4; ++uu) { const int tok = tok0 + uu * nblk * 4; okt[uu] = tok < M; const int t = tok & (T - 1);
#pragma unroll
            for (int k = 0; k < 4; ++k) { x[uu][k] = (v4u){0u, 0u, 0u, 0u}; if (okt[uu] && t - 3 + k >= 0) x[uu][k] = *(const v4u*)(src + (size_t)(tok - 3 + k) * 1024 + c8); } }
#pragma unroll
        for (int uu = 0; uu < 4; ++uu) { if (!okt[uu]) continue; const int tok = tok0 + uu * nblk * 4; float acc[8];
#pragma unroll
            for (int e = 0; e < 8; ++e) acc[e] = bv[e];
#pragma unroll
            for (int k = 0; k < 4; ++k) { const v4u xx = x[uu][k];
                acc[0] += bflo(xx.x) * wv[k][0]; acc[1] += bfhi(xx.x) * wv[k][1]; acc[2] += bflo(xx.y) * wv[k][2]; acc[3] += bfhi(xx.y) * wv[k][3];
                acc[4] += bflo(xx.z) * wv[k][4]; acc[5] += bfhi(xx.z) * wv[k][5]; acc[6] += bflo(xx.w) * wv[k][6]; acc[7] += bfhi(xx.w) * wv[k][7]; }
#pragma unroll
            for (int e = 0; e < 8; ++e) acc[e] = acc[e] * __builtin_amdgcn_rcpf(1.0f + __expf(-acc[e])) * ksc;
            v4u o; o.x = pk2(acc[0], acc[1]); o.y = pk2(acc[2], acc[3]); o.z = pk2(acc[4], acc[5]); o.w = pk2(acc[6], acc[7]);
            *(v4u*)(dst + (size_t)tok * 1024 + c8) = o; }
    }
}
constexpr int ML_KS = 272, ML_VS = 528;
constexpr int ML_K = 0, ML_V = 64 * ML_KS;
__device__ __forceinline__ void mlstm_p1_phase(Frame& F) {
    const int lane = F.lane, r32 = lane & 31, h = lane >> 5, w = F.wave, tid = F.tid;
    LAS unsigned char* kt = F.lds + ML_K; LAS unsigned char* vt = F.lds + ML_V;
    const int row = tid >> 3, ch = tid & 7;
    for (int u = F.vcu; u < 512; u += F.G) {
        const int bh = u >> 5, sc = u & 31, b = bh >> 2, hh = bh & 3;
        const float mend = WSP(float, WS_SCM)[bh * T + 256 * sc + 255];
        const float* av = WSP(float, WS_SCA) + bh * T + 256 * sc;
        const bf16* kp0 = WSP(bf16, WS_QKC) + ((size_t)b * T + 256 * sc + row) * 1024 + 512 + hh * 128 + ch * 16;
        const bf16* vp0 = WSP(bf16, WS_V1) + ((size_t)b * T + 256 * sc + row) * 1024 + hh * 256 + ch * 32;
        f32x16 acc[4]; float nacc = 0.f;
#pragma unroll
        for (int i = 0; i < 4; ++i) acc[i] = (f32x16){};
        v4u kx[2], vx[4]; float wgt;
#pragma unroll
        for (int q = 0; q < 2; ++q) kx[q] = *(const v4u*)(kp0 + 8 * q);
#pragma unroll
        for (int q = 0; q < 4; ++q) vx[q] = *(const v4u*)(vp0 + 8 * q);
        wgt = __expf(av[row] - mend);
        for (int c4 = 0; c4 < 4; ++c4) {
            __syncthreads();
#pragma unroll
            for (int q = 0; q < 2; ++q) { const v4u x = kx[q]; v4u y;
                y.x = pk2(bflo(x.x) * wgt, bfhi(x.x) * wgt); y.y = pk2(bflo(x.y) * wgt, bfhi(x.y) * wgt); y.z = pk2(bflo(x.z) * wgt, bfhi(x.z) * wgt); y.w = pk2(bflo(x.w) * wgt, bfhi(x.w) * wgt);
                *(LAS v4u*)(kt + row * ML_KS + (ch * 16 + 8 * q) * 2) = y; }
#pragma unroll
            for (int q = 0; q < 4; ++q) *(LAS v4u*)(vt + row * ML_VS + (ch * 32 + 8 * q) * 2) = vx[q];
            __syncthreads();
            if (c4 < 3) { const size_t adv = (size_t)(64 * (c4 + 1)) * 1024;
#pragma unroll
                for (int q = 0; q < 2; ++q) kx[q] = *(const v4u*)(kp0 + adv + 8 * q);
#pragma unroll
                for (int q = 0; q < 4; ++q) vx[q] = *(const v4u*)(vp0 + adv + 8 * q);
                wgt = __expf(av[64 * (c4 + 1) + row] - mend); }
            if (tid < 128) { float s = 0.f;
#pragma unroll 8
                for (int rr = 0; rr < 64; ++rr) s += bf2f(*(LAS bf16*)(kt + rr * ML_KS + tid * 2));
                nacc += s; }
            LAS unsigned char* klb = kt + ((lane & 15) >> 2) * ML_KS + (16 * ((lane >> 4) & 1) + 4 * (lane & 3)) * 2 + 8 * h * ML_KS;
            LAS unsigned char* vlb = vt + ((lane & 15) >> 2) * ML_VS + (16 * ((lane >> 4) & 1) + 4 * (lane & 3)) * 2 + 8 * h * ML_VS + 64 * w;
#pragma unroll
            for (int s = 0; s < 4; ++s) {
                const bf16x8 av8 = frag_tr(vlb, 16 * s * ML_VS, (16 * s + 4) * ML_VS);
#pragma unroll
                for (int dkt = 0; dkt < 4; ++dkt) acc[dkt] = mfma32(av8, frag_tr(klb, 16 * s * ML_KS + 64 * dkt, (16 * s + 4) * ML_KS + 64 * dkt), acc[dkt]);
            }
        }
        float* lt = WSP(float, WS_LT) + (size_t)u * 32768;
#pragma unroll
        for (int dkt = 0; dkt < 4; ++dkt)
#pragma unroll
            for (int r = 0; r < 16; ++r) lt[(32 * w + crow(r, h)) * 128 + 32 * dkt + r32] = acc[dkt][r];
        if (tid < 128) WSP(float, WS_NLOC)[u * 128 + tid] = nacc;
    }
    __syncthreads();
}
__device__ __forceinline__ void mlstm_scan_phase(Frame& F) {
    const int gt = F.vcu * 512 + F.tid, NT = F.G * 512;
    for (int item = gt; item < 16 * 8192; item += NT) {
        const int bh = item >> 13, e4 = (item & 8191) * 4; f32x4 C = {0.f, 0.f, 0.f, 0.f}; float mprev = 0.f;
        const float* mx = WSP(float, WS_SCM) + bh * T;
#pragma unroll 8
        for (int sc = 0; sc < 32; ++sc) {
            const size_t off = ((size_t)(bh * 32 + sc)) * 32768 + e4;
            v2u pk; pk.x = pk2(C[0], C[1]); pk.y = pk2(C[2], C[3]); *(v2u*)(WSP(bf16, WS_CST) + off) = pk;
            const float mend = mx[256 * sc + 255], dec = __expf(mprev - mend); mprev = mend;
            const f32x4 L = *(const f32x4*)(WSP(float, WS_LT) + off);
            C = C * dec + L;
        }
    }
    for (int item = gt; item < 16 * 128; item += NT) {
        const int bh = item >> 7, dk = item & 127; float nn = 0.f, mprev = 0.f; const float* mx = WSP(float, WS_SCM) + bh * T;
        for (int sc = 0; sc < 32; ++sc) { const int u = bh * 32 + sc; WSP(float, WS_NST)[u * 128 + dk] = nn;
            const float mend = mx[256 * sc + 255], dec = __expf(mprev - mend); mprev = mend; nn = nn * dec + WSP(float, WS_NLOC)[u * 128 + dk]; }
    }
}
constexpr int M3_C = 0, M3_K = 0, M3_V = 128 * ML_KS, M3_Q = 2 * 128 * ML_KS, M3_A = M3_Q + 256 * ML_KS, M3_N = M3_A + 1024, M3_END = M3_N + 512;
static_assert(M3_END <= LDSCTL_OFF, "mlstm p3 LDS");
__device__ __forceinline__ void mlstm_p3_phase(Frame& F) {
    const int w = F.wave, tid = F.tid;
    LAS unsigned char* ct = F.lds + M3_C; LAS unsigned char* kt = F.lds + M3_K; LAS unsigned char* vt = F.lds + M3_V;
    LAS float* als = (LAS float*)(F.lds + M3_A); LAS float* nls = (LAS float*)(F.lds + M3_N);
    for (int u = F.vcu; u < 512; u += F.G) {
        int lane_ = F.lane; asm volatile("" : "+v"(lane_));
        const int r32 = lane_ & 31, h = lane_ >> 5;
        LAS unsigned char* vlb = vt + ((lane_ & 15) >> 2) * ML_KS + (16 * ((lane_ >> 4) & 1) + 4 * (lane_ & 3)) * 2 + 4 * h * ML_KS;
        LAS unsigned char* klb = kt + r32 * ML_KS + 16 * h; LAS unsigned char* clb = ct + r32 * ML_KS + 16 * h;
        LAS unsigned char* qlb = F.lds + M3_Q + (32 * w + r32) * ML_KS + 16 * h;
        const int bh = u >> 5, sc = u & 31, b = bh >> 2, hh = bh & 3;
        const size_t tok0 = (size_t)b * T + 256 * sc;
        const int tl = 32 * w + r32;
        const size_t tokq = tok0 + tl;
        const float Mt = WSP(float, WS_SCM)[bh * T + 256 * sc + tl];
        const float mprev = sc ? WSP(float, WS_SCM)[bh * T + 256 * sc - 1] : 0.f;
        const float winter = __expf(mprev - Mt);
        float dsum = 0.f, hdiv = 0.f;
        const int srow = tid >> 4, sch = tid & 15;
#pragma unroll 1
        for (int pass = 0; pass < 2; ++pass) {
            const bf16* cs = WSP(bf16, WS_CST) + (size_t)u * 32768 + pass * 16384 + srow * 128 + sch * 8;
            const bf16* kg = WSP(bf16, WS_QKC) + (tok0 + srow) * 1024 + 512 + hh * 128 + sch * 8;
            const bf16* vg = WSP(bf16, WS_V1) + (tok0 + srow) * 1024 + hh * 256 + pass * 128 + sch * 8;
            v4u kx[4], vx[4];
            { v4u cx[4];
#pragma unroll
              for (int i = 0; i < 4; ++i) cx[i] = *(const v4u*)(cs + (size_t)(32 * i) * 128);
#pragma unroll
              for (int i = 0; i < 4; ++i) { kx[i] = *(const v4u*)(kg + (size_t)(32 * i) * 1024); vx[i] = *(const v4u*)(vg + (size_t)(32 * i) * 1024); }
              __syncthreads();
#pragma unroll
              for (int i = 0; i < 4; ++i) *(LAS v4u*)(ct + (srow + 32 * i) * ML_KS + sch * 16) = cx[i]; }
            if (pass == 0) {
#pragma unroll
                for (int i = 0; i < 8; ++i) *(LAS v4u*)(F.lds + M3_Q + (srow + 32 * i) * ML_KS + sch * 16) = *(const v4u*)(WSP(bf16, WS_QKC) + (tok0 + srow + 32 * i) * 1024 + hh * 128 + sch * 8);
                if (tid < 256) als[tid] = WSP(float, WS_SCA)[bh * T + 256 * sc + tid];
                if (tid < 128) nls[tid] = WSP(float, WS_NST)[u * 128 + tid]; }
            __syncthreads();
            f32x16 acc[4];
#pragma unroll
            for (int dvt = 0; dvt < 4; ++dvt) { f32x16 a = {};
#pragma unroll
                for (int s = 0; s < 8; ++s) a = mfma32(*(const LAS bf16x8*)(clb + 32 * dvt * ML_KS + 32 * s), *(const LAS bf16x8*)(qlb + 32 * s), a);
                acc[dvt] = a * winter; __builtin_amdgcn_sched_barrier(0); }
#pragma unroll 1
            for (int half = 0; half < 2; ++half) {
                __syncthreads();
#pragma unroll
                for (int i = 0; i < 4; ++i) { const int o = (srow + 32 * i) * ML_KS + sch * 16; *(LAS v4u*)(kt + o) = kx[i]; *(LAS v4u*)(vt + o) = vx[i]; }
                if (half == 0) {
#pragma unroll
                    for (int i = 0; i < 4; ++i) { kx[i] = *(const v4u*)(kg + (size_t)(128 + 32 * i) * 1024); vx[i] = *(const v4u*)(vg + (size_t)(128 + 32 * i) * 1024); }
                }
                __syncthreads();
#pragma unroll 1
                for (int k4 = 0; k4 < 4; ++k4) { const int ktile = 4 * half + k4;
                    if (ktile > w) break;
                    f32x16 s = {};
#pragma unroll
                    for (int st = 0; st < 8; ++st) s = mfma32(*(const LAS bf16x8*)(klb + 32 * k4 * ML_KS + 32 * st), *(const LAS bf16x8*)(qlb + 32 * st), s);
                    __builtin_amdgcn_sched_barrier(0);
                    float ds = 0.f;
#pragma unroll
                    for (int r = 0; r < 16; ++r) { const int key = 32 * ktile + crow(r, h); const float wg = __expf(als[key] - Mt); s[r] = (key <= tl) ? s[r] * wg : 0.f; ds += s[r]; }
                    if (pass == 0) dsum += ds;
                    const bf16x8 p0 = pack8<0>(s), p1 = pack8<1>(s);
                    LAS unsigned char* vl2 = vlb + 32 * k4 * ML_KS;
#pragma unroll
                    for (int dvt = 0; dvt < 4; ++dvt) {
                        acc[dvt] = mfma32(frag_tr(vl2, 64 * dvt, 8 * ML_KS + 64 * dvt), p0, acc[dvt]);
                        acc[dvt] = mfma32(frag_tr(vl2, 16 * ML_KS + 64 * dvt, 24 * ML_KS + 64 * dvt), p1, acc[dvt]);
                        __builtin_amdgcn_sched_barrier(0);
                    }
                }
            }
            if (pass == 0) {
                float qn = 0.f;
#pragma unroll
                for (int s = 0; s < 8; ++s) { const v4u qq = *(const LAS v4u*)(qlb + 32 * s); const LAS float* np = nls + 16 * s + 8 * h;
                    qn += bflo(qq.x) * np[0] + bfhi(qq.x) * np[1] + bflo(qq.y) * np[2] + bfhi(qq.y) * np[3] + bflo(qq.z) * np[4] + bfhi(qq.z) * np[5] + bflo(qq.w) * np[6] + bfhi(qq.w) * np[7]; }
                dsum += __shfl_xor(dsum, 32); qn += __shfl_xor(qn, 32);
                const float den = winter * qn + dsum, emt = WSP(float, WS_SCE)[bh * T + 256 * sc + tl];
                hdiv = 1.0f / fmaxf(fabsf(den), emt);
            }
            __syncthreads();
            { LAS unsigned char* scr = F.lds + w * (32 * ML_KS);
#pragma unroll
              for (int dvt = 0; dvt < 4; ++dvt)
#pragma unroll
                for (int q = 0; q < 4; ++q) { v2u pk; pk.x = pk2(acc[dvt][4 * q] * hdiv, acc[dvt][4 * q + 1] * hdiv); pk.y = pk2(acc[dvt][4 * q + 2] * hdiv, acc[dvt][4 * q + 3] * hdiv);
                    *(LAS v2u*)(scr + r32 * ML_KS + (32 * dvt + 8 * q + 4 * h) * 2) = pk; }
              LDS_WAIT(); asm volatile("" ::: "memory");
              const size_t rowbase = (tok0 + 32 * w) * 1024 + hh * 256 + pass * 128;
#pragma unroll
              for (int i = 0; i < 8; ++i) { const int idx = i * 64 + lane_, row = idx >> 4, ch = idx & 15;
                  const v4u hv = *(const LAS v4u*)(scr + row * ML_KS + ch * 16); const v4u gv = *(const v4u*)(WSP(bf16, WS_OG) + rowbase + (size_t)row * 1024 + ch * 8);
                  v4u o;
#define GATE2(HW, GW) pk2(bflo(HW) * __builtin_amdgcn_rcpf(1.0f + __expf(-bflo(GW))), bfhi(HW) * __builtin_amdgcn_rcpf(1.0f + __expf(-bfhi(GW))))
                  o.x = GATE2(hv.x, gv.x); o.y = GATE2(hv.y, gv.y); o.z = GATE2(hv.z, gv.z); o.w = GATE2(hv.w, gv.w);
#undef GATE2
                  *(v4u*)(WSP(bf16, WS_QKP) + rowbase + (size_t)row * 1024 + ch * 8) = o; }
            }
        }
    }
    __syncthreads();
}
__device__ __forceinline__ void final_norm_phase(Frame& F) {
    const int gw = F.vcu * NWAVES + F.wave, NGW = F.G * NWAVES, lane = F.lane;
    const pg8::RowScale R{nullptr, WSP(float, WS_PSUM) + 3 * M};
    f32x4 gv[4];
#pragma unroll
    for (int j = 0; j < 4; ++j) gv[j] = ((const f32x4*)F.in[22])[lane + 64 * j];
    for (int m = gw; m < M; m += 2 * NGW) {
        const int m1 = m + NGW; const float rs0 = pg8::row_scale(R, m), rs1 = pg8::row_scale(R, m1);
        const v2u* h0 = (const v2u*)(WSP(bf16, WS_H16) + (size_t)m * D) + lane; const v2u* h1 = (const v2u*)(WSP(bf16, WS_H16) + (size_t)m1 * D) + lane;
        f32x4* x0 = (f32x4*)(F.out + (size_t)m * D) + lane; f32x4* x1 = (f32x4*)(F.out + (size_t)m1 * D) + lane;
        v2u w0[4], w1[4];
#pragma unroll
        for (int j = 0; j < 4; ++j) { w0[j] = h0[64 * j]; w1[j] = h1[64 * j]; }
#pragma unroll
        for (int j = 0; j < 4; ++j) { const f32x4 a0 = {bflo(w0[j].x), bfhi(w0[j].x), bflo(w0[j].y), bfhi(w0[j].y)}, a1 = {bflo(w1[j].x), bfhi(w1[j].x), bflo(w1[j].y), bfhi(w1[j].y)};
            x0[64 * j] = a0 * rs0 * gv[j]; x1[64 * j] = a1 * rs1 * gv[j]; } }
}
#ifndef SKIPMASK
#define SKIPMASK 0
#endif
#ifndef DUPMASK
#define DUPMASK 0

#endif
#define RUNP(n, call) do { if (!((SKIPMASK >> (n)) & 1)) { call; if ((DUPMASK >> (n)) & 1) { __syncthreads(); call; } } } while (0)
struct Args { const float* in[23]; float* out; unsigned char* ws; int ph_lo, ph_hi; };
__global__ void __launch_bounds__(NWAVES * 64, 2) mk_fwd(Args args) {
    extern __shared__ __attribute__((aligned(16))) unsigned char lds[];
    Frame F;
    F.lds = (LAS unsigned char*)lds;
    F.MISC = (volatile LAS unsigned*)(F.lds + MISC_OFF);
    F.tid = threadIdx.x; F.lane = F.tid & 63; F.wave = __builtin_amdgcn_readfirstlane(F.tid >> 6);
    F.G = gridDim.x; { const int bx = blockIdx.x; F.vcu = (F.G % 8 == 0) ? (bx % 8) * (F.G / 8) + bx / 8 : bx; }
    F.ws = args.ws; F.ctl = (gu32*)(args.ws + WS_CTL); F.out = args.out;
#pragma unroll
    for (int i = 0; i < 23; ++i) F.in[i] = args.in[i];
    for (int u = F.tid; u < (LDS_BYTES - LDSCTL_OFF) / 4; u += NWAVES * 64) ((LAS unsigned*)(F.lds + LDSCTL_OFF))[u] = 0u;
    __syncthreads();
    const int lo = args.ph_lo, hi = args.ph_hi;
    XcdBarrier bar; bar.bar = (unsigned*)(F.ctl + CW_BAR); bar.x = 0; bar.st = nullptr;
    if (hi - lo > 1) bar = xcd_barrier_post((unsigned*)(F.ctl + CW_BAR), F.MISC + 8);

#define IN(k) (lo <= (k) && (k) < hi)
    constexpr int RSL_UNITS = 14; LAS float* rsl = (LAS float*)(F.lds + RING_BYTES); static_assert(RING_BYTES + RSL_UNITS * 1024 <= LDSCTL_OFF, "row-scale table");
#define SEAM(k) do { if (IN(k) && IN((k) + 1)) xcd_barrier(bar); } while (0)
#define GEMM_PH(EPI, gg, ee) do { pg8::StaticOrder S_; S_.init(M, (gg).N, F.G, (int)blockIdx.x); pg8::gemm_phase<EPI, pg8::StaticOrder, PG8_ALIGN, PG8_SP2>(F.lds + RING_OFF, gg, S_, ee); } while (0)
#define RSL_FILL(NN, RSC) do { pg8::StaticOrder S_; S_.init(M, (NN), F.G, (int)blockIdx.x); pg8::Unit u_; \
        for (int i_ = 0; i_ < RSL_UNITS && S_.next(i_, u_); ++i_) if (F.tid < 256) rsl[i_ * 256 + F.tid] = pg8::row_scale(RSC, u_.pm * 256 + F.tid); \
        __syncthreads(); } while (0)
    if (IN(0)) { RUNP(0, p0_prologue(F)); } SEAM(0);
    if (IN(1)) { const pg8::Gemm g{WSP(bf16, WS_H16), WSP(bf16, WS_WAB), M, 2048, 1024};
        const pg8::RowScale rsc{WSP(float, WS_RS0), nullptr}; RSL_FILL(2048, rsc);
        const pg8::EpiScaleBf16 e{WSP(bf16, WS_QKV0), 2048, rsl, 0, 0};
        RUNP(21, GEMM_PH(pg8::EpiScaleBf16, g, e)); RUNP(19, gates0_phase(F)); } SEAM(1);
    if (IN(2)) { RUNP(2, compress_phase(F)); } SEAM(2);
    if (IN(3)) { RUNP(3, attention_phase(F)); } SEAM(3);
    if (IN(4)) { const pg8::Gemm g{WSP(bf16, WS_ATT), WSP(bf16, WS_WABO), M, 1024, 1024};
        const pg8::EpiResid e{F.in[0], WSP(bf16, WS_H16), WSP(float, WS_PSUM) + 0 * M, D};
        RUNP(22, GEMM_PH(pg8::EpiResid, g, e)); } SEAM(4);
    if (IN(5)) { const pg8::Gemm g{WSP(bf16, WS_H16), WSP(bf16, WS_WUP0), M, 5632, 1024};
        const pg8::RowScale rsc{nullptr, WSP(float, WS_PSUM) + 0 * M}; RSL_FILL(5632, rsc);
        const pg8::EpiSwiglu e{WSP(bf16, WS_HID), FF, rsl};
        RUNP(23, GEMM_PH(pg8::EpiSwiglu, g, e)); } SEAM(5);
    if (IN(6)) { const pg8::Gemm g{WSP(bf16, WS_HID), WSP(bf16, WS_WDN0), M, 1024, FF};
        const pg8::EpiResid e{nullptr, WSP(bf16, WS_H16), WSP(float, WS_PSUM) + 1 * M, D};
        RUNP(17, GEMM_PH(pg8::EpiResid, g, e)); } SEAM(6);
    if (IN(7)) { const pg8::Gemm g{WSP(bf16, WS_H16), WSP(bf16, WS_WCIN), M, 3072, 1024};
        const pg8::RowScale rsc{nullptr, WSP(float, WS_PSUM) + 1 * M}; RSL_FILL(3072, rsc);
        const pg8::EpiScaleBf16 e{WSP(bf16, WS_QKP), 1024, rsl, 1024, (size_t)(64 * MiB / 2)};
        RUNP(24, GEMM_PH(pg8::EpiScaleBf16, g, e)); RUNP(20, gates1_phase(F)); } SEAM(7);
    if (IN(8)) { RUNP(8, conv_scan_phase(F)); } SEAM(8);
    if (IN(9)) { RUNP(9, mlstm_p1_phase(F)); } SEAM(9);
    if (IN(10)) { RUNP(10, mlstm_scan_phase(F)); } SEAM(10);
    if (IN(11)) { RUNP(11, mlstm_p3_phase(F)); } SEAM(11);
    if (IN(12)) { const pg8::Gemm g{WSP(bf16, WS_QKP), WSP(bf16, WS_WCO), M, 1024, 1024};
        const pg8::EpiResid e{nullptr, WSP(bf16, WS_H16), WSP(float, WS_PSUM) + 2 * M, D};
        RUNP(17, GEMM_PH(pg8::EpiResid, g, e)); } SEAM(12);
    if (IN(13)) { const pg8::Gemm g{WSP(bf16, WS_H16), WSP(bf16, WS_WUP1), M, 5632, 1024};
        const pg8::RowScale rsc{nullptr, WSP(float, WS_PSUM) + 2 * M}; RSL_FILL(5632, rsc);
        const pg8::EpiSwiglu e{WSP(bf16, WS_HID), FF, rsl};
        RUNP(18, GEMM_PH(pg8::EpiSwiglu, g, e)); } SEAM(13);
    if (IN(14)) { const pg8::Gemm g{WSP(bf16, WS_HID), WSP(bf16, WS_WDN1), M, 1024, FF};
        const pg8::EpiResid e{nullptr, WSP(bf16, WS_H16), WSP(float, WS_PSUM) + 3 * M, D};
        RUNP(17, GEMM_PH(pg8::EpiResid, g, e)); } SEAM(14);
    if (IN(15)) { RUNP(15, final_norm_phase(F)); }
}

extern "C" void kernel_launch(void* const* d_in, const int* in_sizes, int n_in, void* d_out, int out_size, void* d_ws, size_t ws_size, hipStream_t stream) {
    static int grid = 0;
    if (grid == 0) {
        if (n_in != 23 || in_sizes[0] != M * D || out_size != M * D || ws_size < WS_END) { fprintf(stderr, "kernel_launch: shape/workspace mismatch (n_in %d, in0 %d, out %d, ws %zu, need %zu); nothing launched\n", n_in, n_in > 0 ? in_sizes[0] : -1, out_size, ws_size, (size_t)WS_END); grid = -1; return; }
        int dev = 0, cus = 0, per_cu = 0;
        if (hipGetDevice(&dev) != hipSuccess || hipDeviceGetAttribute(&cus, hipDeviceAttributeMultiprocessorCount, dev) != hipSuccess) { grid = -1; return; }
        if (hipFuncSetAttribute((const void*)mk_fwd, hipFuncAttributeMaxDynamicSharedMemorySize, LDS_BYTES) != hipSuccess) { fprintf(stderr, "kernel_launch: hipFuncSetAttribute failed\n"); grid = -1; return; }
        if (hipOccupancyMaxActiveBlocksPerMultiprocessor(&per_cu, (const void*)mk_fwd, NWAVES * 64, LDS_BYTES) != hipSuccess || per_cu < 1) { fprintf(stderr, "kernel_launch: occupancy query says %d blocks per CU\n", per_cu); per_cu = 1; }
        (void)hipGetLastError();
        grid = cus;
    }
    if (grid < 0) return;
    if (hipMemsetAsync((char*)d_ws + WS_CTL, 0, CTL_ZERO_BYTES, stream) != hipSuccess) { fprintf(stderr, "kernel_launch: memset failed\n"); return; }
    Args a{};
    for (int i = 0; i < 23; ++i) a.in[i] = (const float*)d_in[i];
    a.out = (float*)d_out; a.ws = (unsigned char*)d_ws;
#if MK_PER_PHASE
    for (int p = 0; p < NPHASE; ++p) { a.ph_lo = p; a.ph_hi = p + 1; hipLaunchKernelGGL(mk_fwd, dim3(grid), dim3(NWAVES * 64), LDS_BYTES, stream, a); }
#else
    a.ph_lo = 0; a.ph_hi = NPHASE;
    hipLaunchKernelGGL(mk_fwd, dim3(grid), dim3(NWAVES * 64), LDS_BYTES, stream, a);
#endif
    const hipError_t le = hipPeekAtLastError();
    if (le != hipSuccess) fprintf(stderr, "kernel_launch: launch failed: %s\n", hipGetErrorName(le));
}
```

```cpp
#include <hip/hip_runtime.h>
#include <cstdio>
#include <cstdint>
#include <cmath>
#define DUPMASK 0

namespace pg8 {
#define PG8_LAS __attribute__((address_space(3)))
typedef unsigned short bf16_t;
typedef short bf16x8 __attribute__((ext_vector_type(8)));
typedef float f32x4 __attribute__((ext_vector_type(4)));
typedef unsigned u32x4 __attribute__((ext_vector_type(4)));
constexpr int BM = 256, BK = 64, HALF = 128, HTB = HALF * BK * 2  , STAGE_BYTES = 8 * HTB, NXCD = 8, WGM = 8;

__host__ __device__ __forceinline__ int lds_byte(int r, int c) { const int st = (r >> 4) * 2 + (c >> 5), rr = r & 15, cc = c & 31, ob = rr * 64 + cc * 2; return st * 1024 + (ob ^ (((ob >> 9) & 1) << 5)); }
__host__ __device__ __forceinline__ void stage_rc(int b, int& R, int& C) { const int st = b / 1024, sb = b % 1024, swz = sb ^ (((sb >> 9) & 1) << 5); R = (st >> 1) * 16 + swz / 64; C = (st & 1) * 32 + (swz % 64) / 2; }
__host__ __device__ __forceinline__ int perm32(int rho) { const int n = rho >> 4, i = rho & 15; return 8 * (i >> 2) + 4 * n + (i & 3); }

struct Unit { int pm, pn; };
struct Gemm { const bf16_t* A; const bf16_t* Bt; int M, N, K; };

struct StaticOrder {
    int nM, nN, nwg, G, c;
    __host__ __device__ __forceinline__ void init(int M, int N, int G_, int c_) { nM = M / BM; nN = N / BM; nwg = nM * nN; G = G_; c = c_; }
    __host__ __device__ __forceinline__ bool next(int i, Unit& u) const {
        const long L = (long)i * G + c; if (L >= nwg) return false;
        int wgid = (int)L; { const int q = nwg / NXCD, r = nwg % NXCD, xcd = wgid % NXCD, off = wgid / NXCD; wgid = (xcd < r ? xcd * (q + 1) : r * (q + 1) + (xcd - r) * q) + off; }
        const int nig = WGM * nN, gid = wgid / nig, fm = gid * WGM, gsz = (nM - fm) < WGM ? (nM - fm) : WGM;
        u.pm = fm + ((wgid % nig) % gsz); u.pn = (wgid % nig) / gsz; return true;
    }
    __device__ __forceinline__ void a_ready(const Unit&) const {}
    __device__ __forceinline__ void done(const Unit&) const {}
};

__device__ __forceinline__ unsigned cvt_pk_bf16(float lo, float hi) { unsigned r; asm volatile("v_cvt_pk_bf16_f32 %0, %1, %2" : "=v"(r) : "v"(lo), "v"(hi)); return r; }
typedef float f32x2 __attribute__((ext_vector_type(2)));
constexpr int MROWS = 32768;
constexpr float RMS_EPS_F = 1e-6f;
struct RowScale { const float* rs; const float* ss; };
__device__ __forceinline__ float row_scale(const RowScale& R, int row) {
    if (R.ss) return 1.0f / sqrtf(R.ss[row] * (1.0f / 1024.0f) + RMS_EPS_F);
    return R.rs[row];
}
struct EpiScaleBf16 {
    static constexpr bool PERM = true, AFTER_DRAIN = false;
    bf16_t* O; int ldc; const PG8_LAS float* rsl; int split_cols; size_t split_stride;
    bf16_t* hm; int hm_pn0;
    __device__ __forceinline__ void operator()(const f32x4 (&acc)[2][2][4][2], const Unit& u, int ui, int wr, int wc, int fr, int fq) const {
        int row0 = u.pm * BM + wr * 64 + fr; int colt = u.pn * BM; bf16_t* base = O; const PG8_LAS float* rsu = rsl + ui * BM + wr * 64 + fr; int ld = ldc;
        if (hm && u.pn >= hm_pn0) {
            const int hp_ = u.pn - hm_pn0, bt = row0 >> 13; base = hm + ((size_t)(((hp_ >> 2) * 4 + bt) * 4 + (hp_ & 3)) << 13) * 256; row0 &= 8191; colt = 0; ld = 256;
        } else if (split_cols) { const int t = colt / split_cols; base += (size_t)t * split_stride; colt -= t * split_cols; }
        const int col0 = colt + wc * 32 + 8 * fq;
#pragma unroll
        for (int ai = 0; ai < 2; ++ai)
#pragma unroll
            for (int m = 0; m < 4; ++m) { const int row = row0 + ai * HALF + m * 16; const float sc = rsu[ai * HALF + m * 16]; bf16_t* rowp = base + (size_t)row * ld + col0;
#pragma unroll
                for (int bj = 0; bj < 2; ++bj) { f32x4 v0 = acc[ai][bj][m][0] * sc, v1 = acc[ai][bj][m][1] * sc;
                    u32x4 w; w.x = cvt_pk_bf16(v0[0], v0[1]); w.y = cvt_pk_bf16(v0[2], v0[3]); w.z = cvt_pk_bf16(v1[0], v1[1]); w.w = cvt_pk_bf16(v1[2], v1[3]);
                    *(u32x4*)(rowp + bj * HALF) = w; } }
    }
};
struct EpiSwiglu {
    static constexpr bool PERM = true, AFTER_DRAIN = false;
    bf16_t* O; int ldc; const PG8_LAS float* rsl;
    __device__ __forceinline__ void operator()(const f32x4 (&acc)[2][2][4][2], const Unit& u, int ui, int wr, int wc, int fr, int fq) const {
        const int row0 = u.pm * BM + wr * 64 + fr; const int col0 = u.pn * HALF + wc * 32 + 8 * fq; const PG8_LAS float* rsu = rsl + ui * BM + wr * 64 + fr;
#pragma unroll
        for (int ai = 0; ai < 2; ++ai)
#pragma unroll
            for (int m = 0; m < 4; ++m) { const int row = row0 + ai * HALF + m * 16; const float sc = rsu[ai * HALF + m * 16]; bf16_t* rowp = O + (size_t)row * ldc + col0;
                float o[8];
#pragma unroll
                for (int n = 0; n < 2; ++n)
#pragma unroll
                    for (int e = 0; e < 4; ++e) { const float g = acc[ai][0][m][n][e] * sc, up = acc[ai][1][m][n][e] * sc; o[n * 4 + e] = g * up * __builtin_amdgcn_rcpf(1.0f + __expf(-g)); }
                u32x4 w; w.x = cvt_pk_bf16(o[0], o[1]); w.y = cvt_pk_bf16(o[2], o[3]); w.z = cvt_pk_bf16(o[4], o[5]); w.w = cvt_pk_bf16(o[6], o[7]);
                *(u32x4*)rowp = w; }
    }
};
struct EpiResid {
    static constexpr bool PERM = true, AFTER_DRAIN = false;
    const float* basef; bf16_t* h16; float* ss; int ldc;
    __device__ __forceinline__ void operator()(const f32x4 (&acc)[2][2][4][2], const Unit& u, int ui, int wr, int wc, int fr, int fq) const {
        const int row0 = u.pm * BM + wr * 64 + fr, col0 = u.pn * BM + wc * 32 + 8 * fq;
        if (basef) {
#pragma unroll
            for (int ai = 0; ai < 2; ++ai) {
                f32x4 pre[4][2][2];
#pragma unroll
                for (int m = 0; m < 4; ++m) { const size_t off = (size_t)(row0 + ai * HALF + m * 16) * ldc + col0;
#pragma unroll
                    for (int bj = 0; bj < 2; ++bj)
#pragma unroll
                        for (int n = 0; n < 2; ++n) pre[m][bj][n] = *(const f32x4*)(basef + off + bj * HALF + n * 4); }
#pragma unroll
                for (int m = 0; m < 4; ++m) { const int row = row0 + ai * HALF + m * 16; const size_t off = (size_t)row * ldc + col0; float sq = 0.f;
#pragma unroll
                    for (int bj = 0; bj < 2; ++bj) { const f32x4 o0 = pre[m][bj][0] + acc[ai][bj][m][0], o1 = pre[m][bj][1] + acc[ai][bj][m][1];
                        sq += ((o0[0] * o0[0] + o0[1] * o0[1]) + (o0[2] * o0[2] + o0[3] * o0[3])) + ((o1[0] * o1[0] + o1[1] * o1[1]) + (o1[2] * o1[2] + o1[3] * o1[3]));
                        u32x4 w; w.x = cvt_pk_bf16(o0[0], o0[1]); w.y = cvt_pk_bf16(o0[2], o0[3]); w.z = cvt_pk_bf16(o1[0], o1[1]); w.w = cvt_pk_bf16(o1[2], o1[3]);
                        *(u32x4*)(h16 + off + bj * HALF) = w; }
                    sq += __shfl_xor(sq, 16); sq += __shfl_xor(sq, 32);
                    if (fq == 0) atomicAdd(ss + row, sq); }
            }
        } else {
            u32x4 pre[2][4][2];
#pragma unroll
            for (int ai = 0; ai < 2; ++ai)
#pragma unroll
                for (int m = 0; m < 4; ++m) { const size_t off = (size_t)(row0 + ai * HALF + m * 16) * ldc + col0;
#pragma unroll
                    for (int bj = 0; bj < 2; ++bj) pre[ai][m][bj] = *(const u32x4*)(h16 + off + bj * HALF); }
#pragma unroll
            for (int ai = 0; ai < 2; ++ai)
#pragma unroll
                for (int m = 0; m < 4; ++m) { const int row = row0 + ai * HALF + m * 16; const size_t off = (size_t)row * ldc + col0; float sq = 0.f;
#pragma unroll
                    for (int bj = 0; bj < 2; ++bj) { const u32x4 pw = pre[ai][m][bj];
                        const f32x4 o0 = (f32x4){__builtin_bit_cast(float, pw.x << 16), __builtin_bit_cast(float, pw.x & 0xffff0000u), __builtin_bit_cast(float, pw.y << 16), __builtin_bit_cast(float, pw.y & 0xffff0000u)} + acc[ai][bj][m][0];
                        const f32x4 o1 = (f32x4){__builtin_bit_cast(float, pw.z << 16), __builtin_bit_cast(float, pw.z & 0xffff0000u), __builtin_bit_cast(float, pw.w << 16), __builtin_bit_cast(float, pw.w & 0xffff0000u)} + acc[ai][bj][m][1];
                        sq += ((o0[0] * o0[0] + o0[1] * o0[1]) + (o0[2] * o0[2] + o0[3] * o0[3])) + ((o1[0] * o1[0] + o1[1] * o1[1]) + (o1[2] * o1[2] + o1[3] * o1[3]));
                        u32x4 w; w.x = cvt_pk_bf16(o0[0], o0[1]); w.y = cvt_pk_bf16(o0[2], o0[3]); w.z = cvt_pk_bf16(o1[0], o1[1]); w.w = cvt_pk_bf16(o1[2], o1[3]);
                        *(u32x4*)(h16 + off + bj * HALF) = w; }
                    sq += __shfl_xor(sq, 16); sq += __shfl_xor(sq, 32);
                    if (fq == 0) atomicAdd(ss + row, sq); }
        }
    }
};
template <class Epi, class Sched, bool ALIGN_EPI = false, bool SP2 = false>
__device__ __forceinline__ void gemm_phase(PG8_LAS unsigned char* lds, const Gemm g, const Sched& S, const Epi& E) {
    const int tid = threadIdx.x, wid = __builtin_amdgcn_readfirstlane(tid >> 6), lane = tid & 63, wr = wid >> 2, wc = wid & 3, fr = lane & 15, fq = lane >> 4;
    const int K = g.K, nt = K / BK;
    unsigned voffA[2], voffB[2];
#pragma unroll
    for (int i = 0; i < 2; ++i) { int R, C; stage_rc(tid * 16 + i * 8192, R, C); const int Rb = Epi::PERM ? ((R & ~31) + perm32(R & 31)) : R;
        voffA[i] = (unsigned)(R * K + C) * 2u; voffB[i] = (unsigned)(Rb * K + C) * 2u; }
    const size_t kstep = (size_t)(BK * 2);
    const size_t hstep = (size_t)HALF * K * 2;
    const size_t tstep = 2 * hstep;
    const unsigned ldsw = (unsigned)wid * 1024u;
    const int aoff = lds_byte(wr * 64 + fr, fq * 8), boff = lds_byte(wc * 32 + fr, fq * 8);
#define PG8_SA(b, h) (((b) * 2 + (h)) * HTB)
#define PG8_SB(b, h) ((4 + (b) * 2 + (h)) * HTB)
#define PG8_STAGE(bufoff, gbase, voff) do { _Pragma("unroll") for (int _i = 0; _i < 2; ++_i) \
        __builtin_amdgcn_global_load_lds((const unsigned*)((const char*)(gbase) + (voff)[_i]), (PG8_LAS unsigned*)(lds + (bufoff) + ldsw + _i * 8192), 16, 0, 0); } while (0)
#define PG8_LDA(dst, b, h) do { _Pragma("unroll") for (int m = 0; m < 4; ++m) _Pragma("unroll") for (int k = 0; k < 2; ++k) dst[m][k] = *(const PG8_LAS bf16x8*)(lds + PG8_SA(b, h) + aoff + m * 2048 + k * 1024); } while (0)
#define PG8_LDB(dst, b, h) do { _Pragma("unroll") for (int n = 0; n < 2; ++n) _Pragma("unroll") for (int k = 0; k < 2; ++k) dst[n][k] = *(const PG8_LAS bf16x8*)(lds + PG8_SB(b, h) + boff + n * 2048 + k * 1024); } while (0)
#define PG8_MMA(ai, bj, At, Bt) do { __builtin_amdgcn_s_setprio(1); _Pragma("unroll") for (int m = 0; m < 4; ++m) _Pragma("unroll") for (int n = 0; n < 2; ++n) _Pragma("unroll") for (int k = 0; k < 2; ++k) \
        acc[ai][bj][m][n] = __builtin_amdgcn_mfma_f32_16x16x32_bf16(Bt[n][k], At[m][k], acc[ai][bj][m][n], 0, 0, 0); __builtin_amdgcn_s_setprio(0); } while (0)
#define PG8_WAIT_V(n) asm volatile("s_waitcnt vmcnt(" #n ")" ::: "memory")
#define PG8_WAIT_L(n) asm volatile("s_waitcnt lgkmcnt(" #n ")" ::: "memory")
#define PG8_BAR __builtin_amdgcn_s_barrier()
#define PG8_SCHED __builtin_amdgcn_sched_barrier(0)
    Unit cur, nxt; int ui = 0;
    if (!S.next(0, cur)) return;
    f32x4 acc[2][2][4][2];
#pragma unroll
    for (int a = 0; a < 2; ++a)
#pragma unroll
        for (int b = 0; b < 2; ++b)
#pragma unroll
            for (int m = 0; m < 4; ++m)
#pragma unroll
                for (int n = 0; n < 2; ++n) acc[a][b][m][n] = (f32x4){0.f, 0.f, 0.f, 0.f};
    bf16x8 At[4][2], B0[2][2], B1[2][2];
    const char* cA = (const char*)g.A + (size_t)cur.pm * tstep; const char* cB = (const char*)g.Bt + (size_t)cur.pn * tstep;
    S.a_ready(cur);
    if constexpr (SP2) {
        PG8_STAGE(PG8_SB(0, 0), cB, voffB); PG8_STAGE(PG8_SB(0, 1), cB + hstep, voffB); PG8_STAGE(PG8_SA(0, 0), cA, voffA); PG8_STAGE(PG8_SA(0, 1), cA + hstep, voffA);
        if (wr == 1) PG8_BAR;
        PG8_WAIT_V(2); PG8_BAR;
        PG8_STAGE(PG8_SB(1, 0), cB + kstep, voffB); PG8_STAGE(PG8_SA(1, 0), cA + kstep, voffA); PG8_STAGE(PG8_SB(1, 1), cB + hstep + kstep, voffB);
        PG8_WAIT_V(6); PG8_BAR;
    } else {
        PG8_STAGE(PG8_SB(0, 0), cB, voffB); PG8_STAGE(PG8_SA(0, 0), cA, voffA); PG8_STAGE(PG8_SB(0, 1), cB + hstep, voffB); PG8_STAGE(PG8_SA(0, 1), cA + hstep, voffA);
        if (wr == 1) PG8_BAR;
        PG8_WAIT_V(4); PG8_BAR;
        PG8_STAGE(PG8_SB(1, 0), cB + kstep, voffB); PG8_STAGE(PG8_SA(1, 0), cA + kstep, voffA); PG8_STAGE(PG8_SB(1, 1), cB + hstep + kstep, voffB);
        PG8_WAIT_V(6); PG8_BAR;
    }
    for (;;) {
        const bool has_next = S.next(ui + 1, nxt);
        const char* nA = has_next ? (const char*)g.A + (size_t)nxt.pm * tstep : cA; const char* nB = has_next ? (const char*)g.Bt + (size_t)nxt.pn * tstep : cB;
        for (int t = 0; t < nt; t += 2) {
            const bool last = (t == nt - 2);
            const char* a1 = cA + (size_t)(t + 1) * kstep;
            const char* a2 = last ? nA : cA + (size_t)(t + 2) * kstep; const char* b2 = last ? nB : cB + (size_t)(t + 2) * kstep;
            const char* a3 = a2 + kstep; const char* b3 = b2 + kstep;
            if (last && has_next) S.a_ready(nxt);
            if constexpr (SP2) {
            PG8_LDB(B0, 0, 0); PG8_LDB(B1, 0, 1); PG8_SCHED; PG8_LDA(At, 0, 0); PG8_STAGE(PG8_SA(1, 1), a1 + hstep, voffA);
            PG8_WAIT_V(8); PG8_WAIT_L(0); PG8_BAR; PG8_MMA(0, 0, At, B0); PG8_MMA(0, 1, At, B1); PG8_BAR; PG8_SCHED;
            PG8_LDA(At, 0, 1); PG8_STAGE(PG8_SB(0, 0), b2, voffB); PG8_STAGE(PG8_SB(0, 1), b2 + hstep, voffB); PG8_STAGE(PG8_SA(0, 0), a2, voffA);
            PG8_WAIT_V(8); PG8_WAIT_L(0); PG8_BAR; PG8_MMA(1, 0, At, B0); PG8_MMA(1, 1, At, B1); PG8_BAR; PG8_SCHED;
            PG8_LDB(B0, 1, 0); PG8_LDB(B1, 1, 1); PG8_SCHED; PG8_LDA(At, 1, 0); PG8_STAGE(PG8_SA(0, 1), a2 + hstep, voffA);
            PG8_WAIT_V(8); PG8_WAIT_L(0); PG8_BAR; PG8_MMA(0, 0, At, B0); PG8_MMA(0, 1, At, B1); PG8_BAR; PG8_SCHED;
            PG8_LDA(At, 1, 1); PG8_STAGE(PG8_SB(1, 0), b3, voffB); PG8_STAGE(PG8_SB(1, 1), b3 + hstep, voffB); PG8_STAGE(PG8_SA(1, 0), a3, voffA);
            PG8_WAIT_V(8); PG8_WAIT_L(0); PG8_BAR; PG8_MMA(1, 0, At, B0); PG8_MMA(1, 1, At, B1); PG8_BAR; PG8_SCHED;
            } else {
            PG8_LDB(B0, 0, 0); PG8_SCHED; PG8_LDA(At, 0, 0); PG8_STAGE(PG8_SA(1, 1), a1 + hstep, voffA);
            PG8_WAIT_L(8); PG8_BAR; PG8_WAIT_L(0); PG8_MMA(0, 0, At, B0); PG8_BAR; PG8_SCHED;
            PG8_LDB(B1, 0, 1); PG8_STAGE(PG8_SB(0, 0), b2, voffB);
            PG8_BAR; PG8_WAIT_L(0); PG8_MMA(0, 1, At, B1); PG8_BAR;
            PG8_LDA(At, 0, 1); PG8_STAGE(PG8_SA(0, 0), a2, voffA);
            PG8_BAR; PG8_WAIT_L(0); PG8_MMA(1, 0, At, B0); PG8_BAR; PG8_SCHED;
            PG8_STAGE(PG8_SB(0, 1), b2 + hstep, voffB);
            PG8_WAIT_V(6); PG8_BAR; PG8_MMA(1, 1, At, B1); PG8_BAR;
            PG8_LDB(B0, 1, 0); PG8_SCHED; PG8_LDA(At, 1, 0); PG8_STAGE(PG8_SA(0, 1), a2 + hstep, voffA);
            PG8_WAIT_L(8); PG8_BAR; PG8_WAIT_L(0); PG8_MMA(0, 0, At, B0); PG8_BAR; PG8_SCHED;
            PG8_LDB(B1, 1, 1); PG8_STAGE(PG8_SB(1, 0), b3, voffB);
            PG8_BAR; PG8_WAIT_L(0); PG8_MMA(0, 1, At, B1); PG8_BAR;
            PG8_LDA(At, 1, 1); PG8_STAGE(PG8_SA(1, 0), a3, voffA);
            PG8_BAR; PG8_WAIT_L(0); PG8_MMA(1, 0, At, B0); PG8_BAR; PG8_SCHED;
            PG8_STAGE(PG8_SB(1, 1), b3 + hstep, voffB);
            PG8_WAIT_V(6); PG8_BAR; PG8_MMA(1, 1, At, B1); PG8_BAR;
            }
        }
        if constexpr (ALIGN_EPI) { if (wr == 0) PG8_BAR; }
        if constexpr (!Epi::AFTER_DRAIN) { E(acc, cur, ui, wr, wc, fr, fq); S.done(cur); }
        if (!has_next) break;
#pragma unroll
        for (int a = 0; a < 2; ++a)
#pragma unroll
            for (int b = 0; b < 2; ++b)
#pragma unroll
                for (int m = 0; m < 4; ++m)
#pragma unroll
                    for (int n = 0; n < 2; ++n) acc[a][b][m][n] = (f32x4){0.f, 0.f, 0.f, 0.f};
        cur = nxt; cA = nA; cB = nB; ++ui;
        if constexpr (ALIGN_EPI) { if (wr == 1) PG8_BAR; }
    }
    PG8_WAIT_V(0);
    if constexpr (!ALIGN_EPI) { if (wr == 0) PG8_BAR; }
    PG8_BAR;
    if constexpr (Epi::AFTER_DRAIN) { E.fused(acc, cur, wr, wc, fr, fq, lds, wid, lane); S.done(cur); }
#undef PG8_SA
#undef PG8_SB
#undef PG8_STAGE
#undef PG8_LDA
#undef PG8_LDB
#undef PG8_MMA
#undef PG8_WAIT_V
#undef PG8_WAIT_L
#undef PG8_BAR
#undef PG8_SCHED
}
}
#ifndef PG8_SP2
#define PG8_SP2 true
#endif
#ifndef PG8_ALIGN
#define PG8_ALIGN true
#endif
constexpr int NWAVES = 8;
#ifndef MK_PER_PHASE
#define MK_PER_PHASE 0
#endif
constexpr int NPHASE = 16;

constexpr int BATCH = 4, T = 8192, D = 1024, M = BATCH * T, FF = 2816;
constexpr int AB_LD = 2072, C_LD = 3080;
constexpr float C2 = 0.125f * 1.4426950408889634f;
constexpr float LOG2E = 1.4426950408889634f;
constexpr int QC_QN = 0, QC_KC = 512, QC_VC = 640, QC_KS = 768, QC_VS = 896, QC_KW = 1024, QC_VW = 1152, QC_QS = 1280, QC_KSW = 1792, QC_VSW = 1920;

constexpr size_t MiB = 1u << 20, KiB = 1024;
constexpr size_t WS_CTL = 0, CTL_ZERO_BYTES = 64 * KiB;
constexpr size_t WS_RS0 = 1 * MiB;
constexpr size_t WS_PSUM = WS_RS0 + 128 * KiB;
constexpr size_t WS_GATES = WS_PSUM + 2 * MiB;
constexpr size_t WS_SCA = WS_GATES + 4 * MiB;
constexpr size_t WS_SCM = WS_SCA + 512 * KiB;
constexpr size_t WS_SCE = WS_SCM + 512 * KiB;
constexpr size_t WS_KC = WS_SCE + 512 * KiB;
constexpr size_t WS_VC = WS_KC + 512 * KiB;
constexpr size_t WS_WABG = WS_VC + 512 * KiB;
constexpr size_t WS_WCG = WS_WABG + 64 * KiB;
constexpr size_t WS_CW1K = WS_WCG + 64 * KiB;
constexpr size_t WS_CW1V = WS_CW1K + 256 * KiB;
constexpr size_t WS_CW2K = WS_CW1V + 256 * KiB;
constexpr size_t WS_CW2V = WS_CW2K + 8 * KiB;
constexpr size_t WS_CBIAS = WS_CW2V + 8 * KiB;
constexpr size_t WS_NLOC = WS_CBIAS + 4 * KiB;
constexpr size_t WS_NST = WS_NLOC + 256 * KiB;
static_assert(WS_NST + 256 * KiB <= 13 * MiB, "small region");
constexpr size_t WS_WAB = 13 * MiB;
constexpr size_t WS_WABO = WS_WAB + 4 * MiB;
constexpr size_t WS_WUP0 = WS_WABO + 2 * MiB;
constexpr size_t WS_WUP1 = WS_WUP0 + 11 * MiB;
constexpr size_t WS_WDN0 = WS_WUP1 + 11 * MiB;
constexpr size_t WS_WDN1 = WS_WDN0 + 5632 * KiB;
constexpr size_t WS_WCIN = WS_WDN1 + 5632 * KiB;
constexpr size_t WS_WCO = WS_WCIN + 6 * MiB;
static_assert(WS_WCO + 2 * MiB <= 60 * MiB, "weights region");
constexpr size_t WS_H16 = 60 * MiB;
constexpr size_t WS_A = 124 * MiB;
constexpr size_t WS_QKV0 = WS_A, WS_ATT = WS_A + 128 * MiB;
constexpr size_t WS_QKP = WS_A, WS_V1 = WS_A + 64 * MiB, WS_OG = WS_A + 128 * MiB;
constexpr size_t WS_B = 316 * MiB;
constexpr size_t WS_HID = WS_B;
constexpr size_t WS_ACCF = WS_B;
constexpr size_t WS_CBPART = WS_B;
constexpr size_t WS_QKC = WS_B, WS_LT = WS_B + 64 * MiB, WS_CST = WS_B + 128 * MiB;
constexpr size_t WS_END = 492 * MiB;
static_assert(WS_HID + (size_t)M * FF * 2 <= WS_END && WS_CST + 32 * MiB <= WS_END, "d_ws map");
constexpr int CW_TMO = 0, CW_CODE = 1, CW_CBIAS = 1024, CW_QUEUE = 2048;
constexpr int CW_BAR = 4096;

constexpr int RING_OFF = 0, RING_BYTES = 131072;
constexpr int LDS_BYTES = 147456;
constexpr int LDSCTL_OFF = LDS_BYTES - 1024, MISC_OFF = LDSCTL_OFF + 320;
static_assert(MISC_OFF + 128 <= LDS_BYTES, "LDS map");

#define GAS __attribute__((address_space(1)))
#define LAS __attribute__((address_space(3)))
typedef unsigned short bf16;
typedef unsigned v4u __attribute__((ext_vector_type(4)));
typedef unsigned v2u __attribute__((ext_vector_type(2)));
typedef float f32x4 __attribute__((ext_vector_type(4)));
typedef float f32x16 __attribute__((ext_vector_type(16)));
typedef short bf16x8 __attribute__((ext_vector_type(8)));
typedef short s16x4 __attribute__((ext_vector_type(4)));
typedef GAS unsigned gu32;
typedef GAS unsigned long long gu64;
#define RLX_AGENT __ATOMIC_RELAXED, __HIP_MEMORY_SCOPE_AGENT
#define LDS_WAIT() asm volatile("s_waitcnt lgkmcnt(0)" ::: "memory")
#define VM_WAIT() asm volatile("s_waitcnt vmcnt(0)" ::: "memory")
__device__ __forceinline__ unsigned f2bf(float f) { unsigned u = __builtin_bit_cast(unsigned, f); return (u + 0x7fffu + ((u >> 16) & 1u)) >> 16; }
typedef float f32x2_t __attribute__((ext_vector_type(2))); typedef __bf16 bf16x2_t __attribute__((ext_vector_type(2)));
__device__ __forceinline__ unsigned cvtpk(float lo, float hi) { f32x2_t v = {lo, hi}; bf16x2_t b = __builtin_convertvector(v, bf16x2_t); return __builtin_bit_cast(unsigned, b); }
__device__ __forceinline__ unsigned pk2(float lo, float hi) { return cvtpk(lo, hi); }
__device__ __forceinline__ float bf2f(unsigned short b) { return __builtin_bit_cast(float, (unsigned)b << 16); }
__device__ __forceinline__ float bflo(unsigned w) { return __builtin_bit_cast(float, w << 16); }
__device__ __forceinline__ float bfhi(unsigned w) { return __builtin_bit_cast(float, w & 0xffff0000u); }
__device__ __forceinline__ int crow(int r, int hi) { return (r & 3) + 8 * (r >> 2) + 4 * hi; }
__device__ __forceinline__ f32x16 mfma32(bf16x8 a, bf16x8 b, f32x16 c) { return __builtin_amdgcn_mfma_f32_32x32x16_bf16(a, b, c, 0, 0, 0); }
typedef short v4i16_t __attribute__((ext_vector_type(4)));
__device__ __forceinline__ s16x4 ds_tr(LAS unsigned char* p) { return __builtin_bit_cast(s16x4, __builtin_amdgcn_ds_read_tr16_b64_v4i16((LAS v4i16_t*)p)); }
__device__ __forceinline__ bf16x8 frag_tr(LAS unsigned char* lb, int off0, int off1) {
    const s16x4 lo = ds_tr(lb + off0), hi = ds_tr(lb + off1);
    return (bf16x8){lo[0], lo[1], lo[2], lo[3], hi[0], hi[1], hi[2], hi[3]};
}
template <int s> __device__ __forceinline__ bf16x8 pack8(const f32x16& p) {
    v4u w; w.x = cvtpk(p[8 * s + 0], p[8 * s + 1]); w.y = cvtpk(p[8 * s + 2], p[8 * s + 3]); w.z = cvtpk(p[8 * s + 4], p[8 * s + 5]); w.w = cvtpk(p[8 * s + 6], p[8 * s + 7]);
    return __builtin_bit_cast(bf16x8, w);
}
__device__ __forceinline__ float wave_sum(float v) {
#pragma unroll
    for (int o = 1; o < 64; o <<= 1) v += __shfl_xor(v, o);
    return v;
}
#define XB_TMO      128
#define XB_XCNT(j)  (256  + 64 * (j))
#define XB_XSUB(j)  (1280 + 64 * (j))
#define XB_XGEN(j)  (2304 + 64 * (j))
#define XB_TOP      3328
#define XB_TOPGEN   3392
#define XCD_BAR_WORDS 3456
#define XB_SPIN_CAP (1u << 18)

__device__ __forceinline__ unsigned xb_ld(unsigned* p)              { return __hip_atomic_load(p, __ATOMIC_RELAXED, __HIP_MEMORY_SCOPE_AGENT); }
__device__ __forceinline__ unsigned xb_add(unsigned* p, unsigned v) { return __hip_atomic_fetch_add(p, v, __ATOMIC_RELAXED, __HIP_MEMORY_SCOPE_AGENT); }
__device__ __forceinline__ unsigned xb_xcc_id() { return (unsigned)__builtin_amdgcn_s_getreg((3 << 11) | 20) & 0xFu; }
#define XB_SPIN(cond, bar) do { unsigned _sp = 0; while (cond) { __builtin_amdgcn_s_sleep(1); \
    if ((++_sp & 255u) == 0u) { if (xb_ld(&(bar)[XB_TMO])) break; if (_sp > XB_SPIN_CAP) { atomicAdd(&(bar)[XB_TMO], 1u); break; } } } } while (0)

struct XcdBarrier {
    unsigned* bar; unsigned x;
    volatile LAS unsigned* st;
};

__device__ __forceinline__ XcdBarrier xcd_barrier_post(unsigned* bar, volatile LAS unsigned* st) {
    XcdBarrier b; b.bar = bar; b.x = xb_xcc_id(); b.st = st;
    if (threadIdx.x == 0) (void)xb_add(&bar[XB_XCNT(b.x)], 1u);
    return b;
}
__device__ __forceinline__ void xcd_barrier_complete(unsigned* bar, unsigned x, unsigned& nloc, unsigned& nx) {
    const unsigned G = gridDim.x * gridDim.y * gridDim.z;
    unsigned sum, cnt, mine, sp = 0u;
    for (;;) {
        sum = 0u; cnt = 0u; mine = 0u;
#pragma unroll
        for (unsigned j = 0; j < 16; ++j) { const unsigned c = xb_ld(&bar[XB_XCNT(j)]); sum += c; cnt += (c > 0u) ? 1u : 0u; mine = (j == x) ? c : mine; }
        if (sum == G) break;
        __builtin_amdgcn_s_sleep(1);
        if ((++sp & 255u) == 0u) { if (xb_ld(&bar[XB_TMO])) break; if (sp > XB_SPIN_CAP) { atomicAdd(&bar[XB_TMO], 1u); break; } }
    }
    nloc = mine > 0u ? mine : 1u; nx = cnt > 0u ? cnt : 1u;
}

__device__ __forceinline__ void xcd_barrier(const XcdBarrier& b) {
    asm volatile("s_waitcnt vmcnt(0)" ::: "memory");
    __syncthreads();
    if (threadIdx.x == 0) {
        unsigned* bar = b.bar;
        __builtin_amdgcn_s_waitcnt(0);
        unsigned nloc = b.st[0], nx = b.st[1];
        if (nloc == 0u) { xcd_barrier_complete(bar, b.x, nloc, nx); b.st[0] = nloc; b.st[1] = nx; }
        const unsigned old = xb_add(&bar[XB_XSUB(b.x)], 1u);
        const unsigned gen = old / nloc;
        if (old + 1u == (gen + 1u) * nloc) {
            __builtin_amdgcn_fence(__ATOMIC_RELEASE, "agent");
            asm volatile("s_waitcnt vmcnt(0)" ::: "memory");
            const unsigned og = xb_add(&bar[XB_TOP], 1u);
            const unsigned tg = og / nx;
            if (og + 1u == (tg + 1u) * nx) xb_add(&bar[XB_TOPGEN], 1u);
            else XB_SPIN(xb_ld(&bar[XB_TOPGEN]) == tg, bar);
            __builtin_amdgcn_fence(__ATOMIC_ACQUIRE, "agent");
            xb_add(&bar[XB_XGEN(b.x)], 1u);
            asm volatile("s_waitcnt vmcnt(0)" ::: "memory");
        } else {
            XB_SPIN(xb_ld(&bar[XB_XGEN(b.x)]) == gen, bar);
            __builtin_amdgcn_fence(__ATOMIC_ACQUIRE, "agent");
            asm volatile("s_waitcnt vmcnt(0)" ::: "memory");
        }
    }
    __syncthreads();
}
struct Frame {
    LAS unsigned char* lds;
    volatile LAS unsigned* MISC;
    gu32* ctl;
    int tid, lane, wave;
    int vcu, G;
    unsigned char* ws;
    const float* in[23];
    float* out;
};
#define WSP(T_, off) ((T_*)(F.ws + (off)))

__device__ __forceinline__ void p0_titem(const float* W, int ldw, int c0, const float* kscale, float mul, bf16* WT, int Kd, int drow0, LAS float* scr, int kb, int lane) {
    const int k0 = 64 * kb; f32x4 v[8];
    if ((c0 & 3) == 0 && (ldw & 3) == 0) {
#pragma unroll
        for (int i = 0; i < 8; ++i) { const int kk = 8 * i + (lane >> 3); v[i] = __builtin_nontemporal_load((const f32x4*)(W + (size_t)(k0 + kk) * ldw + c0 + 4 * (lane & 7))); }
    } else {
#pragma unroll
        for (int i = 0; i < 8; ++i) { const int kk = 8 * i + (lane >> 3); const float* p = W + (size_t)(k0 + kk) * ldw + c0 + 4 * (lane & 7); v[i] = (f32x4){p[0], p[1], p[2], p[3]}; }
    }
#pragma unroll
    for (int i = 0; i < 8; ++i) { const int kk = 8 * i + (lane >> 3); const float sc = (kscale ? kscale[k0 + kk] : 1.0f) * mul; LAS float* d = scr + kk * 33 + 4 * (lane & 7);
        d[0] = v[i][0] * sc; d[1] = v[i][1] * sc; d[2] = v[i][2] * sc; d[3] = v[i][3] * sc; }
    LDS_WAIT(); asm volatile("" ::: "memory");
    const int c = lane & 7;
#pragma unroll
    for (int j = 0; j < 4; ++j) { const int n = (lane >> 3) + 8 * j; const LAS float* s = scr + (8 * c) * 33 + n;
        v4u o; o.x = pk2(s[0 * 33], s[1 * 33]); o.y = pk2(s[2 * 33], s[3 * 33]); o.z = pk2(s[4 * 33], s[5 * 33]); o.w = pk2(s[6 * 33], s[7 * 33]);
        *(GAS v4u*)(WT + (size_t)(drow0 + n) * Kd + k0 + 8 * c) = o; }
    LDS_WAIT(); asm volatile("" ::: "memory");
}
__device__ __forceinline__ void p0_prologue(Frame& F) {
    LAS float* scr = (LAS float*)(F.lds + RING_OFF + F.wave * 16384);
    const int gw = F.vcu * NWAVES + F.wave, NGW = F.G * NWAVES, lane = F.lane;
    const float* norm_mix = F.in[1]; const float* norm_ffn = F.in[2];
    constexpr int I_AB1 = 16 * 40, I_AB2 = 16 * 24, I_ABO = 16 * 32, I_FF = 16 * 88, I_DN = 44 * 32, I_CIN = 16 * 96, I_CO = 16 * 32, I_W1 = 32 * 2, I_W2 = 2;
    constexpr int NITEMS = I_AB1 + I_AB2 + I_ABO + 4 * I_FF + 2 * I_DN + I_CIN + I_CO + 2 * I_W1 + 2 * I_W2;
    for (int it = gw; it < NITEMS; it += NGW) {
        int r = it;
        if (r < I_AB1) { const int kb = r / 40, nb = r % 40; p0_titem(F.in[6], AB_LD, 32 * nb, norm_mix, nb < 16 ? C2 : 1.f, WSP(bf16, WS_WAB), 1024, 32 * nb, scr, kb, lane); continue; } r -= I_AB1;
        if (r < I_AB2) { const int kb = r / 24, nb = r % 24; p0_titem(F.in[6], AB_LD, 1304 + 32 * nb, norm_mix, nb < 16 ? C2 : 1.f, WSP(bf16, WS_WAB), 1024, 1280 + 32 * nb, scr, kb, lane); continue; } r -= I_AB2;
        if (r < I_ABO) { const int kb = r / 32, nb = r % 32; p0_titem(F.in[15], 1024, 32 * nb, nullptr, 1.f, WSP(bf16, WS_WABO), 1024, 32 * nb, scr, kb, lane); continue; } r -= I_ABO;
        if (r < 4 * I_FF) { const int q = r / I_FF, rr = r % I_FF, l = q >> 1, up = q & 1, kb = rr / 88, nb = rr % 88, n0 = 32 * nb;
            const float* W = (up ? F.in[4] : F.in[3]) + (size_t)l * 1024 * FF;
            p0_titem(W, FF, n0, norm_ffn + l * 1024, 1.f, WSP(bf16, l ? WS_WUP1 : WS_WUP0), 1024, 256 * (n0 / 128) + (n0 % 128) + 128 * up, scr, kb, lane); continue; } r -= 4 * I_FF;
        if (r < 2 * I_DN) { const int l = r / I_DN, rr = r % I_DN, kb = rr / 32, nb = rr % 32;
            p0_titem(F.in[5] + (size_t)l * FF * 1024, 1024, 32 * nb, nullptr, 1.f, WSP(bf16, l ? WS_WDN1 : WS_WDN0), FF, 32 * nb, scr, kb, lane); continue; } r -= 2 * I_DN;
        if (r < I_CIN) { const int kb = r / 96, nb = r % 96; p0_titem(F.in[16], C_LD, 32 * nb, norm_mix + 1024, 1.f, WSP(bf16, WS_WCIN), 1024, 32 * nb, scr, kb, lane); continue; } r -= I_CIN;
        if (r < I_CO) { const int kb = r / 32, nb = r % 32; p0_titem(F.in[21], 1024, 32 * nb, nullptr, 1.f, WSP(bf16, WS_WCO), 1024, 32 * nb, scr, kb, lane); continue; } r -= I_CO;
        if (r < 2 * I_W1) { const int kv = r / I_W1, rr = r % I_W1, kb = rr / 2, nb = rr % 2; p0_titem(F.in[kv ? 12 : 10], 64, 32 * nb, nullptr, 1.f, WSP(bf16, kv ? WS_CW1V : WS_CW1K), 2048, 32 * nb, scr, kb, lane); continue; } r -= 2 * I_W1;
        { const int kv = r / I_W2, nb = r % I_W2; p0_titem(F.in[kv ? 13 : 11], 64, 32 * nb, nullptr, 1.f, WSP(bf16, kv ? WS_CW2V : WS_CW2K), 64, 32 * nb, scr, 0, lane); }
    }
    { const int gt = (F.vcu * NWAVES + F.wave) * 64 + lane, NGT = F.G * NWAVES * 64;
      for (int i = gt; i < 2 * 32 * 1024; i += NGT) { const int which = i >> 15, n = (i >> 10) & 31, k = i & 1023; float v = 0.f;
          if (which == 0) { if (n < 24) v = F.in[6][(size_t)k * AB_LD + 1280 + n] * norm_mix[k]; WSP(bf16, WS_WABG)[n * 1024 + k] = (bf16)f2bf(v); }
          else { if (n < 8) v = F.in[16][(size_t)k * C_LD + 3072 + n] * norm_mix[1024 + k]; WSP(bf16, WS_WCG)[n * 1024 + k] = (bf16)f2bf(v); } } }
    { const int gt = (F.vcu * NWAVES + F.wave) * 64 + lane, NGT = F.G * NWAVES * 64; for (int i = gt; i < 4 * M; i += NGT) WSP(float, WS_PSUM)[i] = 0.f; }
    for (int m = gw; m < M; m += 4 * NGW) {
        f32x4 v[4][4]; float s[4];
#pragma unroll
        for (int q = 0; q < 4; ++q) { const GAS f32x4* xr = (const GAS f32x4*)(F.in[0] + (size_t)(m + q * NGW) * D) + lane;
#pragma unroll
            for (int j = 0; j < 4; ++j) v[q][j] = __builtin_nontemporal_load(&xr[64 * j]); }
#pragma unroll
        for (int q = 0; q < 4; ++q) { float t = 0.f;
#pragma unroll
            for (int j = 0; j < 4; ++j) t += (v[q][j].x * v[q][j].x + v[q][j].y * v[q][j].y) + (v[q][j].z * v[q][j].z + v[q][j].w * v[q][j].w);
            s[q] = wave_sum(t); }
#pragma unroll
        for (int q = 0; q < 4; ++q) { GAS unsigned long long* o8 = (GAS unsigned long long*)(WSP(bf16, WS_H16) + (size_t)(m + q * NGW) * D) + lane;
#pragma unroll
            for (int j = 0; j < 4; ++j) o8[64 * j] = (unsigned long long)pk2(v[q][j].x, v[q][j].y) | ((unsigned long long)pk2(v[q][j].z, v[q][j].w) << 32);
            if (lane == 0) WSP(float, WS_RS0)[m + q * NGW] = 1.0f / sqrtf(s[q] * (1.0f / D) + 1e-6f); }
    }
    if (gw < 256) { const int kv = gw >> 7, k0 = (gw & 127) * 16; const float* pos = F.in[kv ? 9 : 8]; const float* w1 = F.in[kv ? 12 : 10]; float acc = 0.f;
#pragma unroll
        for (int k = 0; k < 16; ++k) acc += pos[k0 + k] * w1[(size_t)(k0 + k) * 64 + lane];
        WSP(float, WS_CBPART)[gw * 64 + lane] = acc; }
}
typedef float f32x4v __attribute__((ext_vector_type(4)));
__device__ __forceinline__ void skinny_tile16(const bf16* A, const bf16* Wt, int row0, int lane, f32x4v (&acc)[2]) {
    const int i16 = lane & 15, kq = lane >> 4; acc[0] = (f32x4v){0.f, 0.f, 0.f, 0.f}; acc[1] = acc[0];
    const bf16* ap = A + (size_t)(row0 + i16) * 1024 + 8 * kq; const bf16* w0 = Wt + (size_t)i16 * 1024 + 8 * kq; const bf16* w1 = w0 + 16 * 1024;
#pragma unroll 8
    for (int s = 0; s < 32; ++s) { const bf16x8 x = *(const bf16x8*)(ap + 32 * s);
        acc[0] = __builtin_amdgcn_mfma_f32_16x16x32_bf16(*(const bf16x8*)(w0 + 32 * s), x, acc[0], 0, 0, 0);
        acc[1] = __builtin_amdgcn_mfma_f32_16x16x32_bf16(*(const bf16x8*)(w1 + 32 * s), x, acc[1], 0, 0, 0); }
}
__device__ __forceinline__ void gates0_phase(Frame& F) {
    const int gw = F.vcu * NWAVES + F.wave, NGW = F.G * NWAVES, lane = F.lane, i16 = lane & 15, cg = lane >> 4;
    for (int t = gw; t < M / 16; t += NGW) {
        f32x4v acc[2]; skinny_tile16(WSP(bf16, WS_H16), WSP(bf16, WS_WABG), 16 * t, lane, acc);
        const int row = 16 * t + i16; const float rs = WSP(float, WS_RS0)[row]; float* g = WSP(float, WS_GATES) + (size_t)row * 32;
#pragma unroll
        for (int tt = 0; tt < 2; ++tt) { const int c0 = 16 * tt + 4 * cg; if (c0 < 24) { f32x4v o;
#pragma unroll
                for (int r = 0; r < 4; ++r) o[r] = 1.0f / (1.0f + __expf(-(acc[tt][r] * rs + F.in[7][c0 + r])));
                *(f32x4v*)(g + c0) = o; } }
    }
}
__device__ __forceinline__ void gates1_phase(Frame& F) {
    const int gw = F.vcu * NWAVES + F.wave, NGW = F.G * NWAVES, lane = F.lane, i16 = lane & 15, cg = lane >> 4;
    const pg8::RowScale R{nullptr, WSP(float, WS_PSUM) + 1 * M};
    for (int t = gw; t < M / 16; t += NGW) {
        f32x4v acc[2]; skinny_tile16(WSP(bf16, WS_H16), WSP(bf16, WS_WCG), 16 * t, lane, acc);
        const int row = 16 * t + i16; const float rs = pg8::row_scale(R, row); float* g = WSP(float, WS_GATES) + (size_t)row * 32;
        if (cg < 2) { f32x4v o;
#pragma unroll
            for (int r = 0; r < 4; ++r) { const float x = acc[0][r] * rs + (cg == 0 ? F.in[19][r] : F.in[20][r]); o[r] = cg == 0 ? x : fminf(x, 0.f) - log1pf(__expf(-fabsf(x))); }
            *(f32x4v*)(g + 4 * cg) = o; }
    }
}

__device__ __forceinline__ void compress_phase(Frame& F) {
    const int lane = F.lane, r32 = lane & 31, h = lane >> 5, w = F.wave;
    LAS float* red = (LAS float*)(F.lds + RING_OFF);
    LAS unsigned char* Hs = F.lds + RING_OFF + 65536;
    LAS float* cb = (LAS float*)(F.lds + RING_OFF + 65536 + 8192);
    if (F.tid < 128) { const float* pp = WSP(float, WS_CBPART) + (F.tid >> 6) * 128 * 64 + (F.tid & 63); float s = 0.f;
#pragma unroll 16
        for (int q = 0; q < 128; ++q) s += pp[q * 64];
        cb[F.tid] = s; }
    __syncthreads();
    for (int task = F.vcu; task < 256; task += F.G) {
        const int kv = task & 1, bg = (task >> 1) & 7, rt = task >> 4, b = bg >> 1, g = bg & 1, i0 = rt * 32;
        const bf16* raw = WSP(bf16, WS_QKV0) + (size_t)b * T * 2048 + (kv ? QC_VC : QC_KC) + g * 64;
        const bf16* w1t = WSP(bf16, kv ? WS_CW1V : WS_CW1K);
        const bf16* w2t = WSP(bf16, kv ? WS_CW2V : WS_CW2K);
        int ic = i0 + r32; if (ic > 510) ic = 510;
        f32x16 d0 = {}, d1 = {};
#pragma unroll
        for (int ll = 0; ll < 4; ++ll) { const int l = 4 * w + ll;
#pragma unroll
            for (int ss = 0; ss < 4; ++ss) { const int k = l * 64 + 16 * ss + 8 * h;
                const bf16x8 bfr = *(const bf16x8*)(raw + (size_t)(16 * ic + l) * 2048 + 16 * ss + 8 * h);
                d0 = mfma32(*(const bf16x8*)(w1t + (size_t)r32 * 2048 + k), bfr, d0);
                d1 = mfma32(*(const bf16x8*)(w1t + (size_t)(32 + r32) * 2048 + k), bfr, d1); } }
#pragma unroll
        for (int r = 0; r < 16; ++r) { red[(w * 64 + crow(r, h)) * 32 + r32] = d0[r]; red[(w * 64 + 32 + crow(r, h)) * 32 + r32] = d1[r]; }
        __syncthreads();
#pragma unroll
        for (int e = 0; e < 4; ++e) { const int idx = F.tid * 4 + e, hid = idx >> 5, i = idx & 31; float a = cb[kv * 64 + hid];
#pragma unroll
            for (int ww = 0; ww < 8; ++ww) a += red[(ww * 64 + hid) * 32 + i];
            a = a / (1.0f + __expf(-a));
            *(LAS bf16*)(Hs + i * 144 + hid * 2) = (bf16)f2bf(a); }
        __syncthreads();
        if (w < 2) { f32x16 o = {};
#pragma unroll
            for (int s = 0; s < 4; ++s) o = mfma32(*(const bf16x8*)(w2t + (size_t)(32 * w + r32) * 64 + 16 * s + 8 * h), *(const LAS bf16x8*)(Hs + r32 * 144 + (16 * s + 8 * h) * 2), o);
            bf16* dst = WSP(bf16, kv ? WS_VC : WS_KC) + ((size_t)bg * 512 + i0 + r32) * 64 + 32 * w + 4 * h;
#pragma unroll
            for (int q = 0; q < 4; ++q) { v2u pk; pk.x = pk2(o[4 * q], o[4 * q + 1]); pk.y = pk2(o[4 * q + 2], o[4 * q + 3]); *(v2u*)(dst + 8 * q) = pk; } }
        __syncthreads();
    }
}
constexpr int AT_K = 0, AT_V = 9216, AT_BUF = 18432, AT_IMP = 49152  , AT_SEL = AT_IMP + 128 * 132 * 4, AT_OVF = AT_SEL + 2048, AT_END = AT_OVF + 32;
static_assert(AT_END <= RING_BYTES, "attention LDS");
constexpr int KV_STRIDE = 144;
__device__ __forceinline__ void stage_load(Frame& F, const bf16* Kg, const bf16* Vg, int pitch, int row0, int rmax, v4u& kx, v4u& vx) {
    const int row = F.tid >> 3, ch = F.tid & 7; int rr = row0 + row; rr = rr < 0 ? 0 : (rr > rmax ? rmax : rr);
    kx = *(const v4u*)(Kg + (size_t)rr * pitch + ch * 8);
    if (Vg) vx = *(const v4u*)(Vg + (size_t)rr * pitch + ch * 8);
}
__device__ __forceinline__ void stage_write(Frame& F, int boff, bool hasv, const v4u& kx, const v4u& vx) {
    const int row = F.tid >> 3, ch = F.tid & 7;
    *(LAS v4u*)(F.lds + boff + AT_K + row * KV_STRIDE + ch * 16) = kx;
    if (hasv) *(LAS v4u*)(F.lds + boff + AT_V + row * KV_STRIDE + ch * 16) = vx;
}
__device__ __forceinline__ f32x16 qk_tile(LAS unsigned char* klb, int sub, const bf16x8 (&qf)[4]) {
    f32x16 s = {};
#pragma unroll
    for (int st = 0; st < 4; ++st) s = mfma32(*(const LAS bf16x8*)(klb + 32 * sub * KV_STRIDE + 32 * st), qf[st], s);
    return s;
}
__device__ __forceinline__ void pv_tile(LAS unsigned char* vlb, int sub, const f32x16& p, f32x16 (&o)[2]) {
    const bf16x8 p0 = pack8<0>(p), p1 = pack8<1>(p);
#pragma unroll
    for (int dt = 0; dt < 2; ++dt) {
        o[dt] = mfma32(frag_tr(vlb, (32 * sub) * KV_STRIDE + 64 * dt, (32 * sub + 8) * KV_STRIDE + 64 * dt), p0, o[dt]);
        o[dt] = mfma32(frag_tr(vlb, (32 * sub + 16) * KV_STRIDE + 64 * dt, (32 * sub + 24) * KV_STRIDE + 64 * dt), p1, o[dt]);
    }
}
constexpr float THRL = 6.0f, OVFL = 1073741824.0f  , NEGBIG = -1e30f;
struct HeadState { float m, l; f32x16 o[2]; };
__device__ __forceinline__ void hs_init(HeadState& S, float l0) { S.m = 0.f; S.l = l0; S.o[0] = (f32x16){}; S.o[1] = (f32x16){}; }
__device__ __forceinline__ void osm_tile(f32x16& s, HeadState& S) {
    float mx = fmaxf(fmaxf(s[0], s[1]), fmaxf(s[2], s[3]));
#pragma unroll
    for (int r = 4; r < 16; r += 4) mx = fmaxf(mx, fmaxf(fmaxf(s[r], s[r + 1]), fmaxf(s[r + 2], s[r + 3])));
    { const auto rr = __builtin_amdgcn_permlane32_swap(__float_as_uint(mx), __float_as_uint(mx), false, false); mx = fmaxf(__uint_as_float(rr[0]), __uint_as_float(rr[1])); }
    const bool need = mx > THRL;
    if (__any(need)) {
        const float dl = need ? mx : 0.f, f = __builtin_amdgcn_exp2f(-dl);
        S.m += dl; S.l *= f;
#pragma unroll
        for (int r = 0; r < 16; ++r) s[r] -= dl;
#pragma unroll
        for (int dt = 0; dt < 2; ++dt)
#pragma unroll
            for (int r = 0; r < 16; ++r) S.o[dt][r] *= f;
    }
    float sum = 0.f;
#pragma unroll
    for (int r = 0; r < 16; ++r) { s[r] = __builtin_amdgcn_exp2f(s[r]); sum += s[r]; }
    S.l += sum;
}
template <int MODE, int WIN>
__device__ __forceinline__ f32x16 qk_masked(const bf16x8 (&kf)[4], const bf16x8 (&qf)[4], float c0, bool edge, int kb, int tq, int h) {
    f32x16 s;
#pragma unroll
    for (int r = 0; r < 16; ++r) s[r] = c0;
#pragma unroll
    for (int st = 0; st < 4; ++st) s = mfma32(kf[st], qf[st], s);
    if (edge) {
#pragma unroll
        for (int r = 0; r < 16; ++r) { const int key = kb + crow(r, h); bool ok = key <= tq; if (MODE == 1) ok = ok && (tq - key < WIN); s[r] = ok ? s[r] : NEGBIG; }
    }
    return s;
}
constexpr int RG_SLOT = 32768, RG_V = 16384, RG_NSLOT = 3;
static_assert(RG_NSLOT * RG_SLOT <= AT_SEL, "the DMA ring may overlay the dead importance table, never the selection words");
template <int MODE, int WIN, bool GEN>
__device__ __forceinline__ void attn_blocks(Frame& F, const bf16* Kg, const bf16* Vg, int jlo, int jhi, int tq, int tqmax_w, int tqmin_w, const LAS unsigned* selp,
                                            const bf16x8 (&qf)[2][4], HeadState (&H)[2], LAS unsigned* ovfw) {
    int lane = F.lane; asm volatile("" : "+v"(lane));
    const int r32 = lane & 31, h = lane >> 5;
    int koff[4];
#pragma unroll
    for (int st = 0; st < 4; ++st) koff[st] = r32 * 128 + (((2 * st + h) ^ (r32 & 7)) << 4);
    const int vl = 4 * h + ((lane & 15) >> 2), vlow = (2 * ((lane >> 4) & 1) + ((lane & 3) >> 1)) ^ (vl & 3);
    int voff[2];
#pragma unroll
    for (int dt = 0; dt < 2; ++dt) voff[dt] = RG_V + vl * 128 + ((((4 * dt) ^ (vl & 4)) | vlow) << 4) + 8 * (lane & 1);
    const int drow = 16 * F.wave + (lane >> 3), dch = (lane & 7) ^ (lane >> 3);
    const bf16* ksrc = Kg + (size_t)drow * 2048 + dch * 8; const bf16* vsrc = Vg + (size_t)drow * 2048 + dch * 8;
    const unsigned ring0 = (unsigned)(size_t)F.lds + (unsigned)F.wave * 2048u;
#define RG_GLDS(gsrc, ldsdst) do { unsigned keep_; asm volatile("s_mov_b32 %0, m0\n\ts_mov_b32 m0, %2\n\ts_nop 0\n\tglobal_load_lds_dwordx4 %1, off\n\ts_mov_b32 m0, %0" : "=&s"(keep_) : "v"(gsrc), "s"(ldsdst) : "memory"); } while (0)
#define RG_ISSUE(blk, slot) do { const size_t go_ = (size_t)(blk) * (128 * 2048); const unsigned ld_ = (unsigned)__builtin_amdgcn_readfirstlane((int)(ring0 + (unsigned)(slot) * RG_SLOT)); \
        RG_GLDS(ksrc + go_, ld_); RG_GLDS(ksrc + go_ + 8 * 2048, ld_ + 1024); RG_GLDS(vsrc + go_, ld_ + RG_V); RG_GLDS(vsrc + go_ + 8 * 2048, ld_ + RG_V + 1024); } while (0)
    bool ovf = false;
    __syncthreads();
    const int Jlo = jlo >> 1, Jhi = jhi >> 1;
#pragma unroll
    for (int d = 0; d < 2; ++d) { const int jb = Jlo + d > Jhi ? Jhi : Jlo + d; RG_ISSUE(jb, d); }
    int slot = 0;
    for (int J = Jlo; J <= Jhi; ++J) {
        asm volatile("s_waitcnt vmcnt(4)" ::: "memory");
        __builtin_amdgcn_s_barrier(); asm volatile("" ::: "memory");
        { const int jn = J + 2 > Jhi ? Jhi : J + 2; const int sn = slot == 0 ? 2 : slot - 1; RG_ISSUE(jn, sn); }
        __builtin_amdgcn_sched_barrier(0);
        LAS unsigned char* sb = F.lds + slot * RG_SLOT; slot = slot == 2 ? 0 : slot + 1;
        bool mine0 = true, mine1 = true;
        if (MODE == 0) { const int j0 = 2 * J, j1 = 2 * J + 1; const unsigned sw0 = selp[j0 & 3], sw1 = selp[j1 & 3]; mine0 = ((sw0 >> (j0 >> 2)) & 1u) != 0u; mine1 = ((sw1 >> (j1 >> 2)) & 1u) != 0u; }
        const bool anym0 = MODE != 0 || __any(mine0), anym1 = MODE != 0 || __any(mine1);
#pragma unroll
        for (int sub = 0; sub < 4; ++sub) {
            const int kb = 128 * J + 32 * sub;
            const bool mine = sub < 2 ? mine0 : mine1;
            const bool any = (sub < 2 ? anym0 : anym1) && (kb <= tqmax_w) && (MODE == 0 || kb + 31 > tqmin_w - WIN);
            if (!any) continue;
            bf16x8 kf[4];
#pragma unroll
            for (int st = 0; st < 4; ++st) kf[st] = *(const LAS bf16x8*)(sb + koff[st] + sub * 4096);
            const bool edge = (kb + 31 > tqmin_w) || (MODE == 1 && kb <= tqmax_w - WIN);
            bf16x8 vf[4];
#pragma unroll
            for (int dt = 0; dt < 2; ++dt) {
                vf[2 * dt] = frag_tr(sb + voff[dt], sub * 4096, sub * 4096 + 8 * 128);
                vf[2 * dt + 1] = frag_tr(sb + voff[dt], sub * 4096 + 16 * 128, sub * 4096 + 24 * 128); }
            if (!GEN) {
#define SB_() __builtin_amdgcn_sched_barrier(0)
#define EXP4(S, B, SUM) do { S[B] = __builtin_amdgcn_exp2f(S[B]); S[B + 1] = __builtin_amdgcn_exp2f(S[B + 1]); S[B + 2] = __builtin_amdgcn_exp2f(S[B + 2]); S[B + 3] = __builtin_amdgcn_exp2f(S[B + 3]); \
                    SUM += (S[B] + S[B + 1]) + (S[B + 2] + S[B + 3]); } while (0)
                const float c0 = (MODE == 0 && !mine) ? NEGBIG : 0.f;
                f32x16 cinit;
                if (edge) {
#pragma unroll
                    for (int r = 0; r < 16; ++r) { const int key = kb + crow(r, h); bool ok = key <= tq; if (MODE == 1) ok = ok && (tq - key < WIN); cinit[r] = ok ? c0 : NEGBIG; }
                } else {
#pragma unroll
                    for (int r = 0; r < 16; ++r) cinit[r] = c0;
                }
                SB_();
                f32x16 s0 = mfma32(kf[0], qf[0][0], cinit);
#pragma unroll
                for (int st = 1; st < 4; ++st) s0 = mfma32(kf[st], qf[0][st], s0);
                SB_();
                float sum0 = 0.f, sum1 = 0.f;
                f32x16 s1 = mfma32(kf[0], qf[1][0], cinit); SB_(); EXP4(s0, 0, sum0); SB_();
                s1 = mfma32(kf[1], qf[1][1], s1); SB_(); EXP4(s0, 4, sum0); SB_();
                s1 = mfma32(kf[2], qf[1][2], s1); SB_(); EXP4(s0, 8, sum0); SB_();
                s1 = mfma32(kf[3], qf[1][3], s1); SB_(); EXP4(s0, 12, sum0); SB_();
                const bf16x8 pa0 = pack8<0>(s0), pa1 = pack8<1>(s0);
                SB_();
                H[0].o[0] = mfma32(vf[0], pa0, H[0].o[0]); SB_(); EXP4(s1, 0, sum1); SB_();
                H[0].o[0] = mfma32(vf[1], pa1, H[0].o[0]); SB_(); EXP4(s1, 4, sum1); SB_();
                H[0].o[1] = mfma32(vf[2], pa0, H[0].o[1]); SB_(); EXP4(s1, 8, sum1); SB_();
                H[0].o[1] = mfma32(vf[3], pa1, H[0].o[1]); SB_(); EXP4(s1, 12, sum1); SB_();
                const bf16x8 pb0 = pack8<0>(s1), pb1 = pack8<1>(s1);
                SB_();
                H[1].o[0] = mfma32(vf[0], pb0, H[1].o[0]); H[1].o[0] = mfma32(vf[1], pb1, H[1].o[0]);
                H[1].o[1] = mfma32(vf[2], pb0, H[1].o[1]); H[1].o[1] = mfma32(vf[3], pb1, H[1].o[1]);
                H[0].l += sum0; H[1].l += sum1; ovf = ovf || !(sum0 <= OVFL) || !(sum1 <= OVFL);
#undef SB_
#undef EXP4
            } else {
                f32x16 s[2];
#pragma unroll
                for (int hd = 0; hd < 2; ++hd) { s[hd] = qk_masked<MODE, WIN>(kf, qf[hd], (MODE == 0 && !mine) ? NEGBIG : -H[hd].m, edge, kb, tq, h); osm_tile(s[hd], H[hd]); }
#pragma unroll
                for (int hd = 0; hd < 2; ++hd) {
                    const bf16x8 p0 = pack8<0>(s[hd]), p1 = pack8<1>(s[hd]);
#pragma unroll
                    for (int dt = 0; dt < 2; ++dt) { H[hd].o[dt] = mfma32(vf[2 * dt], p0, H[hd].o[dt]); H[hd].o[dt] = mfma32(vf[2 * dt + 1], p1, H[hd].o[dt]); }
                }
            }
            __builtin_amdgcn_sched_barrier(0);
        }
    }
    asm volatile("s_waitcnt vmcnt(0)" ::: "memory");
    if (!GEN) { if (__any(ovf) && lane == 0) *ovfw = 1u; }
    __syncthreads();
#undef RG_ISSUE
#undef RG_GLDS
}
__device__ __forceinline__ void accf_store(float* accw, int lane, const f32x16 (&o)[2], float sc, bool add) {
#pragma unroll
    for (int dt = 0; dt < 2; ++dt)
#pragma unroll
        for (int q = 0; q < 4; ++q) { f32x4 v = {o[dt][4 * q] * sc, o[dt][4 * q + 1] * sc, o[dt][4 * q + 2] * sc, o[dt][4 * q + 3] * sc};
            f32x4* d = (f32x4*)accw + (dt * 4 + q) * 64 + lane; if (add) v = v + *d; *d = v; }
}
constexpr int AT_OST = 272;
__device__ __forceinline__ void att_stage(LAS unsigned char* scr, int hd, const float* accw, int lane, const f32x16 (&o)[2], float sc, int h) {
    const int r32 = lane & 31;
#pragma unroll
    for (int dt = 0; dt < 2; ++dt)
#pragma unroll
        for (int q = 0; q < 4; ++q) { f32x4 v = {o[dt][4 * q] * sc, o[dt][4 * q + 1] * sc, o[dt][4 * q + 2] * sc, o[dt][4 * q + 3] * sc};
            if (accw) v = v + *((const f32x4*)accw + (dt * 4 + q) * 64 + lane);
            v2u pk; pk.x = pk2(v[0], v[1]); pk.y = pk2(v[2], v[3]); *(LAS v2u*)(scr + r32 * AT_OST + hd * 128 + (32 * dt + 8 * q + 4 * h) * 2) = pk; }
}
__device__ __forceinline__ void att_flush(LAS unsigned char* scr, bf16* att, size_t tok0, int hc, int lane) {
    LDS_WAIT(); asm volatile("" ::: "memory");
#pragma unroll
    for (int i = 0; i < 8; ++i) { const int idx = i * 64 + lane, row = idx >> 4, ch = idx & 15;
        *(v4u*)(att + (tok0 + row) * 1024 + hc + (ch >> 3) * 64 + (ch & 7) * 8) = *(const LAS v4u*)(scr + row * AT_OST + ch * 16); }
    LDS_WAIT(); asm volatile("" ::: "memory");
}
template <int PASS>
__device__ __forceinline__ void cmp_pass(Frame& F, const bf16* kcg, const bf16* vcg, int nvalid, int tq, int tqmax_w, int tqmin_w, const bf16x8 (&qf)[2][4],
                                         float (&l)[2], const float (&lg)[2], f32x16 (&o)[2][2], LAS float* improw, LAS unsigned* ovfw) {
    int lane = F.lane; asm volatile("" : "+v"(lane));
    const int r32 = lane & 31, h = lane >> 5;
    int koff[4];
#pragma unroll
    for (int st = 0; st < 4; ++st) koff[st] = r32 * 128 + (((2 * st + h) ^ (r32 & 7)) << 4);
    const int vl = 4 * h + ((lane & 15) >> 2), vlow = (2 * ((lane >> 4) & 1) + ((lane & 3) >> 1)) ^ (vl & 3);
    int voff[2];
    constexpr int CM_SLOT = 16384, CM_V = 8192; static_assert(3 * CM_SLOT <= AT_IMP, "compressed-branch ring below the importance table");
#pragma unroll
    for (int dt = 0; dt < 2; ++dt) voff[dt] = CM_V + vl * 128 + ((((4 * dt) ^ (vl & 4)) | vlow) << 4) + 8 * (lane & 1);
    const int drow = 8 * F.wave + (lane >> 3), dch = (lane & 7) ^ (lane >> 3);
    const bf16* ksrc = kcg + (size_t)drow * 64 + dch * 8; const bf16* vsrc = vcg + (size_t)drow * 64 + dch * 8;
    const unsigned ring0 = (unsigned)(size_t)F.lds + (unsigned)F.wave * 1024u;
#define RG_GLDS(gsrc, ldsdst) do { unsigned keep_; asm volatile("s_mov_b32 %0, m0\n\ts_mov_b32 m0, %2\n\ts_nop 0\n\tglobal_load_lds_dwordx4 %1, off\n\ts_mov_b32 m0, %0" : "=&s"(keep_) : "v"(gsrc), "s"(ldsdst) : "memory"); } while (0)
#define CM_ISSUE(blk, slot) do { const size_t go_ = (size_t)(blk) * (64 * 64); const unsigned ld_ = (unsigned)__builtin_amdgcn_readfirstlane((int)(ring0 + (unsigned)(slot) * CM_SLOT)); \
        RG_GLDS(ksrc + go_, ld_); if (PASS == 2) RG_GLDS(vsrc + go_, ld_ + CM_V); } while (0)
    const int ilim = tq >= 31 ? (tq - 31) >> 4 : -1, ilmax = tqmax_w >= 31 ? (tqmax_w - 31) >> 4 : -1, ilmin = tqmin_w >= 31 ? (tqmin_w - 31) >> 4 : -1;
    bool ovf = false; float carry = 0.f;
    __syncthreads();
    const int Jhi = (nvalid - 1) >> 6;
#pragma unroll
    for (int d = 0; d < 2; ++d) { const int jb = d > Jhi ? Jhi : d; CM_ISSUE(jb, d); }
    int slot = 0;
    for (int J = 0; J <= Jhi; ++J) {
        if (PASS == 2) asm volatile("s_waitcnt vmcnt(2)" ::: "memory"); else asm volatile("s_waitcnt vmcnt(1)" ::: "memory");
        __builtin_amdgcn_s_barrier(); asm volatile("" ::: "memory");
        { const int jn = J + 2 > Jhi ? Jhi : J + 2; const int sn = slot == 0 ? 2 : slot - 1; CM_ISSUE(jn, sn); }
        __builtin_amdgcn_sched_barrier(0);
        LAS unsigned char* sb = F.lds + slot * CM_SLOT; slot = slot == 2 ? 0 : slot + 1;
#pragma unroll
        for (int sub = 0; sub < 2; ++sub) {
            const int kb = 64 * J + 32 * sub;
            if (kb > ilmax) continue;
            bf16x8 kf[4];
#pragma unroll
            for (int st = 0; st < 4; ++st) kf[st] = *(const LAS bf16x8*)(sb + koff[st] + sub * 4096);
            const bool edge = kb + 31 > ilmin;
            f32x16 s[2];
#pragma unroll
            for (int hd = 0; hd < 2; ++hd) { const float c0 = PASS == 2 ? lg[hd] : 0.f;
                if (edge) {
#pragma unroll
                    for (int r = 0; r < 16; ++r) s[hd][r] = (kb + crow(r, h) <= ilim) ? c0 : NEGBIG;
                } else {
#pragma unroll
                    for (int r = 0; r < 16; ++r) s[hd][r] = c0;
                }
#pragma unroll
                for (int st = 0; st < 4; ++st) s[hd] = mfma32(kf[st], qf[hd][st], s[hd]); }
            if (PASS == 1) {
#pragma unroll
                for (int hd = 0; hd < 2; ++hd) { float sum = 0.f;
#pragma unroll
                    for (int r = 0; r < 16; ++r) sum += __builtin_amdgcn_exp2f(s[hd][r]);
                    l[hd] += sum; ovf = ovf || !(sum <= OVFL); }
            } else {
                bf16x8 vf[4];
#pragma unroll
                for (int dt = 0; dt < 2; ++dt) {
                    vf[2 * dt] = frag_tr(sb + voff[dt], sub * 4096, sub * 4096 + 8 * 128);
                    vf[2 * dt + 1] = frag_tr(sb + voff[dt], sub * 4096 + 16 * 128, sub * 4096 + 24 * 128); }
                float ps4[4] = {0.f, 0.f, 0.f, 0.f}, sp[4] = {0.f, 0.f, 0.f, 0.f};
#pragma unroll
                for (int hd = 0; hd < 2; ++hd) {
#pragma unroll
                    for (int r = 0; r < 16; ++r) s[hd][r] = __builtin_amdgcn_exp2f(s[hd][r]);
#pragma unroll
                    for (int q = 0; q < 4; ++q) { ps4[q] += (s[hd][4 * q] + s[hd][4 * q + 1]) + (s[hd][4 * q + 2] + s[hd][4 * q + 3]); sp[q] += s[hd][4 * q + 3]; }
                    const bf16x8 p0 = pack8<0>(s[hd]), p1 = pack8<1>(s[hd]);
#pragma unroll
                    for (int dt = 0; dt < 2; ++dt) { o[hd][dt] = mfma32(vf[2 * dt], p0, o[hd][dt]); o[hd][dt] = mfma32(vf[2 * dt + 1], p1, o[hd][dt]); }
                }
                float cell[4];
#pragma unroll
                for (int q = 0; q < 4; ++q) { const auto rr = __builtin_amdgcn_permlane32_swap(__float_as_uint(sp[q]), __float_as_uint(sp[q]), false, false);
                    const float rv = __uint_as_float(h ? rr[0] : rr[1]);
                    if (h == 1) cell[q] = ps4[q] + rv; else { cell[q] = ps4[q] + carry; carry = rv; } }
#pragma unroll
                for (int q = 0; q < 4; ++q) atomicAdd((float*)&improw[kb / 4 + h + 2 * q], cell[q]);
            }
            __builtin_amdgcn_sched_barrier(0);
        }
    }
    asm volatile("s_waitcnt vmcnt(0)" ::: "memory");
    if (PASS == 1) { if (__any(ovf) && lane == 0) *ovfw = 1u; }
    __syncthreads();
#undef CM_ISSUE
#undef RG_GLDS
}
__device__ __forceinline__ void nsa_unit(Frame& F, int b, int g, int n) {
    int lane = F.lane, tid = F.tid; asm volatile("" : "+v"(lane), "+v"(tid));
    const int r32 = lane & 31, h = lane >> 5, wave = F.wave;
    const int start = n * 128, qt = wave >> 1, hp = (wave & 1) * 2;
    const int tq = start + qt * 32 + r32, tqmin_w = start + qt * 32, tqmax_w = tqmin_w + 31;
    const size_t tok = (size_t)b * T + tq;
    const bf16* qkv = WSP(bf16, WS_QKV0) + (size_t)b * T * 2048;
    const int trl = ((lane & 15) >> 2) * KV_STRIDE + (16 * ((lane >> 4) & 1) + 4 * (lane & 3)) * 2;
    LAS unsigned char* klb0 = F.lds + AT_K + r32 * KV_STRIDE + 16 * h; LAS unsigned char* vlb0 = F.lds + AT_V + trl + 4 * h * KV_STRIDE;
    LAS float* imp = (LAS float*)(F.lds + AT_IMP); LAS unsigned* sel = (LAS unsigned*)(F.lds + AT_SEL);
    bf16x8 qf[2][4];
#pragma unroll
    for (int hd = 0; hd < 2; ++hd)
#pragma unroll
        for (int s = 0; s < 4; ++s) qf[hd][s] = *(const bf16x8*)(qkv + (size_t)tq * 2048 + QC_QN + (g * 4 + hp + hd) * 64 + 16 * s + 8 * h);
#define GATEP (WSP(float, WS_GATES) + ((size_t)b * T + tq) * 32 + (g * 4 + hp) * 3)
#define ACCFP (WSP(float, WS_ACCF) + (((size_t)((b * 2 + g) * 64 + n) * 8 + wave) * 2) * 2048)
    __syncthreads();
    for (int i = tid; i < 128 * 132; i += 512) imp[i] = 0.f;
    LAS unsigned* ovfw = (LAS unsigned*)(F.lds + AT_OVF); if (tid < 4) ovfw[tid] = 0u;
    const bf16* kcg = WSP(bf16, WS_KC) + (size_t)(b * 2 + g) * 512 * 64; const bf16* vcg = WSP(bf16, WS_VC) + (size_t)(b * 2 + g) * 512 * 64;
    const int nvalid = 8 * n + 7, nbc = (nvalid + 63) >> 6;
    f32x16 o[2][2];
#pragma unroll
    for (int hd = 0; hd < 2; ++hd) { o[hd][0] = (f32x16){}; o[hd][1] = (f32x16){}; }
    LAS float* improw = imp + (qt * 32 + r32) * 132;
    { float lf[2] = {0.f, 0.f}; const float lgd[2] = {0.f, 0.f};
      cmp_pass<1>(F, kcg, vcg, nvalid, tq, tqmax_w, tqmin_w, qf, lf, lgd, o, improw, ovfw + 3);
      if (!ovfw[3]) {
          float lg[2];
#pragma unroll
          for (int hd = 0; hd < 2; ++hd) { const float lt = lf[hd] + __shfl_xor(lf[hd], 32); lg[hd] = lt > 0.f ? -__log2f(lt) : NEGBIG; }
          cmp_pass<2>(F, kcg, vcg, nvalid, tq, tqmax_w, tqmin_w, qf, lf, lg, o, improw, ovfw + 3);
      } else {
    float m[2] = {-1e30f, -1e30f}, l[2] = {0.f, 0.f};
    v4u kx, vx = {0u, 0u, 0u, 0u};
    __syncthreads();
    stage_load(F, kcg, nullptr, 64, 0, 511, kx, vx);
    for (int jb = 0; jb < nbc; ++jb) {
        const int boff = (jb & 1) * AT_BUF;
        stage_write(F, boff, false, kx, vx);
        __syncthreads();
        if (jb + 1 < nbc) stage_load(F, kcg, nullptr, 64, 64 * (jb + 1), 511, kx, vx);
        LAS unsigned char* klb = klb0 + boff;
#pragma unroll
        for (int sub = 0; sub < 2; ++sub)
#pragma unroll
            for (int hd = 0; hd < 2; ++hd) {
                f32x16 s = qk_tile(klb, sub, qf[hd]); float mx = -INFINITY;
#pragma unroll
                for (int r = 0; r < 16; ++r) { const int i = 64 * jb + 32 * sub + crow(r, h); s[r] = (16 * i + 31 <= tq) ? s[r] : -INFINITY; mx = fmaxf(mx, s[r]); }
                mx = fmaxf(mx, __shfl_xor(mx, 32));
                const float mn = fmaxf(m[hd], mx), al = __builtin_amdgcn_exp2f(m[hd] - mn); float sum = 0.f;
#pragma unroll
                for (int r = 0; r < 16; ++r) sum += __builtin_amdgcn_exp2f(s[r] - mn);
                l[hd] = l[hd] * al + sum; m[hd] = mn;
            }
    }
    float il[2];
#pragma unroll
    for (int hd = 0; hd < 2; ++hd) { const float lt = l[hd] + __shfl_xor(l[hd], 32); il[hd] = lt > 0.f ? 1.0f / lt : 0.f; }
    float carry = 0.f;
    __syncthreads();
    stage_load(F, kcg, vcg, 64, 0, 511, kx, vx);
    for (int jb = 0; jb < nbc; ++jb) {
        const int boff = (jb & 1) * AT_BUF;
        stage_write(F, boff, true, kx, vx);
        __syncthreads();
        if (jb + 1 < nbc) stage_load(F, kcg, vcg, 64, 64 * (jb + 1), 511, kx, vx);
        LAS unsigned char* klb = klb0 + boff; LAS unsigned char* vlb = vlb0 + boff;
#pragma unroll
        for (int sub = 0; sub < 2; ++sub) {
            float ps4[4] = {0.f, 0.f, 0.f, 0.f}, sp[4] = {0.f, 0.f, 0.f, 0.f};
#pragma unroll
            for (int hd = 0; hd < 2; ++hd) {
                f32x16 s = qk_tile(klb, sub, qf[hd]);
#pragma unroll
                for (int r = 0; r < 16; ++r) { const int i = 64 * jb + 32 * sub + crow(r, h); s[r] = (16 * i + 31 <= tq) ? __builtin_amdgcn_exp2f(s[r] - m[hd]) * il[hd] : 0.f; }
#pragma unroll
                for (int q = 0; q < 4; ++q) { ps4[q] += (s[4 * q] + s[4 * q + 1]) + (s[4 * q + 2] + s[4 * q + 3]); sp[q] += s[4 * q + 3]; }
                pv_tile(vlb, sub, s, o[hd]);
            }
            float cell[4];
#pragma unroll
            for (int q = 0; q < 4; ++q) { const float rv = __shfl_xor(sp[q], 32);
                if (h == 1) cell[q] = ps4[q] + rv; else { cell[q] = ps4[q] + carry; carry = rv; } }
            const int j0 = (64 * jb + 32 * sub) / 4 + h;
#pragma unroll
            for (int q = 0; q < 4; ++q) atomicAdd((float*)&imp[(qt * 32 + r32) * 132 + j0 + 2 * q], cell[q]);
        }
    }
      }
    }
#pragma unroll
    for (int hd = 0; hd < 2; ++hd) accf_store(ACCFP + hd * 2048, lane, o[hd], GATEP[3 * hd + 0], false);
    __syncthreads();
    {
        const int q = tid >> 2, part = tid & 3, tq2 = start + q, cur = tq2 >> 6; unsigned bits = 0u;
        float val[32];
#pragma unroll
        for (int e = 0; e < 32; ++e) { const int j = 4 * e + part; const bool forced = (j == 0) || (j == cur) || (j == cur - 1);
            if (cur <= 15) { if (j <= cur) bits |= 1u << e; val[e] = -INFINITY; }
            else { if (forced) bits |= 1u << e; val[e] = (!forced && j >= 1 && j <= cur - 2) ? imp[q * 132 + j] : -INFINITY; } }
        if (cur > 15) {
            for (int itr = 0; itr < 13; ++itr) {
                float bv = val[0]; int be = 0;
#pragma unroll
                for (int e = 1; e < 32; ++e) if (val[e] > bv) { bv = val[e]; be = e; }
                int bj = 4 * be + part; float wv = bv; int wj = bj;
#pragma unroll
                for (int d = 1; d < 4; d <<= 1) { const float ov = __shfl_xor(wv, d); const int oj = __shfl_xor(wj, d); if (ov > wv || (ov == wv && oj < wj)) { wv = ov; wj = oj; } }
                const bool win = (wj == bj) && (wv > -INFINITY);
#pragma unroll
                for (int e = 0; e < 32; ++e) if (win && e == be) { val[e] = -INFINITY; bits |= 1u << e; }
            }
        }
        sel[q * 4 + part] = bits;
    }
    __syncthreads();
    const LAS unsigned* selp = sel + (qt * 32 + r32) * 4;
    {
        HeadState H[2]; hs_init(H[0], 0.f); hs_init(H[1], 0.f);
        attn_blocks<0, 0, false>(F, qkv + QC_KS + g * 64, qkv + QC_VS + g * 64, 0, 2 * n + 1, tq, tqmax_w, tqmin_w, selp, qf, H, ovfw + 0);
        if (ovfw[0]) { hs_init(H[0], 0.f); hs_init(H[1], 0.f); attn_blocks<0, 0, true>(F, qkv + QC_KS + g * 64, qkv + QC_VS + g * 64, 0, 2 * n + 1, tq, tqmax_w, tqmin_w, selp, qf, H, ovfw + 0); }
#pragma unroll
        for (int hd = 0; hd < 2; ++hd) { const float lt = H[hd].l + __shfl_xor(H[hd].l, 32); accf_store(ACCFP + hd * 2048, lane, H[hd].o, lt > 0.f ? GATEP[3 * hd + 1] / lt : 0.f, true); }
    }
    {
        HeadState H[2]; hs_init(H[0], 0.f); hs_init(H[1], 0.f);
        attn_blocks<1, 512, false>(F, qkv + QC_KW + g * 64, qkv + QC_VW + g * 64, (2 * n - 8) < 0 ? 0 : (2 * n - 8), 2 * n + 1, tq, tqmax_w, tqmin_w, selp, qf, H, ovfw + 1);
        if (ovfw[1]) { hs_init(H[0], 0.f); hs_init(H[1], 0.f); attn_blocks<1, 512, true>(F, qkv + QC_KW + g * 64, qkv + QC_VW + g * 64, (2 * n - 8) < 0 ? 0 : (2 * n - 8), 2 * n + 1, tq, tqmax_w, tqmin_w, selp, qf, H, ovfw + 1); }
        LAS unsigned char* scr = F.lds + wave * (32 * AT_OST);
#pragma unroll
        for (int hd = 0; hd < 2; ++hd) { const float lt = H[hd].l + __shfl_xor(H[hd].l, 32);
            att_stage(scr, hd, ACCFP + hd * 2048, lane, H[hd].o, lt > 0.f ? GATEP[3 * hd + 2] / lt : 0.f, h); }
        att_flush(scr, WSP(bf16, WS_ATT), (size_t)b * T + tqmin_w, (g * 4 + hp) * 64, lane);
    }
}
__device__ __forceinline__ void swa_unit(Frame& F, int b, int g, int n) {
    int lane = F.lane; asm volatile("" : "+v"(lane));
    const int r32 = lane & 31, h = lane >> 5, wave = F.wave;
    const int start = n * 128, qt = wave >> 1, hp = (wave & 1) * 2;
    const int tq = start + qt * 32 + r32, tqmin_w = start + qt * 32, tqmax_w = tqmin_w + 31;
    const size_t tok = (size_t)b * T + tq;
    const bf16* qkv = WSP(bf16, WS_QKV0) + (size_t)b * T * 2048;
    bf16x8 qf[2][4];
#pragma unroll
    for (int hd = 0; hd < 2; ++hd)
#pragma unroll
        for (int s = 0; s < 4; ++s) qf[hd][s] = *(const bf16x8*)(qkv + (size_t)tq * 2048 + QC_QS + (g * 4 + hp + hd) * 64 + 16 * s + 8 * h);
    const LAS unsigned* selp = (const LAS unsigned*)(F.lds + AT_SEL);
    HeadState H[2];
#pragma unroll
    for (int hd = 0; hd < 2; ++hd) hs_init(H[hd], (h == 0) ? __builtin_amdgcn_exp2f(F.in[14][g * 4 + hp + hd] * LOG2E) : 0.f);
    LAS unsigned* ovfw = (LAS unsigned*)(F.lds + AT_OVF);
    __syncthreads(); if (F.tid == 0) ovfw[2] = 0u; __syncthreads();
    attn_blocks<1, 128, false>(F, qkv + QC_KSW + g * 64, qkv + QC_VSW + g * 64, (2 * n - 2) < 0 ? 0 : (2 * n - 2), 2 * n + 1, tq, tqmax_w, tqmin_w, selp, qf, H, ovfw + 2);
    if (ovfw[2]) {
#pragma unroll
        for (int hd = 0; hd < 2; ++hd) hs_init(H[hd], (h == 0) ? __builtin_amdgcn_exp2f(F.in[14][g * 4 + hp + hd] * LOG2E) : 0.f);
        attn_blocks<1, 128, true>(F, qkv + QC_KSW + g * 64, qkv + QC_VSW + g * 64, (2 * n - 2) < 0 ? 0 : (2 * n - 2), 2 * n + 1, tq, tqmax_w, tqmin_w, selp, qf, H, ovfw + 2); }
    LAS unsigned char* scr = F.lds + wave * (32 * AT_OST);
#pragma unroll
    for (int hd = 0; hd < 2; ++hd) { const float lt = H[hd].l + __shfl_xor(H[hd].l, 32); att_stage(scr, hd, nullptr, lane, H[hd].o, 1.0f / lt, h); }
    att_flush(scr, WSP(bf16, WS_ATT), (size_t)b * T + tqmin_w, 512 + (g * 4 + hp) * 64, lane);
}
__device__ __forceinline__ void attention_phase(Frame& F) {
    const int q = (int)(((long)F.vcu * 8) / F.G);
    LAS unsigned* slotw = (LAS unsigned*)(F.lds + AT_OVF + 28);
    for (;;) {
        __syncthreads();
        if (F.tid == 0) *slotw = __hip_atomic_fetch_add((unsigned*)(F.ctl + CW_QUEUE + 64 * q), 1u, __ATOMIC_RELAXED, __HIP_MEMORY_SCOPE_AGENT);
        __syncthreads();
        const unsigned idx = *slotw;
        if (idx >= 128u) break;
        if (idx < 64u) nsa_unit(F, q >> 1, q & 1, 63 - (int)idx);
        else swa_unit(F, q >> 1, q & 1, (int)idx - 64);
    }
    __syncthreads();
}
__device__ __forceinline__ void conv_scan_phase(Frame& F) {
    const int lane = F.lane, w = F.wave;
    if (F.vcu < 16 && F.G >= 32) {
        const int bh = F.vcu, b = bh >> 2, hh = bh & 3;
        const float* gt = WSP(float, WS_GATES) + (size_t)b * T * 32;
        LAS float* segG = (LAS float*)(F.lds + RING_OFF); LAS float* segP = segG + 8;
        float Gl[16], al[16], Pl[16]; float c = 0.f, cm = -INFINITY;
#pragma unroll
        for (int it = 0; it < 16; ++it) { const int t = 1024 * w + 64 * it + lane; const float li = gt[(size_t)t * 32 + hh]; float x = gt[(size_t)t * 32 + 4 + hh];
#pragma unroll
            for (int d = 1; d < 64; d <<= 1) { const float y = __shfl_up(x, d); if (lane >= d) x += y; }
            Gl[it] = c + x; c = __shfl(Gl[it], 63);
            al[it] = li - Gl[it]; float pm = al[it];
#pragma unroll
            for (int d = 1; d < 64; d <<= 1) { const float y = __shfl_up(pm, d); if (lane >= d) pm = fmaxf(pm, y); }
            pm = fmaxf(pm, cm); Pl[it] = pm; cm = __shfl(pm, 63); }
        if (lane == 0) { segG[w] = c; segP[w] = cm; }
        __syncthreads();
        double gc = 0.0; float mc = 0.f;
        for (int k = 0; k < w; ++k) { mc = fmaxf(mc, (float)((double)segP[k] - gc)); gc += (double)segG[k]; }
#pragma unroll
        for (int it = 0; it < 16; ++it) { const int t = 1024 * w + 64 * it + lane; const float gcf = (float)gc;
            const float a = al[it] - gcf, mv = fmaxf(mc, Pl[it] - gcf); const double mt = (gc + (double)Gl[it]) + (double)mv;
            WSP(float, WS_SCA)[bh * T + t] = a; WSP(float, WS_SCM)[bh * T + t] = mv; WSP(float, WS_SCE)[bh * T + t] = (float)exp(-mt); }
        __syncthreads();
        return;
    }
    const int first = (F.G >= 32) ? 16 : 0, nblk = F.G - first, bi = F.vcu - first;
    const int c8 = (F.tid & 127) * 8;
    const float* cw = F.in[17]; const float* cb = F.in[18];
    float wv[4][8], bv[8];
#pragma unroll
    for (int e = 0; e < 8; ++e) { bv[e] = cb[c8 + e];
#pragma unroll
        for (int k = 0; k < 4; ++k) wv[k][e] = cw[k * 1024 + c8 + e]; }
    const float ksc = (c8 >= 512) ? 0.08838834764831845f : 1.0f;
    const bf16* src = WSP(bf16, WS_QKP); bf16* dst = WSP(bf16, WS_QKC);
    for (int tok0 = bi * 4 + (F.tid >> 7); tok0 < M; tok0 += nblk * 16) {
        v4u x[4][4]; bool okt[4];
#pragma unroll
        for (int uu = 0; uu < 4; ++uu) { const int tok = tok0 + uu * nblk * 4; okt[uu] = tok < M; const int t = tok & (T - 1);
#pragma unroll
            for (int k = 0; k < 4; ++k) { x[uu][k] = (v4u){0u, 0u, 0u, 0u}; if (okt[uu] && t - 3 + k >= 0) x[uu][k] = *(const v4u*)(src + (size_t)(tok - 3 + k) * 1024 + c8); } }
#pragma unroll
        for (int uu = 0; uu < 4; ++uu) { if (!okt[uu]) continue; const int tok = tok0 + uu * nblk * 4; float acc[8];
#pragma unroll
            for (int e = 0; e < 8; ++e) acc[e] = bv[e];
#pragma unroll
            for (int k = 0; k < 4; ++k) { const v4u xx = x[uu][k];
                acc[0] += bflo(xx.x) * wv[k][0]; acc[1] += bfhi(xx.x) * wv[k][1]; acc[2] += bflo(xx.y) * wv[k][2]; acc[3] += bfhi(xx.y) * wv[k][3];
                acc[4] += bflo(xx.z) * wv[k][4]; acc[5] += bfhi(xx.z) * wv[k][5]; acc[6] += bflo(xx.w) * wv[k][6]; acc[7] += bfhi(xx.w) * wv[k][7]; }
#pragma unroll
            for (int e = 0; e < 8; ++e) acc[e] = acc[e] * __builtin_amdgcn_rcpf(1.0f + __expf(-acc[e])) * ksc;
            v4u o; o.x = pk2(acc[0], acc[1]); o.y = pk2(acc[2], acc[3]); o.z = pk2(acc[4], acc[5]); o.w = pk2(acc[6], acc[7]);
            *(v4u*)(dst + ((size_t)((tok >> 13) * 8 + (c8 >> 7)) * T + (tok & (T - 1))) * 128 + (c8 & 127)) = o; }
    }
}
constexpr int ML_KS = 272, ML_VS = 528;
constexpr int ML_K = 0, ML_V = 64 * ML_KS;
__device__ __forceinline__ void mlstm_p1_phase(Frame& F) {
    const int lane = F.lane, r32 = lane & 31, h = lane >> 5, w = F.wave, tid = F.tid;
    LAS unsigned char* kt = F.lds + ML_K; LAS unsigned char* vt = F.lds + ML_V;
    const int row = tid >> 3, ch = tid & 7;
    for (int u = F.vcu; u < 512; u += F.G) {
        const int bh = u >> 5, sc = u & 31, b = bh >> 2, hh = bh & 3;
        const float mend = WSP(float, WS_SCM)[bh * T + 256 * sc + 255];
        const float* av = WSP(float, WS_SCA) + bh * T + 256 * sc;
        const bf16* kp0 = WSP(bf16, WS_QKC) + ((size_t)(b * 8 + 4 + hh) * T + 256 * sc + row) * 128 + ch * 16;
        const bf16* vp0 = WSP(bf16, WS_V1) + ((size_t)(b * 4 + hh) * T + 256 * sc + row) * 256 + ch * 32;
        f32x16 acc[4]; float nacc = 0.f;
#pragma unroll
        for (int i = 0; i < 4; ++i) acc[i] = (f32x16){};
        v4u kx[2], vx[4]; float wgt;
#pragma unroll
        for (int q = 0; q < 2; ++q) kx[q] = *(const v4u*)(kp0 + 8 * q);
#pragma unroll
        for (int q = 0; q < 4; ++q) vx[q] = *(const v4u*)(vp0 + 8 * q);
        wgt = __expf(av[row] - mend);
        for (int c4 = 0; c4 < 4; ++c4) {
            __syncthreads();
#pragma unroll
            for (int q = 0; q < 2; ++q) { const v4u x = kx[q]; v4u y;
                y.x = pk2(bflo(x.x) * wgt, bfhi(x.x) * wgt); y.y = pk2(bflo(x.y) * wgt, bfhi(x.y) * wgt); y.z = pk2(bflo(x.z) * wgt, bfhi(x.z) * wgt); y.w = pk2(bflo(x.w) * wgt, bfhi(x.w) * wgt);
                *(LAS v4u*)(kt + row * ML_KS + (ch * 16 + 8 * q) * 2) = y; }
#pragma unroll
            for (int q = 0; q < 4; ++q) *(LAS v4u*)(vt + row * ML_VS + (ch * 32 + 8 * q) * 2) = vx[q];
            __syncthreads();
            if (c4 < 3) { const size_t adv = (size_t)(64 * (c4 + 1));
#pragma unroll
                for (int q = 0; q < 2; ++q) kx[q] = *(const v4u*)(kp0 + adv * 128 + 8 * q);
#pragma unroll
                for (int q = 0; q < 4; ++q) vx[q] = *(const v4u*)(vp0 + adv * 256 + 8 * q);
                wgt = __expf(av[64 * (c4 + 1) + row] - mend); }
            if (tid < 128) { float s = 0.f;
#pragma unroll 8
                for (int rr = 0; rr < 64; ++rr) s += bf2f(*(LAS bf16*)(kt + rr * ML_KS + tid * 2));
                nacc += s; }
            LAS unsigned char* klb = kt + ((lane & 15) >> 2) * ML_KS + (16 * ((lane >> 4) & 1) + 4 * (lane & 3)) * 2 + 8 * h * ML_KS;
            LAS unsigned char* vlb = vt + ((lane & 15) >> 2) * ML_VS + (16 * ((lane >> 4) & 1) + 4 * (lane & 3)) * 2 + 8 * h * ML_VS + 64 * w;
#pragma unroll
            for (int s = 0; s < 4; ++s) {
                const bf16x8 av8 = frag_tr(vlb, 16 * s * ML_VS, (16 * s + 4) * ML_VS);
#pragma unroll
                for (int dkt = 0; dkt < 4; ++dkt) acc[dkt] = mfma32(av8, frag_tr(klb, 16 * s * ML_KS + 64 * dkt, (16 * s + 4) * ML_KS + 64 * dkt), acc[dkt]);
            }
        }
        float* lt = WSP(float, WS_LT) + (size_t)u * 32768;
#pragma unroll
        for (int dkt = 0; dkt < 4; ++dkt)
#pragma unroll
            for (int r = 0; r < 16; ++r) __builtin_nontemporal_store(acc[dkt][r], &lt[(32 * w + crow(r, h)) * 128 + 32 * dkt + r32]);
        if (tid < 128) WSP(float, WS_NLOC)[u * 128 + tid] = nacc;
    }
    __syncthreads();
}
__device__ __forceinline__ void mlstm_scan_phase(Frame& F) {
    const int gt = F.vcu * 512 + F.tid, NT = F.G * 512;
    for (int item = gt; item < 16 * 8192; item += NT) {
        const int bh = item >> 13, e4 = (item & 8191) * 4; f32x4 C = {0.f, 0.f, 0.f, 0.f}; float mprev = 0.f;
        const float* mx = WSP(float, WS_SCM) + bh * T;
#pragma unroll 8
        for (int sc = 0; sc < 32; ++sc) {
            const size_t off = ((size_t)(bh * 32 + sc)) * 32768 + e4;
            v2u pk; pk.x = pk2(C[0], C[1]); pk.y = pk2(C[2], C[3]); *(v2u*)(WSP(bf16, WS_CST) + off) = pk;
            const float mend = mx[256 * sc + 255], dec = __expf(mprev - mend); mprev = mend;
            const f32x4 L = __builtin_nontemporal_load((const f32x4*)(WSP(float, WS_LT) + off));
            C = C * dec + L;
        }
    }
    for (int item = gt; item < 16 * 128; item += NT) {
        const int bh = item >> 7, dk = item & 127; float nn = 0.f, mprev = 0.f; const float* mx = WSP(float, WS_SCM) + bh * T;
        for (int sc = 0; sc < 32; ++sc) { const int u = bh * 32 + sc; WSP(float, WS_NST)[u * 128 + dk] = nn;
            const float mend = mx[256 * sc + 255], dec = __expf(mprev - mend); mprev = mend; nn = nn * dec + WSP(float, WS_NLOC)[u * 128 + dk]; }
    }
}
constexpr int M3_C = 0, M3_K = 0, M3_V = 128 * ML_KS, M3_Q = 2 * 128 * ML_KS, M3_A = M3_Q + 256 * ML_KS, M3_N = M3_A + 1024, M3_END = M3_N + 512;
static_assert(M3_END <= LDSCTL_OFF, "mlstm p3 LDS");
__device__ __forceinline__ void mlstm_p3_phase(Frame& F) {
    const int w = F.wave;
    LAS unsigned char* ct = F.lds + M3_C; LAS unsigned char* kt = F.lds + M3_K; LAS unsigned char* vt = F.lds + M3_V;
    LAS float* als = (LAS float*)(F.lds + M3_A); LAS float* nls = (LAS float*)(F.lds + M3_N);
    for (int u = F.vcu; u < 512; u += F.G) {
        int lane_ = F.lane, tid = F.tid; asm volatile("" : "+v"(lane_), "+v"(tid));
        const int r32 = lane_ & 31, h = lane_ >> 5;
        LAS unsigned char* vlb = vt + ((lane_ & 15) >> 2) * ML_KS + (16 * ((lane_ >> 4) & 1) + 4 * (lane_ & 3)) * 2 + 4 * h * ML_KS;
        LAS unsigned char* klb = kt + r32 * ML_KS + 16 * h; LAS unsigned char* clb = ct + r32 * ML_KS + 16 * h;
        LAS unsigned char* qlb = F.lds + M3_Q + (32 * w + r32) * ML_KS + 16 * h;
        const int bh = u >> 5, sc = u & 31, b = bh >> 2, hh = bh & 3;
        const size_t tok0 = (size_t)b * T + 256 * sc;
        const int tl = 32 * w + r32;
        const size_t tokq = tok0 + tl;
        const float Mt = WSP(float, WS_SCM)[bh * T + 256 * sc + tl];
        const float mprev = sc ? WSP(float, WS_SCM)[bh * T + 256 * sc - 1] : 0.f;
        const float winter = __expf(mprev - Mt);
        float dsum = 0.f, hdiv = 0.f;
        const int srow = tid >> 4, sch = tid & 15;
#pragma unroll 1
        for (int pass = 0; pass < 2; ++pass) {
            const char* csb = (const char*)(WSP(bf16, WS_CST) + (size_t)u * 32768 + pass * 16384);
            const char* kgb = (const char*)(WSP(bf16, WS_QKC) + ((size_t)(b * 8 + 4 + hh) * T + 256 * sc) * 128); const char* vgb = (const char*)(WSP(bf16, WS_V1) + ((size_t)(b * 4 + hh) * T + 256 * sc) * 256 + pass * 128);
            const unsigned kgo = (unsigned)(srow * 128 + sch * 8) * 2u, vgo = (unsigned)(srow * 256 + sch * 8) * 2u;
            v4u kx[4], vx[4];
            { v4u cx[4];
#pragma unroll
              for (int i = 0; i < 4; ++i) cx[i] = __builtin_nontemporal_load((const v4u*)(csb + kgo + (32 * i) * 256));
#pragma unroll
              for (int i = 0; i < 4; ++i) { kx[i] = *(const v4u*)(kgb + kgo + (32 * i) * 256); vx[i] = __builtin_nontemporal_load((const v4u*)(vgb + vgo + (32 * i) * 512)); }
              __syncthreads();
#pragma unroll
              for (int i = 0; i < 4; ++i) *(LAS v4u*)(ct + (srow + 32 * i) * ML_KS + sch * 16) = cx[i]; }
            if (pass == 0) {
#pragma unroll
                for (int i = 0; i < 8; ++i) *(LAS v4u*)(F.lds + M3_Q + (srow + 32 * i) * ML_KS + sch * 16) = *(const v4u*)((const char*)(WSP(bf16, WS_QKC) + ((size_t)(b * 8 + hh) * T + 256 * sc) * 128) + kgo + i * 32 * 256);
                if (tid < 256) als[tid] = WSP(float, WS_SCA)[bh * T + 256 * sc + tid];
                if (tid < 128) nls[tid] = WSP(float, WS_NST)[u * 128 + tid]; }
            __syncthreads();
            f32x16 acc[4];
#pragma unroll
            for (int dvt = 0; dvt < 4; ++dvt) { f32x16 a = {};
#pragma unroll
                for (int s = 0; s < 8; ++s) a = mfma32(*(const LAS bf16x8*)(clb + 32 * dvt * ML_KS + 32 * s), *(const LAS bf16x8*)(qlb + 32 * s), a);
                acc[dvt] = a * winter; }
#pragma unroll 1
            for (int half = 0; half < 2; ++half) {
                __syncthreads();
#pragma unroll
                for (int i = 0; i < 4; ++i) { const int o = (srow + 32 * i) * ML_KS + sch * 16; *(LAS v4u*)(kt + o) = kx[i]; *(LAS v4u*)(vt + o) = vx[i]; }
                if (half == 0) {
#pragma unroll
                    for (int i = 0; i < 4; ++i) { kx[i] = *(const v4u*)(kgb + kgo + (128 + 32 * i) * 256); vx[i] = __builtin_nontemporal_load((const v4u*)(vgb + vgo + (128 + 32 * i) * 512)); }
                }
                __syncthreads();
#pragma unroll 1
                for (int k4 = 0; k4 < 4; ++k4) { const int ktile = 4 * half + k4;
                    if (ktile > w) break;
                    f32x16 s = {};
                    { bf16x8 kfr[8];
#pragma unroll
                        for (int st = 0; st < 8; ++st) kfr[st] = *(const LAS bf16x8*)(klb + 32 * k4 * ML_KS + 32 * st);
                        bf16x8 qfr[2]; qfr[0] = *(const LAS bf16x8*)(qlb); qfr[1] = *(const LAS bf16x8*)(qlb + 32);
                        __builtin_amdgcn_sched_barrier(0);
#pragma unroll
                        for (int st = 0; st < 8; ++st) { s = mfma32(kfr[st], qfr[st & 1], s); if (st + 2 < 8) qfr[st & 1] = *(const LAS bf16x8*)(qlb + 32 * (st + 2)); }
                        __builtin_amdgcn_sched_barrier(0); }
                    f32x4 aw[4];
#pragma unroll
                    for (int q = 0; q < 4; ++q) aw[q] = *(const LAS f32x4*)(als + 32 * ktile + 8 * q + 4 * h);
                    LAS unsigned char* vl2 = vlb + 32 * k4 * ML_KS;
                    bf16x8 vfr[4];
#pragma unroll
                    for (int dvt = 0; dvt < 2; ++dvt) { vfr[2 * dvt] = frag_tr(vl2, 64 * dvt, 8 * ML_KS + 64 * dvt); vfr[2 * dvt + 1] = frag_tr(vl2, 16 * ML_KS + 64 * dvt, 24 * ML_KS + 64 * dvt); }
                    __builtin_amdgcn_sched_barrier(0);
                    float ds = 0.f;
#pragma unroll
                    for (int r = 0; r < 16; ++r) { const int key = 32 * ktile + crow(r, h); const float wg = __builtin_amdgcn_exp2f((aw[r >> 2][r & 3] - Mt) * LOG2E); s[r] = (key <= tl) ? s[r] * wg : 0.f; ds += s[r]; }
                    if (pass == 0) dsum += ds;
                    const bf16x8 p0 = pack8<0>(s), p1 = pack8<1>(s);
                    bf16x8 vfs[4];
#pragma unroll
                    for (int dvt = 0; dvt < 2; ++dvt) { vfs[2 * dvt] = frag_tr(vl2, 64 * (dvt + 2), 8 * ML_KS + 64 * (dvt + 2)); vfs[2 * dvt + 1] = frag_tr(vl2, 16 * ML_KS + 64 * (dvt + 2), 24 * ML_KS + 64 * (dvt + 2)); }
                    __builtin_amdgcn_sched_barrier(0);
#pragma unroll
                    for (int dvt = 0; dvt < 2; ++dvt) { acc[dvt] = mfma32(vfr[2 * dvt], p0, acc[dvt]); acc[dvt] = mfma32(vfr[2 * dvt + 1], p1, acc[dvt]); }
                    __builtin_amdgcn_sched_barrier(0);
#pragma unroll
                    for (int dvt = 0; dvt < 2; ++dvt) { acc[dvt + 2] = mfma32(vfs[2 * dvt], p0, acc[dvt + 2]); acc[dvt + 2] = mfma32(vfs[2 * dvt + 1], p1, acc[dvt + 2]); }
                    __builtin_amdgcn_sched_barrier(0);
                }
            }
            if (pass == 0) {
                float qn = 0.f;
#pragma unroll
                for (int s = 0; s < 8; ++s) { const v4u qq = *(const LAS v4u*)(qlb + 32 * s); const LAS float* np = nls + 16 * s + 8 * h;
                    qn += bflo(qq.x) * np[0] + bfhi(qq.x) * np[1] + bflo(qq.y) * np[2] + bfhi(qq.y) * np[3] + bflo(qq.z) * np[4] + bfhi(qq.z) * np[5] + bflo(qq.w) * np[6] + bfhi(qq.w) * np[7]; }
                dsum += __shfl_xor(dsum, 32); qn += __shfl_xor(qn, 32);
                const float den = winter * qn + dsum, emt = WSP(float, WS_SCE)[bh * T + 256 * sc + tl];
                hdiv = 1.0f / fmaxf(fabsf(den), emt);
            }
            __syncthreads();
            { LAS unsigned char* scr = F.lds + w * (32 * ML_KS);
#pragma unroll
              for (int dvt = 0; dvt < 4; ++dvt)
#pragma unroll
                for (int q = 0; q < 4; ++q) { v2u pk; pk.x = pk2(acc[dvt][4 * q] * hdiv, acc[dvt][4 * q + 1] * hdiv); pk.y = pk2(acc[dvt][4 * q + 2] * hdiv, acc[dvt][4 * q + 3] * hdiv);
                    *(LAS v2u*)(scr + r32 * ML_KS + (32 * dvt + 8 * q + 4 * h) * 2) = pk; }
              LDS_WAIT(); asm volatile("" ::: "memory");
              const char* ogb = (const char*)(WSP(bf16, WS_V1) + ((size_t)((4 + b) * 4 + hh) * T + 256 * sc + 32 * w) * 256 + pass * 128);
              char* opb = (char*)(WSP(bf16, WS_QKP) + (tok0 + 32 * w) * 1024 + hh * 256 + pass * 128);
              const unsigned lo_g = (unsigned)((lane_ >> 4) * 256 + (lane_ & 15) * 8) * 2u, lo_o = (unsigned)((lane_ >> 4) * 1024 + (lane_ & 15) * 8) * 2u, lo_s = (unsigned)((lane_ >> 4) * ML_KS + (lane_ & 15) * 16);
#pragma unroll
              for (int i = 0; i < 8; ++i) {
                  const v4u hv = *(const LAS v4u*)(scr + lo_s + i * 4 * ML_KS); const v4u gv = __builtin_nontemporal_load((const v4u*)(ogb + lo_g + i * 2048));
                  v4u o;
#define GATE2(HW, GW) pk2(bflo(HW) * __builtin_amdgcn_rcpf(1.0f + __expf(-bflo(GW))), bfhi(HW) * __builtin_amdgcn_rcpf(1.0f + __expf(-bfhi(GW))))
                  o.x = GATE2(hv.x, gv.x); o.y = GATE2(hv.y, gv.y); o.z = GATE2(hv.z, gv.z); o.w = GATE2(hv.w, gv.w);
#undef GATE2
                  *(v4u*)(opb + lo_o + i * 8192) = o; }
            }
        }
    }
    __syncthreads();
}
__device__ __forceinline__ void final_norm_phase(Frame& F) {
    const int gw = F.vcu * NWAVES + F.wave, NGW = F.G * NWAVES, lane = F.lane;
    const pg8::RowScale R{nullptr, WSP(float, WS_PSUM) + 3 * M};
    f32x4 gv[4];
#pragma unroll
    for (int j = 0; j < 4; ++j) gv[j] = ((const f32x4*)F.in[22])[lane + 64 * j];
    for (int m = gw; m < M; m += 2 * NGW) {
        const int m1 = m + NGW; const float rs0 = pg8::row_scale(R, m), rs1 = pg8::row_scale(R, m1);
        const v2u* h0 = (const v2u*)(WSP(bf16, WS_H16) + (size_t)m * D) + lane; const v2u* h1 = (const v2u*)(WSP(bf16, WS_H16) + (size_t)m1 * D) + lane;
        f32x4* x0 = (f32x4*)(F.out + (size_t)m * D) + lane; f32x4* x1 = (f32x4*)(F.out + (size_t)m1 * D) + lane;
        v2u w0[4], w1[4];
#pragma unroll
        for (int j = 0; j < 4; ++j) { w0[j] = __builtin_nontemporal_load(&h0[64 * j]); w1[j] = __builtin_nontemporal_load(&h1[64 * j]); }
#pragma unroll
        for (int j = 0; j < 4; ++j) { const f32x4 a0 = {bflo(w0[j].x), bfhi(w0[j].x), bflo(w0[j].y), bfhi(w0[j].y)}, a1 = {bflo(w1[j].x), bfhi(w1[j].x), bflo(w1[j].y), bfhi(w1[j].y)};
            __builtin_nontemporal_store(a0 * rs0 * gv[j], &x0[64 * j]); __builtin_nontemporal_store(a1 * rs1 * gv[j], &x1[64 * j]); } }
}
#ifndef SKIPMASK
#define SKIPMASK 0
#endif
#ifndef DUPMASK
#define DUPMASK 0

#endif
#define RUNP(n, call) do { if (!((SKIPMASK >> (n)) & 1)) { call; if ((DUPMASK >> (n)) & 1) { __syncthreads(); call; } } } while (0)
struct Args { const float* in[23]; float* out; unsigned char* ws; int ph_lo, ph_hi; };
__global__ void __launch_bounds__(NWAVES * 64, 2) mk_fwd(Args args) {
    extern __shared__ __attribute__((aligned(16))) unsigned char lds[];
    Frame F;
    F.lds = (LAS unsigned char*)lds;
    F.MISC = (volatile LAS unsigned*)(F.lds + MISC_OFF);
    F.tid = threadIdx.x; F.lane = F.tid & 63; F.wave = __builtin_amdgcn_readfirstlane(F.tid >> 6);
    F.G = gridDim.x; { const int bx = blockIdx.x; F.vcu = (F.G % 8 == 0) ? (bx % 8) * (F.G / 8) + bx / 8 : bx; }
    F.ws = args.ws; F.ctl = (gu32*)(args.ws + WS_CTL); F.out = args.out;
#pragma unroll
    for (int i = 0; i < 23; ++i) F.in[i] = args.in[i];
    for (int u = F.tid; u < (LDS_BYTES - LDSCTL_OFF) / 4; u += NWAVES * 64) ((LAS unsigned*)(F.lds + LDSCTL_OFF))[u] = 0u;
    __syncthreads();
    const int lo = args.ph_lo, hi = args.ph_hi;
    XcdBarrier bar; bar.bar = (unsigned*)(F.ctl + CW_BAR); bar.x = 0; bar.st = nullptr;
    if (hi - lo > 1) bar = xcd_barrier_post((unsigned*)(F.ctl + CW_BAR), F.MISC + 8);

#define IN(k) (lo <= (k) && (k) < hi)
    constexpr int RSL_UNITS = 14; LAS float* rsl = (LAS float*)(F.lds + RING_BYTES); static_assert(RING_BYTES + RSL_UNITS * 1024 <= LDSCTL_OFF, "row-scale table");
#define SEAM(k) do { if (IN(k) && IN((k) + 1)) xcd_barrier(bar); } while (0)
#define GEMM_PH(EPI, gg, ee) do { pg8::StaticOrder S_; S_.init(M, (gg).N, F.G, (int)blockIdx.x); pg8::gemm_phase<EPI, pg8::StaticOrder, PG8_ALIGN, PG8_SP2>(F.lds + RING_OFF, gg, S_, ee); } while (0)
#define RSL_FILL(NN, RSC) do { pg8::StaticOrder S_; S_.init(M, (NN), F.G, (int)blockIdx.x); pg8::Unit u_; \
        for (int i_ = 0; i_ < RSL_UNITS && S_.next(i_, u_); ++i_) if (F.tid < 256) rsl[i_ * 256 + F.tid] = pg8::row_scale(RSC, u_.pm * 256 + F.tid); \
        __syncthreads(); } while (0)
    if (IN(0)) { RUNP(0, p0_prologue(F)); } SEAM(0);
    if (IN(1)) { const pg8::Gemm g{WSP(bf16, WS_H16), WSP(bf16, WS_WAB), M, 2048, 1024};
        const pg8::RowScale rsc{WSP(float, WS_RS0), nullptr}; RSL_FILL(2048, rsc);
        const pg8::EpiScaleBf16 e{WSP(bf16, WS_QKV0), 2048, rsl, 0, 0, nullptr, 0};
        RUNP(21, GEMM_PH(pg8::EpiScaleBf16, g, e)); RUNP(19, gates0_phase(F)); } SEAM(1);
    if (IN(2)) { RUNP(2, compress_phase(F)); } SEAM(2);
    if (IN(3)) { RUNP(3, attention_phase(F)); } SEAM(3);
    if (IN(4)) { const pg8::Gemm g{WSP(bf16, WS_ATT), WSP(bf16, WS_WABO), M, 1024, 1024};
        const pg8::EpiResid e{F.in[0], WSP(bf16, WS_H16), WSP(float, WS_PSUM) + 0 * M, D};
        RUNP(22, GEMM_PH(pg8::EpiResid, g, e)); } SEAM(4);
    if (IN(5)) { const pg8::Gemm g{WSP(bf16, WS_H16), WSP(bf16, WS_WUP0), M, 5632, 1024};
        const pg8::RowScale rsc{nullptr, WSP(float, WS_PSUM) + 0 * M}; RSL_FILL(5632, rsc);
        const pg8::EpiSwiglu e{WSP(bf16, WS_HID), FF, rsl};
        RUNP(23, GEMM_PH(pg8::EpiSwiglu, g, e)); } SEAM(5);
    if (IN(6)) { const pg8::Gemm g{WSP(bf16, WS_HID), WSP(bf16, WS_WDN0), M, 1024, FF};
        const pg8::EpiResid e{nullptr, WSP(bf16, WS_H16), WSP(float, WS_PSUM) + 1 * M, D};
        RUNP(17, GEMM_PH(pg8::EpiResid, g, e)); } SEAM(6);
    if (IN(7)) { const pg8::Gemm g{WSP(bf16, WS_H16), WSP(bf16, WS_WCIN), M, 3072, 1024};
        const pg8::RowScale rsc{nullptr, WSP(float, WS_PSUM) + 1 * M}; RSL_FILL(3072, rsc);
        const pg8::EpiScaleBf16 e{WSP(bf16, WS_QKP), 1024, rsl, 1024, (size_t)(64 * MiB / 2), WSP(bf16, WS_V1), 4};
        RUNP(24, GEMM_PH(pg8::EpiScaleBf16, g, e)); RUNP(20, gates1_phase(F)); } SEAM(7);
    if (IN(8)) { RUNP(8, conv_scan_phase(F)); } SEAM(8);
    if (IN(9)) { RUNP(9, mlstm_p1_phase(F)); } SEAM(9);
    if (IN(10)) { RUNP(10, mlstm_scan_phase(F)); } SEAM(10);
    if (IN(11)) { RUNP(11, mlstm_p3_phase(F)); } SEAM(11);
    if (IN(12)) { const pg8::Gemm g{WSP(bf16, WS_QKP), WSP(bf16, WS_WCO), M, 1024, 1024};
        const pg8::EpiResid e{nullptr, WSP(bf16, WS_H16), WSP(float, WS_PSUM) + 2 * M, D};
        RUNP(17, GEMM_PH(pg8::EpiResid, g, e)); } SEAM(12);
    if (IN(13)) { const pg8::Gemm g{WSP(bf16, WS_H16), WSP(bf16, WS_WUP1), M, 5632, 1024};
        const pg8::RowScale rsc{nullptr, WSP(float, WS_PSUM) + 2 * M}; RSL_FILL(5632, rsc);
        const pg8::EpiSwiglu e{WSP(bf16, WS_HID), FF, rsl};
        RUNP(18, GEMM_PH(pg8::EpiSwiglu, g, e)); } SEAM(13);
    if (IN(14)) { const pg8::Gemm g{WSP(bf16, WS_HID), WSP(bf16, WS_WDN1), M, 1024, FF};
        const pg8::EpiResid e{nullptr, WSP(bf16, WS_H16), WSP(float, WS_PSUM) + 3 * M, D};
        RUNP(17, GEMM_PH(pg8::EpiResid, g, e)); } SEAM(14);
    if (IN(15)) { RUNP(15, final_norm_phase(F)); }
}

extern "C" void kernel_launch(void* const* d_in, const int* in_sizes, int n_in, void* d_out, int out_size, void* d_ws, size_t ws_size, hipStream_t stream) {
    static int grid = 0;
    if (grid == 0) {
        if (n_in != 23 || in_sizes[0] != M * D || out_size != M * D || ws_size < WS_END) { fprintf(stderr, "kernel_launch: shape/workspace mismatch (n_in %d, in0 %d, out %d, ws %zu, need %zu); nothing launched\n", n_in, n_in > 0 ? in_sizes[0] : -1, out_size, ws_size, (size_t)WS_END); grid = -1; return; }
        int dev = 0, cus = 0, per_cu = 0;
        if (hipGetDevice(&dev) != hipSuccess || hipDeviceGetAttribute(&cus, hipDeviceAttributeMultiprocessorCount, dev) != hipSuccess) { grid = -1; return; }
        if (hipFuncSetAttribute((const void*)mk_fwd, hipFuncAttributeMaxDynamicSharedMemorySize, LDS_BYTES) != hipSuccess) { fprintf(stderr, "kernel_launch: hipFuncSetAttribute failed\n"); grid = -1; return; }
        if (hipOccupancyMaxActiveBlocksPerMultiprocessor(&per_cu, (const void*)mk_fwd, NWAVES * 64, LDS_BYTES) != hipSuccess || per_cu < 1) { fprintf(stderr, "kernel_launch: occupancy query says %d blocks per CU\n", per_cu); per_cu = 1; }
        (void)hipGetLastError();
        grid = cus;
    }
    if (grid < 0) return;
    if (hipMemsetAsync((char*)d_ws + WS_CTL, 0, CTL_ZERO_BYTES, stream) != hipSuccess) { fprintf(stderr, "kernel_launch: memset failed\n"); return; }
    Args a{};
    for (int i = 0; i < 23; ++i) a.in[i] = (const float*)d_in[i];
    a.out = (float*)d_out; a.ws = (unsigned char*)d_ws;
#if MK_PER_PHASE
    for (int p = 0; p < NPHASE; ++p) { a.ph_lo = p; a.ph_hi = p + 1; hipLaunchKernelGGL(mk_fwd, dim3(grid), dim3(NWAVES * 64), LDS_BYTES, stream, a); }
#else
    a.ph_lo = 0; a.ph_hi = NPHASE;
    hipLaunchKernelGGL(mk_fwd, dim3(grid), dim3(NWAVES * 64), LDS_BYTES, stream, a);
#endif
    const hipError_t le = hipPeekAtLastError();
    if (le != hipSuccess) fprintf(stderr, "kernel_launch: launch failed: %s\n", hipGetErrorName(le));
}
```

```cpp
#include <hip/hip_runtime.h>
#include <cstdio>
#include <cstdint>
#include <cmath>
#define DUPMASK 0

namespace pg8 {
#define PG8_LAS __attribute__((address_space(3)))
typedef unsigned short bf16_t;
typedef short bf16x8 __attribute__((ext_vector_type(8)));
typedef float f32x4 __attribute__((ext_vector_type(4)));
typedef unsigned u32x4 __attribute__((ext_vector_type(4)));
constexpr int BM = 256, BK = 64, HALF = 128, HTB = HALF * BK * 2  , STAGE_BYTES = 8 * HTB, NXCD = 8, WGM = 4;

__host__ __device__ __forceinline__ int lds_byte(int r, int c) { const int st = (r >> 4) * 2 + (c >> 5), rr = r & 15, cc = c & 31, ob = rr * 64 + cc * 2; return st * 1024 + (ob ^ (((ob >> 9) & 1) << 5)); }
__host__ __device__ __forceinline__ void stage_rc(int b, int& R, int& C) { const int st = b / 1024, sb = b % 1024, swz = sb ^ (((sb >> 9) & 1) << 5); R = (st >> 1) * 16 + swz / 64; C = (st & 1) * 32 + (swz % 64) / 2; }
__host__ __device__ __forceinline__ int perm32(int rho) { const int n = rho >> 4, i = rho & 15; return 8 * (i >> 2) + 4 * n + (i & 3); }

struct Unit { int pm, pn; };
struct Gemm { const bf16_t* A; const bf16_t* Bt; int M, N, K; };

struct StaticOrder {
    int nM, nN, nwg, G, c;
    __host__ __device__ __forceinline__ void init(int M, int N, int G_, int c_) { nM = M / BM; nN = N / BM; nwg = nM * nN; G = G_; c = c_; }
    __host__ __device__ __forceinline__ bool next(int i, Unit& u) const {
        const long L = (long)i * G + c; if (L >= nwg) return false;
        int wgid = (int)L; { const int q = nwg / NXCD, r = nwg % NXCD, xcd = wgid % NXCD, off = wgid / NXCD; wgid = (xcd < r ? xcd * (q + 1) : r * (q + 1) + (xcd - r) * q) + off; }
        const int nig = WGM * nN, gid = wgid / nig, fm = gid * WGM, gsz = (nM - fm) < WGM ? (nM - fm) : WGM;
        u.pm = fm + ((wgid % nig) % gsz); u.pn = (wgid % nig) / gsz; return true;
    }
    __device__ __forceinline__ void a_ready(const Unit&) const {}
    __device__ __forceinline__ void done(const Unit&) const {}
};

__device__ __forceinline__ unsigned cvt_pk_bf16(float lo, float hi) { unsigned r; asm volatile("v_cvt_pk_bf16_f32 %0, %1, %2" : "=v"(r) : "v"(lo), "v"(hi)); return r; }
typedef float f32x2 __attribute__((ext_vector_type(2)));
constexpr int MROWS = 32768;
constexpr float RMS_EPS_F = 1e-6f;
struct RowScale { const float* rs; const float* ss; };
__device__ __forceinline__ float row_scale(const RowScale& R, int row) {
    if (R.ss) return 1.0f / sqrtf(R.ss[row] * (1.0f / 1024.0f) + RMS_EPS_F);
    return R.rs[row];
}
struct EpiScaleBf16 {
    static constexpr bool PERM = true, AFTER_DRAIN = false;
    bf16_t* O; int ldc; const PG8_LAS float* rsl; int split_cols; size_t split_stride;
    bf16_t* hm; int hm_pn0;
    __device__ __forceinline__ void operator()(const f32x4 (&acc)[2][2][4][2], const Unit& u, int ui, int wr, int wc, int fr, int fq) const {
        int row0 = u.pm * BM + wr * 64 + fr; int colt = u.pn * BM; bf16_t* base = O; const PG8_LAS float* rsu = rsl + ui * BM + wr * 64 + fr; int ld = ldc;
        if (hm && u.pn >= hm_pn0) {
            const int hp_ = u.pn - hm_pn0, bt = row0 >> 13; base = hm + ((size_t)(((hp_ >> 2) * 4 + bt) * 4 + (hp_ & 3)) << 13) * 256; row0 &= 8191; colt = 0; ld = 256;
        } else if (split_cols) { const int t = colt / split_cols; base += (size_t)t * split_stride; colt -= t * split_cols; }
        const int col0 = colt + wc * 32 + 8 * fq;
#pragma unroll
        for (int ai = 0; ai < 2; ++ai)
#pragma unroll
            for (int m = 0; m < 4; ++m) { const int row = row0 + ai * HALF + m * 16; const float sc = rsu[ai * HALF + m * 16]; bf16_t* rowp = base + (size_t)row * ld + col0;
#pragma unroll
                for (int bj = 0; bj < 2; ++bj) { f32x4 v0 = acc[ai][bj][m][0] * sc, v1 = acc[ai][bj][m][1] * sc;
                    u32x4 w; w.x = cvt_pk_bf16(v0[0], v0[1]); w.y = cvt_pk_bf16(v0[2], v0[3]); w.z = cvt_pk_bf16(v1[0], v1[1]); w.w = cvt_pk_bf16(v1[2], v1[3]);
                    *(u32x4*)(rowp + bj * HALF) = w; } }
    }
};
struct EpiSwiglu {
    static constexpr bool PERM = true, AFTER_DRAIN = false;
    bf16_t* O; int ldc; const PG8_LAS float* rsl;
    __device__ __forceinline__ void operator()(const f32x4 (&acc)[2][2][4][2], const Unit& u, int ui, int wr, int wc, int fr, int fq) const {
        const int row0 = u.pm * BM + wr * 64 + fr; const int col0 = u.pn * HALF + wc * 32 + 8 * fq; const PG8_LAS float* rsu = rsl + ui * BM + wr * 64 + fr;
#pragma unroll
        for (int ai = 0; ai < 2; ++ai)
#pragma unroll
            for (int m = 0; m < 4; ++m) { const int row = row0 + ai * HALF + m * 16; const float sc = rsu[ai * HALF + m * 16]; bf16_t* rowp = O + (size_t)row * ldc + col0;
                float o[8];
#pragma unroll
                for (int n = 0; n < 2; ++n)
#pragma unroll
                    for (int e = 0; e < 4; ++e) { const float g = acc[ai][0][m][n][e] * sc, up = acc[ai][1][m][n][e] * sc; o[n * 4 + e] = g * up * __builtin_amdgcn_rcpf(1.0f + __expf(-g)); }
                u32x4 w; w.x = cvt_pk_bf16(o[0], o[1]); w.y = cvt_pk_bf16(o[2], o[3]); w.z = cvt_pk_bf16(o[4], o[5]); w.w = cvt_pk_bf16(o[6], o[7]);
                __builtin_nontemporal_store(w, (u32x4*)rowp); }
    }
};
struct EpiResid {
    static constexpr bool PERM = true, AFTER_DRAIN = false;
    const float* basef; bf16_t* h16; float* ss; int ldc;
    __device__ __forceinline__ void operator()(const f32x4 (&acc)[2][2][4][2], const Unit& u, int ui, int wr, int wc, int fr, int fq) const {
        const int row0 = u.pm * BM + wr * 64 + fr, col0 = u.pn * BM + wc * 32 + 8 * fq;
        if (basef) {
#pragma unroll
            for (int ai = 0; ai < 2; ++ai) {
                f32x4 pre[4][2][2];
#pragma unroll
                for (int m = 0; m < 4; ++m) { const size_t off = (size_t)(row0 + ai * HALF + m * 16) * ldc + col0;
#pragma unroll
                    for (int bj = 0; bj < 2; ++bj)
#pragma unroll
                        for (int n = 0; n < 2; ++n) pre[m][bj][n] = *(const f32x4*)(basef + off + bj * HALF + n * 4); }
#pragma unroll
                for (int m = 0; m < 4; ++m) { const int row = row0 + ai * HALF + m * 16; const size_t off = (size_t)row * ldc + col0; float sq = 0.f;
#pragma unroll
                    for (int bj = 0; bj < 2; ++bj) { const f32x4 o0 = pre[m][bj][0] + acc[ai][bj][m][0], o1 = pre[m][bj][1] + acc[ai][bj][m][1];
                        sq += ((o0[0] * o0[0] + o0[1] * o0[1]) + (o0[2] * o0[2] + o0[3] * o0[3])) + ((o1[0] * o1[0] + o1[1] * o1[1]) + (o1[2] * o1[2] + o1[3] * o1[3]));
                        u32x4 w; w.x = cvt_pk_bf16(o0[0], o0[1]); w.y = cvt_pk_bf16(o0[2], o0[3]); w.z = cvt_pk_bf16(o1[0], o1[1]); w.w = cvt_pk_bf16(o1[2], o1[3]);
                        *(u32x4*)(h16 + off + bj * HALF) = w; }
                    sq += __shfl_xor(sq, 16); sq += __shfl_xor(sq, 32);
                    if (fq == 0) atomicAdd(ss + row, sq); }
            }
        } else {
            u32x4 pre[2][4][2];
#pragma unroll
            for (int ai = 0; ai < 2; ++ai)
#pragma unroll
                for (int m = 0; m < 4; ++m) { const size_t off = (size_t)(row0 + ai * HALF + m * 16) * ldc + col0;
#pragma unroll
                    for (int bj = 0; bj < 2; ++bj) pre[ai][m][bj] = *(const u32x4*)(h16 + off + bj * HALF); }
#pragma unroll
            for (int ai = 0; ai < 2; ++ai)
#pragma unroll
                for (int m = 0; m < 4; ++m) { const int row = row0 + ai * HALF + m * 16; const size_t off = (size_t)row * ldc + col0; float sq = 0.f;
#pragma unroll
                    for (int bj = 0; bj < 2; ++bj) { const u32x4 pw = pre[ai][m][bj];
                        const f32x4 o0 = (f32x4){__builtin_bit_cast(float, pw.x << 16), __builtin_bit_cast(float, pw.x & 0xffff0000u), __builtin_bit_cast(float, pw.y << 16), __builtin_bit_cast(float, pw.y & 0xffff0000u)} + acc[ai][bj][m][0];
                        const f32x4 o1 = (f32x4){__builtin_bit_cast(float, pw.z << 16), __builtin_bit_cast(float, pw.z & 0xffff0000u), __builtin_bit_cast(float, pw.w << 16), __builtin_bit_cast(float, pw.w & 0xffff0000u)} + acc[ai][bj][m][1];
                        sq += ((o0[0] * o0[0] + o0[1] * o0[1]) + (o0[2] * o0[2] + o0[3] * o0[3])) + ((o1[0] * o1[0] + o1[1] * o1[1]) + (o1[2] * o1[2] + o1[3] * o1[3]));
                        u32x4 w; w.x = cvt_pk_bf16(o0[0], o0[1]); w.y = cvt_pk_bf16(o0[2], o0[3]); w.z = cvt_pk_bf16(o1[0], o1[1]); w.w = cvt_pk_bf16(o1[2], o1[3]);
                        *(u32x4*)(h16 + off + bj * HALF) = w; }
                    sq += __shfl_xor(sq, 16); sq += __shfl_xor(sq, 32);
                    if (fq == 0) atomicAdd(ss + row, sq); }
        }
    }
};
template <class Epi, class Sched, bool ALIGN_EPI = false, bool SP2 = false>
__device__ __forceinline__ void gemm_phase(PG8_LAS unsigned char* lds, const Gemm g, const Sched& S, const Epi& E) {
    const int tid = threadIdx.x, wid = __builtin_amdgcn_readfirstlane(tid >> 6), lane = tid & 63, wr = wid >> 2, wc = wid & 3, fr = lane & 15, fq = lane >> 4;
    const int K = g.K, nt = K / BK;
    unsigned voffA[2], voffB[2];
#pragma unroll
    for (int i = 0; i < 2; ++i) { int R, C; stage_rc(tid * 16 + i * 8192, R, C); const int Rb = Epi::PERM ? ((R & ~31) + perm32(R & 31)) : R;
        voffA[i] = (unsigned)(R * K + C) * 2u; voffB[i] = (unsigned)(Rb * K + C) * 2u; }
    const size_t kstep = (size_t)(BK * 2);
    const size_t hstep = (size_t)HALF * K * 2;
    const size_t tstep = 2 * hstep;
    const unsigned ldsw = (unsigned)wid * 1024u;
    const int aoff = lds_byte(wr * 64 + fr, fq * 8), boff = lds_byte(wc * 32 + fr, fq * 8);
#define PG8_SA(b, h) (((b) * 2 + (h)) * HTB)
#define PG8_SB(b, h) ((4 + (b) * 2 + (h)) * HTB)
#define PG8_STAGE(bufoff, gbase, voff) do { _Pragma("unroll") for (int _i = 0; _i < 2; ++_i) \
        __builtin_amdgcn_global_load_lds((const unsigned*)((const char*)(gbase) + (voff)[_i]), (PG8_LAS unsigned*)(lds + (bufoff) + ldsw + _i * 8192), 16, 0, 0); } while (0)
#define PG8_LDA(dst, b, h) do { _Pragma("unroll") for (int m = 0; m < 4; ++m) _Pragma("unroll") for (int k = 0; k < 2; ++k) dst[m][k] = *(const PG8_LAS bf16x8*)(lds + PG8_SA(b, h) + aoff + m * 2048 + k * 1024); } while (0)
#define PG8_LDB(dst, b, h) do { _Pragma("unroll") for (int n = 0; n < 2; ++n) _Pragma("unroll") for (int k = 0; k < 2; ++k) dst[n][k] = *(const PG8_LAS bf16x8*)(lds + PG8_SB(b, h) + boff + n * 2048 + k * 1024); } while (0)
#define PG8_MMA(ai, bj, At, Bt) do { __builtin_amdgcn_s_setprio(1); _Pragma("unroll") for (int m = 0; m < 4; ++m) _Pragma("unroll") for (int n = 0; n < 2; ++n) _Pragma("unroll") for (int k = 0; k < 2; ++k) \
        acc[ai][bj][m][n] = __builtin_amdgcn_mfma_f32_16x16x32_bf16(Bt[n][k], At[m][k], acc[ai][bj][m][n], 0, 0, 0); __builtin_amdgcn_s_setprio(0); } while (0)
#define PG8_WAIT_V(n) asm volatile("s_waitcnt vmcnt(" #n ")" ::: "memory")
#define PG8_WAIT_L(n) asm volatile("s_waitcnt lgkmcnt(" #n ")" ::: "memory")
#define PG8_BAR __builtin_amdgcn_s_barrier()
#define PG8_SCHED __builtin_amdgcn_sched_barrier(0)
    Unit cur, nxt; int ui = 0;
    if (!S.next(0, cur)) return;
    f32x4 acc[2][2][4][2];
#pragma unroll
    for (int a = 0; a < 2; ++a)
#pragma unroll
        for (int b = 0; b < 2; ++b)
#pragma unroll
            for (int m = 0; m < 4; ++m)
#pragma unroll
                for (int n = 0; n < 2; ++n) acc[a][b][m][n] = (f32x4){0.f, 0.f, 0.f, 0.f};
    bf16x8 At[4][2], B0[2][2], B1[2][2];
    const char* cA = (const char*)g.A + (size_t)cur.pm * tstep; const char* cB = (const char*)g.Bt + (size_t)cur.pn * tstep;
    S.a_ready(cur);
    if constexpr (SP2) {
        PG8_STAGE(PG8_SB(0, 0), cB, voffB); PG8_STAGE(PG8_SB(0, 1), cB + hstep, voffB); PG8_STAGE(PG8_SA(0, 0), cA, voffA); PG8_STAGE(PG8_SA(0, 1), cA + hstep, voffA);
        if (wr == 1) PG8_BAR;
        PG8_WAIT_V(2); PG8_BAR;
        PG8_STAGE(PG8_SB(1, 0), cB + kstep, voffB); PG8_STAGE(PG8_SA(1, 0), cA + kstep, voffA); PG8_STAGE(PG8_SB(1, 1), cB + hstep + kstep, voffB);
        PG8_WAIT_V(6); PG8_BAR;
    } else {
        PG8_STAGE(PG8_SB(0, 0), cB, voffB); PG8_STAGE(PG8_SA(0, 0), cA, voffA); PG8_STAGE(PG8_SB(0, 1), cB + hstep, voffB); PG8_STAGE(PG8_SA(0, 1), cA + hstep, voffA);
        if (wr == 1) PG8_BAR;
        PG8_WAIT_V(4); PG8_BAR;
        PG8_STAGE(PG8_SB(1, 0), cB + kstep, voffB); PG8_STAGE(PG8_SA(1, 0), cA + kstep, voffA); PG8_STAGE(PG8_SB(1, 1), cB + hstep + kstep, voffB);
        PG8_WAIT_V(6); PG8_BAR;
    }
    for (;;) {
        const bool has_next = S.next(ui + 1, nxt);
        const char* nA = has_next ? (const char*)g.A + (size_t)nxt.pm * tstep : cA; const char* nB = has_next ? (const char*)g.Bt + (size_t)nxt.pn * tstep : cB;
        for (int t = 0; t < nt; t += 2) {
            const bool last = (t == nt - 2);
            const char* a1 = cA + (size_t)(t + 1) * kstep;
            const char* a2 = last ? nA : cA + (size_t)(t + 2) * kstep; const char* b2 = last ? nB : cB + (size_t)(t + 2) * kstep;
            const char* a3 = a2 + kstep; const char* b3 = b2 + kstep;
            if (last && has_next) S.a_ready(nxt);
            if constexpr (SP2) {
            PG8_LDB(B0, 0, 0); PG8_LDB(B1, 0, 1); PG8_SCHED; PG8_LDA(At, 0, 0); PG8_STAGE(PG8_SA(1, 1), a1 + hstep, voffA);
            PG8_WAIT_V(8); PG8_WAIT_L(0); PG8_BAR; PG8_MMA(0, 0, At, B0); PG8_MMA(0, 1, At, B1); PG8_BAR; PG8_SCHED;
            PG8_LDA(At, 0, 1); PG8_STAGE(PG8_SB(0, 0), b2, voffB); PG8_STAGE(PG8_SB(0, 1), b2 + hstep, voffB); PG8_STAGE(PG8_SA(0, 0), a2, voffA);
            PG8_WAIT_V(8); PG8_WAIT_L(0); PG8_BAR; PG8_MMA(1, 0, At, B0); PG8_MMA(1, 1, At, B1); PG8_BAR; PG8_SCHED;
            PG8_LDB(B0, 1, 0); PG8_LDB(B1, 1, 1); PG8_SCHED; PG8_LDA(At, 1, 0); PG8_STAGE(PG8_SA(0, 1), a2 + hstep, voffA);
            PG8_WAIT_V(8); PG8_WAIT_L(0); PG8_BAR; PG8_MMA(0, 0, At, B0); PG8_MMA(0, 1, At, B1); PG8_BAR; PG8_SCHED;
            PG8_LDA(At, 1, 1); PG8_STAGE(PG8_SB(1, 0), b3, voffB); PG8_STAGE(PG8_SB(1, 1), b3 + hstep, voffB); PG8_STAGE(PG8_SA(1, 0), a3, voffA);
            PG8_WAIT_V(8); PG8_WAIT_L(0); PG8_BAR; PG8_MMA(1, 0, At, B0); PG8_MMA(1, 1, At, B1); PG8_BAR; PG8_SCHED;
            } else {
            PG8_LDB(B0, 0, 0); PG8_SCHED; PG8_LDA(At, 0, 0); PG8_STAGE(PG8_SA(1, 1), a1 + hstep, voffA);
            PG8_WAIT_L(8); PG8_BAR; PG8_WAIT_L(0); PG8_MMA(0, 0, At, B0); PG8_BAR; PG8_SCHED;
            PG8_LDB(B1, 0, 1); PG8_STAGE(PG8_SB(0, 0), b2, voffB);
            PG8_BAR; PG8_WAIT_L(0); PG8_MMA(0, 1, At, B1); PG8_BAR;
            PG8_LDA(At, 0, 1); PG8_STAGE(PG8_SA(0, 0), a2, voffA);
            PG8_BAR; PG8_WAIT_L(0); PG8_MMA(1, 0, At, B0); PG8_BAR; PG8_SCHED;
            PG8_STAGE(PG8_SB(0, 1), b2 + hstep, voffB);
            PG8_WAIT_V(6); PG8_BAR; PG8_MMA(1, 1, At, B1); PG8_BAR;
            PG8_LDB(B0, 1, 0); PG8_SCHED; PG8_LDA(At, 1, 0); PG8_STAGE(PG8_SA(0, 1), a2 + hstep, voffA);
            PG8_WAIT_L(8); PG8_BAR; PG8_WAIT_L(0); PG8_MMA(0, 0, At, B0); PG8_BAR; PG8_SCHED;
            PG8_LDB(B1, 1, 1); PG8_STAGE(PG8_SB(1, 0), b3, voffB);
            PG8_BAR; PG8_WAIT_L(0); PG8_MMA(0, 1, At, B1); PG8_BAR;
            PG8_LDA(At, 1, 1); PG8_STAGE(PG8_SA(1, 0), a3, voffA);
            PG8_BAR; PG8_WAIT_L(0); PG8_MMA(1, 0, At, B0); PG8_BAR; PG8_SCHED;
            PG8_STAGE(PG8_SB(1, 1), b3 + hstep, voffB);
            PG8_WAIT_V(6); PG8_BAR; PG8_MMA(1, 1, At, B1); PG8_BAR;
            }
        }
        if constexpr (ALIGN_EPI) { if (wr == 0) PG8_BAR; }
        if constexpr (!Epi::AFTER_DRAIN) { E(acc, cur, ui, wr, wc, fr, fq); S.done(cur); }
        if (!has_next) break;
#pragma unroll
        for (int a = 0; a < 2; ++a)
#pragma unroll
            for (int b = 0; b < 2; ++b)
#pragma unroll
                for (int m = 0; m < 4; ++m)
#pragma unroll
                    for (int n = 0; n < 2; ++n) acc[a][b][m][n] = (f32x4){0.f, 0.f, 0.f, 0.f};
        cur = nxt; cA = nA; cB = nB; ++ui;
        if constexpr (ALIGN_EPI) { if (wr == 1) PG8_BAR; }
    }
    PG8_WAIT_V(0);
    if constexpr (!ALIGN_EPI) { if (wr == 0) PG8_BAR; }
    PG8_BAR;
    if constexpr (Epi::AFTER_DRAIN) { E.fused(acc, cur, wr, wc, fr, fq, lds, wid, lane); S.done(cur); }
#undef PG8_SA
#undef PG8_SB
#undef PG8_STAGE
#undef PG8_LDA
#undef PG8_LDB
#undef PG8_MMA
#undef PG8_WAIT_V
#undef PG8_WAIT_L
#undef PG8_BAR
#undef PG8_SCHED
}
}
#ifndef PG8_SP2
#define PG8_SP2 true
#endif
#ifndef PG8_ALIGN
#define PG8_ALIGN true
#endif
constexpr int NWAVES = 8;
#ifndef MK_PER_PHASE
#define MK_PER_PHASE 0
#endif
constexpr int NPHASE = 16;

constexpr int BATCH = 4, T = 8192, D = 1024, M = BATCH * T, FF = 2816;
constexpr int AB_LD = 2072, C_LD = 3080;
constexpr float C2 = 0.125f * 1.4426950408889634f;
constexpr float LOG2E = 1.4426950408889634f;
constexpr int QC_QN = 0, QC_KC = 512, QC_VC = 640, QC_KS = 768, QC_VS = 896, QC_KW = 1024, QC_VW = 1152, QC_QS = 1280, QC_KSW = 1792, QC_VSW = 1920;

constexpr size_t MiB = 1u << 20, KiB = 1024;
constexpr size_t WS_CTL = 0, CTL_ZERO_BYTES = 64 * KiB;
constexpr size_t WS_RS0 = 1 * MiB;
constexpr size_t WS_PSUM = WS_RS0 + 128 * KiB;
constexpr size_t WS_GATES = WS_PSUM + 2 * MiB;
constexpr size_t WS_SCA = WS_GATES + 4 * MiB;
constexpr size_t WS_SCM = WS_SCA + 512 * KiB;
constexpr size_t WS_SCE = WS_SCM + 512 * KiB;
constexpr size_t WS_KC = WS_SCE + 512 * KiB;
constexpr size_t WS_VC = WS_KC + 512 * KiB;
constexpr size_t WS_WABG = WS_VC + 512 * KiB;
constexpr size_t WS_WCG = WS_WABG + 64 * KiB;
constexpr size_t WS_CW1K = WS_WCG + 64 * KiB;
constexpr size_t WS_CW1V = WS_CW1K + 256 * KiB;
constexpr size_t WS_CW2K = WS_CW1V + 256 * KiB;
constexpr size_t WS_CW2V = WS_CW2K + 8 * KiB;
constexpr size_t WS_CBIAS = WS_CW2V + 8 * KiB;
constexpr size_t WS_NLOC = WS_CBIAS + 4 * KiB;
constexpr size_t WS_NST = WS_NLOC + 256 * KiB;
static_assert(WS_NST + 256 * KiB <= 13 * MiB, "small region");
constexpr size_t WS_WAB = 13 * MiB;
constexpr size_t WS_WABO = WS_WAB + 4 * MiB;
constexpr size_t WS_WUP0 = WS_WABO + 2 * MiB;
constexpr size_t WS_WUP1 = WS_WUP0 + 11 * MiB;
constexpr size_t WS_WDN0 = WS_WUP1 + 11 * MiB;
constexpr size_t WS_WDN1 = WS_WDN0 + 5632 * KiB;
constexpr size_t WS_WCIN = WS_WDN1 + 5632 * KiB;
constexpr size_t WS_WCO = WS_WCIN + 6 * MiB;
static_assert(WS_WCO + 2 * MiB <= 60 * MiB, "weights region");
constexpr size_t WS_H16 = 60 * MiB;
constexpr size_t WS_A = 124 * MiB;
constexpr size_t WS_QKV0 = WS_A, WS_ATT = WS_A + 128 * MiB;
constexpr size_t WS_QKP = WS_A, WS_V1 = WS_A + 64 * MiB, WS_OG = WS_A + 128 * MiB;
constexpr size_t WS_B = 316 * MiB;
constexpr size_t WS_HID = WS_B;
constexpr size_t WS_ACCF = WS_B;
constexpr size_t WS_CBPART = WS_B;
constexpr size_t WS_QKC = WS_B, WS_LT = WS_B + 64 * MiB, WS_CST = WS_B + 128 * MiB;
constexpr size_t WS_END = 492 * MiB;
static_assert(WS_HID + (size_t)M * FF * 2 <= WS_END && WS_CST + 32 * MiB <= WS_END, "d_ws map");
constexpr int CW_TMO = 0, CW_CODE = 1, CW_CBIAS = 1024, CW_QUEUE = 2048;
constexpr int CW_BAR = 4096;

constexpr int RING_OFF = 0, RING_BYTES = 131072;
constexpr int LDS_BYTES = 147456;
constexpr int LDSCTL_OFF = LDS_BYTES - 1024, MISC_OFF = LDSCTL_OFF + 320;
static_assert(MISC_OFF + 128 <= LDS_BYTES, "LDS map");

#define GAS __attribute__((address_space(1)))
#define LAS __attribute__((address_space(3)))
typedef unsigned short bf16;
typedef unsigned v4u __attribute__((ext_vector_type(4)));
typedef unsigned v2u __attribute__((ext_vector_type(2)));
typedef float f32x4 __attribute__((ext_vector_type(4)));
typedef float f32x16 __attribute__((ext_vector_type(16)));
typedef short bf16x8 __attribute__((ext_vector_type(8)));
typedef short s16x4 __attribute__((ext_vector_type(4)));
typedef GAS unsigned gu32;
typedef GAS unsigned long long gu64;
#define RLX_AGENT __ATOMIC_RELAXED, __HIP_MEMORY_SCOPE_AGENT
#define LDS_WAIT() asm volatile("s_waitcnt lgkmcnt(0)" ::: "memory")
#define VM_WAIT() asm volatile("s_waitcnt vmcnt(0)" ::: "memory")
__device__ __forceinline__ unsigned f2bf(float f) { unsigned u = __builtin_bit_cast(unsigned, f); return (u + 0x7fffu + ((u >> 16) & 1u)) >> 16; }
typedef float f32x2_t __attribute__((ext_vector_type(2))); typedef __bf16 bf16x2_t __attribute__((ext_vector_type(2)));
__device__ __forceinline__ unsigned cvtpk(float lo, float hi) { f32x2_t v = {lo, hi}; bf16x2_t b = __builtin_convertvector(v, bf16x2_t); return __builtin_bit_cast(unsigned, b); }
__device__ __forceinline__ unsigned pk2(float lo, float hi) { return cvtpk(lo, hi); }
__device__ __forceinline__ float bf2f(unsigned short b) { return __builtin_bit_cast(float, (unsigned)b << 16); }
__device__ __forceinline__ float bflo(unsigned w) { return __builtin_bit_cast(float, w << 16); }
__device__ __forceinline__ float bfhi(unsigned w) { return __builtin_bit_cast(float, w & 0xffff0000u); }
__device__ __forceinline__ int crow(int r, int hi) { return (r & 3) + 8 * (r >> 2) + 4 * hi; }
__device__ __forceinline__ f32x16 mfma32(bf16x8 a, bf16x8 b, f32x16 c) { return __builtin_amdgcn_mfma_f32_32x32x16_bf16(a, b, c, 0, 0, 0); }
typedef short v4i16_t __attribute__((ext_vector_type(4)));
__device__ __forceinline__ s16x4 ds_tr(LAS unsigned char* p) { return __builtin_bit_cast(s16x4, __builtin_amdgcn_ds_read_tr16_b64_v4i16((LAS v4i16_t*)p)); }
__device__ __forceinline__ bf16x8 frag_tr(LAS unsigned char* lb, int off0, int off1) {
    const s16x4 lo = ds_tr(lb + off0), hi = ds_tr(lb + off1);
    return (bf16x8){lo[0], lo[1], lo[2], lo[3], hi[0], hi[1], hi[2], hi[3]};
}
template <int s> __device__ __forceinline__ bf16x8 pack8(const f32x16& p) {
    v4u w; w.x = cvtpk(p[8 * s + 0], p[8 * s + 1]); w.y = cvtpk(p[8 * s + 2], p[8 * s + 3]); w.z = cvtpk(p[8 * s + 4], p[8 * s + 5]); w.w = cvtpk(p[8 * s + 6], p[8 * s + 7]);
    return __builtin_bit_cast(bf16x8, w);
}
__device__ __forceinline__ float wave_sum(float v) {
#pragma unroll
    for (int o = 1; o < 64; o <<= 1) v += __shfl_xor(v, o);
    return v;
}
#define XB_TMO      128
#define XB_XCNT(j)  (256  + 64 * (j))
#define XB_XSUB(j)  (1280 + 64 * (j))
#define XB_XGEN(j)  (2304 + 64 * (j))
#define XB_TOP      3328
#define XB_TOPGEN   3392
#define XCD_BAR_WORDS 3456
#define XB_SPIN_CAP (1u << 18)

__device__ __forceinline__ unsigned xb_ld(unsigned* p)              { return __hip_atomic_load(p, __ATOMIC_RELAXED, __HIP_MEMORY_SCOPE_AGENT); }
__device__ __forceinline__ unsigned xb_add(unsigned* p, unsigned v) { return __hip_atomic_fetch_add(p, v, __ATOMIC_RELAXED, __HIP_MEMORY_SCOPE_AGENT); }
__device__ __forceinline__ unsigned xb_xcc_id() { return (unsigned)__builtin_amdgcn_s_getreg((3 << 11) | 20) & 0xFu; }
#define XB_SPIN(cond, bar) do { unsigned _sp = 0; while (cond) { __builtin_amdgcn_s_sleep(1); \
    if ((++_sp & 255u) == 0u) { if (xb_ld(&(bar)[XB_TMO])) break; if (_sp > XB_SPIN_CAP) { atomicAdd(&(bar)[XB_TMO], 1u); break; } } } } while (0)

struct XcdBarrier {
    unsigned* bar; unsigned x;
    volatile LAS unsigned* st;
};

__device__ __forceinline__ XcdBarrier xcd_barrier_post(unsigned* bar, volatile LAS unsigned* st) {
    XcdBarrier b; b.bar = bar; b.x = xb_xcc_id(); b.st = st;
    if (threadIdx.x == 0) (void)xb_add(&bar[XB_XCNT(b.x)], 1u);
    return b;
}
__device__ __forceinline__ void xcd_barrier_complete(unsigned* bar, unsigned x, unsigned& nloc, unsigned& nx) {
    const unsigned G = gridDim.x * gridDim.y * gridDim.z;
    unsigned sum, cnt, mine, sp = 0u;
    for (;;) {
        sum = 0u; cnt = 0u; mine = 0u;
#pragma unroll
        for (unsigned j = 0; j < 16; ++j) { const unsigned c = xb_ld(&bar[XB_XCNT(j)]); sum += c; cnt += (c > 0u) ? 1u : 0u; mine = (j == x) ? c : mine; }
        if (sum == G) break;
        __builtin_amdgcn_s_sleep(1);
        if ((++sp & 255u) == 0u) { if (xb_ld(&bar[XB_TMO])) break; if (sp > XB_SPIN_CAP) { atomicAdd(&bar[XB_TMO], 1u); break; } }
    }
    nloc = mine > 0u ? mine : 1u; nx = cnt > 0u ? cnt : 1u;
}

__device__ __forceinline__ void xcd_barrier(const XcdBarrier& b) {
    asm volatile("s_waitcnt vmcnt(0)" ::: "memory");
    __syncthreads();
    if (threadIdx.x == 0) {
        unsigned* bar = b.bar;
        __builtin_amdgcn_s_waitcnt(0);
        unsigned nloc = b.st[0], nx = b.st[1];
        if (nloc == 0u) { xcd_barrier_complete(bar, b.x, nloc, nx); b.st[0] = nloc; b.st[1] = nx; }
        const unsigned old = xb_add(&bar[XB_XSUB(b.x)], 1u);
        const unsigned gen = old / nloc;
        if (old + 1u == (gen + 1u) * nloc) {
            __builtin_amdgcn_fence(__ATOMIC_RELEASE, "agent");
            asm volatile("s_waitcnt vmcnt(0)" ::: "memory");
            const unsigned og = xb_add(&bar[XB_TOP], 1u);
            const unsigned tg = og / nx;
            if (og + 1u == (tg + 1u) * nx) xb_add(&bar[XB_TOPGEN], 1u);
            else XB_SPIN(xb_ld(&bar[XB_TOPGEN]) == tg, bar);
            __builtin_amdgcn_fence(__ATOMIC_ACQUIRE, "agent");
            xb_add(&bar[XB_XGEN(b.x)], 1u);
            asm volatile("s_waitcnt vmcnt(0)" ::: "memory");
        } else {
            XB_SPIN(xb_ld(&bar[XB_XGEN(b.x)]) == gen, bar);
            __builtin_amdgcn_fence(__ATOMIC_ACQUIRE, "agent");
            asm volatile("s_waitcnt vmcnt(0)" ::: "memory");
        }
    }
    __syncthreads();
}
struct Frame {
    LAS unsigned char* lds;
    volatile LAS unsigned* MISC;
    gu32* ctl;
    int tid, lane, wave;
    int vcu, G;
    unsigned char* ws;
    const float* in[23];
    float* out;
};
#define WSP(T_, off) ((T_*)(F.ws + (off)))

__device__ __forceinline__ void p0_titem(const float* W, int ldw, int c0, const float* kscale, float mul, bf16* WT, int Kd, int drow0, LAS float* scr, int kb, int lane) {
    const int k0 = 64 * kb; f32x4 v[8];
    if ((c0 & 3) == 0 && (ldw & 3) == 0) {
#pragma unroll
        for (int i = 0; i < 8; ++i) { const int kk = 8 * i + (lane >> 3); v[i] = __builtin_nontemporal_load((const f32x4*)(W + (size_t)(k0 + kk) * ldw + c0 + 4 * (lane & 7))); }
    } else {
#pragma unroll
        for (int i = 0; i < 8; ++i) { const int kk = 8 * i + (lane >> 3); const float* p = W + (size_t)(k0 + kk) * ldw + c0 + 4 * (lane & 7); v[i] = (f32x4){p[0], p[1], p[2], p[3]}; }
    }
#pragma unroll
    for (int i = 0; i < 8; ++i) { const int kk = 8 * i + (lane >> 3); const float sc = (kscale ? kscale[k0 + kk] : 1.0f) * mul; LAS float* d = scr + kk * 33 + 4 * (lane & 7);
        d[0] = v[i][0] * sc; d[1] = v[i][1] * sc; d[2] = v[i][2] * sc; d[3] = v[i][3] * sc; }
    LDS_WAIT(); asm volatile("" ::: "memory");
    const int c = lane & 7;
#pragma unroll
    for (int j = 0; j < 4; ++j) { const int n = (lane >> 3) + 8 * j; const LAS float* s = scr + (8 * c) * 33 + n;
        v4u o; o.x = pk2(s[0 * 33], s[1 * 33]); o.y = pk2(s[2 * 33], s[3 * 33]); o.z = pk2(s[4 * 33], s[5 * 33]); o.w = pk2(s[6 * 33], s[7 * 33]);
        *(GAS v4u*)(WT + (size_t)(drow0 + n) * Kd + k0 + 8 * c) = o; }
    LDS_WAIT(); asm volatile("" ::: "memory");
}
__device__ __forceinline__ void p0_prologue(Frame& F) {
    LAS float* scr = (LAS float*)(F.lds + RING_OFF + F.wave * 16384);
    const int gw = F.vcu * NWAVES + F.wave, NGW = F.G * NWAVES, lane = F.lane;
    const float* norm_mix = F.in[1]; const float* norm_ffn = F.in[2];
    constexpr int I_AB1 = 16 * 40, I_AB2 = 16 * 24, I_ABO = 16 * 32, I_FF = 16 * 88, I_DN = 44 * 32, I_CIN = 16 * 96, I_CO = 16 * 32, I_W1 = 32 * 2, I_W2 = 2;
    constexpr int NITEMS = I_AB1 + I_AB2 + I_ABO + 4 * I_FF + 2 * I_DN + I_CIN + I_CO + 2 * I_W1 + 2 * I_W2;
    for (int it = gw; it < NITEMS; it += NGW) {
        int r = it;
        if (r < I_AB1) { const int kb = r / 40, nb = r % 40; p0_titem(F.in[6], AB_LD, 32 * nb, norm_mix, nb < 16 ? C2 : 1.f, WSP(bf16, WS_WAB), 1024, 32 * nb, scr, kb, lane); continue; } r -= I_AB1;
        if (r < I_AB2) { const int kb = r / 24, nb = r % 24; p0_titem(F.in[6], AB_LD, 1304 + 32 * nb, norm_mix, nb < 16 ? C2 : 1.f, WSP(bf16, WS_WAB), 1024, 1280 + 32 * nb, scr, kb, lane); continue; } r -= I_AB2;
        if (r < I_ABO) { const int kb = r / 32, nb = r % 32; p0_titem(F.in[15], 1024, 32 * nb, nullptr, 1.f, WSP(bf16, WS_WABO), 1024, 32 * nb, scr, kb, lane); continue; } r -= I_ABO;
        if (r < 4 * I_FF) { const int q = r / I_FF, rr = r % I_FF, l = q >> 1, up = q & 1, kb = rr / 88, nb = rr % 88, n0 = 32 * nb;
            const float* W = (up ? F.in[4] : F.in[3]) + (size_t)l * 1024 * FF;
            p0_titem(W, FF, n0, norm_ffn + l * 1024, 1.f, WSP(bf16, l ? WS_WUP1 : WS_WUP0), 1024, 256 * (n0 / 128) + (n0 % 128) + 128 * up, scr, kb, lane); continue; } r -= 4 * I_FF;
        if (r < 2 * I_DN) { const int l = r / I_DN, rr = r % I_DN, kb = rr / 32, nb = rr % 32;
            p0_titem(F.in[5] + (size_t)l * FF * 1024, 1024, 32 * nb, nullptr, 1.f, WSP(bf16, l ? WS_WDN1 : WS_WDN0), FF, 32 * nb, scr, kb, lane); continue; } r -= 2 * I_DN;
        if (r < I_CIN) { const int kb = r / 96, nb = r % 96; p0_titem(F.in[16], C_LD, 32 * nb, norm_mix + 1024, 1.f, WSP(bf16, WS_WCIN), 1024, 32 * nb, scr, kb, lane); continue; } r -= I_CIN;
        if (r < I_CO) { const int kb = r / 32, nb = r % 32; p0_titem(F.in[21], 1024, 32 * nb, nullptr, 1.f, WSP(bf16, WS_WCO), 1024, 32 * nb, scr, kb, lane); continue; } r -= I_CO;
        if (r < 2 * I_W1) { const int kv = r / I_W1, rr = r % I_W1, kb = rr / 2, nb = rr % 2; p0_titem(F.in[kv ? 12 : 10], 64, 32 * nb, nullptr, 1.f, WSP(bf16, kv ? WS_CW1V : WS_CW1K), 2048, 32 * nb, scr, kb, lane); continue; } r -= 2 * I_W1;
        { const int kv = r / I_W2, nb = r % I_W2; p0_titem(F.in[kv ? 13 : 11], 64, 32 * nb, nullptr, 1.f, WSP(bf16, kv ? WS_CW2V : WS_CW2K), 64, 32 * nb, scr, 0, lane); }
    }
    { const int gt = (F.vcu * NWAVES + F.wave) * 64 + lane, NGT = F.G * NWAVES * 64;
      for (int i = gt; i < 2 * 32 * 1024; i += NGT) { const int which = i >> 15, n = (i >> 10) & 31, k = i & 1023; float v = 0.f;
          if (which == 0) { if (n < 24) v = F.in[6][(size_t)k * AB_LD + 1280 + n] * norm_mix[k]; WSP(bf16, WS_WABG)[n * 1024 + k] = (bf16)f2bf(v); }
          else { if (n < 8) v = F.in[16][(size_t)k * C_LD + 3072 + n] * norm_mix[1024 + k]; WSP(bf16, WS_WCG)[n * 1024 + k] = (bf16)f2bf(v); } } }
    { const int gt = (F.vcu * NWAVES + F.wave) * 64 + lane, NGT = F.G * NWAVES * 64; for (int i = gt; i < 4 * M; i += NGT) WSP(float, WS_PSUM)[i] = 0.f; }
    for (int m = gw; m < M; m += 4 * NGW) {
        f32x4 v[4][4]; float s[4];
#pragma unroll
        for (int q = 0; q < 4; ++q) { const GAS f32x4* xr = (const GAS f32x4*)(F.in[0] + (size_t)(m + q * NGW) * D) + lane;
#pragma unroll
            for (int j = 0; j < 4; ++j) v[q][j] = __builtin_nontemporal_load(&xr[64 * j]); }
#pragma unroll
        for (int q = 0; q < 4; ++q) { float t = 0.f;
#pragma unroll
            for (int j = 0; j < 4; ++j) t += (v[q][j].x * v[q][j].x + v[q][j].y * v[q][j].y) + (v[q][j].z * v[q][j].z + v[q][j].w * v[q][j].w);
            s[q] = wave_sum(t); }
#pragma unroll
        for (int q = 0; q < 4; ++q) { GAS unsigned long long* o8 = (GAS unsigned long long*)(WSP(bf16, WS_H16) + (size_t)(m + q * NGW) * D) + lane;
#pragma unroll
            for (int j = 0; j < 4; ++j) o8[64 * j] = (unsigned long long)pk2(v[q][j].x, v[q][j].y) | ((unsigned long long)pk2(v[q][j].z, v[q][j].w) << 32);
            if (lane == 0) WSP(float, WS_RS0)[m + q * NGW] = 1.0f / sqrtf(s[q] * (1.0f / D) + 1e-6f); }
    }
    if (gw < 256) { const int kv = gw >> 7, k0 = (gw & 127) * 16; const float* pos = F.in[kv ? 9 : 8]; const float* w1 = F.in[kv ? 12 : 10]; float acc = 0.f;
#pragma unroll
        for (int k = 0; k < 16; ++k) acc += pos[k0 + k] * w1[(size_t)(k0 + k) * 64 + lane];
        WSP(float, WS_CBPART)[gw * 64 + lane] = acc; }
}
typedef float f32x4v __attribute__((ext_vector_type(4)));
__device__ __forceinline__ void skinny_tile16(const bf16* A, const bf16* Wt, int row0, int lane, f32x4v (&acc)[2]) {
    const int i16 = lane & 15, kq = lane >> 4; acc[0] = (f32x4v){0.f, 0.f, 0.f, 0.f}; acc[1] = acc[0];
    const bf16* ap = A + (size_t)(row0 + i16) * 1024 + 8 * kq; const bf16* w0 = Wt + (size_t)i16 * 1024 + 8 * kq; const bf16* w1 = w0 + 16 * 1024;
#pragma unroll 8
    for (int s = 0; s < 32; ++s) { const bf16x8 x = *(const bf16x8*)(ap + 32 * s);
        acc[0] = __builtin_amdgcn_mfma_f32_16x16x32_bf16(*(const bf16x8*)(w0 + 32 * s), x, acc[0], 0, 0, 0);
        acc[1] = __builtin_amdgcn_mfma_f32_16x16x32_bf16(*(const bf16x8*)(w1 + 32 * s), x, acc[1], 0, 0, 0); }
}
__device__ __forceinline__ void gates0_phase(Frame& F) {
    const int gw = F.vcu * NWAVES + F.wave, NGW = F.G * NWAVES, lane = F.lane, i16 = lane & 15, cg = lane >> 4;
    for (int t = gw; t < M / 16; t += NGW) {
        f32x4v acc[2]; skinny_tile16(WSP(bf16, WS_H16), WSP(bf16, WS_WABG), 16 * t, lane, acc);
        const int row = 16 * t + i16; const float rs = WSP(float, WS_RS0)[row]; float* g = WSP(float, WS_GATES) + (size_t)row * 32;
#pragma unroll
        for (int tt = 0; tt < 2; ++tt) { const int c0 = 16 * tt + 4 * cg; if (c0 < 24) { f32x4v o;
#pragma unroll
                for (int r = 0; r < 4; ++r) o[r] = 1.0f / (1.0f + __expf(-(acc[tt][r] * rs + F.in[7][c0 + r])));
                *(f32x4v*)(g + c0) = o; } }
    }
}
__device__ __forceinline__ void gates1_phase(Frame& F) {
    const int gw = F.vcu * NWAVES + F.wave, NGW = F.G * NWAVES, lane = F.lane, i16 = lane & 15, cg = lane >> 4;
    const pg8::RowScale R{nullptr, WSP(float, WS_PSUM) + 1 * M};
    for (int t = gw; t < M / 16; t += NGW) {
        f32x4v acc[2]; skinny_tile16(WSP(bf16, WS_H16), WSP(bf16, WS_WCG), 16 * t, lane, acc);
        const int row = 16 * t + i16; const float rs = pg8::row_scale(R, row); float* g = WSP(float, WS_GATES) + (size_t)row * 32;
        if (cg < 2) { f32x4v o;
#pragma unroll
            for (int r = 0; r < 4; ++r) { const float x = acc[0][r] * rs + (cg == 0 ? F.in[19][r] : F.in[20][r]); o[r] = cg == 0 ? x : fminf(x, 0.f) - log1pf(__expf(-fabsf(x))); }
            *(f32x4v*)(g + 4 * cg) = o; }
    }
}

__device__ __forceinline__ void compress_phase(Frame& F) {
    const int lane = F.lane, r32 = lane & 31, h = lane >> 5, w = F.wave;
    LAS float* red = (LAS float*)(F.lds + RING_OFF);
    LAS unsigned char* Hs = F.lds + RING_OFF + 65536;
    LAS float* cb = (LAS float*)(F.lds + RING_OFF + 65536 + 8192);
    if (F.tid < 128) { const float* pp = WSP(float, WS_CBPART) + (F.tid >> 6) * 128 * 64 + (F.tid & 63); float s = 0.f;
#pragma unroll 16
        for (int q = 0; q < 128; ++q) s += pp[q * 64];
        cb[F.tid] = s; }
    __syncthreads();
    for (int task = F.vcu; task < 256; task += F.G) {
        const int kv = task & 1, bg = (task >> 1) & 7, rt = task >> 4, b = bg >> 1, g = bg & 1, i0 = rt * 32;
        const bf16* raw = WSP(bf16, WS_QKV0) + (size_t)b * T * 2048 + (kv ? QC_VC : QC_KC) + g * 64;
        const bf16* w1t = WSP(bf16, kv ? WS_CW1V : WS_CW1K);
        const bf16* w2t = WSP(bf16, kv ? WS_CW2V : WS_CW2K);
        int ic = i0 + r32; if (ic > 510) ic = 510;
        f32x16 d0 = {}, d1 = {};
#pragma unroll
        for (int ll = 0; ll < 4; ++ll) { const int l = 4 * w + ll;
#pragma unroll
            for (int ss = 0; ss < 4; ++ss) { const int k = l * 64 + 16 * ss + 8 * h;
                const bf16x8 bfr = *(const bf16x8*)(raw + (size_t)(16 * ic + l) * 2048 + 16 * ss + 8 * h);
                d0 = mfma32(*(const bf16x8*)(w1t + (size_t)r32 * 2048 + k), bfr, d0);
                d1 = mfma32(*(const bf16x8*)(w1t + (size_t)(32 + r32) * 2048 + k), bfr, d1); } }
#pragma unroll
        for (int r = 0; r < 16; ++r) { red[(w * 64 + crow(r, h)) * 32 + r32] = d0[r]; red[(w * 64 + 32 + crow(r, h)) * 32 + r32] = d1[r]; }
        __syncthreads();
#pragma unroll
        for (int e = 0; e < 4; ++e) { const int idx = F.tid * 4 + e, hid = idx >> 5, i = idx & 31; float a = cb[kv * 64 + hid];
#pragma unroll
            for (int ww = 0; ww < 8; ++ww) a += red[(ww * 64 + hid) * 32 + i];
            a = a / (1.0f + __expf(-a));
            *(LAS bf16*)(Hs + i * 144 + hid * 2) = (bf16)f2bf(a); }
        __syncthreads();
        if (w < 2) { f32x16 o = {};
#pragma unroll
            for (int s = 0; s < 4; ++s) o = mfma32(*(const bf16x8*)(w2t + (size_t)(32 * w + r32) * 64 + 16 * s + 8 * h), *(const LAS bf16x8*)(Hs + r32 * 144 + (16 * s + 8 * h) * 2), o);
            bf16* dst = WSP(bf16, kv ? WS_VC : WS_KC) + ((size_t)bg * 512 + i0 + r32) * 64 + 32 * w + 4 * h;
#pragma unroll
            for (int q = 0; q < 4; ++q) { v2u pk; pk.x = pk2(o[4 * q], o[4 * q + 1]); pk.y = pk2(o[4 * q + 2], o[4 * q + 3]); *(v2u*)(dst + 8 * q) = pk; } }
        __syncthreads();
    }
}
constexpr int AT_K = 0, AT_V = 9216, AT_BUF = 18432, AT_IMP = 49152  , AT_SEL = AT_IMP + 128 * 132 * 4, AT_OVF = AT_SEL + 2048, AT_END = AT_OVF + 32;
static_assert(AT_END <= RING_BYTES, "attention LDS");
constexpr int KV_STRIDE = 144;
__device__ __forceinline__ void stage_load(Frame& F, const bf16* Kg, const bf16* Vg, int pitch, int row0, int rmax, v4u& kx, v4u& vx) {
    const int row = F.tid >> 3, ch = F.tid & 7; int rr = row0 + row; rr = rr < 0 ? 0 : (rr > rmax ? rmax : rr);
    kx = *(const v4u*)(Kg + (size_t)rr * pitch + ch * 8);
    if (Vg) vx = *(const v4u*)(Vg + (size_t)rr * pitch + ch * 8);
}
__device__ __forceinline__ void stage_write(Frame& F, int boff, bool hasv, const v4u& kx, const v4u& vx) {
    const int row = F.tid >> 3, ch = F.tid & 7;
    *(LAS v4u*)(F.lds + boff + AT_K + row * KV_STRIDE + ch * 16) = kx;
    if (hasv) *(LAS v4u*)(F.lds + boff + AT_V + row * KV_STRIDE + ch * 16) = vx;
}
__device__ __forceinline__ f32x16 qk_tile(LAS unsigned char* klb, int sub, const bf16x8 (&qf)[4]) {
    f32x16 s = {};
#pragma unroll
    for (int st = 0; st < 4; ++st) s = mfma32(*(const LAS bf16x8*)(klb + 32 * sub * KV_STRIDE + 32 * st), qf[st], s);
    return s;
}
__device__ __forceinline__ void pv_tile(LAS unsigned char* vlb, int sub, const f32x16& p, f32x16 (&o)[2]) {
    const bf16x8 p0 = pack8<0>(p), p1 = pack8<1>(p);
#pragma unroll
    for (int dt = 0; dt < 2; ++dt) {
        o[dt] = mfma32(frag_tr(vlb, (32 * sub) * KV_STRIDE + 64 * dt, (32 * sub + 8) * KV_STRIDE + 64 * dt), p0, o[dt]);
        o[dt] = mfma32(frag_tr(vlb, (32 * sub + 16) * KV_STRIDE + 64 * dt, (32 * sub + 24) * KV_STRIDE + 64 * dt), p1, o[dt]);
    }
}
constexpr float THRL = 6.0f, OVFL = 1073741824.0f  , NEGBIG = -1e30f;
struct HeadState { float m, l; f32x16 o[2]; };
__device__ __forceinline__ void hs_init(HeadState& S, float l0) { S.m = 0.f; S.l = l0; S.o[0] = (f32x16){}; S.o[1] = (f32x16){}; }
__device__ __forceinline__ void osm_tile(f32x16& s, HeadState& S) {
    float mx = fmaxf(fmaxf(s[0], s[1]), fmaxf(s[2], s[3]));
#pragma unroll
    for (int r = 4; r < 16; r += 4) mx = fmaxf(mx, fmaxf(fmaxf(s[r], s[r + 1]), fmaxf(s[r + 2], s[r + 3])));
    { const auto rr = __builtin_amdgcn_permlane32_swap(__float_as_uint(mx), __float_as_uint(mx), false, false); mx = fmaxf(__uint_as_float(rr[0]), __uint_as_float(rr[1])); }
    const bool need = mx > THRL;
    if (__any(need)) {
        const float dl = need ? mx : 0.f, f = __builtin_amdgcn_exp2f(-dl);
        S.m += dl; S.l *= f;
#pragma unroll
        for (int r = 0; r < 16; ++r) s[r] -= dl;
#pragma unroll
        for (int dt = 0; dt < 2; ++dt)
#pragma unroll
            for (int r = 0; r < 16; ++r) S.o[dt][r] *= f;
    }
    float sum = 0.f;
#pragma unroll
    for (int r = 0; r < 16; ++r) { s[r] = __builtin_amdgcn_exp2f(s[r]); sum += s[r]; }
    S.l += sum;
}
template <int MODE, int WIN>
__device__ __forceinline__ f32x16 qk_masked(const bf16x8 (&kf)[4], const bf16x8 (&qf)[4], float c0, bool edge, int kb, int tq, int h) {
    f32x16 s;
#pragma unroll
    for (int r = 0; r < 16; ++r) s[r] = c0;
#pragma unroll
    for (int st = 0; st < 4; ++st) s = mfma32(kf[st], qf[st], s);
    if (edge) {
#pragma unroll
        for (int r = 0; r < 16; ++r) { const int key = kb + crow(r, h); bool ok = key <= tq; if (MODE == 1) ok = ok && (tq - key < WIN); s[r] = ok ? s[r] : NEGBIG; }
    }
    return s;
}
constexpr int RG_SLOT = 32768, RG_V = 16384, RG_NSLOT = 3;
static_assert(RG_NSLOT * RG_SLOT <= AT_SEL, "the DMA ring may overlay the dead importance table, never the selection words");
template <int MODE, int WIN, bool GEN>
__device__ __forceinline__ void attn_blocks(Frame& F, const bf16* Kg, const bf16* Vg, int jlo, int jhi, int tq, int tqmax_w, int tqmin_w, const LAS unsigned* selp,
                                            const bf16x8 (&qf)[2][4], HeadState (&H)[2], LAS unsigned* ovfw) {
    int lane = F.lane; asm volatile("" : "+v"(lane));
    const int r32 = lane & 31, h = lane >> 5;
    int koff[4];
#pragma unroll
    for (int st = 0; st < 4; ++st) koff[st] = r32 * 128 + (((2 * st + h) ^ (r32 & 7)) << 4);
    const int vl = 4 * h + ((lane & 15) >> 2), vlow = (2 * ((lane >> 4) & 1) + ((lane & 3) >> 1)) ^ (vl & 3);
    int voff[2];
#pragma unroll
    for (int dt = 0; dt < 2; ++dt) voff[dt] = RG_V + vl * 128 + ((((4 * dt) ^ (vl & 4)) | vlow) << 4) + 8 * (lane & 1);
    const int drow = 16 * F.wave + (lane >> 3), dch = (lane & 7) ^ (lane >> 3);
    const bf16* ksrc = Kg + (size_t)drow * 2048 + dch * 8; const bf16* vsrc = Vg + (size_t)drow * 2048 + dch * 8;
    const unsigned ring0 = (unsigned)(size_t)F.lds + (unsigned)F.wave * 2048u;
#define RG_GLDS(gsrc, ldsdst) do { unsigned keep_; asm volatile("s_mov_b32 %0, m0\n\ts_mov_b32 m0, %2\n\ts_nop 0\n\tglobal_load_lds_dwordx4 %1, off\n\ts_mov_b32 m0, %0" : "=&s"(keep_) : "v"(gsrc), "s"(ldsdst) : "memory"); } while (0)
#define RG_ISSUE(blk, slot) do { const size_t go_ = (size_t)(blk) * (128 * 2048); const unsigned ld_ = (unsigned)__builtin_amdgcn_readfirstlane((int)(ring0 + (unsigned)(slot) * RG_SLOT)); \
        RG_GLDS(ksrc + go_, ld_); RG_GLDS(ksrc + go_ + 8 * 2048, ld_ + 1024); RG_GLDS(vsrc + go_, ld_ + RG_V); RG_GLDS(vsrc + go_ + 8 * 2048, ld_ + RG_V + 1024); } while (0)
    bool ovf = false;
    __syncthreads();
    const int Jlo = jlo >> 1, Jhi = jhi >> 1;
#pragma unroll
    for (int d = 0; d < 2; ++d) { const int jb = Jlo + d > Jhi ? Jhi : Jlo + d; RG_ISSUE(jb, d); }
    int slot = 0;
    for (int J = Jlo; J <= Jhi; ++J) {
        asm volatile("s_waitcnt vmcnt(4)" ::: "memory");
        __builtin_amdgcn_s_barrier(); asm volatile("" ::: "memory");
        { const int jn = J + 2 > Jhi ? Jhi : J + 2; const int sn = slot == 0 ? 2 : slot - 1; RG_ISSUE(jn, sn); }
        __builtin_amdgcn_sched_barrier(0);
        LAS unsigned char* sb = F.lds + slot * RG_SLOT; slot = slot == 2 ? 0 : slot + 1;
        bool mine0 = true, mine1 = true;
        if (MODE == 0) { const int j0 = 2 * J, j1 = 2 * J + 1; const unsigned sw0 = selp[j0 & 3], sw1 = selp[j1 & 3]; mine0 = ((sw0 >> (j0 >> 2)) & 1u) != 0u; mine1 = ((sw1 >> (j1 >> 2)) & 1u) != 0u; }
        const bool anym0 = MODE != 0 || __any(mine0), anym1 = MODE != 0 || __any(mine1);
#pragma unroll
        for (int sub = 0; sub < 4; ++sub) {
            const int kb = 128 * J + 32 * sub;
            const bool mine = sub < 2 ? mine0 : mine1;
            const bool any = (sub < 2 ? anym0 : anym1) && (kb <= tqmax_w) && (MODE == 0 || kb + 31 > tqmin_w - WIN);
            if (!any) continue;
            bf16x8 kf[4];
#pragma unroll
            for (int st = 0; st < 4; ++st) kf[st] = *(const LAS bf16x8*)(sb + koff[st] + sub * 4096);
            const bool edge = (kb + 31 > tqmin_w) || (MODE == 1 && kb <= tqmax_w - WIN);
            bf16x8 vf[4];
#pragma unroll
            for (int dt = 0; dt < 2; ++dt) {
                vf[2 * dt] = frag_tr(sb + voff[dt], sub * 4096, sub * 4096 + 8 * 128);
                vf[2 * dt + 1] = frag_tr(sb + voff[dt], sub * 4096 + 16 * 128, sub * 4096 + 24 * 128); }
            if (!GEN) {
#define SB_() __builtin_amdgcn_sched_barrier(0)
#define EXP4(S, B, SUM) do { S[B] = __builtin_amdgcn_exp2f(S[B]); S[B + 1] = __builtin_amdgcn_exp2f(S[B + 1]); S[B + 2] = __builtin_amdgcn_exp2f(S[B + 2]); S[B + 3] = __builtin_amdgcn_exp2f(S[B + 3]); \
                    SUM += (S[B] + S[B + 1]) + (S[B + 2] + S[B + 3]); } while (0)
                const float c0 = (MODE == 0 && !mine) ? NEGBIG : 0.f;
                f32x16 cinit;
                if (edge) {
#pragma unroll
                    for (int r = 0; r < 16; ++r) { const int key = kb + crow(r, h); bool ok = key <= tq; if (MODE == 1) ok = ok && (tq - key < WIN); cinit[r] = ok ? c0 : NEGBIG; }
                } else {
#pragma unroll
                    for (int r = 0; r < 16; ++r) cinit[r] = c0;
                }
                SB_();
                f32x16 s0 = mfma32(kf[0], qf[0][0], cinit);
#pragma unroll
                for (int st = 1; st < 4; ++st) s0 = mfma32(kf[st], qf[0][st], s0);
                SB_();
                float sum0 = 0.f, sum1 = 0.f;
                f32x16 s1 = mfma32(kf[0], qf[1][0], cinit); SB_(); EXP4(s0, 0, sum0); SB_();
                s1 = mfma32(kf[1], qf[1][1], s1); SB_(); EXP4(s0, 4, sum0); SB_();
                s1 = mfma32(kf[2], qf[1][2], s1); SB_(); EXP4(s0, 8, sum0); SB_();
                s1 = mfma32(kf[3], qf[1][3], s1); SB_(); EXP4(s0, 12, sum0); SB_();
                const bf16x8 pa0 = pack8<0>(s0), pa1 = pack8<1>(s0);
                SB_();
                H[0].o[0] = mfma32(vf[0], pa0, H[0].o[0]); SB_(); EXP4(s1, 0, sum1); SB_();
                H[0].o[0] = mfma32(vf[1], pa1, H[0].o[0]); SB_(); EXP4(s1, 4, sum1); SB_();
                H[0].o[1] = mfma32(vf[2], pa0, H[0].o[1]); SB_(); EXP4(s1, 8, sum1); SB_();
                H[0].o[1] = mfma32(vf[3], pa1, H[0].o[1]); SB_(); EXP4(s1, 12, sum1); SB_();
                const bf16x8 pb0 = pack8<0>(s1), pb1 = pack8<1>(s1);
                SB_();
                H[1].o[0] = mfma32(vf[0], pb0, H[1].o[0]); H[1].o[0] = mfma32(vf[1], pb1, H[1].o[0]);
                H[1].o[1] = mfma32(vf[2], pb0, H[1].o[1]); H[1].o[1] = mfma32(vf[3], pb1, H[1].o[1]);
                H[0].l += sum0; H[1].l += sum1; ovf = ovf || !(sum0 <= OVFL) || !(sum1 <= OVFL);
#undef SB_
#undef EXP4
            } else {
                f32x16 s[2];
#pragma unroll
                for (int hd = 0; hd < 2; ++hd) { s[hd] = qk_masked<MODE, WIN>(kf, qf[hd], (MODE == 0 && !mine) ? NEGBIG : -H[hd].m, edge, kb, tq, h); osm_tile(s[hd], H[hd]); }
#pragma unroll
                for (int hd = 0; hd < 2; ++hd) {
                    const bf16x8 p0 = pack8<0>(s[hd]), p1 = pack8<1>(s[hd]);
#pragma unroll
                    for (int dt = 0; dt < 2; ++dt) { H[hd].o[dt] = mfma32(vf[2 * dt], p0, H[hd].o[dt]); H[hd].o[dt] = mfma32(vf[2 * dt + 1], p1, H[hd].o[dt]); }
                }
            }
            __builtin_amdgcn_sched_barrier(0);
        }
    }
    asm volatile("s_waitcnt vmcnt(0)" ::: "memory");
    if (!GEN) { if (__any(ovf) && lane == 0) *ovfw = 1u; }
    __syncthreads();
#undef RG_ISSUE
#undef RG_GLDS
}
__device__ __forceinline__ void accf_store(float* accw, int lane, const f32x16 (&o)[2], float sc, bool add) {
#pragma unroll
    for (int dt = 0; dt < 2; ++dt)
#pragma unroll
        for (int q = 0; q < 4; ++q) { f32x4 v = {o[dt][4 * q] * sc, o[dt][4 * q + 1] * sc, o[dt][4 * q + 2] * sc, o[dt][4 * q + 3] * sc};
            f32x4* d = (f32x4*)accw + (dt * 4 + q) * 64 + lane; if (add) v = v + *d; *d = v; }
}
constexpr int AT_OST = 272;
__device__ __forceinline__ void att_stage(LAS unsigned char* scr, int hd, const float* accw, int lane, const f32x16 (&o)[2], float sc, int h) {
    const int r32 = lane & 31;
#pragma unroll
    for (int dt = 0; dt < 2; ++dt)
#pragma unroll
        for (int q = 0; q < 4; ++q) { f32x4 v = {o[dt][4 * q] * sc, o[dt][4 * q + 1] * sc, o[dt][4 * q + 2] * sc, o[dt][4 * q + 3] * sc};
            if (accw) v = v + *((const f32x4*)accw + (dt * 4 + q) * 64 + lane);
            v2u pk; pk.x = pk2(v[0], v[1]); pk.y = pk2(v[2], v[3]); *(LAS v2u*)(scr + r32 * AT_OST + hd * 128 + (32 * dt + 8 * q + 4 * h) * 2) = pk; }
}
__device__ __forceinline__ void att_flush(LAS unsigned char* scr, bf16* att, size_t tok0, int hc, int lane) {
    LDS_WAIT(); asm volatile("" ::: "memory");
#pragma unroll
    for (int i = 0; i < 8; ++i) { const int idx = i * 64 + lane, row = idx >> 4, ch = idx & 15;
        *(v4u*)(att + (tok0 + row) * 1024 + hc + (ch >> 3) * 64 + (ch & 7) * 8) = *(const LAS v4u*)(scr + row * AT_OST + ch * 16); }
    LDS_WAIT(); asm volatile("" ::: "memory");
}
template <int PASS>
__device__ __forceinline__ void cmp_pass(Frame& F, const bf16* kcg, const bf16* vcg, int nvalid, int tq, int tqmax_w, int tqmin_w, const bf16x8 (&qf)[2][4],
                                         float (&l)[2], const float (&lg)[2], f32x16 (&o)[2][2], LAS float* improw, LAS unsigned* ovfw) {
    int lane = F.lane; asm volatile("" : "+v"(lane));
    const int r32 = lane & 31, h = lane >> 5;
    int koff[4];
#pragma unroll
    for (int st = 0; st < 4; ++st) koff[st] = r32 * 128 + (((2 * st + h) ^ (r32 & 7)) << 4);
    const int vl = 4 * h + ((lane & 15) >> 2), vlow = (2 * ((lane >> 4) & 1) + ((lane & 3) >> 1)) ^ (vl & 3);
    int voff[2];
    constexpr int CM_SLOT = 16384, CM_V = 8192; static_assert(3 * CM_SLOT <= AT_IMP, "compressed-branch ring below the importance table");
#pragma unroll
    for (int dt = 0; dt < 2; ++dt) voff[dt] = CM_V + vl * 128 + ((((4 * dt) ^ (vl & 4)) | vlow) << 4) + 8 * (lane & 1);
    const int drow = 8 * F.wave + (lane >> 3), dch = (lane & 7) ^ (lane >> 3);
    const bf16* ksrc = kcg + (size_t)drow * 64 + dch * 8; const bf16* vsrc = vcg + (size_t)drow * 64 + dch * 8;
    const unsigned ring0 = (unsigned)(size_t)F.lds + (unsigned)F.wave * 1024u;
#define RG_GLDS(gsrc, ldsdst) do { unsigned keep_; asm volatile("s_mov_b32 %0, m0\n\ts_mov_b32 m0, %2\n\ts_nop 0\n\tglobal_load_lds_dwordx4 %1, off\n\ts_mov_b32 m0, %0" : "=&s"(keep_) : "v"(gsrc), "s"(ldsdst) : "memory"); } while (0)
#define CM_ISSUE(blk, slot) do { const size_t go_ = (size_t)(blk) * (64 * 64); const unsigned ld_ = (unsigned)__builtin_amdgcn_readfirstlane((int)(ring0 + (unsigned)(slot) * CM_SLOT)); \
        RG_GLDS(ksrc + go_, ld_); if (PASS == 2) RG_GLDS(vsrc + go_, ld_ + CM_V); } while (0)
    const int ilim = tq >= 31 ? (tq - 31) >> 4 : -1, ilmax = tqmax_w >= 31 ? (tqmax_w - 31) >> 4 : -1, ilmin = tqmin_w >= 31 ? (tqmin_w - 31) >> 4 : -1;
    bool ovf = false; float carry = 0.f;
    __syncthreads();
    const int Jhi = (nvalid - 1) >> 6;
#pragma unroll
    for (int d = 0; d < 2; ++d) { const int jb = d > Jhi ? Jhi : d; CM_ISSUE(jb, d); }
    int slot = 0;
    for (int J = 0; J <= Jhi; ++J) {
        if (PASS == 2) asm volatile("s_waitcnt vmcnt(2)" ::: "memory"); else asm volatile("s_waitcnt vmcnt(1)" ::: "memory");
        __builtin_amdgcn_s_barrier(); asm volatile("" ::: "memory");
        { const int jn = J + 2 > Jhi ? Jhi : J + 2; const int sn = slot == 0 ? 2 : slot - 1; CM_ISSUE(jn, sn); }
        __builtin_amdgcn_sched_barrier(0);
        LAS unsigned char* sb = F.lds + slot * CM_SLOT; slot = slot == 2 ? 0 : slot + 1;
#pragma unroll
        for (int sub = 0; sub < 2; ++sub) {
            const int kb = 64 * J + 32 * sub;
            if (kb > ilmax) continue;
            bf16x8 kf[4];
#pragma unroll
            for (int st = 0; st < 4; ++st) kf[st] = *(const LAS bf16x8*)(sb + koff[st] + sub * 4096);
            const bool edge = kb + 31 > ilmin;
            f32x16 s[2];
#pragma unroll
            for (int hd = 0; hd < 2; ++hd) { const float c0 = PASS == 2 ? lg[hd] : 0.f;
                if (edge) {
#pragma unroll
                    for (int r = 0; r < 16; ++r) s[hd][r] = (kb + crow(r, h) <= ilim) ? c0 : NEGBIG;
                } else {
#pragma unroll
                    for (int r = 0; r < 16; ++r) s[hd][r] = c0;
                }
#pragma unroll
                for (int st = 0; st < 4; ++st) s[hd] = mfma32(kf[st], qf[hd][st], s[hd]); }
            if (PASS == 1) {
#pragma unroll
                for (int hd = 0; hd < 2; ++hd) { float sum = 0.f;
#pragma unroll
                    for (int r = 0; r < 16; ++r) sum += __builtin_amdgcn_exp2f(s[hd][r]);
                    l[hd] += sum; ovf = ovf || !(sum <= OVFL); }
            } else {
                bf16x8 vf[4];
#pragma unroll
                for (int dt = 0; dt < 2; ++dt) {
                    vf[2 * dt] = frag_tr(sb + voff[dt], sub * 4096, sub * 4096 + 8 * 128);
                    vf[2 * dt + 1] = frag_tr(sb + voff[dt], sub * 4096 + 16 * 128, sub * 4096 + 24 * 128); }
                float ps4[4] = {0.f, 0.f, 0.f, 0.f}, sp[4] = {0.f, 0.f, 0.f, 0.f};
#pragma unroll
                for (int hd = 0; hd < 2; ++hd) {
#pragma unroll
                    for (int r = 0; r < 16; ++r) s[hd][r] = __builtin_amdgcn_exp2f(s[hd][r]);
#pragma unroll
                    for (int q = 0; q < 4; ++q) { ps4[q] += (s[hd][4 * q] + s[hd][4 * q + 1]) + (s[hd][4 * q + 2] + s[hd][4 * q + 3]); sp[q] += s[hd][4 * q + 3]; }
                    const bf16x8 p0 = pack8<0>(s[hd]), p1 = pack8<1>(s[hd]);
#pragma unroll
                    for (int dt = 0; dt < 2; ++dt) { o[hd][dt] = mfma32(vf[2 * dt], p0, o[hd][dt]); o[hd][dt] = mfma32(vf[2 * dt + 1], p1, o[hd][dt]); }
                }
                float cell[4];
#pragma unroll
                for (int q = 0; q < 4; ++q) { const auto rr = __builtin_amdgcn_permlane32_swap(__float_as_uint(sp[q]), __float_as_uint(sp[q]), false, false);
                    const float rv = __uint_as_float(h ? rr[0] : rr[1]);
                    if (h == 1) cell[q] = ps4[q] + rv; else { cell[q] = ps4[q] + carry; carry = rv; } }
#pragma unroll
                for (int q = 0; q < 4; ++q) atomicAdd((float*)&improw[kb / 4 + h + 2 * q], cell[q]);
            }
            __builtin_amdgcn_sched_barrier(0);
        }
    }
    asm volatile("s_waitcnt vmcnt(0)" ::: "memory");
    if (PASS == 1) { if (__any(ovf) && lane == 0) *ovfw = 1u; }
    __syncthreads();
#undef CM_ISSUE
#undef RG_GLDS
}
__device__ __forceinline__ void nsa_unit(Frame& F, int b, int g, int n) {
    int lane = F.lane, tid = F.tid; asm volatile("" : "+v"(lane), "+v"(tid));
    const int r32 = lane & 31, h = lane >> 5, wave = F.wave;
    const int start = n * 128, qt = wave >> 1, hp = (wave & 1) * 2;
    const int tq = start + qt * 32 + r32, tqmin_w = start + qt * 32, tqmax_w = tqmin_w + 31;
    const size_t tok = (size_t)b * T + tq;
    const bf16* qkv = WSP(bf16, WS_QKV0) + (size_t)b * T * 2048;
    const int trl = ((lane & 15) >> 2) * KV_STRIDE + (16 * ((lane >> 4) & 1) + 4 * (lane & 3)) * 2;
    LAS unsigned char* klb0 = F.lds + AT_K + r32 * KV_STRIDE + 16 * h; LAS unsigned char* vlb0 = F.lds + AT_V + trl + 4 * h * KV_STRIDE;
    LAS float* imp = (LAS float*)(F.lds + AT_IMP); LAS unsigned* sel = (LAS unsigned*)(F.lds + AT_SEL);
    bf16x8 qf[2][4];
#pragma unroll
    for (int hd = 0; hd < 2; ++hd)
#pragma unroll
        for (int s = 0; s < 4; ++s) qf[hd][s] = *(const bf16x8*)(qkv + (size_t)tq * 2048 + QC_QN + (g * 4 + hp + hd) * 64 + 16 * s + 8 * h);
#define GATEP (WSP(float, WS_GATES) + ((size_t)b * T + tq) * 32 + (g * 4 + hp) * 3)
#define ACCFP (WSP(float, WS_ACCF) + (((size_t)((b * 2 + g) * 64 + n) * 8 + wave) * 2) * 2048)
    __syncthreads();
    for (int i = tid; i < 128 * 132; i += 512) imp[i] = 0.f;
    LAS unsigned* ovfw = (LAS unsigned*)(F.lds + AT_OVF); if (tid < 4) ovfw[tid] = 0u;
    const bf16* kcg = WSP(bf16, WS_KC) + (size_t)(b * 2 + g) * 512 * 64; const bf16* vcg = WSP(bf16, WS_VC) + (size_t)(b * 2 + g) * 512 * 64;
    const int nvalid = 8 * n + 7, nbc = (nvalid + 63) >> 6;
    f32x16 o[2][2];
#pragma unroll
    for (int hd = 0; hd < 2; ++hd) { o[hd][0] = (f32x16){}; o[hd][1] = (f32x16){}; }
    LAS float* improw = imp + (qt * 32 + r32) * 132;
    { float lf[2] = {0.f, 0.f}; const float lgd[2] = {0.f, 0.f};
      cmp_pass<1>(F, kcg, vcg, nvalid, tq, tqmax_w, tqmin_w, qf, lf, lgd, o, improw, ovfw + 3);
      if (!ovfw[3]) {
          float lg[2];
#pragma unroll
          for (int hd = 0; hd < 2; ++hd) { const float lt = lf[hd] + __shfl_xor(lf[hd], 32); lg[hd] = lt > 0.f ? -__log2f(lt) : NEGBIG; }
          cmp_pass<2>(F, kcg, vcg, nvalid, tq, tqmax_w, tqmin_w, qf, lf, lg, o, improw, ovfw + 3);
      } else {
    float m[2] = {-1e30f, -1e30f}, l[2] = {0.f, 0.f};
    v4u kx, vx = {0u, 0u, 0u, 0u};
    __syncthreads();
    stage_load(F, kcg, nullptr, 64, 0, 511, kx, vx);
    for (int jb = 0; jb < nbc; ++jb) {
        const int boff = (jb & 1) * AT_BUF;
        stage_write(F, boff, false, kx, vx);
        __syncthreads();
        if (jb + 1 < nbc) stage_load(F, kcg, nullptr, 64, 64 * (jb + 1), 511, kx, vx);
        LAS unsigned char* klb = klb0 + boff;
#pragma unroll
        for (int sub = 0; sub < 2; ++sub)
#pragma unroll
            for (int hd = 0; hd < 2; ++hd) {
                f32x16 s = qk_tile(klb, sub, qf[hd]); float mx = -INFINITY;
#pragma unroll
                for (int r = 0; r < 16; ++r) { const int i = 64 * jb + 32 * sub + crow(r, h); s[r] = (16 * i + 31 <= tq) ? s[r] : -INFINITY; mx = fmaxf(mx, s[r]); }
                mx = fmaxf(mx, __shfl_xor(mx, 32));
                const float mn = fmaxf(m[hd], mx), al = __builtin_amdgcn_exp2f(m[hd] - mn); float sum = 0.f;
#pragma unroll
                for (int r = 0; r < 16; ++r) sum += __builtin_amdgcn_exp2f(s[r] - mn);
                l[hd] = l[hd] * al + sum; m[hd] = mn;
            }
    }
    float il[2];
#pragma unroll
    for (int hd = 0; hd < 2; ++hd) { const float lt = l[hd] + __shfl_xor(l[hd], 32); il[hd] = lt > 0.f ? 1.0f / lt : 0.f; }
    float carry = 0.f;
    __syncthreads();
    stage_load(F, kcg, vcg, 64, 0, 511, kx, vx);
    for (int jb = 0; jb < nbc; ++jb) {
        const int boff = (jb & 1) * AT_BUF;
        stage_write(F, boff, true, kx, vx);
        __syncthreads();
        if (jb + 1 < nbc) stage_load(F, kcg, vcg, 64, 64 * (jb + 1), 511, kx, vx);
        LAS unsigned char* klb = klb0 + boff; LAS unsigned char* vlb = vlb0 + boff;
#pragma unroll
        for (int sub = 0; sub < 2; ++sub) {
            float ps4[4] = {0.f, 0.f, 0.f, 0.f}, sp[4] = {0.f, 0.f, 0.f, 0.f};
#pragma unroll
            for (int hd = 0; hd < 2; ++hd) {
                f32x16 s = qk_tile(klb, sub, qf[hd]);
#pragma unroll
                for (int r = 0; r < 16; ++r) { const int i = 64 * jb + 32 * sub + crow(r, h); s[r] = (16 * i + 31 <= tq) ? __builtin_amdgcn_exp2f(s[r] - m[hd]) * il[hd] : 0.f; }
#pragma unroll
                for (int q = 0; q < 4; ++q) { ps4[q] += (s[4 * q] + s[4 * q + 1]) + (s[4 * q + 2] + s[4 * q + 3]); sp[q] += s[4 * q + 3]; }
                pv_tile(vlb, sub, s, o[hd]);
            }
            float cell[4];
#pragma unroll
            for (int q = 0; q < 4; ++q) { const float rv = __shfl_xor(sp[q], 32);
                if (h == 1) cell[q] = ps4[q] + rv; else { cell[q] = ps4[q] + carry; carry = rv; } }
            const int j0 = (64 * jb + 32 * sub) / 4 + h;
#pragma unroll
            for (int q = 0; q < 4; ++q) atomicAdd((float*)&imp[(qt * 32 + r32) * 132 + j0 + 2 * q], cell[q]);
        }
    }
      }
    }
#pragma unroll
    for (int hd = 0; hd < 2; ++hd) accf_store(ACCFP + hd * 2048, lane, o[hd], GATEP[3 * hd + 0], false);
    __syncthreads();
    {
        const int q = tid >> 2, part = tid & 3, tq2 = start + q, cur = tq2 >> 6; unsigned bits = 0u;
        float val[32];
#pragma unroll
        for (int e = 0; e < 32; ++e) { const int j = 4 * e + part; const bool forced = (j == 0) || (j == cur) || (j == cur - 1);
            if (cur <= 15) { if (j <= cur) bits |= 1u << e; val[e] = -INFINITY; }
            else { if (forced) bits |= 1u << e; val[e] = (!forced && j >= 1 && j <= cur - 2) ? imp[q * 132 + j] : -INFINITY; } }
        if (cur > 15) {
            for (int itr = 0; itr < 13; ++itr) {
                float bv = val[0]; int be = 0;
#pragma unroll
                for (int e = 1; e < 32; ++e) if (val[e] > bv) { bv = val[e]; be = e; }
                int bj = 4 * be + part; float wv = bv; int wj = bj;
#pragma unroll
                for (int d = 1; d < 4; d <<= 1) { const float ov = __shfl_xor(wv, d); const int oj = __shfl_xor(wj, d); if (ov > wv || (ov == wv && oj < wj)) { wv = ov; wj = oj; } }
                const bool win = (wj == bj) && (wv > -INFINITY);
#pragma unroll
                for (int e = 0; e < 32; ++e) if (win && e == be) { val[e] = -INFINITY; bits |= 1u << e; }
            }
        }
        sel[q * 4 + part] = bits;
    }
    __syncthreads();
    const LAS unsigned* selp = sel + (qt * 32 + r32) * 4;
    {
        HeadState H[2]; hs_init(H[0], 0.f); hs_init(H[1], 0.f);
        attn_blocks<0, 0, false>(F, qkv + QC_KS + g * 64, qkv + QC_VS + g * 64, 0, 2 * n + 1, tq, tqmax_w, tqmin_w, selp, qf, H, ovfw + 0);
        if (ovfw[0]) { hs_init(H[0], 0.f); hs_init(H[1], 0.f); attn_blocks<0, 0, true>(F, qkv + QC_KS + g * 64, qkv + QC_VS + g * 64, 0, 2 * n + 1, tq, tqmax_w, tqmin_w, selp, qf, H, ovfw + 0); }
#pragma unroll
        for (int hd = 0; hd < 2; ++hd) { const float lt = H[hd].l + __shfl_xor(H[hd].l, 32); accf_store(ACCFP + hd * 2048, lane, H[hd].o, lt > 0.f ? GATEP[3 * hd + 1] / lt : 0.f, true); }
    }
    {
        HeadState H[2]; hs_init(H[0], 0.f); hs_init(H[1], 0.f);
        attn_blocks<1, 512, false>(F, qkv + QC_KW + g * 64, qkv + QC_VW + g * 64, (2 * n - 8) < 0 ? 0 : (2 * n - 8), 2 * n + 1, tq, tqmax_w, tqmin_w, selp, qf, H, ovfw + 1);
        if (ovfw[1]) { hs_init(H[0], 0.f); hs_init(H[1], 0.f); attn_blocks<1, 512, true>(F, qkv + QC_KW + g * 64, qkv + QC_VW + g * 64, (2 * n - 8) < 0 ? 0 : (2 * n - 8), 2 * n + 1, tq, tqmax_w, tqmin_w, selp, qf, H, ovfw + 1); }
        LAS unsigned char* scr = F.lds + wave * (32 * AT_OST);
#pragma unroll
        for (int hd = 0; hd < 2; ++hd) { const float lt = H[hd].l + __shfl_xor(H[hd].l, 32);
            att_stage(scr, hd, ACCFP + hd * 2048, lane, H[hd].o, lt > 0.f ? GATEP[3 * hd + 2] / lt : 0.f, h); }
        att_flush(scr, WSP(bf16, WS_ATT), (size_t)b * T + tqmin_w, (g * 4 + hp) * 64, lane);
    }
}
__device__ __forceinline__ void swa_unit(Frame& F, int b, int g, int n) {
    int lane = F.lane; asm volatile("" : "+v"(lane));
    const int r32 = lane & 31, h = lane >> 5, wave = F.wave;
    const int start = n * 128, qt = wave >> 1, hp = (wave & 1) * 2;
    const int tq = start + qt * 32 + r32, tqmin_w = start + qt * 32, tqmax_w = tqmin_w + 31;
    const size_t tok = (size_t)b * T + tq;
    const bf16* qkv = WSP(bf16, WS_QKV0) + (size_t)b * T * 2048;
    bf16x8 qf[2][4];
#pragma unroll
    for (int hd = 0; hd < 2; ++hd)
#pragma unroll
        for (int s = 0; s < 4; ++s) qf[hd][s] = *(const bf16x8*)(qkv + (size_t)tq * 2048 + QC_QS + (g * 4 + hp + hd) * 64 + 16 * s + 8 * h);
    const LAS unsigned* selp = (const LAS unsigned*)(F.lds + AT_SEL);
    HeadState H[2];
#pragma unroll
    for (int hd = 0; hd < 2; ++hd) hs_init(H[hd], (h == 0) ? __builtin_amdgcn_exp2f(F.in[14][g * 4 + hp + hd] * LOG2E) : 0.f);
    LAS unsigned* ovfw = (LAS unsigned*)(F.lds + AT_OVF);
    __syncthreads(); if (F.tid == 0) ovfw[2] = 0u; __syncthreads();
    attn_blocks<1, 128, false>(F, qkv + QC_KSW + g * 64, qkv + QC_VSW + g * 64, (2 * n - 2) < 0 ? 0 : (2 * n - 2), 2 * n + 1, tq, tqmax_w, tqmin_w, selp, qf, H, ovfw + 2);
    if (ovfw[2]) {
#pragma unroll
        for (int hd = 0; hd < 2; ++hd) hs_init(H[hd], (h == 0) ? __builtin_amdgcn_exp2f(F.in[14][g * 4 + hp + hd] * LOG2E) : 0.f);
        attn_blocks<1, 128, true>(F, qkv + QC_KSW + g * 64, qkv + QC_VSW + g * 64, (2 * n - 2) < 0 ? 0 : (2 * n - 2), 2 * n + 1, tq, tqmax_w, tqmin_w, selp, qf, H, ovfw + 2); }
    LAS unsigned char* scr = F.lds + wave * (32 * AT_OST);
#pragma unroll
    for (int hd = 0; hd < 2; ++hd) { const float lt = H[hd].l + __shfl_xor(H[hd].l, 32); att_stage(scr, hd, nullptr, lane, H[hd].o, 1.0f / lt, h); }
    att_flush(scr, WSP(bf16, WS_ATT), (size_t)b * T + tqmin_w, 512 + (g * 4 + hp) * 64, lane);
}
__device__ __forceinline__ void attention_phase(Frame& F) {
    const int q = (int)(((long)F.vcu * 8) / F.G);
    LAS unsigned* slotw = (LAS unsigned*)(F.lds + AT_OVF + 28);
    for (;;) {
        __syncthreads();
        if (F.tid == 0) *slotw = __hip_atomic_fetch_add((unsigned*)(F.ctl + CW_QUEUE + 64 * q), 1u, __ATOMIC_RELAXED, __HIP_MEMORY_SCOPE_AGENT);
        __syncthreads();
        const unsigned idx = *slotw;
        if (idx >= 128u) break;
        if (idx < 64u) nsa_unit(F, q >> 1, q & 1, 63 - (int)idx);
        else swa_unit(F, q >> 1, q & 1, (int)idx - 64);
    }
    __syncthreads();
}
__device__ __forceinline__ void conv_scan_phase(Frame& F) {
    const int lane = F.lane, w = F.wave;
    if (F.vcu < 16 && F.G >= 32) {
        const int bh = F.vcu, b = bh >> 2, hh = bh & 3;
        const float* gt = WSP(float, WS_GATES) + (size_t)b * T * 32;
        LAS float* segG = (LAS float*)(F.lds + RING_OFF); LAS float* segP = segG + 8;
        float Gl[16], al[16], Pl[16]; float c = 0.f, cm = -INFINITY;
#pragma unroll
        for (int it = 0; it < 16; ++it) { const int t = 1024 * w + 64 * it + lane; const float li = gt[(size_t)t * 32 + hh]; float x = gt[(size_t)t * 32 + 4 + hh];
#pragma unroll
            for (int d = 1; d < 64; d <<= 1) { const float y = __shfl_up(x, d); if (lane >= d) x += y; }
            Gl[it] = c + x; c = __shfl(Gl[it], 63);
            al[it] = li - Gl[it]; float pm = al[it];
#pragma unroll
            for (int d = 1; d < 64; d <<= 1) { const float y = __shfl_up(pm, d); if (lane >= d) pm = fmaxf(pm, y); }
            pm = fmaxf(pm, cm); Pl[it] = pm; cm = __shfl(pm, 63); }
        if (lane == 0) { segG[w] = c; segP[w] = cm; }
        __syncthreads();
        double gc = 0.0; float mc = 0.f;
        for (int k = 0; k < w; ++k) { mc = fmaxf(mc, (float)((double)segP[k] - gc)); gc += (double)segG[k]; }
#pragma unroll
        for (int it = 0; it < 16; ++it) { const int t = 1024 * w + 64 * it + lane; const float gcf = (float)gc;
            const float a = al[it] - gcf, mv = fmaxf(mc, Pl[it] - gcf); const double mt = (gc + (double)Gl[it]) + (double)mv;
            WSP(float, WS_SCA)[bh * T + t] = a; WSP(float, WS_SCM)[bh * T + t] = mv; WSP(float, WS_SCE)[bh * T + t] = (float)exp(-mt); }
        __syncthreads();
        return;
    }
    const int first = (F.G >= 32) ? 16 : 0, nblk = F.G - first, bi = F.vcu - first;
    const int c8 = (F.tid & 127) * 8;
    const float* cw = F.in[17]; const float* cb = F.in[18];
    float wv[4][8], bv[8];
#pragma unroll
    for (int e = 0; e < 8; ++e) { bv[e] = cb[c8 + e];
#pragma unroll
        for (int k = 0; k < 4; ++k) wv[k][e] = cw[k * 1024 + c8 + e]; }
    const float ksc = (c8 >= 512) ? 0.08838834764831845f : 1.0f;
    const bf16* src = WSP(bf16, WS_QKP); bf16* dst = WSP(bf16, WS_QKC);
    for (int tok0 = bi * 4 + (F.tid >> 7); tok0 < M; tok0 += nblk * 16) {
        v4u x[4][4]; bool okt[4];
#pragma unroll
        for (int uu = 0; uu < 4; ++uu) { const int tok = tok0 + uu * nblk * 4; okt[uu] = tok < M; const int t = tok & (T - 1);
#pragma unroll
            for (int k = 0; k < 4; ++k) { x[uu][k] = (v4u){0u, 0u, 0u, 0u}; if (okt[uu] && t - 3 + k >= 0) x[uu][k] = *(const v4u*)(src + (size_t)(tok - 3 + k) * 1024 + c8); } }
#pragma unroll
        for (int uu = 0; uu < 4; ++uu) { if (!okt[uu]) continue; const int tok = tok0 + uu * nblk * 4; float acc[8];
#pragma unroll
            for (int e = 0; e < 8; ++e) acc[e] = bv[e];
#pragma unroll
            for (int k = 0; k < 4; ++k) { const v4u xx = x[uu][k];
                acc[0] += bflo(xx.x) * wv[k][0]; acc[1] += bfhi(xx.x) * wv[k][1]; acc[2] += bflo(xx.y) * wv[k][2]; acc[3] += bfhi(xx.y) * wv[k][3];
                acc[4] += bflo(xx.z) * wv[k][4]; acc[5] += bfhi(xx.z) * wv[k][5]; acc[6] += bflo(xx.w) * wv[k][6]; acc[7] += bfhi(xx.w) * wv[k][7]; }
#pragma unroll
            for (int e = 0; e < 8; ++e) acc[e] = acc[e] * __builtin_amdgcn_rcpf(1.0f + __expf(-acc[e])) * ksc;
            v4u o; o.x = pk2(acc[0], acc[1]); o.y = pk2(acc[2], acc[3]); o.z = pk2(acc[4], acc[5]); o.w = pk2(acc[6], acc[7]);
            *(v4u*)(dst + ((size_t)((tok >> 13) * 8 + (c8 >> 7)) * T + (tok & (T - 1))) * 128 + (c8 & 127)) = o; }
    }
}
constexpr int ML_KS = 272, ML_VS = 528;
constexpr int ML_K = 0, ML_V = 64 * ML_KS;
__device__ __forceinline__ void mlstm_p1_phase(Frame& F) {
    const int lane = F.lane, r32 = lane & 31, h = lane >> 5, w = F.wave, tid = F.tid;
    LAS unsigned char* kt = F.lds + ML_K; LAS unsigned char* vt = F.lds + ML_V;
    const int row = tid >> 3, ch = tid & 7;
    for (int u = F.vcu; u < 512; u += F.G) {
        const int bh = u >> 5, sc = u & 31, b = bh >> 2, hh = bh & 3;
        const float mend = WSP(float, WS_SCM)[bh * T + 256 * sc + 255];
        const float* av = WSP(float, WS_SCA) + bh * T + 256 * sc;
        const bf16* kp0 = WSP(bf16, WS_QKC) + ((size_t)(b * 8 + 4 + hh) * T + 256 * sc + row) * 128 + ch * 16;
        const bf16* vp0 = WSP(bf16, WS_V1) + ((size_t)(b * 4 + hh) * T + 256 * sc + row) * 256 + ch * 32;
        f32x16 acc[4]; float nacc = 0.f;
#pragma unroll
        for (int i = 0; i < 4; ++i) acc[i] = (f32x16){};
        v4u kx[2], vx[4]; float wgt;
#pragma unroll
        for (int q = 0; q < 2; ++q) kx[q] = *(const v4u*)(kp0 + 8 * q);
#pragma unroll
        for (int q = 0; q < 4; ++q) vx[q] = *(const v4u*)(vp0 + 8 * q);
        wgt = __expf(av[row] - mend);
        for (int c4 = 0; c4 < 4; ++c4) {
            __syncthreads();
#pragma unroll
            for (int q = 0; q < 2; ++q) { const v4u x = kx[q]; v4u y;
                y.x = pk2(bflo(x.x) * wgt, bfhi(x.x) * wgt); y.y = pk2(bflo(x.y) * wgt, bfhi(x.y) * wgt); y.z = pk2(bflo(x.z) * wgt, bfhi(x.z) * wgt); y.w = pk2(bflo(x.w) * wgt, bfhi(x.w) * wgt);
                *(LAS v4u*)(kt + row * ML_KS + (ch * 16 + 8 * q) * 2) = y; }
#pragma unroll
            for (int q = 0; q < 4; ++q) *(LAS v4u*)(vt + row * ML_VS + (ch * 32 + 8 * q) * 2) = vx[q];
            __syncthreads();
            if (c4 < 3) { const size_t adv = (size_t)(64 * (c4 + 1));
#pragma unroll
                for (int q = 0; q < 2; ++q) kx[q] = *(const v4u*)(kp0 + adv * 128 + 8 * q);
#pragma unroll
                for (int q = 0; q < 4; ++q) vx[q] = *(const v4u*)(vp0 + adv * 256 + 8 * q);
                wgt = __expf(av[64 * (c4 + 1) + row] - mend); }
            if (tid < 128) { float s = 0.f;
#pragma unroll 8
                for (int rr = 0; rr < 64; ++rr) s += bf2f(*(LAS bf16*)(kt + rr * ML_KS + tid * 2));
                nacc += s; }
            LAS unsigned char* klb = kt + ((lane & 15) >> 2) * ML_KS + (16 * ((lane >> 4) & 1) + 4 * (lane & 3)) * 2 + 8 * h * ML_KS;
            LAS unsigned char* vlb = vt + ((lane & 15) >> 2) * ML_VS + (16 * ((lane >> 4) & 1) + 4 * (lane & 3)) * 2 + 8 * h * ML_VS + 64 * w;
#pragma unroll
            for (int s = 0; s < 4; ++s) {
                const bf16x8 av8 = frag_tr(vlb, 16 * s * ML_VS, (16 * s + 4) * ML_VS);
#pragma unroll
                for (int dkt = 0; dkt < 4; ++dkt) acc[dkt] = mfma32(av8, frag_tr(klb, 16 * s * ML_KS + 64 * dkt, (16 * s + 4) * ML_KS + 64 * dkt), acc[dkt]);
            }
        }
        float* lt = WSP(float, WS_LT) + (size_t)u * 32768;
#pragma unroll
        for (int dkt = 0; dkt < 4; ++dkt)
#pragma unroll
            for (int r = 0; r < 16; ++r) __builtin_nontemporal_store(acc[dkt][r], &lt[(32 * w + crow(r, h)) * 128 + 32 * dkt + r32]);
        if (tid < 128) WSP(float, WS_NLOC)[u * 128 + tid] = nacc;
    }
    __syncthreads();
}
__device__ __forceinline__ void mlstm_scan_phase(Frame& F) {
    const int gt = F.vcu * 512 + F.tid, NT = F.G * 512;
    for (int item = gt; item < 16 * 8192; item += NT) {
        const int bh = item >> 13, e4 = (item & 8191) * 4; f32x4 C = {0.f, 0.f, 0.f, 0.f}; float mprev = 0.f;
        const float* mx = WSP(float, WS_SCM) + bh * T;
#pragma unroll 8
        for (int sc = 0; sc < 32; ++sc) {
            const size_t off = ((size_t)(bh * 32 + sc)) * 32768 + e4;
            v2u pk; pk.x = pk2(C[0], C[1]); pk.y = pk2(C[2], C[3]); *(v2u*)(WSP(bf16, WS_CST) + off) = pk;
            const float mend = mx[256 * sc + 255], dec = __expf(mprev - mend); mprev = mend;
            const f32x4 L = __builtin_nontemporal_load((const f32x4*)(WSP(float, WS_LT) + off));
            C = C * dec + L;
        }
    }
    for (int item = gt; item < 16 * 128; item += NT) {
        const int bh = item >> 7, dk = item & 127; float nn = 0.f, mprev = 0.f; const float* mx = WSP(float, WS_SCM) + bh * T;
        for (int sc = 0; sc < 32; ++sc) { const int u = bh * 32 + sc; WSP(float, WS_NST)[u * 128 + dk] = nn;
            const float mend = mx[256 * sc + 255], dec = __expf(mprev - mend); mprev = mend; nn = nn * dec + WSP(float, WS_NLOC)[u * 128 + dk]; }
    }
}
constexpr int M3_C = 0, M3_K = 0, M3_V = 128 * ML_KS, M3_Q = 2 * 128 * ML_KS, M3_A = M3_Q + 256 * ML_KS, M3_N = M3_A + 1024, M3_END = M3_N + 512;
static_assert(M3_END <= LDSCTL_OFF, "mlstm p3 LDS");
__device__ __forceinline__ void mlstm_p3_phase(Frame& F) {
    const int w = F.wave;
    LAS unsigned char* ct = F.lds + M3_C; LAS unsigned char* kt = F.lds + M3_K; LAS unsigned char* vt = F.lds + M3_V;
    LAS float* als = (LAS float*)(F.lds + M3_A); LAS float* nls = (LAS float*)(F.lds + M3_N);
    for (int u = F.vcu; u < 512; u += F.G) {
        int lane_ = F.lane, tid = F.tid; asm volatile("" : "+v"(lane_), "+v"(tid));
        const int r32 = lane_ & 31, h = lane_ >> 5;
        LAS unsigned char* vlb = vt + ((lane_ & 15) >> 2) * ML_KS + (16 * ((lane_ >> 4) & 1) + 4 * (lane_ & 3)) * 2 + 4 * h * ML_KS;
        LAS unsigned char* klb = kt + r32 * ML_KS + 16 * h; LAS unsigned char* clb = ct + r32 * ML_KS + 16 * h;
        LAS unsigned char* qlb = F.lds + M3_Q + (32 * w + r32) * ML_KS + 16 * h;
        const int bh = u >> 5, sc = u & 31, b = bh >> 2, hh = bh & 3;
        const size_t tok0 = (size_t)b * T + 256 * sc;
        const int tl = 32 * w + r32;
        const size_t tokq = tok0 + tl;
        const float Mt = WSP(float, WS_SCM)[bh * T + 256 * sc + tl];
        const float mprev = sc ? WSP(float, WS_SCM)[bh * T + 256 * sc - 1] : 0.f;
        const float winter = __expf(mprev - Mt);
        float dsum = 0.f, hdiv = 0.f;
        const int srow = tid >> 4, sch = tid & 15;
#pragma unroll 1
        for (int pass = 0; pass < 2; ++pass) {
            const char* csb = (const char*)(WSP(bf16, WS_CST) + (size_t)u * 32768 + pass * 16384);
            const char* kgb = (const char*)(WSP(bf16, WS_QKC) + ((size_t)(b * 8 + 4 + hh) * T + 256 * sc) * 128); const char* vgb = (const char*)(WSP(bf16, WS_V1) + ((size_t)(b * 4 + hh) * T + 256 * sc) * 256 + pass * 128);
            const unsigned kgo = (unsigned)(srow * 128 + sch * 8) * 2u, vgo = (unsigned)(srow * 256 + sch * 8) * 2u;
            v4u kx[4], vx[4];
            { v4u cx[4];
#pragma unroll
              for (int i = 0; i < 4; ++i) cx[i] = __builtin_nontemporal_load((const v4u*)(csb + kgo + (32 * i) * 256));
#pragma unroll
              for (int i = 0; i < 4; ++i) { kx[i] = *(const v4u*)(kgb + kgo + (32 * i) * 256); vx[i] = __builtin_nontemporal_load((const v4u*)(vgb + vgo + (32 * i) * 512)); }
              __syncthreads();
#pragma unroll
              for (int i = 0; i < 4; ++i) *(LAS v4u*)(ct + (srow + 32 * i) * ML_KS + sch * 16) = cx[i]; }
            if (pass == 0) {
#pragma unroll
                for (int i = 0; i < 8; ++i) *(LAS v4u*)(F.lds + M3_Q + (srow + 32 * i) * ML_KS + sch * 16) = *(const v4u*)((const char*)(WSP(bf16, WS_QKC) + ((size_t)(b * 8 + hh) * T + 256 * sc) * 128) + kgo + i * 32 * 256);
                if (tid < 256) als[tid] = WSP(float, WS_SCA)[bh * T + 256 * sc + tid];
                if (tid < 128) nls[tid] = WSP(float, WS_NST)[u * 128 + tid]; }
            __syncthreads();
            f32x16 acc[4];
#pragma unroll
            for (int dvt = 0; dvt < 4; ++dvt) { f32x16 a = {};
#pragma unroll
                for (int s = 0; s < 8; ++s) a = mfma32(*(const LAS bf16x8*)(clb + 32 * dvt * ML_KS + 32 * s), *(const LAS bf16x8*)(qlb + 32 * s), a);
                acc[dvt] = a * winter; }
#pragma unroll 1
            for (int half = 0; half < 2; ++half) {
                __syncthreads();
#pragma unroll
                for (int i = 0; i < 4; ++i) { const int o = (srow + 32 * i) * ML_KS + sch * 16; *(LAS v4u*)(kt + o) = kx[i]; *(LAS v4u*)(vt + o) = vx[i]; }
                if (half == 0) {
#pragma unroll
                    for (int i = 0; i < 4; ++i) { kx[i] = *(const v4u*)(kgb + kgo + (128 + 32 * i) * 256); vx[i] = __builtin_nontemporal_load((const v4u*)(vgb + vgo + (128 + 32 * i) * 512)); }
                }
                __syncthreads();
#pragma unroll 1
                for (int k4 = 0; k4 < 4; ++k4) { const int ktile = 4 * half + k4;
                    if (ktile > w) break;
                    f32x16 s = {};
                    { bf16x8 kfr[8];
#pragma unroll
                        for (int st = 0; st < 8; ++st) kfr[st] = *(const LAS bf16x8*)(klb + 32 * k4 * ML_KS + 32 * st);
                        bf16x8 qfr[2]; qfr[0] = *(const LAS bf16x8*)(qlb); qfr[1] = *(const LAS bf16x8*)(qlb + 32);
                        __builtin_amdgcn_sched_barrier(0);
#pragma unroll
                        for (int st = 0; st < 8; ++st) { s = mfma32(kfr[st], qfr[st & 1], s); if (st + 2 < 8) qfr[st & 1] = *(const LAS bf16x8*)(qlb + 32 * (st + 2)); }
                        __builtin_amdgcn_sched_barrier(0); }
                    f32x4 aw[4];
#pragma unroll
                    for (int q = 0; q < 4; ++q) aw[q] = *(const LAS f32x4*)(als + 32 * ktile + 8 * q + 4 * h);
                    LAS unsigned char* vl2 = vlb + 32 * k4 * ML_KS;
                    bf16x8 vfr[4];
#pragma unroll
                    for (int dvt = 0; dvt < 2; ++dvt) { vfr[2 * dvt] = frag_tr(vl2, 64 * dvt, 8 * ML_KS + 64 * dvt); vfr[2 * dvt + 1] = frag_tr(vl2, 16 * ML_KS + 64 * dvt, 24 * ML_KS + 64 * dvt); }
                    __builtin_amdgcn_sched_barrier(0);
                    float ds = 0.f;
#pragma unroll
                    for (int r = 0; r < 16; ++r) { const int key = 32 * ktile + crow(r, h); const float wg = __builtin_amdgcn_exp2f((aw[r >> 2][r & 3] - Mt) * LOG2E); s[r] = (key <= tl) ? s[r] * wg : 0.f; ds += s[r]; }
                    if (pass == 0) dsum += ds;
                    const bf16x8 p0 = pack8<0>(s), p1 = pack8<1>(s);
                    bf16x8 vfs[4];
#pragma unroll
                    for (int dvt = 0; dvt < 2; ++dvt) { vfs[2 * dvt] = frag_tr(vl2, 64 * (dvt + 2), 8 * ML_KS + 64 * (dvt + 2)); vfs[2 * dvt + 1] = frag_tr(vl2, 16 * ML_KS + 64 * (dvt + 2), 24 * ML_KS + 64 * (dvt + 2)); }
                    __builtin_amdgcn_sched_barrier(0);
#pragma unroll
                    for (int dvt = 0; dvt < 2; ++dvt) { acc[dvt] = mfma32(vfr[2 * dvt], p0, acc[dvt]); acc[dvt] = mfma32(vfr[2 * dvt + 1], p1, acc[dvt]); }
                    __builtin_amdgcn_sched_barrier(0);
#pragma unroll
                    for (int dvt = 0; dvt < 2; ++dvt) { acc[dvt + 2] = mfma32(vfs[2 * dvt], p0, acc[dvt + 2]); acc[dvt + 2] = mfma32(vfs[2 * dvt + 1], p1, acc[dvt + 2]); }
                    __builtin_amdgcn_sched_barrier(0);
                }
            }
            if (pass == 0) {
                float qn = 0.f;
#pragma unroll
                for (int s = 0; s < 8; ++s) { const v4u qq = *(const LAS v4u*)(qlb + 32 * s); const LAS float* np = nls + 16 * s + 8 * h;
                    qn += bflo(qq.x) * np[0] + bfhi(qq.x) * np[1] + bflo(qq.y) * np[2] + bfhi(qq.y) * np[3] + bflo(qq.z) * np[4] + bfhi(qq.z) * np[5] + bflo(qq.w) * np[6] + bfhi(qq.w) * np[7]; }
                dsum += __shfl_xor(dsum, 32); qn += __shfl_xor(qn, 32);
                const float den = winter * qn + dsum, emt = WSP(float, WS_SCE)[bh * T + 256 * sc + tl];
                hdiv = 1.0f / fmaxf(fabsf(den), emt);
            }
            __syncthreads();
            { LAS unsigned char* scr = F.lds + w * (32 * ML_KS);
#pragma unroll
              for (int dvt = 0; dvt < 4; ++dvt)
#pragma unroll
                for (int q = 0; q < 4; ++q) { v2u pk; pk.x = pk2(acc[dvt][4 * q] * hdiv, acc[dvt][4 * q + 1] * hdiv); pk.y = pk2(acc[dvt][4 * q + 2] * hdiv, acc[dvt][4 * q + 3] * hdiv);
                    *(LAS v2u*)(scr + r32 * ML_KS + (32 * dvt + 8 * q + 4 * h) * 2) = pk; }
              LDS_WAIT(); asm volatile("" ::: "memory");
              const char* ogb = (const char*)(WSP(bf16, WS_V1) + ((size_t)((4 + b) * 4 + hh) * T + 256 * sc + 32 * w) * 256 + pass * 128);
              char* opb = (char*)(WSP(bf16, WS_QKP) + (tok0 + 32 * w) * 1024 + hh * 256 + pass * 128);
              const unsigned lo_g = (unsigned)((lane_ >> 4) * 256 + (lane_ & 15) * 8) * 2u, lo_o = (unsigned)((lane_ >> 4) * 1024 + (lane_ & 15) * 8) * 2u, lo_s = (unsigned)((lane_ >> 4) * ML_KS + (lane_ & 15) * 16);
#pragma unroll
              for (int i = 0; i < 8; ++i) {
                  const v4u hv = *(const LAS v4u*)(scr + lo_s + i * 4 * ML_KS); const v4u gv = __builtin_nontemporal_load((const v4u*)(ogb + lo_g + i * 2048));
                  v4u o;
#define GATE2(HW, GW) pk2(bflo(HW) * __builtin_amdgcn_rcpf(1.0f + __expf(-bflo(GW))), bfhi(HW) * __builtin_amdgcn_rcpf(1.0f + __expf(-bfhi(GW))))
                  o.x = GATE2(hv.x, gv.x); o.y = GATE2(hv.y, gv.y); o.z = GATE2(hv.z, gv.z); o.w = GATE2(hv.w, gv.w);
#undef GATE2
                  *(v4u*)(opb + lo_o + i * 8192) = o; }
            }
        }
    }
    __syncthreads();
}
__device__ __forceinline__ void final_norm_phase(Frame& F) {
    const int gw = F.vcu * NWAVES + F.wave, NGW = F.G * NWAVES, lane = F.lane;
    const pg8::RowScale R{nullptr, WSP(float, WS_PSUM) + 3 * M};
    f32x4 gv[4];
#pragma unroll
    for (int j = 0; j < 4; ++j) gv[j] = ((const f32x4*)F.in[22])[lane + 64 * j];
    for (int m = gw; m < M; m += 2 * NGW) {
        const int m1 = m + NGW; const float rs0 = pg8::row_scale(R, m), rs1 = pg8::row_scale(R, m1);
        const v2u* h0 = (const v2u*)(WSP(bf16, WS_H16) + (size_t)m * D) + lane; const v2u* h1 = (const v2u*)(WSP(bf16, WS_H16) + (size_t)m1 * D) + lane;
        f32x4* x0 = (f32x4*)(F.out + (size_t)m * D) + lane; f32x4* x1 = (f32x4*)(F.out + (size_t)m1 * D) + lane;
        v2u w0[4], w1[4];
#pragma unroll
        for (int j = 0; j < 4; ++j) { w0[j] = __builtin_nontemporal_load(&h0[64 * j]); w1[j] = __builtin_nontemporal_load(&h1[64 * j]); }
#pragma unroll
        for (int j = 0; j < 4; ++j) { const f32x4 a0 = {bflo(w0[j].x), bfhi(w0[j].x), bflo(w0[j].y), bfhi(w0[j].y)}, a1 = {bflo(w1[j].x), bfhi(w1[j].x), bflo(w1[j].y), bfhi(w1[j].y)};
            __builtin_nontemporal_store(a0 * rs0 * gv[j], &x0[64 * j]); __builtin_nontemporal_store(a1 * rs1 * gv[j], &x1[64 * j]); } }
}
#ifndef SKIPMASK
#define SKIPMASK 0
#endif
#ifndef DUPMASK
#define DUPMASK 0

#endif
#define RUNP(n, call) do { if (!((SKIPMASK >> (n)) & 1)) { call; if ((DUPMASK >> (n)) & 1) { __syncthreads(); call; } } } while (0)
struct Args { const float* in[23]; float* out; unsigned char* ws; int ph_lo, ph_hi; };
__global__ void __launch_bounds__(NWAVES * 64, 2) mk_fwd(Args args) {
    extern __shared__ __attribute__((aligned(16))) unsigned char lds[];
    Frame F;
    F.lds = (LAS unsigned char*)lds;
    F.MISC = (volatile LAS unsigned*)(F.lds + MISC_OFF);
    F.tid = threadIdx.x; F.lane = F.tid & 63; F.wave = __builtin_amdgcn_readfirstlane(F.tid >> 6);
    F.G = gridDim.x; { const int bx = blockIdx.x; F.vcu = (F.G % 8 == 0) ? (bx % 8) * (F.G / 8) + bx / 8 : bx; }
    F.ws = args.ws; F.ctl = (gu32*)(args.ws + WS_CTL); F.out = args.out;
#pragma unroll
    for (int i = 0; i < 23; ++i) F.in[i] = args.in[i];
    for (int u = F.tid; u < (LDS_BYTES - LDSCTL_OFF) / 4; u += NWAVES * 64) ((LAS unsigned*)(F.lds + LDSCTL_OFF))[u] = 0u;
    __syncthreads();
    const int lo = args.ph_lo, hi = args.ph_hi;
    XcdBarrier bar; bar.bar = (unsigned*)(F.ctl + CW_BAR); bar.x = 0; bar.st = nullptr;
    if (hi - lo > 1) bar = xcd_barrier_post((unsigned*)(F.ctl + CW_BAR), F.MISC + 8);

#define IN(k) (lo <= (k) && (k) < hi)
    constexpr int RSL_UNITS = 14; LAS float* rsl = (LAS float*)(F.lds + RING_BYTES); static_assert(RING_BYTES + RSL_UNITS * 1024 <= LDSCTL_OFF, "row-scale table");
#define SEAM(k) do { if (IN(k) && IN((k) + 1)) xcd_barrier(bar); } while (0)
#define GEMM_PH(EPI, gg, ee) do { pg8::StaticOrder S_; S_.init(M, (gg).N, F.G, (int)blockIdx.x); pg8::gemm_phase<EPI, pg8::StaticOrder, PG8_ALIGN, PG8_SP2>(F.lds + RING_OFF, gg, S_, ee); } while (0)
#define RSL_FILL(NN, RSC) do { pg8::StaticOrder S_; S_.init(M, (NN), F.G, (int)blockIdx.x); pg8::Unit u_; \
        for (int i_ = 0; i_ < RSL_UNITS && S_.next(i_, u_); ++i_) if (F.tid < 256) rsl[i_ * 256 + F.tid] = pg8::row_scale(RSC, u_.pm * 256 + F.tid); \
        __syncthreads(); } while (0)
    if (IN(0)) { RUNP(0, p0_prologue(F)); } SEAM(0);
    if (IN(1)) { const pg8::Gemm g{WSP(bf16, WS_H16), WSP(bf16, WS_WAB), M, 2048, 1024};
        const pg8::RowScale rsc{WSP(float, WS_RS0), nullptr}; RSL_FILL(2048, rsc);
        const pg8::EpiScaleBf16 e{WSP(bf16, WS_QKV0), 2048, rsl, 0, 0, nullptr, 0};
        RUNP(21, GEMM_PH(pg8::EpiScaleBf16, g, e)); RUNP(19, gates0_phase(F)); } SEAM(1);
    if (IN(2)) { RUNP(2, compress_phase(F)); } SEAM(2);
    if (IN(3)) { RUNP(3, attention_phase(F)); } SEAM(3);
    if (IN(4)) { const pg8::Gemm g{WSP(bf16, WS_ATT), WSP(bf16, WS_WABO), M, 1024, 1024};
        const pg8::EpiResid e{F.in[0], WSP(bf16, WS_H16), WSP(float, WS_PSUM) + 0 * M, D};
        RUNP(22, GEMM_PH(pg8::EpiResid, g, e)); } SEAM(4);
    if (IN(5)) { const pg8::Gemm g{WSP(bf16, WS_H16), WSP(bf16, WS_WUP0), M, 5632, 1024};
        const pg8::RowScale rsc{nullptr, WSP(float, WS_PSUM) + 0 * M}; RSL_FILL(5632, rsc);
        const pg8::EpiSwiglu e{WSP(bf16, WS_HID), FF, rsl};
        RUNP(23, GEMM_PH(pg8::EpiSwiglu, g, e)); } SEAM(5);
    if (IN(6)) { const pg8::Gemm g{WSP(bf16, WS_HID), WSP(bf16, WS_WDN0), M, 1024, FF};
        const pg8::EpiResid e{nullptr, WSP(bf16, WS_H16), WSP(float, WS_PSUM) + 1 * M, D};
        RUNP(17, GEMM_PH(pg8::EpiResid, g, e)); } SEAM(6);
    if (IN(7)) { const pg8::Gemm g{WSP(bf16, WS_H16), WSP(bf16, WS_WCIN), M, 3072, 1024};
        const pg8::RowScale rsc{nullptr, WSP(float, WS_PSUM) + 1 * M}; RSL_FILL(3072, rsc);
        const pg8::EpiScaleBf16 e{WSP(bf16, WS_QKP), 1024, rsl, 1024, (size_t)(64 * MiB / 2), WSP(bf16, WS_V1), 4};
        RUNP(24, GEMM_PH(pg8::EpiScaleBf16, g, e)); RUNP(20, gates1_phase(F)); } SEAM(7);
    if (IN(8)) { RUNP(8, conv_scan_phase(F)); } SEAM(8);
    if (IN(9)) { RUNP(9, mlstm_p1_phase(F)); } SEAM(9);
    if (IN(10)) { RUNP(10, mlstm_scan_phase(F)); } SEAM(10);
    if (IN(11)) { RUNP(11, mlstm_p3_phase(F)); } SEAM(11);
    if (IN(12)) { const pg8::Gemm g{WSP(bf16, WS_QKP), WSP(bf16, WS_WCO), M, 1024, 1024};
        const pg8::EpiResid e{nullptr, WSP(bf16, WS_H16), WSP(float, WS_PSUM) + 2 * M, D};
        RUNP(17, GEMM_PH(pg8::EpiResid, g, e)); } SEAM(12);
    if (IN(13)) { const pg8::Gemm g{WSP(bf16, WS_H16), WSP(bf16, WS_WUP1), M, 5632, 1024};
        const pg8::RowScale rsc{nullptr, WSP(float, WS_PSUM) + 2 * M}; RSL_FILL(5632, rsc);
        const pg8::EpiSwiglu e{WSP(bf16, WS_HID), FF, rsl};
        RUNP(18, GEMM_PH(pg8::EpiSwiglu, g, e)); } SEAM(13);
    if (IN(14)) { const pg8::Gemm g{WSP(bf16, WS_HID), WSP(bf16, WS_WDN1), M, 1024, FF};
        const pg8::EpiResid e{nullptr, WSP(bf16, WS_H16), WSP(float, WS_PSUM) + 3 * M, D};
        RUNP(17, GEMM_PH(pg8::EpiResid, g, e)); } SEAM(14);
    if (IN(15)) { RUNP(15, final_norm_phase(F)); }
}

extern "C" void kernel_launch(void* const* d_in, const int* in_sizes, int n_in, void* d_out, int out_size, void* d_ws, size_t ws_size, hipStream_t stream) {
    static int grid = 0;
    if (grid == 0) {
        if (n_in != 23 || in_sizes[0] != M * D || out_size != M * D || ws_size < WS_END) { fprintf(stderr, "kernel_launch: shape/workspace mismatch (n_in %d, in0 %d, out %d, ws %zu, need %zu); nothing launched\n", n_in, n_in > 0 ? in_sizes[0] : -1, out_size, ws_size, (size_t)WS_END); grid = -1; return; }
        int dev = 0, cus = 0, per_cu = 0;
        if (hipGetDevice(&dev) != hipSuccess || hipDeviceGetAttribute(&cus, hipDeviceAttributeMultiprocessorCount, dev) != hipSuccess) { grid = -1; return; }
        if (hipFuncSetAttribute((const void*)mk_fwd, hipFuncAttributeMaxDynamicSharedMemorySize, LDS_BYTES) != hipSuccess) { fprintf(stderr, "kernel_launch: hipFuncSetAttribute failed\n"); grid = -1; return; }
        if (hipOccupancyMaxActiveBlocksPerMultiprocessor(&per_cu, (const void*)mk_fwd, NWAVES * 64, LDS_BYTES) != hipSuccess || per_cu < 1) { fprintf(stderr, "kernel_launch: occupancy query says %d blocks per CU\n", per_cu); per_cu = 1; }
        (void)hipGetLastError();
        grid = cus;
    }
    if (grid < 0) return;
    if (hipMemsetAsync((char*)d_ws + WS_CTL, 0, CTL_ZERO_BYTES, stream) != hipSuccess) { fprintf(stderr, "kernel_launch: memset failed\n"); return; }
    Args a{};
    for (int i = 0; i < 23; ++i) a.in[i] = (const float*)d_in[i];
    a.out = (float*)d_out; a.ws = (unsigned char*)d_ws;
#if MK_PER_PHASE
    for (int p = 0; p < NPHASE; ++p) { a.ph_lo = p; a.ph_hi = p + 1; hipLaunchKernelGGL(mk_fwd, dim3(grid), dim3(NWAVES * 64), LDS_BYTES, stream, a); }
#else
    a.ph_lo = 0; a.ph_hi = NPHASE;
    hipLaunchKernelGGL(mk_fwd, dim3(grid), dim3(NWAVES * 64), LDS_BYTES, stream, a);
#endif
    const hipError_t le = hipPeekAtLastError();
    if (le != hipSuccess) fprintf(stderr, "kernel_launch: launch failed: %s\n", hipGetErrorName(le));
}
```
